# Optimizing an MI355X kernel written in HIP

```python
import jax, jax.numpy as jnp
from jax import lax
import numpy as np

D_MODEL = 1024
BATCH = 32
SEQ = 2048
DEPTH = 1

GRID_W = 64
CTX_LEN = 256

FOURIER_GROUPS = 4
FOURIER_GROUP_DIM = 128
FOURIER_WIDTH = FOURIER_GROUPS * FOURIER_GROUP_DIM
LRU_WIDTH = D_MODEL
LRU_HEADS = 8
LRU_HEAD_DIM = LRU_WIDTH // LRU_HEADS
CONV_WIDTH = 4
CONV_PAD_LEFT = 1
LRU_C = 8.0
IN_WIDTH = FOURIER_WIDTH + 2 * LRU_WIDTH + 2 * D_MODEL
PEER_HEADS = 8
PEER_KEY_DIM = 256
PEER_HALF_DIM = PEER_KEY_DIM // 2
N_KEYS = 128
N_EXPERTS = N_KEYS * N_KEYS
PEER_TOPK = 16
TOKEN_BLOCK = 128
NORM_EPS = 1e-6
POS_BASE = 10000.0

kernel_name = "hybrid_fourier_rglru_peer_dit_block"


def rmsnorm(x, g):
    xf = x.astype(jnp.float32)
    y = xf * lax.rsqrt(jnp.mean(xf * xf, axis=-1, keepdims=True) + NORM_EPS)
    return y.astype(x.dtype) * g


def modulate(h, shift, scale):
    return h * (1.0 + scale) + shift


def adaln(cond, w_mod, b_mod):
    return jnp.split(jax.nn.silu(cond) @ w_mod + b_mod, 6, axis=-1)


def sincos_2d(num_tokens, dim):
    rows = num_tokens // GRID_W
    row = jnp.repeat(jnp.arange(rows, dtype=jnp.float32), GRID_W)
    col = jnp.tile(jnp.arange(GRID_W, dtype=jnp.float32), rows)
    nf = dim // 4
    omega = 1.0 / (POS_BASE ** (jnp.arange(nf, dtype=jnp.float32) / nf))
    er = row[:, None] * omega[None]
    ec = col[:, None] * omega[None]
    return jnp.concatenate([jnp.sin(er), jnp.cos(er), jnp.sin(ec), jnp.cos(ec)], axis=-1)


def fourier_mix(z):
    B, T, _ = z.shape
    zg = z.astype(jnp.float32).reshape(B, T, FOURIER_GROUPS, FOURIER_GROUP_DIM)
    y = jnp.fft.fft2(zg, axes=(1, 3), norm="ortho").real
    return y.reshape(B, T, FOURIER_WIDTH).astype(z.dtype)


def centred_dwconv(z, w, b):
    T = z.shape[1]
    zp = jnp.pad(z, ((0, 0), (CONV_PAD_LEFT, CONV_WIDTH - 1 - CONV_PAD_LEFT), (0, 0)))
    y = b
    for k in range(CONV_WIDTH):
        y = y + zp[:, k:k + T] * w[k]
    return y


def block_diag(z, w):
    B, T, _ = z.shape
    zh = z.reshape(B, T, LRU_HEADS, LRU_HEAD_DIM)
    return jnp.einsum('bthi,hij->bthj', zh, w).reshape(B, T, LRU_WIDTH)


def linear_scan(a, b, h0, reverse):
    def step(h, ab):
        a_t, b_t = ab
        h = a_t * h + b_t
        return h, h
    h_final, hs = lax.scan(step, h0, (jnp.swapaxes(a, 0, 1), jnp.swapaxes(b, 0, 1)), reverse=reverse)
    return jnp.swapaxes(hs, 0, 1), h_final


def rglru_dir(xc, wa, ba, wx, bx, lam, h0, reverse):
    r = jax.nn.sigmoid((block_diag(xc, wa) + ba).astype(jnp.float32))
    i = jax.nn.sigmoid((block_diag(xc, wx) + bx).astype(jnp.float32))
    log_a = -LRU_C * r * jax.nn.softplus(-lam.astype(jnp.float32))
    a = jnp.exp(log_a)
    b = jnp.sqrt(-jnp.expm1(2.0 * log_a)) * (i * xc.astype(jnp.float32))
    return linear_scan(a, b, h0, reverse)


def rglru_bidir(xc, lp, h0_f, h0_b):
    hf, hTf = rglru_dir(xc, lp['lru_wa'][0], lp['lru_ba'][0], lp['lru_wx'][0], lp['lru_bx'][0],
                        lp['lru_lambda'][0], h0_f, False)
    hb, hTb = rglru_dir(xc, lp['lru_wa'][1], lp['lru_ba'][1], lp['lru_wx'][1], lp['lru_bx'][1],
                        lp['lru_lambda'][1], h0_b, True)
    return hf, hb, hTf, hTb


def mixer(h, lp, h0_f, h0_b):
    F, R, D = FOURIER_WIDTH, LRU_WIDTH, D_MODEL
    z = h @ lp['w_in']
    zf, zx, zy, zga, zgb = jnp.split(z, [F, F + R, F + 2 * R, F + 2 * R + D], axis=-1)
    y_a = fourier_mix(zf) @ lp['w_fourier']
    xc = centred_dwconv(zx, lp['conv_w'], lp['conv_b'])
    hf, hb, hTf, hTb = rglru_bidir(xc, lp, h0_f, h0_b)
    y_b = ((hf + hb).astype(h.dtype) * jax.nn.gelu(zy)) @ lp['w_lru_out']
    merged = jax.nn.sigmoid(zga) * y_a + jax.nn.sigmoid(zgb) * y_b
    return merged @ lp['w_out'] + lp['b_out'], hTf, hTb


def context_scan_states(h_c, lp, h0):
    F, R = FOURIER_WIDTH, LRU_WIDTH
    zx = h_c @ lp['w_in'][:, F:F + R]
    xc = centred_dwconv(zx, lp['conv_w'], lp['conv_b'])
    _, _, hTf, hTb = rglru_bidir(xc, lp, h0, h0)
    return hTf, hTb


def peer_block(xb, wq, keys, u_tab, v_tab):
    T = xb.shape[0]
    q = (xb @ wq).reshape(T, PEER_HEADS, 2, PEER_HALF_DIM).astype(jnp.float32)
    s = jnp.einsum('thpd,hpkd->thpk', q, keys.astype(jnp.float32))
    sv, si = lax.top_k(s, PEER_TOPK)
    cand = (sv[:, :, 0, :, None] + sv[:, :, 1, None, :]).reshape(T, PEER_HEADS, PEER_TOPK * PEER_TOPK)
    cidx = (si[:, :, 0, :, None] * N_KEYS + si[:, :, 1, None, :]).reshape(T, PEER_HEADS, PEER_TOPK * PEER_TOPK)
    top_s, pos = lax.top_k(cand, PEER_TOPK)
    eidx = jnp.take_along_axis(cidx, pos, axis=-1)
    g = jax.nn.softmax(top_s, axis=-1)
    u = jnp.take(u_tab, eidx, axis=0)
    act = jax.nn.gelu(jnp.einsum('thkd,td->thk', u, xb).astype(jnp.float32))
    v = jnp.take(v_tab, eidx, axis=0)
    return jnp.einsum('thk,thkd->td', (g * act).astype(xb.dtype), v)


def peer(h, wq, keys, u_tab, v_tab):
    B, T, D = h.shape
    blocks = h.reshape(-1, TOKEN_BLOCK, D)
    out = lax.map(lambda xb: peer_block(xb, wq, keys, u_tab, v_tab), blocks)
    return out.reshape(B, T, D)


def setup_inputs(seed: int = 0) -> dict:
    key = jax.random.key(seed)
    ks = jax.random.split(key, 26)
    D, F, R, L = D_MODEL, FOURIER_WIDTH, LRU_WIDTH, DEPTH
    nrm = lambda k, shape, s: jax.random.normal(k, shape, jnp.float32) * s
    a0 = jax.random.uniform(ks[16], (L, 2, R), jnp.float32, 0.9, 0.999)
    return {
        'x': nrm(ks[0], (BATCH, SEQ, D), 1.0),
        'c': nrm(ks[1], (BATCH, D), 1.0),
        'ctx': nrm(ks[2], (BATCH, CTX_LEN, D), 1.0),
        'c_ctx': nrm(ks[3], (D,), 1.0),
        'w_mod': nrm(ks[4], (L, D, 6 * D), D ** -0.5),
        'b_mod': nrm(ks[5], (L, 6 * D), 0.01),
        'norm1_g': 1.0 + nrm(ks[6], (L, D), 0.05),
        'norm2_g': 1.0 + nrm(ks[7], (L, D), 0.05),
        'w_in': nrm(ks[8], (L, D, IN_WIDTH), D ** -0.5),
        'w_fourier': nrm(ks[9], (L, F, D), F ** -0.5),
        'conv_w': nrm(ks[10], (L, CONV_WIDTH, R), CONV_WIDTH ** -0.5),
        'conv_b': nrm(ks[11], (L, R), 0.01),
        'lru_wa': nrm(ks[12], (L, 2, LRU_HEADS, LRU_HEAD_DIM, LRU_HEAD_DIM), LRU_HEAD_DIM ** -0.5),
        'lru_ba': nrm(ks[13], (L, 2, R), 0.01),
        'lru_wx': nrm(ks[14], (L, 2, LRU_HEADS, LRU_HEAD_DIM, LRU_HEAD_DIM), LRU_HEAD_DIM ** -0.5),
        'lru_bx': nrm(ks[15], (L, 2, R), 0.01),
        'lru_lambda': jnp.log(a0) - jnp.log1p(-a0),
        'w_lru_out': nrm(ks[17], (L, R, D), R ** -0.5),
        'w_out': nrm(ks[18], (L, D, D), D ** -0.5),
        'b_out': nrm(ks[19], (L, D), 0.01),
        'peer_wq': nrm(ks[20], (L, D, PEER_HEADS * PEER_KEY_DIM), D ** -0.5),
        'peer_keys': nrm(ks[21], (L, PEER_HEADS, 2, N_KEYS, PEER_HALF_DIM), PEER_HALF_DIM ** -0.5),
        'peer_u': nrm(ks[22], (L, N_EXPERTS, D), D ** -0.5),
        'peer_v': nrm(ks[23], (L, N_EXPERTS, D), 1.0),
        'final_g': 1.0 + nrm(ks[24], (D,), 0.05),
    }


def reference(x, c, ctx, c_ctx, w_mod, b_mod, norm1_g, norm2_g, w_in, w_fourier, conv_w, conv_b,
              lru_wa, lru_ba, lru_wx, lru_bx, lru_lambda, w_lru_out, w_out, b_out,
              peer_wq, peer_keys, peer_u, peer_v, final_g):
    B, S, D = x.shape
    x = x + sincos_2d(S, D).astype(x.dtype)[None]
    zeros = jnp.zeros((B, LRU_WIDTH), jnp.float32)
    for layer in range(DEPTH):
        is_last = layer == DEPTH - 1
        lp = {
            'w_in': w_in[layer], 'w_fourier': w_fourier[layer],
            'conv_w': conv_w[layer], 'conv_b': conv_b[layer],
            'lru_wa': lru_wa[layer], 'lru_ba': lru_ba[layer],
            'lru_wx': lru_wx[layer], 'lru_bx': lru_bx[layer], 'lru_lambda': lru_lambda[layer],
            'w_lru_out': w_lru_out[layer], 'w_out': w_out[layer], 'b_out': b_out[layer],
        }
        sh1, sc1, g1, sh2, sc2, g2 = adaln(c, w_mod[layer], b_mod[layer])
        csh1, csc1, cg1, csh2, csc2, cg2 = adaln(c_ctx, w_mod[layer], b_mod[layer])

        h_c = modulate(rmsnorm(ctx, norm1_g[layer]), csh1, csc1)
        if is_last:
            hTf, hTb = context_scan_states(h_c, lp, zeros)
        else:
            ctx_mix, hTf, hTb = mixer(h_c, lp, zeros, zeros)
            ctx = ctx + cg1 * ctx_mix
            h2c = modulate(rmsnorm(ctx, norm2_g[layer]), csh2, csc2)
            ctx = ctx + cg2 * peer(h2c, peer_wq[layer], peer_keys[layer], peer_u[layer], peer_v[layer])

        h = modulate(rmsnorm(x, norm1_g[layer]), sh1[:, None], sc1[:, None])
        mix, _, _ = mixer(h, lp, hTf, hTb)
        x = x + g1[:, None] * mix
        h2 = modulate(rmsnorm(x, norm2_g[layer]), sh2[:, None], sc2[:, None])
        x = x + g2[:, None] * peer(h2, peer_wq[layer], peer_keys[layer], peer_u[layer], peer_v[layer])
    return rmsnorm(x, final_g)
```

```cpp
#include <hip/hip_runtime.h>
#include <hip/hip_cooperative_groups.h>
#include <cstdio>
#include <cstdint>

#define LAS __attribute__((address_space(3)))
typedef unsigned short bf16_t;
typedef short bf16x8 __attribute__((ext_vector_type(8)));
typedef float f32x2 __attribute__((ext_vector_type(2)));
typedef float f32x4 __attribute__((ext_vector_type(4)));
typedef float f32x16 __attribute__((ext_vector_type(16)));
typedef unsigned u32x2 __attribute__((ext_vector_type(2)));
typedef unsigned u32x4 __attribute__((ext_vector_type(4)));
typedef __bf16 bf2_t __attribute__((ext_vector_type(2)));

constexpr int DM = 1024, SEQ = 2048, CTXL = 256, NBATCH = 32;
constexpr int NTHR = 512;
constexpr int LDS_BYTES = 160 * 1024;

__device__ __forceinline__ float bf2f(bf16_t b) { return __uint_as_float(((unsigned)b) << 16); }
__device__ __forceinline__ float bflo(unsigned w) { return __uint_as_float(w << 16); }
__device__ __forceinline__ float bfhi(unsigned w) { return __uint_as_float(w & 0xffff0000u); }
typedef __bf16 bf16x2_t __attribute__((ext_vector_type(2)));
__device__ __forceinline__ unsigned pk2(float lo, float hi) { return __builtin_bit_cast(unsigned, __builtin_convertvector((f32x2){lo, hi}, bf16x2_t)); }
__device__ __forceinline__ bf16_t f2bf(float f) { return (bf16_t)(pk2(f, 0.f) & 0xffffu); }
__device__ __forceinline__ float sigmoid_f(float x) { return __builtin_amdgcn_rcpf(1.0f + __builtin_amdgcn_exp2f(-1.4426950409f * x)); }
__device__ __forceinline__ float gelu_f(float x) { const float in = x + 0.044715f * x * x * x; return x * __builtin_amdgcn_rcpf(1.0f + __builtin_amdgcn_exp2f(-2.3022082f * in)); }
__device__ __forceinline__ int lane_opaque() { int t = threadIdx.x & 63; asm volatile("" : "+v"(t)); return t; }
__device__ __forceinline__ float shx_f(float v, int o) { return __int_as_float(__builtin_amdgcn_ds_bpermute((lane_opaque() ^ o) << 2, __float_as_int(v))); }
__device__ __forceinline__ int shx_i(int v, int o) { return __builtin_amdgcn_ds_bpermute((lane_opaque() ^ o) << 2, v); }
__device__ __forceinline__ f32x2 sigmoid2(f32x2 x) { const f32x2 t = x * (f32x2){-1.4426950409f, -1.4426950409f}; f32x2 e; e[0] = __builtin_amdgcn_exp2f(t[0]); e[1] = __builtin_amdgcn_exp2f(t[1]);
    const f32x2 d = e + (f32x2){1.0f, 1.0f}; f32x2 r; r[0] = __builtin_amdgcn_rcpf(d[0]); r[1] = __builtin_amdgcn_rcpf(d[1]); return r; }
__device__ __forceinline__ f32x2 gelu2(f32x2 x) {
    const f32x2 x2 = x * x; const f32x2 u = x2 * (f32x2){-0.10294324f, -0.10294324f} + (f32x2){-2.3022082f, -2.3022082f}; const f32x2 t = x * u;
    f32x2 e; e[0] = __builtin_amdgcn_exp2f(t[0]); e[1] = __builtin_amdgcn_exp2f(t[1]);
    const f32x2 d = e + (f32x2){1.0f, 1.0f}; f32x2 r; r[0] = __builtin_amdgcn_rcpf(d[0]); r[1] = __builtin_amdgcn_rcpf(d[1]); return x * r; }
__device__ __forceinline__ float wave_sum(float v) {
#pragma unroll
    for (int o = 1; o < 64; o <<= 1) v += shx_f(v, o);
    return v;
}

__device__ __forceinline__ int tid_opaque() { int t = threadIdx.x; asm volatile("" : "+v"(t)); return t; }
struct Params {
    const float *x, *c, *ctx, *c_ctx, *w_mod, *b_mod, *norm1_g, *norm2_g, *w_in, *w_fourier, *conv_w, *conv_b, *lru_wa, *lru_ba, *lru_wx, *lru_bx, *lru_lambda,
        *w_lru_out, *w_out, *b_out, *peer_wq, *peer_keys, *peer_u, *peer_v, *final_g;
    float* out;
    float *mod, *pos;
    bf16_t *Wt_in, *Wfp, *Wt_lru, *Wt_out, *Wt_q, *keys_bf, *gates_bf, *dft, *u_bf, *v_bf;
    bf16_t *h, *hc, *zxc, *zfT, *zx, *gzy, *sga, *sgb, *hf, *ybin, *UV, *Pb, *merged, *h2, *q;
    float* x1; bf16_t* x1b; int* eidx; float* gw; float* su;
    unsigned char *u8, *v8, *h8, *u4, *v4; float* scu; float* scv; bf16_t* peer16; float* pd; float* ssb; unsigned* tmax; unsigned* bar;
    unsigned* diag;
    unsigned char* w8; float* wsc;
    size_t zseg;
    int nb, pad;
};

typedef const Params __attribute__((address_space(4))) CParams;
#ifdef DIAG
#define PREF const Params&
#else
#define PREF CParams&
#endif
__device__ __forceinline__ void dev_transpose(const float* src, int ld, int col0, int K, int N, bf16_t* dst, int nbat, size_t sbs, size_t dbs, LAS unsigned char* lds, int bfirst, int bcount) {
    const int rel = (int)blockIdx.x - bfirst;
    if (rel < 0 || rel >= bcount) return;
    const int tid = tid_opaque(), tk = K / 64, tn = N / 64, per = tk * tn, total = per * nbat;
    const int r = tid >> 4, c4 = tid & 15, nn = tid >> 3, kc = tid & 7;
#define TR_LOAD(V0, V1, it) do { const int it_ = (it) < total ? (it) : total - 1; const int bz_ = it_ / per, rem_ = it_ % per, k0_ = (rem_ / tn) * 64, n0_ = (rem_ % tn) * 64; \
        const float* s_ = src + (size_t)bz_ * sbs + (size_t)(k0_ + r) * ld + col0 + n0_ + 4 * c4; V0 = *(const f32x4*)s_; V1 = *(const f32x4*)(s_ + (size_t)32 * ld); } while (0)
    f32x4 v0, v1, w0, w1;
    TR_LOAD(v0, v1, rel);
    int par = 0;
    for (int item = rel; item < total; item += bcount) {
        TR_LOAD(w0, w1, item + bcount);
        const int bz = item / per, rem = item % per, k0 = (rem / tn) * 64, n0 = (rem % tn) * 64;
        LAS float* tile = (LAS float*)lds + par * (64 * 65);
        { LAS float* t = tile + r * 65 + 4 * c4; t[0] = v0[0]; t[1] = v0[1]; t[2] = v0[2]; t[3] = v0[3]; t += 32 * 65; t[0] = v1[0]; t[1] = v1[1]; t[2] = v1[2]; t[3] = v1[3]; }
        __syncthreads();
        const LAS float* t = tile + (8 * kc) * 65 + nn;
        u32x4 o; o[0] = pk2(t[0], t[65]); o[1] = pk2(t[2 * 65], t[3 * 65]); o[2] = pk2(t[4 * 65], t[5 * 65]); o[3] = pk2(t[6 * 65], t[7 * 65]);
        *(u32x4*)(dst + (size_t)bz * dbs + (size_t)(n0 + nn) * K + k0 + 8 * kc) = o;
        v0 = w0; v1 = w1; par ^= 1;
    }
    __syncthreads();
#undef TR_LOAD
}
__device__ __forceinline__ void dev_convert(const float* src, bf16_t* dst, size_t n) {
    const int tid = tid_opaque();
    for (size_t i = ((size_t)blockIdx.x * NTHR + tid) * 8; i < n; i += (size_t)gridDim.x * NTHR * 8) {
        const f32x4 a = *(const f32x4*)(src + i), b = *(const f32x4*)(src + i + 4);
        u32x4 o; o[0] = pk2(a[0], a[1]); o[1] = pk2(a[2], a[3]); o[2] = pk2(b[0], b[1]); o[3] = pk2(b[2], b[3]);
        *(u32x4*)(dst + i) = o;
    }
}
__device__ __forceinline__ void dev_wfp(PREF p, LAS unsigned char* lds) {
    LAS float* cs = (LAS float*)lds; LAS float* sn = cs + 128;
    const int tid = tid_opaque();
    if (tid < 128) { cs[tid] = cospif((float)tid * (1.0f / 64.0f)); sn[tid] = sinpif((float)tid * (1.0f / 64.0f)); }
    __syncthreads();
    for (int idx = blockIdx.x * NTHR + tid; idx < 1024 * 1024; idx += gridDim.x * NTHR) {
        const int d = idx >> 10, kap = idx & 1023, g = (kap & 511) >> 7, cc = kap & 127, iss = kap >> 9;
        const LAS float* tab = iss ? sn : cs; const float* wf = p.w_fourier + (size_t)(g * 128) * 1024 + d;
        float acc = 0.f;
        for (int kc = 0; kc < 128; ++kc) acc += tab[(kc * cc) & 127] * wf[(size_t)kc * 1024];
        p.Wfp[idx] = f2bf(acc * (iss ? -1.0f / 512.0f : 1.0f / 512.0f));
    }
    __syncthreads();
}
__device__ __forceinline__ void dev_dft(PREF p) {
    const int tid = tid_opaque();
    for (int i8 = blockIdx.x * NTHR + tid; i8 < 2048 * 2048 / 8; i8 += gridDim.x * NTHR) {
        const int m = i8 >> 8, t0 = (i8 & 255) * 8, mm = m & 1023, iss = m >> 10;
        float v[8];
#pragma unroll
        for (int j = 0; j < 8; ++j) { const int kk = (iss && mm == 0) ? 1024 : mm; const float a = (float)((kk * (t0 + j)) & 2047) * (1.0f / 2048.0f);
            v[j] = (iss && mm != 0) ? __builtin_amdgcn_sinf(a) : __builtin_amdgcn_cosf(a); }
        u32x4 o; o[0] = pk2(v[0], v[1]); o[1] = pk2(v[2], v[3]); o[2] = pk2(v[4], v[5]); o[3] = pk2(v[6], v[7]);
        *(u32x4*)(p.dft + (size_t)i8 * 8) = o;
    }
}
__device__ __forceinline__ void dev_pos(PREF p) {
    const int tid = tid_opaque();
    for (int idx = blockIdx.x * NTHR + tid; idx < SEQ * 512; idx += gridDim.x * NTHR) {
        const int t = idx >> 9, half = (idx >> 8) & 1, j = idx & 255;
        const float omega = 1.0f / powf(10000.0f, (float)j * (1.0f / 256.0f));
        const float arg = (float)(half == 0 ? (t >> 6) : (t & 63)) * omega;
        float* d = p.pos + (size_t)t * DM + half * 512 + j;
        d[0] = sinf(arg); d[256] = cosf(arg);
    }
}
__device__ __forceinline__ void dev_adaln(PREF p, LAS unsigned char* lds) {
    constexpr int SROW = 1032;
    LAS bf16_t* Sh = (LAS bf16_t*)lds; LAS bf16_t* Sl = Sh + 33 * SROW;
    const int tid = tid_opaque(), w = tid >> 6, l = tid & 63, c16 = l & 15, g = l >> 4;
    if ((int)blockIdx.x < 192) {
        for (int i = tid; i < 33 * 1024; i += NTHR) { const float v = (i < 32 * 1024) ? p.c[i] : p.c_ctx[i - 32 * 1024]; const float sv = v * sigmoid_f(v);
            const unsigned hi = pk2(sv, 0.f) & 0xffffu; const unsigned lo = pk2(sv - bflo(hi), 0.f) & 0xffffu; const int r = i >> 10, k = i & 1023;
            Sh[r * SROW + k] = (bf16_t)hi; Sl[r * SROW + k] = (bf16_t)lo; }
        __syncthreads();
        const int nt = w & 1, kq = w >> 1, n0 = blockIdx.x * 32 + nt * 16;
        f32x4 acc[3];
#pragma unroll
        for (int mt = 0; mt < 3; ++mt) acc[mt] = (f32x4){0.f, 0.f, 0.f, 0.f};
#pragma unroll
        for (int ks = 0; ks < 8; ++ks) { const int k0 = kq * 256 + ks * 32 + 8 * g;
            float wv[8];
#pragma unroll
            for (int j = 0; j < 8; ++j) wv[j] = p.w_mod[(size_t)(k0 + j) * 6144 + n0 + c16];
            u32x4 bh, bl;
#pragma unroll
            for (int j = 0; j < 4; ++j) { bh[j] = pk2(wv[2 * j], wv[2 * j + 1]); bl[j] = pk2(wv[2 * j] - bflo(bh[j]), wv[2 * j + 1] - bfhi(bh[j])); }
            const bf16x8 Bh = __builtin_bit_cast(bf16x8, bh), Bl = __builtin_bit_cast(bf16x8, bl);
#pragma unroll
            for (int mt = 0; mt < 3; ++mt) { const int row = min(mt * 16 + c16, 32);
                const bf16x8 Ah = *(const LAS bf16x8*)(Sh + row * SROW + k0), Al = *(const LAS bf16x8*)(Sl + row * SROW + k0);
                acc[mt] = __builtin_amdgcn_mfma_f32_16x16x32_bf16(Ah, Bh, acc[mt], 0, 0, 0);
                acc[mt] = __builtin_amdgcn_mfma_f32_16x16x32_bf16(Ah, Bl, acc[mt], 0, 0, 0);
                acc[mt] = __builtin_amdgcn_mfma_f32_16x16x32_bf16(Al, Bh, acc[mt], 0, 0, 0); }
        }
        __syncthreads();
        LAS float* red = (LAS float*)lds;
#pragma unroll
        for (int mt = 0; mt < 3; ++mt)
#pragma unroll
            for (int reg = 0; reg < 4; ++reg) red[(kq * 48 + mt * 16 + 4 * g + reg) * 32 + nt * 16 + c16] = acc[mt][reg];
        __syncthreads();
        for (int o = tid; o < 33 * 32; o += NTHR) { const int r = o >> 5, n = o & 31;
            const float sum = (red[(0 * 48 + r) * 32 + n] + red[(1 * 48 + r) * 32 + n]) + (red[(2 * 48 + r) * 32 + n] + red[(3 * 48 + r) * 32 + n]);
            p.mod[(size_t)r * 6144 + blockIdx.x * 32 + n] = sum + p.b_mod[blockIdx.x * 32 + n]; }
        __syncthreads();
    }
}

__device__ __forceinline__ void dev_norm(PREF p, int which) {
    const int tid = tid_opaque(); const int w = tid >> 6, lane = tid & 63;
    const int T = p.nb * SEQ, TC = (which == 0) ? p.nb * CTXL : 0, NR = T + TC;
    const int first = blockIdx.x * 8 + w, stride = gridDim.x * 8;
#define NORM_LOAD(XV, PV, r) do { const int r_ = (r) < NR ? (r) : NR - 1; const bool c_ = r_ >= T; const int lr_ = c_ ? r_ - T : r_; \
        const float* s_ = c_ ? p.ctx + (size_t)lr_ * DM : p.x + (size_t)lr_ * DM; \
        _Pragma("unroll") for (int i_ = 0; i_ < 4; ++i_) { const int d_ = 4 * lane + 256 * i_; \
            if (which == 1) { const u32x2 q_ = *(const u32x2*)(p.x1b + (size_t)lr_ * DM + d_); XV[i_] = (f32x4){bflo(q_[0]), bfhi(q_[0]), bflo(q_[1]), bfhi(q_[1])}; } else XV[i_] = __builtin_nontemporal_load((const f32x4*)(s_ + d_)); \
            PV[i_] = (which == 0 && !c_) ? (pos_fixed ? pfix[i_] : *(const f32x4*)(p.pos + (size_t)(lr_ & 2047) * DM + d_)) : (f32x4){0.f, 0.f, 0.f, 0.f}; } } while (0)
    const bool pos_fixed = (which == 0) && (stride % SEQ == 0) && (first < T);
    f32x4 pfix[4];
#pragma unroll
    for (int i = 0; i < 4; ++i) pfix[i] = pos_fixed ? *(const f32x4*)(p.pos + (size_t)(first & 2047) * DM + 4 * lane + 256 * i) : (f32x4){0.f, 0.f, 0.f, 0.f};
    f32x4 xv[4], pv[4], xn[4], pn[4];
    if (first < NR) NORM_LOAD(xv, pv, first);
    for (int row = first; row < NR; row += stride) {
        NORM_LOAD(xn, pn, row + stride);
        const bool isctx = row >= T; const int lrow = isctx ? row - T : row;
        const int b = isctx ? 32 : (lrow >> 11);
        const float* g = (which == 0) ? p.norm1_g : p.norm2_g;
        const float* md = p.mod + (size_t)b * 6144 + (which == 0 ? 0 : 3 * 1024);
        bf16_t* dst = (which == 1) ? p.h2 + (size_t)lrow * DM : (isctx ? p.hc + (size_t)lrow * DM : p.h + (size_t)lrow * DM);
        f32x4 v[4]; float ss = 0.f;
#pragma unroll
        for (int i = 0; i < 4; ++i) { v[i] = xv[i] + pv[i];
            ss += (v[i][0] * v[i][0] + v[i][1] * v[i][1]) + (v[i][2] * v[i][2] + v[i][3] * v[i][3]); }
        ss = wave_sum(ss);
        const float rs = rsqrtf(ss * (1.0f / 1024.0f) + 1e-6f);
#pragma unroll
        for (int i = 0; i < 4; ++i) { const int d = 4 * lane + 256 * i;
            const f32x4 gg = *(const f32x4*)(g + d), sh = *(const f32x4*)(md + d), sc = *(const f32x4*)(md + 1024 + d);
            f32x4 y;
#pragma unroll
            for (int j = 0; j < 4; ++j) y[j] = (v[i][j] * rs * gg[j]) * (1.0f + sc[j]) + sh[j];
            u32x2 o; o[0] = pk2(y[0], y[1]); o[1] = pk2(y[2], y[3]);
            __builtin_nontemporal_store(o, (u32x2*)(dst + d));
            if (which == 1) { int w8 = 0; w8 = __builtin_amdgcn_cvt_pk_fp8_f32(y[0] * 4.0f, y[1] * 4.0f, w8, false); w8 = __builtin_amdgcn_cvt_pk_fp8_f32(y[2] * 4.0f, y[3] * 4.0f, w8, true);
                *(unsigned*)(p.h8 + (size_t)lrow * DM + d) = (unsigned)w8; } }
#pragma unroll
        for (int i = 0; i < 4; ++i) { xv[i] = xn[i]; pv[i] = pn[i]; }
    }
#undef NORM_LOAD
}

namespace pg8 {
constexpr int BM = 256, BK = 64, HALF = 128, HTB = HALF * BK * 2, STAGE_BYTES = 8 * HTB, NXCD = 8, WGM = 8;
__host__ __device__ __forceinline__ int lds_byte(int r, int c) { const int st = (r >> 4) * 2 + (c >> 5), rr = r & 15, cc = c & 31, ob = rr * 64 + cc * 2; return st * 1024 + (ob ^ (((ob >> 9) & 1) << 5)); }
__host__ __device__ __forceinline__ void stage_rc(int b, int& R, int& C) { const int st = b / 1024, sb = b % 1024, swz = sb ^ (((sb >> 9) & 1) << 5); R = (st >> 1) * 16 + swz / 64; C = (st & 1) * 32 + (swz % 64) / 2; }
__host__ __device__ __forceinline__ int perm32(int rho) { const int n = rho >> 4, i = rho & 15; return 8 * (i >> 2) + 4 * n + (i & 3); }
struct Unit { int pm, pn, z; };
struct Gemm { const bf16_t* A; const bf16_t* Bt; int K, lda, ldb; long aZ, bZ; int natA = 0, natB = 0; };
struct StaticOrder {
    int nM, nN, nwg, G, c;
    __device__ void init(int M, int N, int G_, int c_) { nM = M / BM; nN = N / BM; nwg = nM * nN; G = G_; c = c_; }
    __device__ bool next(int i, Unit& u) const {
        const long L = (long)i * G + c; if (L >= nwg) return false;
        int wgid = (int)L; { const int q = nwg / NXCD, r = nwg % NXCD, xcd = wgid % NXCD, off = wgid / NXCD; wgid = (xcd < r ? xcd * (q + 1) : r * (q + 1) + (xcd - r) * q) + off; }
        const int nig = WGM * nN, gid = wgid / nig, fm = gid * WGM, gsz = (nM - fm) < WGM ? (nM - fm) : WGM;
        u.pm = fm + ((wgid % nig) % gsz); u.pn = (wgid % nig) / gsz; u.z = 0; return true;
    }
};
struct BatchOrder {
    int nM, nN, nz, G, c;
    __device__ void init(int M, int N, int nz_, int G_, int c_) { nM = M / BM; nN = N / BM; nz = nz_; G = G_; c = c_; }
    __device__ bool next(int i, Unit& u) const {
        const long L = (long)i * G + c; const int per = nM * nN; if (L >= (long)per * nz) return false;
        u.z = (int)(L / per); const int r = (int)(L % per); u.pm = r % nM; u.pn = r / nM; return true;
    }
};

template <class Epi, class Sched>
__device__ __forceinline__ void gemm_phase(LAS unsigned char* lds, const Gemm g, const Sched& S, const Epi& E) {
    const int tid = tid_opaque(), wid = __builtin_amdgcn_readfirstlane(tid >> 6), lane = tid & 63, wr = wid >> 2, wc = wid & 3, fr = lane & 15, fq = lane >> 4;
    const int K = g.K, nt = K / BK;
    unsigned voffA[2], voffB[2];
#pragma unroll
    for (int i = 0; i < 2; ++i) { int R, C; stage_rc(tid * 16 + i * 8192, R, C); const int Rb = Epi::PERM ? ((R & ~31) + perm32(R & 31)) : R;
#define PG8_NATOFF(R_, C_) ((unsigned)(((((R_) >> 6) & 1) * 4 + ((C_) >> 5)) * 8192 + ((((R_) >> 4) & 3) * 2) * 512 + (((R_) & 15) + 16 * (((C_) >> 3) & 3)) * 8) * 2u)
        voffA[i] = g.natA ? PG8_NATOFF(R, C) : (unsigned)(R * g.lda + C) * 2u; voffB[i] = g.natB ? PG8_NATOFF(Rb, C) : (unsigned)(Rb * g.ldb + C) * 2u; }
#undef PG8_NATOFF
    const int s0A = g.natA ? 32768 : BK * 2, s1A = g.natA ? 1024 : BK * 4, s2A = g.natA ? 131072 : BK * 8;
    const int s0B = g.natB ? 32768 : BK * 2, s1B = g.natB ? 1024 : BK * 4, s2B = g.natB ? 131072 : BK * 8;
    const size_t hstepA = g.natA ? (size_t)8192 : (size_t)HALF * g.lda * 2, hstepB = g.natB ? (size_t)8192 : (size_t)HALF * g.ldb * 2;
    const size_t tstepA = (size_t)BM * g.lda * 2, tstepB = (size_t)BM * g.ldb * 2;
    const unsigned ldsw = (unsigned)wid * 1024u;
    const int aoff = lds_byte(wr * 64 + fr, fq * 8), boff = lds_byte(wc * 32 + fr, fq * 8);
#define PG8_SA(b, h) (((b) * 2 + (h)) * HTB)
#define PG8_SB(b, h) ((4 + (b) * 2 + (h)) * HTB)
#define PG8_STAGE(bufoff, gbase, voff) do { _Pragma("unroll") for (int _i = 0; _i < 2; ++_i) \
        __builtin_amdgcn_global_load_lds((const unsigned*)((const char*)(gbase) + (voff)[_i]), (LAS unsigned*)(lds + (bufoff) + ldsw + _i * 8192), 16, 0, 0); } while (0)
#define PG8_LDA(dst, b, h) do { _Pragma("unroll") for (int m = 0; m < 4; ++m) _Pragma("unroll") for (int k = 0; k < 2; ++k) dst[m][k] = *(const LAS bf16x8*)(lds + PG8_SA(b, h) + aoff + m * 2048 + k * 1024); } while (0)
#define PG8_LDB(dst, b, h) do { _Pragma("unroll") for (int n = 0; n < 2; ++n) _Pragma("unroll") for (int k = 0; k < 2; ++k) dst[n][k] = *(const LAS bf16x8*)(lds + PG8_SB(b, h) + boff + n * 2048 + k * 1024); } while (0)
#define PG8_MMA(ai, bj, At, Bt) do { __builtin_amdgcn_s_setprio(1); _Pragma("unroll") for (int m = 0; m < 4; ++m) _Pragma("unroll") for (int n = 0; n < 2; ++n) _Pragma("unroll") for (int k = 0; k < 2; ++k) \
        acc[ai][bj][m][n] = __builtin_amdgcn_mfma_f32_16x16x32_bf16(Bt[n][k], At[m][k], acc[ai][bj][m][n], 0, 0, 0); __builtin_amdgcn_s_setprio(0); } while (0)
#define PG8_WAIT_V(n) asm volatile("s_waitcnt vmcnt(" #n ")" ::: "memory")
#define PG8_WAIT_L(n) asm volatile("s_waitcnt lgkmcnt(" #n ")" ::: "memory")
#define PG8_BAR __builtin_amdgcn_s_barrier()
#define PG8_SCHED __builtin_amdgcn_sched_barrier(0)
    Unit cur, nxt; int ui = 0;
    if (!S.next(0, cur)) return;
    f32x4 acc[2][2][4][2];
#pragma unroll
    for (int a = 0; a < 2; ++a)
#pragma unroll
        for (int b = 0; b < 2; ++b)
#pragma unroll
            for (int m = 0; m < 4; ++m)
#pragma unroll
                for (int n = 0; n < 2; ++n) acc[a][b][m][n] = (f32x4){0.f, 0.f, 0.f, 0.f};
    bf16x8 At[4][2], B0[2][2], B1[2][2];
    const char* cA = (const char*)g.A + (size_t)cur.pm * tstepA + (size_t)cur.z * g.aZ * 2; const char* cB = (const char*)g.Bt + (size_t)cur.pn * tstepB + (size_t)cur.z * g.bZ * 2;
    PG8_STAGE(PG8_SB(0, 0), cB, voffB); PG8_STAGE(PG8_SA(0, 0), cA, voffA); PG8_STAGE(PG8_SB(0, 1), cB + hstepB, voffB); PG8_STAGE(PG8_SA(0, 1), cA + hstepA, voffA);
    if (wr == 1) PG8_BAR;
    PG8_WAIT_V(4); PG8_BAR;
    PG8_STAGE(PG8_SB(1, 0), cB + s0B, voffB); PG8_STAGE(PG8_SA(1, 0), cA + s0A, voffA); PG8_STAGE(PG8_SB(1, 1), cB + hstepB + s0B, voffB);
    PG8_WAIT_V(6); PG8_BAR;
    for (;;) {
        const bool has_next = S.next(ui + 1, nxt);
        const char* nA = has_next ? (const char*)g.A + (size_t)nxt.pm * tstepA + (size_t)nxt.z * g.aZ * 2 : cA;
        const char* nB = has_next ? (const char*)g.Bt + (size_t)nxt.pn * tstepB + (size_t)nxt.z * g.bZ * 2 : cB;
        for (int t = 0; t < nt; t += 2) {
            const bool last = (t == nt - 2);
            const int th = t >> 1, tn = th + 1;
            const char* a1 = cA + (size_t)(th >> 1) * s2A + (th & 1) * s1A + s0A;
            const char* a2 = last ? nA : cA + (size_t)(tn >> 1) * s2A + (tn & 1) * s1A; const char* b2 = last ? nB : cB + (size_t)(tn >> 1) * s2B + (tn & 1) * s1B;
            const char* a3 = a2 + s0A; const char* b3 = b2 + s0B;
            PG8_LDB(B0, 0, 0); PG8_SCHED; PG8_LDA(At, 0, 0); PG8_STAGE(PG8_SA(1, 1), a1 + hstepA, voffA);
            PG8_WAIT_L(8); PG8_BAR; PG8_WAIT_L(0); PG8_MMA(0, 0, At, B0); PG8_BAR; PG8_SCHED;
            PG8_LDB(B1, 0, 1); PG8_STAGE(PG8_SB(0, 0), b2, voffB);
            PG8_BAR; PG8_WAIT_L(0); PG8_MMA(0, 1, At, B1); PG8_BAR;
            PG8_LDA(At, 0, 1); PG8_STAGE(PG8_SA(0, 0), a2, voffA);
            PG8_BAR; PG8_WAIT_L(0); PG8_MMA(1, 0, At, B0); PG8_BAR; PG8_SCHED;
            PG8_STAGE(PG8_SB(0, 1), b2 + hstepB, voffB);
            PG8_WAIT_V(6); PG8_BAR; PG8_MMA(1, 1, At, B1); PG8_BAR;
            PG8_LDB(B0, 1, 0); PG8_SCHED; PG8_LDA(At, 1, 0); PG8_STAGE(PG8_SA(0, 1), a2 + hstepA, voffA);
            PG8_WAIT_L(8); PG8_BAR; PG8_WAIT_L(0); PG8_MMA(0, 0, At, B0); PG8_BAR; PG8_SCHED;
            PG8_LDB(B1, 1, 1); PG8_STAGE(PG8_SB(1, 0), b3, voffB);
            PG8_BAR; PG8_WAIT_L(0); PG8_MMA(0, 1, At, B1); PG8_BAR;
            PG8_LDA(At, 1, 1); PG8_STAGE(PG8_SA(1, 0), a3, voffA);
            PG8_BAR; PG8_WAIT_L(0); PG8_MMA(1, 0, At, B0); PG8_BAR; PG8_SCHED;
            PG8_STAGE(PG8_SB(1, 1), b3 + hstepB, voffB);
            PG8_WAIT_V(6); PG8_BAR; PG8_MMA(1, 1, At, B1); PG8_BAR;
        }
        E(acc, cur, wr, wc, fr, fq);
        if (!has_next) break;
#pragma unroll
        for (int a = 0; a < 2; ++a)
#pragma unroll
            for (int b = 0; b < 2; ++b)
#pragma unroll
                for (int m = 0; m < 4; ++m)
#pragma unroll
                    for (int n = 0; n < 2; ++n) acc[a][b][m][n] = (f32x4){0.f, 0.f, 0.f, 0.f};
        cur = nxt; cA = nA; cB = nB; ++ui;
    }
    PG8_WAIT_V(0);
    if (wr == 0) PG8_BAR;
    PG8_BAR;
#undef PG8_SA
#undef PG8_SB
#undef PG8_STAGE
#undef PG8_LDA
#undef PG8_LDB
#undef PG8_MMA
#undef PG8_WAIT_V
#undef PG8_WAIT_L
#undef PG8_BAR
#undef PG8_SCHED
}

__device__ __forceinline__ u32x4 pack8(const f32x4 v0, const f32x4 v1) { u32x4 w; w[0] = pk2(v0[0], v0[1]); w[1] = pk2(v0[2], v0[3]); w[2] = pk2(v1[0], v1[1]); w[3] = pk2(v1[2], v1[3]); return w; }
struct EpiAct {
    static constexpr bool PERM = true;
    bf16_t* O; size_t segstride; int actmask; int segtiles; int ldc; int nt; int native;
    template <int ACT, bool NT, bool NATIVE>
    __device__ __forceinline__ void body(const f32x4 (&acc)[2][2][4][2], bf16_t* base, int row0, int col0, size_t toff) const {
#pragma unroll
        for (int ai = 0; ai < 2; ++ai)
#pragma unroll
            for (int m = 0; m < 4; ++m) { bf16_t* rowp = NATIVE ? base + toff + ((ai * 4 + m) * 2) * 512 : base + (size_t)(row0 + ai * HALF + m * 16) * ldc + col0;
#pragma unroll
                for (int bj = 0; bj < 2; ++bj) { f32x4 v0 = acc[ai][bj][m][0], v1 = acc[ai][bj][m][1];
                    if (ACT == 1) { const f32x2 a = gelu2((f32x2){v0[0], v0[1]}), b = gelu2((f32x2){v0[2], v0[3]}), c = gelu2((f32x2){v1[0], v1[1]}), d = gelu2((f32x2){v1[2], v1[3]});
                        v0 = (f32x4){a[0], a[1], b[0], b[1]}; v1 = (f32x4){c[0], c[1], d[0], d[1]}; }
                    else if (ACT == 2) { const f32x2 a = sigmoid2((f32x2){v0[0], v0[1]}), b = sigmoid2((f32x2){v0[2], v0[3]}), c = sigmoid2((f32x2){v1[0], v1[1]}), d = sigmoid2((f32x2){v1[2], v1[3]});
                        v0 = (f32x4){a[0], a[1], b[0], b[1]}; v1 = (f32x4){c[0], c[1], d[0], d[1]}; }
                    bf16_t* dp = NATIVE ? rowp + bj * 512 : rowp + bj * HALF;
                    if (NT) __builtin_nontemporal_store(pack8(v0, v1), (u32x4*)dp); else *(u32x4*)dp = pack8(v0, v1); } }
    }
    __device__ __forceinline__ void operator()(const f32x4 (&acc)[2][2][4][2], const Unit& u, int wr, int wc, int fr, int fq) const {
        const int seg = u.pn / segtiles, colt = (u.pn - seg * segtiles) * BM;
        bf16_t* base = O + (size_t)seg * segstride; const int act = seg < 8 ? ((actmask >> (4 * seg)) & 15) : 0;
        const int row0 = u.pm * BM + wr * 64 + fr, col0 = colt + wc * 32 + 8 * fq;
        const size_t toff = ((size_t)u.pm * (ldc >> 8) + (u.pn - seg * segtiles)) * 65536 + (size_t)(wr * 4 + wc) * 8192 + (size_t)(fr + 16 * fq) * 8;
        if (act == 1) body<1, true, false>(acc, base, row0, col0, 0); else if (act == 2) body<2, true, true>(acc, base, row0, col0, toff); else if (native) body<0, true, true>(acc, base, row0, col0, toff); else if (nt) body<0, true, false>(acc, base, row0, col0, 0); else body<0, false, false>(acc, base, row0, col0, 0);
    }
};
struct EpiUV {
    static constexpr bool PERM = true;
    bf16_t* UV;
    __device__ __forceinline__ void operator()(const f32x4 (&acc)[2][2][4][2], const Unit& u, int wr, int wc, int fr, int fq) const {
        const int isv = u.pm >> 2, mp0 = (u.pm & 3) * BM + wr * 64 + fr, colb = u.pn * BM + wc * 32 + 8 * fq;
        bf16_t* base = UV + (size_t)u.z * SEQ * DM;
#pragma unroll
        for (int ai = 0; ai < 2; ++ai)
#pragma unroll
            for (int m = 0; m < 4; ++m) { const int mp = mp0 + ai * HALF + m * 16;
#pragma unroll
                for (int bj = 0; bj < 2; ++bj) { const u32x4 v = pack8(acc[ai][bj][m][0], acc[ai][bj][m][1]); const int col = colb + bj * HALF;
                    if (!isv) { *(u32x4*)(base + (size_t)mp * DM + col) = v; if (mp) *(u32x4*)(base + (size_t)(SEQ - mp) * DM + col) = v; }
                    else if (mp == 0) { *(u32x4*)(base + (size_t)1024 * DM + col) = v; const u32x4 z = (u32x4){0u, 0u, 0u, 0u};
                        *(u32x4*)(base + 512 + col) = z; *(u32x4*)(base + (size_t)1024 * DM + 512 + col) = z; }
                    else { *(u32x4*)(base + (size_t)mp * DM + 512 + col) = v; const u32x4 nv = (u32x4){v[0] ^ 0x80008000u, v[1] ^ 0x80008000u, v[2] ^ 0x80008000u, v[3] ^ 0x80008000u};
                        *(u32x4*)(base + (size_t)(SEQ - mp) * DM + 512 + col) = nv; } } }
    }
};
struct EpiGate {
    static constexpr bool PERM = true;
    const bf16_t* gate; const bf16_t* addsrc; bf16_t* dst;
    __device__ __forceinline__ void operator()(const f32x4 (&acc)[2][2][4][2], const Unit& u, int wr, int wc, int fr, int fq) const {
        const size_t toff = ((size_t)u.pm * 4 + u.pn) * 65536 + (size_t)(wr * 4 + wc) * 8192 + (size_t)(fr + 16 * fq) * 8;
#pragma unroll
        for (int ai = 0; ai < 2; ++ai)
#pragma unroll
            for (int m = 0; m < 4; ++m) {
#pragma unroll
                for (int bj = 0; bj < 2; ++bj) { const size_t noff = toff + ((ai * 4 + m) * 2 + bj) * 512;
                    const u32x4 gv = __builtin_nontemporal_load((const u32x4*)(gate + noff));
                    f32x4 v0 = acc[ai][bj][m][0], v1 = acc[ai][bj][m][1];
                    v0[0] *= bflo(gv[0]); v0[1] *= bfhi(gv[0]); v0[2] *= bflo(gv[1]); v0[3] *= bfhi(gv[1]);
                    v1[0] *= bflo(gv[2]); v1[1] *= bfhi(gv[2]); v1[2] *= bflo(gv[3]); v1[3] *= bfhi(gv[3]);
                    if (addsrc) { const u32x4 av = *(const u32x4*)(addsrc + noff);
                        v0[0] += bflo(av[0]); v0[1] += bfhi(av[0]); v0[2] += bflo(av[1]); v0[3] += bfhi(av[1]);
                        v1[0] += bflo(av[2]); v1[1] += bfhi(av[2]); v1[2] += bflo(av[3]); v1[3] += bfhi(av[3]); }
                    *(u32x4*)(dst + noff) = pack8(v0, v1); } }
    }
};
struct EpiX1 {
    static constexpr bool PERM = true;
    const float *x, *pos, *mod, *b_out; bf16_t* x1b;
    __device__ __forceinline__ void operator()(const f32x4 (&acc)[2][2][4][2], const Unit& u, int wr, int wc, int fr, int fq) const {
        const int row0 = u.pm * BM + wr * 64 + fr, col0 = u.pn * BM + wc * 32 + 8 * fq;
        const int b = (u.pm * BM) >> 11;
        f32x4 bv[2][2], gv[2][2];
#pragma unroll
        for (int bj = 0; bj < 2; ++bj)
#pragma unroll
            for (int n = 0; n < 2; ++n) { bv[bj][n] = *(const f32x4*)(b_out + col0 + bj * HALF + 4 * n); gv[bj][n] = *(const f32x4*)(mod + (size_t)b * 6144 + 2 * 1024 + col0 + bj * HALF + 4 * n); }
#pragma unroll
        for (int ai = 0; ai < 2; ++ai)
#pragma unroll
            for (int m = 0; m < 4; ++m) { const int row = row0 + ai * HALF + m * 16; const size_t off = (size_t)row * DM + col0; const size_t poff = (size_t)(row & 2047) * DM + col0;
#pragma unroll
                for (int bj = 0; bj < 2; ++bj) { f32x4 r[2];
#pragma unroll
                    for (int n = 0; n < 2; ++n) { const f32x4 xv = __builtin_nontemporal_load((const f32x4*)(x + off + bj * HALF + 4 * n)), pv = *(const f32x4*)(pos + poff + bj * HALF + 4 * n);
                        r[n] = xv + pv + gv[bj][n] * (acc[ai][bj][m][n] + bv[bj][n]); }
                    *(u32x4*)(x1b + off + bj * HALF) = pack8(r[0], r[1]); } }
    }
};
}

constexpr int XC_STRIDE = 272;
constexpr int HT_STRIDE = 132;
constexpr int XC_BYTES = 64 * XC_STRIDE, HT_BYTES = 64 * HT_STRIDE * 4, SCAN_CW_OFF = 2 * XC_BYTES + 2 * HT_BYTES;
template <int DIR>
__device__ __forceinline__ void scan_dir(PREF p, LAS unsigned char* lds, int b, int head) {
    const int tid = tid_opaque(), w = tid >> 6, l = tid & 63, c16 = l & 15, q4 = l >> 4;
    LAS float* CW = (LAS float*)(lds + SCAN_CW_OFF);
    const int ch = head * 128 + 16 * w + c16;
    bf16x8 bfa[4], bfx[4];
    {
        const bf16_t* Ga = p.gates_bf + ((size_t)((DIR * 2 + 0) * 8 + head) * 128 + 16 * w + c16) * 128 + 8 * q4;
        const bf16_t* Gx = p.gates_bf + ((size_t)((DIR * 2 + 1) * 8 + head) * 128 + 16 * w + c16) * 128 + 8 * q4;
#pragma unroll
        for (int ks = 0; ks < 4; ++ks) { bfa[ks] = *(const bf16x8*)(Ga + 32 * ks); bfx[ks] = *(const bf16x8*)(Gx + 32 * ks); }
    }
    const float nba = -1.4426950409f * p.lru_ba[DIR * 1024 + ch], nbx = -1.4426950409f * p.lru_bx[DIR * 1024 + ch];
    const float m8sp = -8.0f * log1pf(expf(-p.lru_lambda[DIR * 1024 + ch])) * 1.4426950409f;
    const int pos4 = DIR == 0 ? q4 : 3 - q4;
    const int src1 = (DIR == 0 ? l - 16 : l + 16) & 63, src2 = (DIR == 0 ? l - 32 : l + 32) & 63, srcl = DIR == 0 ? c16 + 48 : c16;
    float carry = 0.f;
    const int tt = tid >> 3, cg = tid & 7;
#define SCAN_CREF(k, SEQI, T0, TSEQ, SRC) const int SEQI = (k) >= 4 ? 1 : 0; const int TSEQ = SEQI ? SEQ : CTXL; \
        const int T0 = (DIR == 0 ? (SEQI ? (k) - 4 : (k)) : (SEQI ? 35 - (k) : 3 - (k))) * 64; const bf16_t* SRC = SEQI ? p.zx + (size_t)b * SEQ * DM : p.zxc + (size_t)b * CTXL * DM;
#define SCAN_LOADZ(k) do { SCAN_CREF(k, sq_, t0_, ts_, sr_) \
        if (t0_ >= 1 && t0_ + 66 <= ts_) { const bf16_t* zp_ = sr_ + (size_t)(t0_ + tt - 1) * DM + head * 128 + 16 * cg;     \
            _Pragma("unroll") for (int r_ = 0; r_ < 4; ++r_) { Z[2 * r_] = *(const u32x4*)(zp_ + (size_t)r_ * DM); Z[2 * r_ + 1] = *(const u32x4*)(zp_ + (size_t)r_ * DM + 8); } } \
        else { _Pragma("unroll") for (int r_ = 0; r_ < 4; ++r_) { const int tr_ = t0_ + tt - 1 + r_; const bool ok_ = tr_ >= 0 && tr_ < ts_; \
            const bf16_t* zp_ = sr_ + (size_t)(ok_ ? tr_ : 0) * DM + head * 128 + 16 * cg; const u32x4 za_ = *(const u32x4*)zp_, zb_ = *(const u32x4*)(zp_ + 8); const u32x4 zz_ = (u32x4){0u, 0u, 0u, 0u}; \
            Z[2 * r_] = ok_ ? za_ : zz_; Z[2 * r_ + 1] = ok_ ? zb_ : zz_; } } } while (0)
#define SCAN_BUILD(XCB) do { f32x2 xc2[8]; \
        { const LAS f32x4* cb_ = (const LAS f32x4*)(CW + 4 * 128 + 16 * cg); _Pragma("unroll") for (int j4 = 0; j4 < 4; ++j4) { const f32x4 v_ = cb_[j4]; xc2[2 * j4] = (f32x2){v_[0], v_[1]}; xc2[2 * j4 + 1] = (f32x2){v_[2], v_[3]}; } } \
        _Pragma("unroll") for (int r = 0; r < 4; ++r) { const u32x4 z0 = Z[2 * r], z1 = Z[2 * r + 1]; const LAS f32x4* cw_ = (const LAS f32x4*)(CW + r * 128 + 16 * cg); \
            _Pragma("unroll") for (int j4 = 0; j4 < 4; ++j4) { const f32x4 w_ = cw_[j4]; const unsigned da_ = j4 < 2 ? z0[2 * j4] : z1[2 * (j4 - 2)], db_ = j4 < 2 ? z0[2 * j4 + 1] : z1[2 * (j4 - 2) + 1]; \
                xc2[2 * j4] = (f32x2){w_[0], w_[1]} * (f32x2){bflo(da_), bfhi(da_)} + xc2[2 * j4]; xc2[2 * j4 + 1] = (f32x2){w_[2], w_[3]} * (f32x2){bflo(db_), bfhi(db_)} + xc2[2 * j4 + 1]; } } \
        u32x4 o0_, o1_; o0_[0] = pk2(xc2[0][0], xc2[0][1]); o0_[1] = pk2(xc2[1][0], xc2[1][1]); o0_[2] = pk2(xc2[2][0], xc2[2][1]); o0_[3] = pk2(xc2[3][0], xc2[3][1]); \
        o1_[0] = pk2(xc2[4][0], xc2[4][1]); o1_[1] = pk2(xc2[5][0], xc2[5][1]); o1_[2] = pk2(xc2[6][0], xc2[6][1]); o1_[3] = pk2(xc2[7][0], xc2[7][1]); \
        *(LAS u32x4*)((XCB) + tt * XC_STRIDE + cg * 32) = o0_; *(LAS u32x4*)((XCB) + tt * XC_STRIDE + cg * 32 + 16) = o1_; } while (0)
    u32x4 Z[8];
    SCAN_LOADZ(0);
    SCAN_BUILD(lds);
    SCAN_LOADZ(1);
    __syncthreads();
    size_t off_prev = 0; int seqi_prev = 0;
    u32x4 f0 = (u32x4){0u, 0u, 0u, 0u}, f1 = f0, g0 = f0, g1 = f0;
    for (int k = 0; k <= 36; ++k) {
        if (k > 0 && seqi_prev == 1) {
            const LAS float* HTp = (const LAS float*)(lds + 2 * XC_BYTES + ((k - 1) & 1) * HT_BYTES);
            const LAS f32x4* hp = (const LAS f32x4*)(HTp + tt * HT_STRIDE + 16 * cg);
            const f32x4 h0 = hp[0], h1 = hp[1], h2 = hp[2], h3 = hp[3];
            const size_t off = off_prev;
            if (DIR == 0) {
                *(u32x4*)(p.hf + off) = pg8::pack8(h0, h1); *(u32x4*)(p.hf + off + 8) = pg8::pack8(h2, h3);
            } else {
                f32x4 y0, y1, y2, y3;
                y0[0] = (h0[0] + bflo(f0[0])) * bflo(g0[0]); y0[1] = (h0[1] + bfhi(f0[0])) * bfhi(g0[0]); y0[2] = (h0[2] + bflo(f0[1])) * bflo(g0[1]); y0[3] = (h0[3] + bfhi(f0[1])) * bfhi(g0[1]);
                y1[0] = (h1[0] + bflo(f0[2])) * bflo(g0[2]); y1[1] = (h1[1] + bfhi(f0[2])) * bfhi(g0[2]); y1[2] = (h1[2] + bflo(f0[3])) * bflo(g0[3]); y1[3] = (h1[3] + bfhi(f0[3])) * bfhi(g0[3]);
                y2[0] = (h2[0] + bflo(f1[0])) * bflo(g1[0]); y2[1] = (h2[1] + bfhi(f1[0])) * bfhi(g1[0]); y2[2] = (h2[2] + bflo(f1[1])) * bflo(g1[1]); y2[3] = (h2[3] + bfhi(f1[1])) * bfhi(g1[1]);
                y3[0] = (h3[0] + bflo(f1[2])) * bflo(g1[2]); y3[1] = (h3[1] + bfhi(f1[2])) * bfhi(g1[2]); y3[2] = (h3[2] + bflo(f1[3])) * bflo(g1[3]); y3[3] = (h3[3] + bfhi(f1[3])) * bfhi(g1[3]);
                *(u32x4*)(p.ybin + off) = pg8::pack8(y0, y1); *(u32x4*)(p.ybin + off + 8) = pg8::pack8(y2, y3);
            }
        }
        if (k == 36) break;
        if (k + 1 < 36) { SCAN_BUILD(lds + ((k + 1) & 1) * XC_BYTES); if (k + 2 < 36) SCAN_LOADZ(k + 2); }
        SCAN_CREF(k, seqi, t0, Tseq, src) (void)Tseq; (void)src;
        {
            const size_t off = ((size_t)b * SEQ + t0 + tt) * DM + head * 128 + 16 * cg;
            if (DIR == 1 && seqi == 1) { f0 = *(const u32x4*)(p.hf + off); f1 = *(const u32x4*)(p.hf + off + 8); g0 = __builtin_nontemporal_load((const u32x4*)(p.gzy + off)); g1 = __builtin_nontemporal_load((const u32x4*)(p.gzy + off + 8)); }
            off_prev = off; seqi_prev = seqi;
        }
        {
            const LAS unsigned char* XC = lds + (k & 1) * XC_BYTES;
            LAS float* HT = (LAS float*)(lds + 2 * XC_BYTES + (k & 1) * HT_BYTES);
            f32x4 accr[4], acci[4];
#pragma unroll
            for (int mt = 0; mt < 4; ++mt) { accr[mt] = (f32x4){0.f, 0.f, 0.f, 0.f}; acci[mt] = (f32x4){0.f, 0.f, 0.f, 0.f}; }
#pragma unroll
            for (int mt = 0; mt < 4; ++mt)
#pragma unroll
                for (int ks = 0; ks < 4; ++ks) { const bf16x8 a = *(const LAS bf16x8*)(XC + (16 * mt + c16) * XC_STRIDE + (32 * ks + 8 * q4) * 2);
                    accr[mt] = __builtin_amdgcn_mfma_f32_16x16x32_bf16(a, bfa[ks], accr[mt], 0, 0, 0);
                    acci[mt] = __builtin_amdgcn_mfma_f32_16x16x32_bf16(a, bfx[ks], acci[mt], 0, 0, 0); }
#pragma unroll
            for (int mi = 0; mi < 4; ++mi) {
                const int mt = DIR == 0 ? mi : 3 - mi;
                float av[4], bv[4];
#pragma unroll
                for (int reg = 0; reg < 4; ++reg) {
                    const float xcv = bf2f(*(const LAS bf16_t*)(XC + (16 * mt + 4 * q4 + reg) * XC_STRIDE + (16 * w + c16) * 2));
                    const float r = __builtin_amdgcn_rcpf(1.0f + __builtin_amdgcn_exp2f(__builtin_fmaf(accr[mt][reg], -1.4426950409f, nba))), ig = __builtin_amdgcn_rcpf(1.0f + __builtin_amdgcn_exp2f(__builtin_fmaf(acci[mt][reg], -1.4426950409f, nbx)));
                    const float a = __builtin_amdgcn_exp2f(m8sp * r);
                    av[reg] = a; bv[reg] = __builtin_amdgcn_sqrtf(1.0f - a * a) * ig * xcv;
                }
                float A, B;
                if (DIR == 0) { A = av[0]; B = bv[0];
#pragma unroll
                    for (int reg = 1; reg < 4; ++reg) { B = av[reg] * B + bv[reg]; A *= av[reg]; } }
                else { A = av[3]; B = bv[3];
#pragma unroll
                    for (int reg = 2; reg >= 0; --reg) { B = av[reg] * B + bv[reg]; A *= av[reg]; } }
                { const float A1 = __shfl(A, src1), B1 = __shfl(B, src1); if (pos4 >= 1) { B = A * B1 + B; A = A * A1; } }
                { const float A2 = __shfl(A, src2), B2 = __shfl(B, src2); if (pos4 >= 2) { B = A * B2 + B; A = A * A2; } }
                float Aex = __shfl(A, src1), Bex = __shfl(B, src1); if (pos4 == 0) { Aex = 1.f; Bex = 0.f; }
                const float A3 = __shfl(A, srcl), B3 = __shfl(B, srcl);
                float hs = Aex * carry + Bex;
                float st[4];
                if (DIR == 0) {
#pragma unroll
                    for (int reg = 0; reg < 4; ++reg) { hs = av[reg] * hs + bv[reg]; st[reg] = hs; } }
                else {
#pragma unroll
                    for (int reg = 3; reg >= 0; --reg) { hs = av[reg] * hs + bv[reg]; st[reg] = hs; } }
                carry = A3 * carry + B3;
                if (seqi == 1) {
#pragma unroll
                    for (int reg = 0; reg < 4; ++reg) HT[(16 * mt + 4 * q4 + reg) * HT_STRIDE + 16 * w + c16] = st[reg]; }
            }
        }
        __syncthreads();
    }
#undef SCAN_CREF
#undef SCAN_LOADZ
#undef SCAN_BUILD
}
__device__ __forceinline__ void dev_scan(PREF p, LAS unsigned char* lds) {
    LAS float* CW = (LAS float*)(lds + SCAN_CW_OFF);
    for (int item = blockIdx.x; item < p.nb * 8; item += gridDim.x) {
        const int b = item >> 3, head = item & 7;
        __syncthreads();
        for (int i = tid_opaque(); i < 640; i += NTHR) CW[i] = (i < 512) ? p.conv_w[(i >> 7) * 1024 + head * 128 + (i & 127)] : p.conv_b[head * 128 + (i - 512)];
        __syncthreads();
        scan_dir<0>(p, lds, b, head);
        __syncthreads();
        scan_dir<1>(p, lds, b, head);
    }
}

#define CASD(a, b) { const int _x = max(a, b), _y = min(a, b); a = _x; b = _y; }
template <int K, int J, int BASE, int N> __device__ __forceinline__ void bitonic_step(int (&v)[N]) {
#pragma unroll
    for (int i = 0; i < 16; ++i) { const int l = i ^ J; if (l > i) { if ((i & K) == 0) { CASD(v[BASE + i], v[BASE + l]); } else { CASD(v[BASE + l], v[BASE + i]); } } }
}
template <int BASE, int N> __device__ __forceinline__ void sort16_desc(int (&v)[N]) {
    bitonic_step<2, 1, BASE>(v);
    bitonic_step<4, 2, BASE>(v); bitonic_step<4, 1, BASE>(v);
    bitonic_step<8, 4, BASE>(v); bitonic_step<8, 2, BASE>(v); bitonic_step<8, 1, BASE>(v);
    bitonic_step<16, 8, BASE>(v); bitonic_step<16, 4, BASE>(v); bitonic_step<16, 2, BASE>(v); bitonic_step<16, 1, BASE>(v);
}
template <int AB, int BB, int NA, int NB> __device__ __forceinline__ void merge16(int (&a)[NA], const int (&b)[NB]) {
#pragma unroll
    for (int i = 0; i < 16; ++i) a[AB + i] = max(a[AB + i], b[BB + 15 - i]);
    bitonic_step<32, 8, AB>(a); bitonic_step<32, 4, AB>(a); bitonic_step<32, 2, AB>(a); bitonic_step<32, 1, AB>(a);
}
__device__ __forceinline__ void top16_of_64(int (&v)[64]) {
    sort16_desc<0>(v); sort16_desc<16>(v); sort16_desc<32>(v); sort16_desc<48>(v);
    merge16<0, 16>(v, v); merge16<32, 48>(v, v); merge16<0, 32>(v, v);
}
__device__ __forceinline__ int f2key(float f) { const int b = __float_as_int(f); return b ^ ((b >> 31) & 0x7fffffff); }
__device__ __forceinline__ float key2f(int k) { return __int_as_float(k ^ ((k >> 31) & 0x7fffffff)); }
__device__ __forceinline__ int lut16(unsigned t0, unsigned t1, unsigned t2, unsigned t3, int i) {
    const int wsel = i >> 2; const unsigned lo = (wsel & 1) ? t1 : t0, hi = (wsel & 1) ? t3 : t2; const unsigned wv = (wsel & 2) ? hi : lo;
    return (int)((wv >> (8 * (i & 3))) & 0xffu);
}
#define CROW(I, CNT, OFF) { _Pragma("unroll") for (int j = 0; j < CNT; ++j) cv[OFF + j] = (f2key(s0[I] + s1[j]) & ~255) | (I << 4) | j; }
constexpr int TK_ROW = 272;
__device__ __forceinline__ void dev_topk(PREF p, LAS unsigned char* lds) {
    const int tid = tid_opaque(), w = tid >> 6, l = tid & 63, tl = l & 31, hh = l >> 5;
    const int T = p.nb * SEQ;
    const int hd = blockIdx.x & 7, sub = blockIdx.x >> 3, nsub = gridDim.x >> 3;
    __syncthreads();
    {
        const bf16_t* kg = p.keys_bf + (size_t)hd * 2 * 128 * 128;
        for (int c = tid; c < 2 * 128 * 16; c += NTHR) { const int row = c >> 4, ch = c & 15; *(LAS u32x4*)(lds + row * TK_ROW + ch * 16) = *(const u32x4*)(kg + (size_t)row * 128 + ch * 8); }
    }
    __syncthreads();
    for (int tg = sub * 8 + w; tg < T / 32; tg += nsub * 8) {
        const int tok = tg * 32 + tl;
        int k0[16], k1[16];
        u32x4 qr[8];
        LAS unsigned char* qrel = lds + 2 * 128 * TK_ROW + w * (32 * TK_ROW);
#define TK_QLOAD(ph_) do { _Pragma("unroll") for (int i_ = 0; i_ < 8; ++i_) { const int tk_ = tg * 32 + 8 * (i_ >> 1) + (l & 7), tr_ = tk_ & 255, ch_ = 8 * (i_ & 1) + (l >> 3);     \
            qr[i_] = __builtin_nontemporal_load((const u32x4*)(p.q + ((size_t)(tk_ >> 8) * 8 + hd) * 65536 + (size_t)((((tr_ >> 6) & 1) * 4 + (ch_ >> 2)) * 8192 + (((tr_ >> 7) * 4 + ((tr_ >> 4) & 3)) * 2 + (ph_)) * 512 + ((tr_ & 15) + 16 * (ch_ & 3)) * 8))); } } while (0)
#define TK_QSTORE() do { _Pragma("unroll") for (int i_ = 0; i_ < 8; ++i_) *(LAS u32x4*)(qrel + (8 * (i_ >> 1) + (l & 7)) * TK_ROW + 16 * (8 * (i_ & 1) + (l >> 3))) = qr[i_]; } while (0)
        TK_QLOAD(0);
#pragma unroll
        for (int ph = 0; ph < 2; ++ph) {
            f32x16 acc[4];
#pragma unroll
            for (int kb = 0; kb < 4; ++kb)
#pragma unroll
                for (int r = 0; r < 16; ++r) acc[kb][r] = 0.f;
            const LAS unsigned char* kpl = lds + (ph * 128 + tl) * TK_ROW + 16 * hh;
            TK_QSTORE();
            if (ph == 0) TK_QLOAD(1);
#pragma unroll
            for (int ks = 0; ks < 8; ++ks) {
                if (ks == 2 || ks == 4 || ks == 6) asm volatile("" : "+v"(acc[0]), "+v"(acc[1]), "+v"(acc[2]), "+v"(acc[3]));
                const bf16x8 bq = *(const LAS bf16x8*)(qrel + tl * TK_ROW + 32 * ks + 16 * hh);
#pragma unroll
                for (int kb = 0; kb < 4; ++kb) { const bf16x8 ak = *(const LAS bf16x8*)(kpl + kb * 32 * TK_ROW + 32 * ks);
                    acc[kb] = __builtin_amdgcn_mfma_f32_32x32x16_bf16(ak, bq, acc[kb], 0, 0, 0); }
            }
            int v[64];
#pragma unroll
            for (int kb = 0; kb < 4; ++kb)
#pragma unroll
                for (int r = 0; r < 16; ++r) { const int idx = 32 * kb + (r & 3) + 8 * (r >> 2); v[kb * 16 + r] = (f2key(acc[kb][r]) & ~127) | idx | (hh << 2); }
            top16_of_64(v);
            int o[16];
#pragma unroll
            for (int i = 0; i < 16; ++i) o[i] = shx_i(v[i], 32);
            merge16<0, 0>(v, o);
#pragma unroll
            for (int i = 0; i < 16; ++i) { if (ph == 0) k0[i] = v[i]; else k1[i] = v[i]; }
        }
        float s0[16], s1[16];
#pragma unroll
        for (int i = 0; i < 16; ++i) { s0[i] = key2f(k0[i] & ~127); s1[i] = key2f(k1[i] & ~127); }
        int cv[64];
        CROW(0, 16, 0) CROW(1, 8, 16) CROW(2, 5, 24) CROW(3, 4, 29) CROW(4, 3, 33) CROW(5, 2, 36) CROW(6, 2, 38) CROW(7, 2, 40)
        CROW(8, 1, 42) CROW(9, 1, 43) CROW(10, 1, 44) CROW(11, 1, 45) CROW(12, 1, 46) CROW(13, 1, 47) CROW(14, 1, 48) CROW(15, 1, 49)
#pragma unroll
        for (int i = 50; i < 64; ++i) cv[i] = (int)0x80000000;
        top16_of_64(cv);
#define PK4(K, W) ((unsigned)(K[4 * W] & 127) | ((unsigned)(K[4 * W + 1] & 127) << 8) | ((unsigned)(K[4 * W + 2] & 127) << 16) | ((unsigned)(K[4 * W + 3] & 127) << 24))
        unsigned ta0 = PK4(k0, 0), ta1 = PK4(k0, 1), ta2 = PK4(k0, 2), ta3 = PK4(k0, 3);
        unsigned tc0 = PK4(k1, 0), tc1 = PK4(k1, 1), tc2 = PK4(k1, 2), tc3 = PK4(k1, 3);
        asm volatile("" : "+v"(ta0), "+v"(ta1), "+v"(ta2), "+v"(ta3), "+v"(tc0), "+v"(tc1), "+v"(tc2), "+v"(tc3));
        const float mx = key2f(cv[0] & ~255);
        float e[16], sum = 0.f;
#pragma unroll
        for (int k = 0; k < 16; ++k) { e[k] = __builtin_amdgcn_exp2f((key2f(cv[k] & ~255) - mx) * 1.4426950409f); sum += e[k]; }
        const float inv = 1.0f / sum;
        int eo[8]; float go[8];
#pragma unroll
        for (int k = 0; k < 8; ++k) { int c_lo = cv[k], c_hi = cv[8 + k]; float e_lo = e[k], e_hi = e[8 + k];
            asm volatile("" : "+v"(c_lo), "+v"(c_hi), "+v"(e_lo), "+v"(e_hi));
            const int cvk = hh ? c_hi : c_lo; const float ek = hh ? e_hi : e_lo;
            const int i = (cvk >> 4) & 15, j = cvk & 15;
            eo[k] = lut16(ta0, ta1, ta2, ta3, i) * 128 + lut16(tc0, tc1, tc2, tc3, j); go[k] = ek * inv; }
        float so[8];
#pragma unroll
        for (int k = 0; k < 8; ++k) { const f32x2 s2 = *(const f32x2*)(p.scu + 2 * eo[k]); go[k] *= s2[1]; so[k] = s2[0]; }
        const size_t off = (size_t)tok * 128 + hd * 16 + hh * 8;
        *(u32x4*)(p.eidx + off) = (u32x4){(unsigned)eo[0], (unsigned)eo[1], (unsigned)eo[2], (unsigned)eo[3]};
        *(u32x4*)(p.eidx + off + 4) = (u32x4){(unsigned)eo[4], (unsigned)eo[5], (unsigned)eo[6], (unsigned)eo[7]};
        *(f32x4*)(p.gw + off) = (f32x4){go[0], go[1], go[2], go[3]};
        *(f32x4*)(p.gw + off + 4) = (f32x4){go[4], go[5], go[6], go[7]};
        *(f32x4*)(p.su + off) = (f32x4){so[0], so[1], so[2], so[3]};
        *(f32x4*)(p.su + off + 4) = (f32x4){so[4], so[5], so[6], so[7]};
    }
}

__device__ __forceinline__ float dot8(const u32x4 a, const u32x4 b, float acc) {
    const unsigned a0 = a[0], a1 = a[1], a2 = a[2], a3 = a[3], b0 = b[0], b1 = b[1], b2 = b[2], b3 = b[3];
    asm("v_dot2c_f32_bf16 %0, %1, %2" : "+v"(acc) : "v"(a0), "v"(b0));
    asm("v_dot2c_f32_bf16 %0, %1, %2" : "+v"(acc) : "v"(a1), "v"(b1));
    asm("v_dot2c_f32_bf16 %0, %1, %2" : "+v"(acc) : "v"(a2), "v"(b2));
    asm("v_dot2c_f32_bf16 %0, %1, %2" : "+v"(acc) : "v"(a3), "v"(b3));
    return acc;
}
__device__ __forceinline__ void dev_peer(PREF p) {
    const int tid = tid_opaque(), w = tid >> 6, l = tid & 63;
    const int T = p.nb * SEQ;
    const int b5 = (l >> 5) & 1, b4 = (l >> 4) & 1, b3 = (l >> 3) & 1;
    for (int tok = blockIdx.x * 8 + w; tok < T; tok += gridDim.x * 8) {
        const int b = tok >> 11;
        const u32x4 ha = *(const u32x4*)(p.h2 + (size_t)tok * DM + 8 * l), hb = *(const u32x4*)(p.h2 + (size_t)tok * DM + 512 + 8 * l);
        const int e_lo = p.eidx[(size_t)tok * 128 + l], e_hi = p.eidx[(size_t)tok * 128 + 64 + l];
        const float g_lo = p.gw[(size_t)tok * 128 + l], g_hi = p.gw[(size_t)tok * 128 + 64 + l];
        float acc[16];
#pragma unroll
        for (int i = 0; i < 16; ++i) acc[i] = 0.f;
        for (int grp = 0; grp < 16; ++grp) {
            const int esrc = grp < 8 ? e_lo : e_hi; const float gsrc = grp < 8 ? g_lo : g_hi; const int lbase = (grp & 7) * 8;
            int e[8];
#pragma unroll
            for (int k = 0; k < 8; ++k) e[k] = __builtin_amdgcn_readlane(esrc, lbase + k);
            u32x4 s0[8], s1[8];
            float part[8];
            {
                u32x4 r0[8], r1[8];
#pragma unroll
                for (int k = 0; k < 8; ++k) { const bf16_t* up = p.u_bf + (size_t)e[k] * DM + 8 * l; r0[k] = *(const u32x4*)up; r1[k] = *(const u32x4*)(up + 512); }
#pragma unroll
                for (int k = 0; k < 8; ++k) part[k] = dot8(r1[k], hb, dot8(r0[k], ha, 0.f));
            }
            asm volatile("" : "+v"(part[0]), "+v"(part[1]), "+v"(part[2]), "+v"(part[3]), "+v"(part[4]), "+v"(part[5]), "+v"(part[6]), "+v"(part[7]));
#pragma unroll
            for (int k = 0; k < 8; ++k) { const bf16_t* vp = p.v_bf + (size_t)e[k] * DM + 8 * l; s0[k] = *(const u32x4*)vp; s1[k] = *(const u32x4*)(vp + 512); }
            float q4v[4];
#pragma unroll
            for (int k = 0; k < 4; ++k) { const float send = b5 ? part[k] : part[k + 4]; const float recv = __shfl_xor(send, 32); q4v[k] = (b5 ? part[k + 4] : part[k]) + recv; }
            float r2[2];
#pragma unroll
            for (int k = 0; k < 2; ++k) { const float send = b4 ? q4v[k] : q4v[k + 2]; const float recv = __shfl_xor(send, 16); r2[k] = (b4 ? q4v[k + 2] : q4v[k]) + recv; }
            float sdot;
            { const float send = b3 ? r2[0] : r2[1]; const float recv = __shfl_xor(send, 8); sdot = (b3 ? r2[1] : r2[0]) + recv; }
            sdot += __shfl_xor(sdot, 4); sdot += __shfl_xor(sdot, 2); sdot += __shfl_xor(sdot, 1);
            const int kk = 4 * b5 + 2 * b4 + b3;
            const float gv = __shfl(gsrc, lbase + kk);
            const float wv = gv * gelu_f(sdot);
#pragma unroll
            for (int k = 0; k < 8; ++k) {
                const float wk = __int_as_float(__builtin_amdgcn_readlane(__float_as_int(wv), ((k >> 2) & 1) * 32 + ((k >> 1) & 1) * 16 + (k & 1) * 8));
#pragma unroll
                for (int i = 0; i < 4; ++i) { acc[2 * i] += wk * bflo(s0[k][i]); acc[2 * i + 1] += wk * bfhi(s0[k][i]); acc[8 + 2 * i] += wk * bflo(s1[k][i]); acc[8 + 2 * i + 1] += wk * bfhi(s1[k][i]); }
            }
        }
        const float* x1p = p.x1 + (size_t)tok * DM; const float* g2p = p.mod + (size_t)b * 6144 + 5 * 1024;
        f32x4 xv[4]; float ss = 0.f;
#pragma unroll
        for (int hlf = 0; hlf < 2; ++hlf)
#pragma unroll
            for (int q = 0; q < 2; ++q) { const int d = hlf * 512 + 8 * l + 4 * q; const f32x4 xx = *(const f32x4*)(x1p + d), gg = *(const f32x4*)(g2p + d);
                f32x4 r;
#pragma unroll
                for (int j = 0; j < 4; ++j) { r[j] = xx[j] + gg[j] * acc[hlf * 8 + 4 * q + j]; ss += r[j] * r[j]; }
                xv[hlf * 2 + q] = r; }
        ss = wave_sum(ss);
        const float rs = rsqrtf(ss * (1.0f / 1024.0f) + 1e-6f);
#pragma unroll
        for (int hlf = 0; hlf < 2; ++hlf)
#pragma unroll
            for (int q = 0; q < 2; ++q) { const int d = hlf * 512 + 8 * l + 4 * q; const f32x4 fg = *(const f32x4*)(p.final_g + d);
                f32x4 o;
#pragma unroll
                for (int j = 0; j < 4; ++j) o[j] = xv[hlf * 2 + q][j] * rs * fg[j];
                *(f32x4*)(p.out + (size_t)tok * DM + d) = o; }
    }
}


__device__ __forceinline__ float table_scale(unsigned maxbits) { const float m = fmaxf(__uint_as_float(maxbits), 1e-30f); return exp2f(floorf(log2f(448.0f / m))); }
__device__ __forceinline__ void dev_tabmax(PREF p) {
    const int tid = tid_opaque();
    float mu = 0.f, mv = 0.f;
    for (size_t i = ((size_t)blockIdx.x * NTHR + tid) * 4; i < (size_t)16384 * 1024; i += (size_t)gridDim.x * NTHR * 4) {
        const f32x4 a = *(const f32x4*)(p.peer_u + i), b = *(const f32x4*)(p.peer_v + i);
        mu = fmaxf(mu, fmaxf(fmaxf(fabsf(a[0]), fabsf(a[1])), fmaxf(fabsf(a[2]), fabsf(a[3]))));
        mv = fmaxf(mv, fmaxf(fmaxf(fabsf(b[0]), fabsf(b[1])), fmaxf(fabsf(b[2]), fabsf(b[3])))); }
#pragma unroll
    for (int o = 1; o < 64; o <<= 1) { mu = fmaxf(mu, __shfl_xor(mu, o)); mv = fmaxf(mv, __shfl_xor(mv, o)); }
    if ((tid & 63) == 0) { atomicMax(p.tmax + 0, __float_as_uint(mu)); atomicMax(p.tmax + 1, __float_as_uint(mv)); }
}
__device__ __forceinline__ unsigned fp4_code(float x) {
    const float ax = fabsf(x);
    unsigned c = ax < 0.25f ? 0u : ax < 0.75f ? 1u : ax < 1.25f ? 2u : ax < 1.75f ? 3u : ax < 2.5f ? 4u : ax < 3.5f ? 5u : ax < 5.0f ? 6u : 7u;
    return c | (x < 0.f ? 8u : 0u);
}
__device__ __forceinline__ void tab8_row(PREF p, const f32x4 (&a)[4], int r, int lane) {
    const int tab = r >> 14, e = r & 16383;
    float m = 0.f, ss = 0.f;
#pragma unroll
    for (int i = 0; i < 4; ++i) { m = fmaxf(m, fmaxf(fmaxf(fabsf(a[i][0]), fabsf(a[i][1])), fmaxf(fabsf(a[i][2]), fabsf(a[i][3]))));
        ss += (a[i][0] * a[i][0] + a[i][1] * a[i][1]) + (a[i][2] * a[i][2] + a[i][3] * a[i][3]); }
#pragma unroll
    for (int o = 1; o < 64; o <<= 1) { m = fmaxf(m, shx_f(m, o)); ss += shx_f(ss, o); }
    const float rms = sqrtf(ss * (1.0f / 1024.0f));
    const float sc = m > 0.f ? fminf(2.0f / rms, 9.0f / m) : 1.0f;
    unsigned char* dst = (tab ? p.v4 : p.u4) + (size_t)e * 128 + 2 * lane;
#pragma unroll
    for (int i = 0; i < 4; ++i) { unsigned b = 0u;
        b = __builtin_amdgcn_cvt_scalef32_pk_fp4_f32(b, a[i][0] * sc, a[i][1] * sc, 1.0f, 0); b = __builtin_amdgcn_cvt_scalef32_pk_fp4_f32(b, a[i][2] * sc, a[i][3] * sc, 1.0f, 1);
        *(unsigned short*)(dst + (size_t)i * 16384 * 128) = (unsigned short)b; }
    if (lane == 0) p.scu[2 * e + tab] = 1.0f / sc;
}
__device__ __forceinline__ void dev_tab8(PREF p) {
    const int tid = tid_opaque();
    const int w = tid >> 6, lane = tid & 63;
    const int G = (int)gridDim.x, nctx = (p.nb * CTXL / 256) * 4, NR = 2 * 16384;
    const int Wt = nctx + 7 * (G - nctx), unit = (G > nctx) ? NR / Wt : 0;
    int first, S, end;
    if (G > nctx && unit * Wt == NR && (unit & 7) == 0) { const int b = (int)blockIdx.x; const int r0 = b < nctx ? b * unit : nctx * unit + (b - nctx) * 7 * unit; first = r0 + w; S = 8; end = r0 + (b < nctx ? unit : 7 * unit); }
    else { first = (int)blockIdx.x * 8 + w; S = G * 8; end = NR; }
#define TAB_LOAD(A, r) do { const int r_ = (r) < NR ? (r) : NR - 1; const float* s_ = ((r_ >> 14) ? p.peer_v : p.peer_u) + (size_t)(r_ & 16383) * 1024 + 4 * lane; \
        _Pragma("unroll") for (int i_ = 0; i_ < 4; ++i_) A[i_] = __builtin_nontemporal_load((const f32x4*)(s_ + 256 * i_)); } while (0)
    f32x4 A0[4], A1[4], A2[4], A3[4];
    if (first < end) { TAB_LOAD(A0, first); TAB_LOAD(A1, first + S); TAB_LOAD(A2, first + 2 * S); }
    for (int r = first; r < end; r += 4 * S) {
        TAB_LOAD(A3, r + 3 * S); tab8_row(p, A0, r, lane);
        TAB_LOAD(A0, r + 4 * S); if (r + S < end) tab8_row(p, A1, r + S, lane);
        TAB_LOAD(A1, r + 5 * S); if (r + 2 * S < end) tab8_row(p, A2, r + 2 * S, lane);
        TAB_LOAD(A2, r + 6 * S); if (r + 3 * S < end) tab8_row(p, A3, r + 3 * S, lane);
    }
#undef TAB_LOAD
}
#define PEER_ISSUE(R, E0, E1, E2, E3) do { _Pragma("unroll") for (int i_ = 0; i_ < 4; ++i_) { R[i_] = *(const u32x4*)(tab + (E0[i_] * 128u + kc16)); R[4 + i_] = *(const u32x4*)(tab + (E1[i_] * 128u + kc16)); \
        R[8 + i_] = *(const u32x4*)(tab + (E2[i_] * 128u + kc16)); R[12 + i_] = *(const u32x4*)(tab + (E3[i_] * 128u + kc16)); } } while (0)
#define PEER_LD_E(E0, E1, E2, E3, t) do { const u32x4* ep_ = (const u32x4*)(p.eidx + (size_t)(t) * 128 + 16 * rsub); E0 = ep_[0]; E1 = ep_[1]; E2 = ep_[2]; E3 = ep_[3]; } while (0)
typedef int i32x8 __attribute__((ext_vector_type(8)));
__device__ __forceinline__ void sddmm_compute(u32x4 (&R)[16], const u32x4 (&hb)[4], LAS unsigned char* wbuf, float* dst_tok, int l) {
    const int rsub = l >> 3, kc = l & 7, rho = l & 15, kg = l >> 4;
    const int wr0 = rsub * 128 + ((kc ^ rsub) << 4), wr1 = (8 + rsub) * 128 + ((kc ^ rsub ^ 1) << 4);
    const int key = (rho & 7) ^ (rho >> 3), rbase = rho * 128;
    i32x8 b0, b1;
#pragma unroll
    for (int i = 0; i < 4; ++i) { b0[i] = (int)hb[0][i]; b0[4 + i] = (int)hb[1][i]; b1[i] = (int)hb[2][i]; b1[4 + i] = (int)hb[3][i]; }
    f32x4 acc[8];
#pragma unroll
    for (int t = 0; t < 8; ++t) {
        LAS unsigned char* buf = wbuf + (t & 1) * 2048;
        *(LAS u32x4*)(buf + wr0) = R[t]; *(LAS u32x4*)(buf + wr1) = R[t + 8];
        const u32x4 x0 = *(const LAS u32x4*)(buf + rbase + ((kg ^ key) << 4)), x1 = *(const LAS u32x4*)(buf + rbase + (((4 + kg) ^ key) << 4));
        i32x8 a0, a1;
#pragma unroll
        for (int i = 0; i < 4; ++i) { a0[i] = (int)x0[i]; a0[4 + i] = 0; a1[i] = (int)x1[i]; a1[4 + i] = 0; }
        f32x4 c = (f32x4){0.f, 0.f, 0.f, 0.f};
        c = __builtin_amdgcn_mfma_scale_f32_16x16x128_f8f6f4(a0, b0, c, 4, 0, 0, 0x7f7f7f7f, 0, 0x7f7f7f7f);
        c = __builtin_amdgcn_mfma_scale_f32_16x16x128_f8f6f4(a1, b1, c, 4, 0, 0, 0x7f7f7f7f, 0, 0x7f7f7f7f);
        acc[t] = c;
    }
    const int reg = rho & 3, half = (rho >> 2) & 1;
    f32x4 o;
#pragma unroll
    for (int c4 = 0; c4 < 4; ++c4) { f32x4 lo = acc[c4], hi = acc[4 + c4];
        asm volatile("" : "+v"(lo), "+v"(hi));
        const f32x4 x = half ? hi : lo; float x0 = x[0], x1 = x[1], x2 = x[2], x3 = x[3];
        asm volatile("" : "+v"(x0), "+v"(x1), "+v"(x2), "+v"(x3));
        o[c4] = (reg & 2) ? ((reg & 1) ? x3 : x2) : ((reg & 1) ? x1 : x0); }
    if (rho < 8) *(f32x4*)(dst_tok + 16 * (4 * (kg & 1) + reg) + 8 * (kg >> 1) + 4 * half) = o;
}
__device__ __forceinline__ void dev_sddmm(PREF p, LAS unsigned char* lds) {
    const int tid = tid_opaque(), w = tid >> 6, l = tid & 63, rsub = l >> 3, kc = l & 7, kg = l >> 4;
    const int T = p.nb * SEQ; const int s = blockIdx.x & 3, sub = blockIdx.x >> 2, nsub = gridDim.x >> 2;
    const unsigned char* tab = p.u4 + (size_t)s * 16384 * 128; const unsigned kc16 = 16u * kc;
    const int first = sub * 8 + w, S = nsub * 8;
    const int n = first < T ? (T - first + S - 1) / S : 0;
    LAS unsigned char* wbuf = lds + w * 4096;
    float* pdb = p.pd + (size_t)s * T * 128;
#define TOKI(i) (first + ((i) < n ? (i) : n - 1) * S)
#define LD_H(H, t) do { const unsigned char* hp_ = p.h8 + (size_t)(t) * DM + 256 * s + 16 * kg; H[0] = *(const u32x4*)hp_; H[1] = *(const u32x4*)(hp_ + 64); H[2] = *(const u32x4*)(hp_ + 128); H[3] = *(const u32x4*)(hp_ + 192); } while (0)
    if (n > 0) {
        u32x4 RA[16], RB[16], eA0, eA1, eA2, eA3, eB0, eB1, eB2, eB3, hA[4], hB[4];
        PEER_LD_E(eA0, eA1, eA2, eA3, TOKI(0)); LD_H(hA, TOKI(0)); PEER_ISSUE(RA, eA0, eA1, eA2, eA3);
        PEER_LD_E(eB0, eB1, eB2, eB3, TOKI(1)); LD_H(hB, TOKI(1));
        for (int i = 0; i < n; i += 2) {
            PEER_ISSUE(RB, eB0, eB1, eB2, eB3);
            PEER_LD_E(eA0, eA1, eA2, eA3, TOKI(i + 2));
            sddmm_compute(RA, hA, wbuf, pdb + (size_t)TOKI(i) * 128, l);
            LD_H(hA, TOKI(i + 2));
            PEER_ISSUE(RA, eA0, eA1, eA2, eA3);
            PEER_LD_E(eB0, eB1, eB2, eB3, TOKI(i + 3));
            if (i + 1 < n) sddmm_compute(RB, hB, wbuf, pdb + (size_t)TOKI(i + 1) * 128, l);
            LD_H(hB, TOKI(i + 3));
        }
    }
#undef LD_H
}
__device__ __forceinline__ void dev_act(PREF p) {
    const int tid = tid_opaque(); const int T = p.nb * SEQ; const size_t n = (size_t)T * 128;
    for (size_t i = ((size_t)blockIdx.x * NTHR + tid) * 4; i < n; i += (size_t)gridDim.x * NTHR * 4) {
        f32x4 a = *(const f32x4*)(p.pd + i);
#pragma unroll
        for (int s = 1; s < 4; ++s) a += *(const f32x4*)(p.pd + (size_t)s * n + i);
        const u32x4 e = *(const u32x4*)(p.eidx + i);
        f32x4 g = *(const f32x4*)(p.gw + i);
#pragma unroll
        for (int j = 0; j < 4; ++j) g[j] *= gelu_f(a[j] * (0.25f * p.scu[2 * e[j]])) * p.scu[2 * e[j] + 1];
        *(f32x4*)(p.gw + i) = g;
    }
}
template <int CTRL> __device__ __forceinline__ float dpp_f(float v) { return __int_as_float(__builtin_amdgcn_update_dpp(0, __float_as_int(v), CTRL, 0xf, 0xf, true)); }
__device__ __forceinline__ void spmm_compute(PREF p, u32x4 (&R)[16], const f32x4 w0, const f32x4 w1, const f32x4 w2, const f32x4 w3, int t, int col, int l) {
    const int b5 = (l >> 5) & 1, b4 = (l >> 4) & 1, b3 = (l >> 3) & 1;
    f32x2 ac2[16];
#pragma unroll
    for (int i = 0; i < 16; ++i) ac2[i] = (f32x2){0.f, 0.f};
#pragma unroll
    for (int r = 0; r < 16; ++r) { const float wg = (r < 4) ? w0[r & 3] : (r < 8) ? w1[r & 3] : (r < 12) ? w2[r & 3] : w3[r & 3];
        if (r >= 1) asm volatile("" : "+v"(R[r]) : "v"(ac2[0]));
        const f32x2 wg2 = (f32x2){wg, wg};
#pragma unroll
        for (int i = 0; i < 4; ++i) {
            ac2[4 * i + 0] = wg2 * __builtin_amdgcn_cvt_scalef32_pk_f32_fp4(R[r][i], 1.0f, 0) + ac2[4 * i + 0];
            ac2[4 * i + 1] = wg2 * __builtin_amdgcn_cvt_scalef32_pk_f32_fp4(R[r][i], 1.0f, 1) + ac2[4 * i + 1];
            ac2[4 * i + 2] = wg2 * __builtin_amdgcn_cvt_scalef32_pk_f32_fp4(R[r][i], 1.0f, 2) + ac2[4 * i + 2];
            ac2[4 * i + 3] = wg2 * __builtin_amdgcn_cvt_scalef32_pk_f32_fp4(R[r][i], 1.0f, 3) + ac2[4 * i + 3]; } }
    f32x2 a8[8], a4[4], a2[2];
#pragma unroll
    for (int k = 0; k < 8; ++k)
#pragma unroll
        for (int c = 0; c < 2; ++c) { const u32x2 r = __builtin_amdgcn_permlane32_swap(__float_as_uint(ac2[k][c]), __float_as_uint(ac2[k + 8][c]), false, false); a8[k][c] = __uint_as_float(r[0]) + __uint_as_float(r[1]); }
#pragma unroll
    for (int k = 0; k < 4; ++k)
#pragma unroll
        for (int c = 0; c < 2; ++c) { const u32x2 r = __builtin_amdgcn_permlane16_swap(__float_as_uint(a8[k][c]), __float_as_uint(a8[k + 4][c]), false, false); a4[k][c] = __uint_as_float(r[0]) + __uint_as_float(r[1]); }
#pragma unroll
    for (int k = 0; k < 2; ++k)
#pragma unroll
        for (int c = 0; c < 2; ++c) { const float snd = b3 ? a4[k][c] : a4[k + 2][c]; a2[k][c] = (b3 ? a4[k + 2][c] : a4[k][c]) + dpp_f<0x128>(snd); }
    *(u32x2*)(p.peer16 + (size_t)t * DM + col) = (u32x2){pk2(a2[0][0], a2[0][1]), pk2(a2[1][0], a2[1][1])};
}
__device__ __forceinline__ void dev_spmm(PREF p) {
    const int tid = tid_opaque(), w = tid >> 6, l = tid & 63, rsub = l >> 3, kc = l & 7;
    const int T = p.nb * SEQ; const int s = blockIdx.x & 3, sub = blockIdx.x >> 2, nsub = gridDim.x >> 2;
    const unsigned char* tab = p.v4 + (size_t)s * 16384 * 128; const unsigned kc16 = 16u * kc;
    const int col = 256 * s + 32 * kc + 2 * (8 * ((l >> 5) & 1) + 4 * ((l >> 4) & 1) + 2 * ((l >> 3) & 1));
    const int first = sub * 8 + w, S = nsub * 8;
    const int n = first < T ? (T - first + S - 1) / S : 0;
#define LD_W(W0, W1, W2, W3, t) do { const f32x4* wp_ = (const f32x4*)(p.gw + (size_t)(t) * 128 + 16 * rsub); W0 = wp_[0]; W1 = wp_[1]; W2 = wp_[2]; W3 = wp_[3]; } while (0)
    if (n > 0) {
        u32x4 RA[16], RB[16], eA0, eA1, eA2, eA3, eB0, eB1, eB2, eB3; f32x4 wA0, wA1, wA2, wA3, wB0, wB1, wB2, wB3;
        PEER_LD_E(eA0, eA1, eA2, eA3, TOKI(0)); LD_W(wA0, wA1, wA2, wA3, TOKI(0)); PEER_ISSUE(RA, eA0, eA1, eA2, eA3);
        PEER_LD_E(eB0, eB1, eB2, eB3, TOKI(1)); LD_W(wB0, wB1, wB2, wB3, TOKI(1));
        for (int i = 0; i < n; i += 2) {
            PEER_ISSUE(RB, eB0, eB1, eB2, eB3);
            PEER_LD_E(eA0, eA1, eA2, eA3, TOKI(i + 2));
            spmm_compute(p, RA, wA0, wA1, wA2, wA3, TOKI(i), col, l);
            LD_W(wA0, wA1, wA2, wA3, TOKI(i + 2));
            PEER_ISSUE(RA, eA0, eA1, eA2, eA3);
            PEER_LD_E(eB0, eB1, eB2, eB3, TOKI(i + 3));
            if (i + 1 < n) spmm_compute(p, RB, wB0, wB1, wB2, wB3, TOKI(i + 1), col, l);
            LD_W(wB0, wB1, wB2, wB3, TOKI(i + 3));
        }
    }
#undef LD_W
#undef TOKI
}
__device__ __forceinline__ void dev_final(PREF p) {
    const int tid = tid_opaque(), w = tid >> 6, lane = tid & 63; const int T = p.nb * SEQ;
    for (int t = blockIdx.x * 8 + w; t < T; t += gridDim.x * 8) {
        const float* g2p = p.mod + (size_t)(t >> 11) * 6144 + 5 * 1024;
        f32x4 xv[4]; float ss = 0.f;
#pragma unroll
        for (int i = 0; i < 4; ++i) { const int d = 4 * lane + 256 * i; const f32x4 x = *(const f32x4*)(p.x1 + (size_t)t * DM + d), gg = *(const f32x4*)(g2p + d);
            const u32x2 pv = *(const u32x2*)(p.peer16 + (size_t)t * DM + d);
            f32x4 r; r[0] = x[0] + gg[0] * bflo(pv[0]); r[1] = x[1] + gg[1] * bfhi(pv[0]); r[2] = x[2] + gg[2] * bflo(pv[1]); r[3] = x[3] + gg[3] * bfhi(pv[1]);
            ss += (r[0] * r[0] + r[1] * r[1]) + (r[2] * r[2] + r[3] * r[3]); xv[i] = r; }
        ss = wave_sum(ss);
        const float rs = rsqrtf(ss * (1.0f / 1024.0f) + 1e-6f);
#pragma unroll
        for (int i = 0; i < 4; ++i) { const int d = 4 * lane + 256 * i; const f32x4 fg = *(const f32x4*)(p.final_g + d);
            f32x4 o;
#pragma unroll
            for (int j = 0; j < 4; ++j) o[j] = xv[i][j] * rs * fg[j];
            *(f32x4*)(p.out + (size_t)t * DM + d) = o; }
    }
}


__device__ __forceinline__ void sddmm_accum(u32x4 (&R)[16], const u32x4 (&hb)[4], LAS unsigned char* wbuf, f32x4 (&acc)[8], int l) {
    const int rsub = l >> 3, kc = l & 7, rho = l & 15, kg = l >> 4;
    const int wr0 = rsub * 128 + ((kc ^ rsub) << 4), wr1 = (8 + rsub) * 128 + ((kc ^ rsub ^ 1) << 4);
    const int key = (rho & 7) ^ (rho >> 3), rbase = rho * 128;
    i32x8 b0, b1;
#pragma unroll
    for (int i = 0; i < 4; ++i) { b0[i] = (int)hb[0][i]; b0[4 + i] = (int)hb[1][i]; b1[i] = (int)hb[2][i]; b1[4 + i] = (int)hb[3][i]; }
#pragma unroll
    for (int t = 0; t < 8; ++t) {
        LAS unsigned char* buf = wbuf + (t & 1) * 2048;
        *(LAS u32x4*)(buf + wr0) = R[t]; *(LAS u32x4*)(buf + wr1) = R[t + 8];
        const u32x4 x0 = *(const LAS u32x4*)(buf + rbase + ((kg ^ key) << 4)), x1 = *(const LAS u32x4*)(buf + rbase + (((4 + kg) ^ key) << 4));
        i32x8 a0, a1;
#pragma unroll
        for (int i = 0; i < 4; ++i) { a0[i] = (int)x0[i]; a0[4 + i] = 0; a1[i] = (int)x1[i]; a1[4 + i] = 0; }
        f32x4 c = acc[t];
        c = __builtin_amdgcn_mfma_scale_f32_16x16x128_f8f6f4(a0, b0, c, 4, 0, 0, 0x7f7f7f7f, 0, 0x7f7f7f7f);
        c = __builtin_amdgcn_mfma_scale_f32_16x16x128_f8f6f4(a1, b1, c, 4, 0, 0, 0x7f7f7f7f, 0, 0x7f7f7f7f);
        acc[t] = c;
    }
}
__device__ __forceinline__ void dev_sddmm_act(PREF p, LAS unsigned char* lds) {
    const int tid = tid_opaque(), w = __builtin_amdgcn_readfirstlane(tid >> 6), l = tid & 63, rsub = l >> 3, kc = l & 7, kg = l >> 4, rho = l & 15;
    const int T = p.nb * SEQ;
    const unsigned kc16 = 16u * kc;
    const int first = blockIdx.x * 8 + w, S = gridDim.x * 8;
    const int n = first < T ? (T - first + S - 1) / S : 0;
    LAS unsigned char* wbuf = lds + w * 4096;
    const int reg = rho & 3, half = (rho >> 2) & 1, j0 = 16 * (4 * (kg & 1) + reg) + 8 * (kg >> 1) + 4 * half;
#define TOKI(i) (first + ((i) < n ? (i) : n - 1) * S)
#define SA_ISSUE(R, E0, E1, E2, E3, sl) do { const unsigned char* tab = p.u4 + (size_t)(sl) * 16384 * 128; PEER_ISSUE(R, E0, E1, E2, E3); } while (0)
#define SA_LD_H(H, t, sl) do { const unsigned char* hp_ = p.h8 + (size_t)(t) * DM + 256 * (sl) + 16 * kg; H[0] = *(const u32x4*)hp_; H[1] = *(const u32x4*)(hp_ + 64); H[2] = *(const u32x4*)(hp_ + 128); H[3] = *(const u32x4*)(hp_ + 192); } while (0)
    if (n > 0) {
        u32x4 RA[16], RB[16], eC0, eC1, eC2, eC3, eN0, eN1, eN2, eN3, hA[4], hB[4];
        PEER_LD_E(eC0, eC1, eC2, eC3, TOKI(0)); SA_LD_H(hA, TOKI(0), 0); SA_ISSUE(RA, eC0, eC1, eC2, eC3, 0);
        PEER_LD_E(eN0, eN1, eN2, eN3, TOKI(1));
        for (int i = 0; i < n; ++i) {
            const int t = TOKI(i);
            f32x4 acc[8];
#pragma unroll
            for (int k = 0; k < 8; ++k) acc[k] = (f32x4){0.f, 0.f, 0.f, 0.f};
            SA_ISSUE(RB, eC0, eC1, eC2, eC3, 1); SA_LD_H(hB, t, 1); sddmm_accum(RA, hA, wbuf, acc, l);
            SA_ISSUE(RA, eC0, eC1, eC2, eC3, 2); SA_LD_H(hA, t, 2); sddmm_accum(RB, hB, wbuf, acc, l);
            SA_ISSUE(RB, eC0, eC1, eC2, eC3, 3); SA_LD_H(hB, t, 3); sddmm_accum(RA, hA, wbuf, acc, l);
            const f32x4 sj = *(const f32x4*)(p.su + (size_t)t * 128 + j0); const f32x4 gj = *(const f32x4*)(p.gw + (size_t)t * 128 + j0);
            SA_ISSUE(RA, eN0, eN1, eN2, eN3, 0); SA_LD_H(hA, TOKI(i + 1), 0); sddmm_accum(RB, hB, wbuf, acc, l);
            eC0 = eN0; eC1 = eN1; eC2 = eN2; eC3 = eN3;
            PEER_LD_E(eN0, eN1, eN2, eN3, TOKI(i + 2));
            f32x4 o;
#pragma unroll
            for (int c4 = 0; c4 < 4; ++c4) { f32x4 lo = acc[c4], hi = acc[4 + c4];
                asm volatile("" : "+v"(lo), "+v"(hi));
                const f32x4 x = half ? hi : lo; float x0 = x[0], x1 = x[1], x2 = x[2], x3 = x[3];
                asm volatile("" : "+v"(x0), "+v"(x1), "+v"(x2), "+v"(x3));
                o[c4] = (reg & 2) ? ((reg & 1) ? x3 : x2) : ((reg & 1) ? x1 : x0); }
            f32x4 wv = (f32x4){0.f, 0.f, 0.f, 0.f};
            if (rho < 8) {
#pragma unroll
                for (int c4 = 0; c4 < 4; ++c4) wv[c4] = gj[c4] * gelu_f(o[c4] * (0.25f * sj[c4])); }
            float mx = fmaxf(fmaxf(fabsf(wv[0]), fabsf(wv[1])), fmaxf(fabsf(wv[2]), fabsf(wv[3])));
#pragma unroll
            for (int sh = 1; sh < 64; sh <<= 1) mx = fmaxf(mx, shx_f(mx, sh));
            const int bexp = max((__float_as_int(mx) >> 23) & 255, 8);
            const float wsc = __int_as_float((261 - bexp) << 23);
            if (rho < 8) { int w8v = 0; w8v = __builtin_amdgcn_cvt_pk_fp8_f32(wv[0] * wsc, wv[1] * wsc, w8v, false); w8v = __builtin_amdgcn_cvt_pk_fp8_f32(wv[2] * wsc, wv[3] * wsc, w8v, true);
                *(unsigned*)(p.w8 + (size_t)t * 128 + j0) = (unsigned)w8v; }
            if (l == 0) p.wsc[t] = __int_as_float((bexp - 7) << 23);
        }
    }
#undef SA_ISSUE
#undef SA_LD_H
#undef TOKI
}
#define SF_ISSUE(R, ESRC, LBASE) do { int es_ = ESRC; _Pragma("unroll") for (int r_ = 0; r_ < 32; ++r_) { if ((r_ & 7) == 0) asm volatile("" : "+v"(es_) :: "memory");     \
        const unsigned e_ = (unsigned)__builtin_amdgcn_readlane(es_, (LBASE) + r_); R[r_] = *(const u32x2*)(tab + (lane_off + e_ * 128u)); } } while (0)
#define SF_COMPUTE(R, WSRC, LBASE) do { int ws_ = __float_as_int(WSRC); _Pragma("unroll") for (int r_ = 0; r_ < 32; ++r_) { \
        if ((r_ & 3) == 0 && r_ > 0) asm volatile("" : "+v"(R[r_]), "+v"(R[r_ + 1]), "+v"(R[r_ + 2]), "+v"(R[r_ + 3]), "+v"(ws_) : "v"(acc[0])); \
        const float wj_ = __int_as_float(__builtin_amdgcn_readlane(ws_, (LBASE) + r_)); const f32x2 w2_ = (f32x2){wj_, wj_}; \
        _Pragma("unroll") for (int i_ = 0; i_ < 2; ++i_) { \
            acc[4 * i_ + 0] = w2_ * __builtin_amdgcn_cvt_scalef32_pk_f32_fp4(R[r_][i_], 1.0f, 0) + acc[4 * i_ + 0]; acc[4 * i_ + 1] = w2_ * __builtin_amdgcn_cvt_scalef32_pk_f32_fp4(R[r_][i_], 1.0f, 1) + acc[4 * i_ + 1]; \
            acc[4 * i_ + 2] = w2_ * __builtin_amdgcn_cvt_scalef32_pk_f32_fp4(R[r_][i_], 1.0f, 2) + acc[4 * i_ + 2]; acc[4 * i_ + 3] = w2_ * __builtin_amdgcn_cvt_scalef32_pk_f32_fp4(R[r_][i_], 1.0f, 3) + acc[4 * i_ + 3]; } } } while (0)
__device__ __forceinline__ void dev_spmm_final(PREF p) {
    const int tid = tid_opaque(), w = __builtin_amdgcn_readfirstlane(tid >> 6), l = tid & 63;
    const int T = p.nb * SEQ;
    const unsigned char* tab = p.v4; const unsigned lane_off = (unsigned)(l >> 4) * (16384u * 128u) + 8u * (unsigned)(l & 15);
    const int first = blockIdx.x * 8 + w, S = gridDim.x * 8;
    const int n = first < T ? (T - first + S - 1) / S : 0;
#define TOKJ(i) (first + ((i) < n ? (i) : n - 1) * S)
#define SF_LISTS(EL, EH, WL, WH, t) do { EL = p.eidx[(size_t)(t) * 128 + l]; EH = p.eidx[(size_t)(t) * 128 + 64 + l]; const float is_ = p.wsc[t]; \
        WL = __builtin_amdgcn_cvt_f32_fp8((int)p.w8[(size_t)(t) * 128 + l], 0) * is_; WH = __builtin_amdgcn_cvt_f32_fp8((int)p.w8[(size_t)(t) * 128 + 64 + l], 0) * is_; } while (0)
    if (n > 0) {
        u32x2 RA[32], RB[32]; int eCl, eCh, eNl, eNh; float wCl, wCh, wNl, wNh;
        SF_LISTS(eCl, eCh, wCl, wCh, TOKJ(0)); SF_ISSUE(RA, eCl, 0); SF_LISTS(eNl, eNh, wNl, wNh, TOKJ(1));
        for (int i = 0; i < n; ++i) {
            const int t = TOKJ(i);
            f32x2 acc[8];
#pragma unroll
            for (int k = 0; k < 8; ++k) acc[k] = (f32x2){0.f, 0.f};
            SF_ISSUE(RB, eCl, 32); SF_COMPUTE(RA, wCl, 0);
            SF_ISSUE(RA, eCh, 0);  SF_COMPUTE(RB, wCl, 32);
            SF_ISSUE(RB, eCh, 32); SF_COMPUTE(RA, wCh, 0);
            int lo16 = 16 * l; asm volatile("" : "+v"(lo16));
            const bf16_t* x1p = p.x1b + (size_t)t * DM + lo16; const float* g2p = p.mod + (size_t)(t >> 11) * 6144 + 5 * 1024 + lo16;
            f32x4 xv[4], gg[4];
            { const u32x4 xa = *(const u32x4*)x1p, xb = *(const u32x4*)(x1p + 8);
              xv[0] = (f32x4){bflo(xa[0]), bfhi(xa[0]), bflo(xa[1]), bfhi(xa[1])}; xv[1] = (f32x4){bflo(xa[2]), bfhi(xa[2]), bflo(xa[3]), bfhi(xa[3])};
              xv[2] = (f32x4){bflo(xb[0]), bfhi(xb[0]), bflo(xb[1]), bfhi(xb[1])}; xv[3] = (f32x4){bflo(xb[2]), bfhi(xb[2]), bflo(xb[3]), bfhi(xb[3])}; }
#pragma unroll
            for (int q = 0; q < 4; ++q) gg[q] = *(const f32x4*)(g2p + 4 * q);
            SF_ISSUE(RA, eNl, 0);  SF_COMPUTE(RB, wCh, 32);
            eCl = eNl; eCh = eNh; wCl = wNl; wCh = wNh;
            SF_LISTS(eNl, eNh, wNl, wNh, TOKJ(i + 2));
            float ss = 0.f;
#pragma unroll
            for (int q = 0; q < 4; ++q) { xv[q][0] += gg[q][0] * acc[2 * q][0]; xv[q][1] += gg[q][1] * acc[2 * q][1]; xv[q][2] += gg[q][2] * acc[2 * q + 1][0]; xv[q][3] += gg[q][3] * acc[2 * q + 1][1];
                ss += (xv[q][0] * xv[q][0] + xv[q][1] * xv[q][1]) + (xv[q][2] * xv[q][2] + xv[q][3] * xv[q][3]); }
            ss = wave_sum(ss);
            const float rs = rsqrtf(ss * (1.0f / 1024.0f) + 1e-6f);
#pragma unroll
            for (int q = 0; q < 4; ++q) { const f32x4 fg = *(const f32x4*)(p.final_g + lo16 + 4 * q); f32x4 o;
#pragma unroll
                for (int j = 0; j < 4; ++j) o[j] = xv[q][j] * rs * fg[j];
                *(f32x4*)(p.out + (size_t)t * DM + lo16 + 4 * q) = o; }
        }
    }
#undef TOKJ
#undef SF_LISTS
}

typedef int v2i_t __attribute__((ext_vector_type(2)));
__device__ __forceinline__ void spmm_slice(const u32x4 (&R)[16], const i32x8 bw, LAS unsigned char* wbuf, int wa, int rb, int L, f32x4& acc) {
#pragma unroll
    for (int i = 0; i < 16; ++i) { LAS u32x4* d = (LAS u32x4*)(wbuf + (wa ^ ((i >> 1) << 4)) + i * 128);
        if (i & 1) *d = (u32x4){R[i][2], R[i][3], R[i][0], R[i][1]}; else *d = R[i]; }
#pragma unroll
    for (int mf = 0; mf < 16; ++mf) {
        LAS unsigned char* ap = wbuf + (rb ^ (mf << 3));
        const v2i_t lo = __builtin_amdgcn_ds_read_tr4_b64_v2i32((LAS v2i_t*)ap), hi = __builtin_amdgcn_ds_read_tr4_b64_v2i32((LAS v2i_t*)(ap + 2048));
        i32x8 a; a[0] = lo[0]; a[1] = lo[1]; a[2] = hi[0]; a[3] = hi[1]; a[4] = 0; a[5] = 0; a[6] = 0; a[7] = 0;
        const f32x4 d = __builtin_amdgcn_mfma_scale_f32_16x16x128_f8f6f4(a, bw, (f32x4){0.f, 0.f, 0.f, 0.f}, 4, 0, 0, 0x7f7f7f7f, 0, 0x7f7f7f7f);
        const bool keep = (L == mf);
#pragma unroll
        for (int j = 0; j < 4; ++j) acc[j] = keep ? d[j] : acc[j];
    }
}
__device__ __forceinline__ void dev_spmm_mfma(PREF p, LAS unsigned char* lds) {
    const int tid = tid_opaque(), w = __builtin_amdgcn_readfirstlane(tid >> 6), l = tid & 63, rsub = l >> 3, kc = l & 7, L = l & 15, g = l >> 4;
    const int T = p.nb * SEQ;
    const unsigned kc16 = 16u * kc;
    const int first = blockIdx.x * 8 + w, S = gridDim.x * 8;
    const int n = first < T ? (T - first + S - 1) / S : 0;
    LAS unsigned char* wbuf = lds + w * 16384;
    const int wa = rsub * 2048 + (kc << 4);
    const int rb = g * 4096 + L * 128 + (L << 3);
#define TOKI(i) (first + ((i) < n ? (i) : n - 1) * S)
#define SV_ISSUE(R, E0, E1, E2, E3, sl) do { const unsigned char* tab = p.v4 + (size_t)(sl) * 16384 * 128; PEER_ISSUE(R, E0, E1, E2, E3); } while (0)
    if (n > 0) {
        u32x4 RA[16], RB[16], eC0, eC1, eC2, eC3;
        PEER_LD_E(eC0, eC1, eC2, eC3, TOKI(0)); SV_ISSUE(RA, eC0, eC1, eC2, eC3, 0);
        for (int i = 0; i < n; ++i) {
            const int t = TOKI(i);
            const unsigned char* wp = p.w8 + (size_t)t * 128 + 16 * g;
            const u32x4 w0 = *(const u32x4*)wp, w1 = *(const u32x4*)(wp + 64);
            i32x8 bw;
#pragma unroll
            for (int j = 0; j < 4; ++j) { bw[j] = (int)w0[j]; bw[4 + j] = (int)w1[j]; }
            const float isc = p.wsc[t];
            f32x4 acc[4];
#pragma unroll
            for (int k = 0; k < 4; ++k) acc[k] = (f32x4){0.f, 0.f, 0.f, 0.f};
            SV_ISSUE(RB, eC0, eC1, eC2, eC3, 1); spmm_slice(RA, bw, wbuf, wa, rb, L, acc[0]);
            SV_ISSUE(RA, eC0, eC1, eC2, eC3, 2); spmm_slice(RB, bw, wbuf, wa, rb, L, acc[1]);
            SV_ISSUE(RB, eC0, eC1, eC2, eC3, 3);
            PEER_LD_E(eC0, eC1, eC2, eC3, TOKI(i + 1));
            spmm_slice(RA, bw, wbuf, wa, rb, L, acc[2]);
            int col4 = 16 * L + 4 * g; asm volatile("" : "+v"(col4));
            const bf16_t* x1p = p.x1b + (size_t)t * DM + col4; const float* g2p = p.mod + (size_t)(t >> 11) * 6144 + 5 * 1024 + col4;
            u32x2 xq[4]; f32x4 gg[4];
#pragma unroll
            for (int q = 0; q < 4; ++q) { xq[q] = __builtin_nontemporal_load((const u32x2*)(x1p + 256 * q)); gg[q] = *(const f32x4*)(g2p + 256 * q); }
            SV_ISSUE(RA, eC0, eC1, eC2, eC3, 0); spmm_slice(RB, bw, wbuf, wa, rb, L, acc[3]);
            f32x4 xv[4]; float ss = 0.f;
#pragma unroll
            for (int q = 0; q < 4; ++q) { xv[q] = (f32x4){bflo(xq[q][0]), bfhi(xq[q][0]), bflo(xq[q][1]), bfhi(xq[q][1])};
#pragma unroll
                for (int j = 0; j < 4; ++j) xv[q][j] += gg[q][j] * (acc[q][j] * isc);
                ss += (xv[q][0] * xv[q][0] + xv[q][1] * xv[q][1]) + (xv[q][2] * xv[q][2] + xv[q][3] * xv[q][3]); }
            ss = wave_sum(ss);
            const float rs = rsqrtf(ss * (1.0f / 1024.0f) + 1e-6f);
#pragma unroll
            for (int q = 0; q < 4; ++q) { const f32x4 fg = *(const f32x4*)(p.final_g + col4 + 256 * q); f32x4 o;
#pragma unroll
                for (int j = 0; j < 4; ++j) o[j] = xv[q][j] * rs * fg[j];
                __builtin_nontemporal_store(o, (f32x4*)(p.out + (size_t)t * DM + col4 + 256 * q)); }
        }
    }
#undef SV_ISSUE
#undef TOKI
}

__device__ __forceinline__ void dev_gemm_in(PREF p, LAS unsigned char* lds) {
    const int T = p.nb * SEQ, TC = p.nb * CTXL;
    {
        pg8::Gemm g{p.hc, p.Wt_in + (size_t)512 * DM, DM, DM, DM, 0, 0}; pg8::StaticOrder S; S.init(TC, 1024, gridDim.x, blockIdx.x);
        pg8::EpiAct E{p.zxc, 0, 0, 1 << 20, DM, 0, 0};
        pg8::gemm_phase(lds, g, S, E);
    }
    {
        pg8::Gemm g{p.h, p.Wt_in + (size_t)512 * DM, DM, DM, DM, 0, 0}; pg8::StaticOrder S; S.init(T, 4096, gridDim.x, blockIdx.x);
        pg8::EpiAct E{p.zx, p.zseg, 0x2210, 4, DM, 1, 0};
        pg8::gemm_phase(lds, g, S, E);
    }
    {
        pg8::Gemm g{p.Wt_in, p.h, DM, DM, DM, 0, 0}; pg8::StaticOrder S; S.init(512, T, gridDim.x, blockIdx.x);
        pg8::EpiAct E{p.zfT, (size_t)512 * SEQ, 0, SEQ / 256, SEQ, 0, 0};
        pg8::gemm_phase(lds, g, S, E);
    }
}
__device__ __forceinline__ void dev_gemm_dft(PREF p, LAS unsigned char* lds) {
    const int T = p.nb * SEQ;
    pg8::Gemm g{p.dft, p.zfT, SEQ, SEQ, SEQ, 0, (long)512 * SEQ}; pg8::BatchOrder S; S.init(2048, 512, p.nb, gridDim.x, blockIdx.x);
    pg8::EpiUV E{p.UV};
    pg8::gemm_phase(lds, g, S, E);
}
__device__ __forceinline__ void dev_gemm_mix(PREF p, LAS unsigned char* lds) {
    const int T = p.nb * SEQ;
    {
        pg8::Gemm g{p.UV, p.Wfp, DM, DM, DM, 0, 0}; pg8::StaticOrder S; S.init(T, 1024, gridDim.x, blockIdx.x);
        pg8::EpiGate E{p.sga, nullptr, p.Pb};
        pg8::gemm_phase(lds, g, S, E);
    }
    {
        pg8::Gemm g{p.ybin, p.Wt_lru, DM, DM, DM, 0, 0}; pg8::StaticOrder S; S.init(T, 1024, gridDim.x, blockIdx.x);
        pg8::EpiGate E{p.sgb, p.Pb, p.merged};
        pg8::gemm_phase(lds, g, S, E);
    }
}
__device__ __forceinline__ void dev_gemm_out(PREF p, LAS unsigned char* lds) {
    const int T = p.nb * SEQ;
    pg8::Gemm g{p.merged, p.Wt_out, DM, DM, DM, 0, 0, 1, 0}; pg8::StaticOrder S; S.init(T, 1024, gridDim.x, blockIdx.x);
    pg8::EpiX1 E{p.x, p.pos, p.mod, p.b_out, p.x1b};
    pg8::gemm_phase(lds, g, S, E);
}
__device__ __forceinline__ void dev_gemm_q(PREF p, LAS unsigned char* lds) {
    const int T = p.nb * SEQ;
    pg8::Gemm g{p.h2, p.Wt_q, DM, DM, DM, 0, 0}; pg8::StaticOrder S; S.init(T, 2048, gridDim.x, blockIdx.x);
    pg8::EpiAct E{p.q, 0, 0, 1 << 20, 2048, 1, 1};
    pg8::gemm_phase(lds, g, S, E);
}

#define KERNEL_HEAD extern __shared__ __attribute__((aligned(16))) unsigned char smem_raw[]; LAS unsigned char* lds = (LAS unsigned char*)smem_raw;
#ifdef DIAG
__global__ void __launch_bounds__(NTHR, 2) k_prep_t(Params p) { KERNEL_HEAD
    dev_transpose(p.w_in, 4608, 0, 1024, 4608, p.Wt_in, 1, 0, 0, lds, 0, (int)gridDim.x);
    dev_transpose(p.w_lru_out, 1024, 0, 1024, 1024, p.Wt_lru, 1, 0, 0, lds, 0, (int)gridDim.x);
    dev_transpose(p.w_out, 1024, 0, 1024, 1024, p.Wt_out, 1, 0, 0, lds, 0, (int)gridDim.x);
    dev_transpose(p.peer_wq, 2048, 0, 1024, 2048, p.Wt_q, 1, 0, 0, lds, 0, (int)gridDim.x);
    dev_transpose(p.lru_wa, 128, 0, 128, 128, p.gates_bf, 8, 16384, 16384, lds, 0, (int)gridDim.x);
    dev_transpose(p.lru_wx, 128, 0, 128, 128, p.gates_bf + (size_t)8 * 16384, 8, 16384, 16384, lds, 0, (int)gridDim.x);
    dev_transpose(p.lru_wa + (size_t)8 * 16384, 128, 0, 128, 128, p.gates_bf + (size_t)16 * 16384, 8, 16384, 16384, lds, 0, (int)gridDim.x);
    dev_transpose(p.lru_wx + (size_t)8 * 16384, 128, 0, 128, 128, p.gates_bf + (size_t)24 * 16384, 8, 16384, 16384, lds, 0, (int)gridDim.x);
}
__global__ void __launch_bounds__(NTHR, 2) k_prep_c(Params p) { KERNEL_HEAD
    dev_convert(p.peer_keys, p.keys_bf, (size_t)8 * 2 * 128 * 128);
    dev_convert(p.peer_u, p.u_bf, (size_t)16384 * 1024);
    dev_convert(p.peer_v, p.v_bf, (size_t)16384 * 1024);
    dev_wfp(p, lds);
    dev_dft(p);
    dev_pos(p);
}
__global__ void __launch_bounds__(NTHR, 2) k_adaln(Params p) { KERNEL_HEAD dev_adaln(p, lds); }
__global__ void __launch_bounds__(NTHR, 2) k_norm1(Params p) { dev_norm(p, 0); }
__global__ void __launch_bounds__(NTHR, 2) k_gemm_in(Params p) { KERNEL_HEAD dev_gemm_in(p, lds); }
__global__ void __launch_bounds__(NTHR, 2) k_scan(Params p) { KERNEL_HEAD dev_scan(p, lds); }
__global__ void __launch_bounds__(NTHR, 2) k_gemm_dft(Params p) { KERNEL_HEAD dev_gemm_dft(p, lds); }
__global__ void __launch_bounds__(NTHR, 2) k_gemm_mix(Params p) { KERNEL_HEAD dev_gemm_mix(p, lds); }
__global__ void __launch_bounds__(NTHR, 2) k_gemm_out(Params p) { KERNEL_HEAD dev_gemm_out(p, lds); }
__global__ void __launch_bounds__(NTHR, 2) k_norm2(Params p) { dev_norm(p, 1); }
__global__ void __launch_bounds__(NTHR, 2) k_gemm_q(Params p) { KERNEL_HEAD dev_gemm_q(p, lds); }
__global__ void __launch_bounds__(NTHR, 2) k_topk(Params p) { dev_topk(p); }
__global__ void __launch_bounds__(NTHR, 2) k_peer(Params p) { dev_peer(p); }


#endif
namespace cg = cooperative_groups;

#define XB_TMO      128
#define XB_XCNT(j)  (256  + 64 * (j))
#define XB_XSUB(j)  (1280 + 64 * (j))
#define XB_XGEN(j)  (2304 + 64 * (j))
#define XB_TOP      3328
#define XB_TOPGEN   3392
#define XCD_BAR_WORDS 3456
#define XB_SPIN_CAP (1u << 22)
__device__ __forceinline__ unsigned xb_ld(unsigned* p)              { return __hip_atomic_load(p, __ATOMIC_RELAXED, __HIP_MEMORY_SCOPE_AGENT); }
__device__ __forceinline__ unsigned xb_add(unsigned* p, unsigned v) { return __hip_atomic_fetch_add(p, v, __ATOMIC_RELAXED, __HIP_MEMORY_SCOPE_AGENT); }
__device__ __forceinline__ unsigned xb_xcc_id() { return (unsigned)__builtin_amdgcn_s_getreg((3 << 11) | 20) & 0xFu; }
#define XB_SPIN(cond, bar) do { unsigned _sp = 0; while (cond) { __builtin_amdgcn_s_sleep(1); \
    if ((++_sp & 255u) == 0u) { if (xb_ld(&(bar)[XB_TMO])) break; if (_sp > XB_SPIN_CAP) { atomicAdd(&(bar)[XB_TMO], 1u); break; } } } } while (0)
struct XcdBarrier { unsigned* bar; unsigned x; volatile LAS unsigned* st; };
__device__ __forceinline__ XcdBarrier xcd_barrier_post(unsigned* bar, volatile LAS unsigned* st) {
    XcdBarrier b; b.bar = bar; b.x = xb_xcc_id(); b.st = st;
    if (threadIdx.x == 0) (void)xb_add(&bar[XB_XCNT(b.x)], 1u);
    return b;
}
__device__ __forceinline__ void xcd_barrier_complete(unsigned* bar, unsigned x, unsigned& nloc, unsigned& nx) {
    const unsigned G = gridDim.x * gridDim.y * gridDim.z;
    unsigned sum, cnt, mine, sp = 0u;
    for (;;) {
        sum = 0u; cnt = 0u; mine = 0u;
#pragma unroll
        for (unsigned j = 0; j < 16; ++j) { const unsigned c = xb_ld(&bar[XB_XCNT(j)]); sum += c; cnt += (c > 0u) ? 1u : 0u; mine = (j == x) ? c : mine; }
        if (sum == G) break;
        __builtin_amdgcn_s_sleep(1);
        if ((++sp & 255u) == 0u) { if (xb_ld(&bar[XB_TMO])) break; if (sp > XB_SPIN_CAP) { atomicAdd(&bar[XB_TMO], 1u); break; } }
    }
    nloc = mine > 0u ? mine : 1u; nx = cnt > 0u ? cnt : 1u;
}
__device__ __forceinline__ void xcd_barrier(const XcdBarrier& b) {
    asm volatile("s_waitcnt vmcnt(0)" ::: "memory");
    __syncthreads();
    if (threadIdx.x == 0) {
        unsigned* bar = b.bar;
        __builtin_amdgcn_s_waitcnt(0);
        unsigned nloc = b.st[0], nx = b.st[1];
        if (nloc == 0u) { xcd_barrier_complete(bar, b.x, nloc, nx); b.st[0] = nloc; b.st[1] = nx; }
        const unsigned old = xb_add(&bar[XB_XSUB(b.x)], 1u);
        const unsigned gen = old / nloc;
        if (old + 1u == (gen + 1u) * nloc) {
            __builtin_amdgcn_fence(__ATOMIC_RELEASE, "agent");
            asm volatile("s_waitcnt vmcnt(0)" ::: "memory");
            const unsigned og = xb_add(&bar[XB_TOP], 1u);
            const unsigned tg = og / nx;
            if (og + 1u == (tg + 1u) * nx) xb_add(&bar[XB_TOPGEN], 1u);
            else XB_SPIN(xb_ld(&bar[XB_TOPGEN]) == tg, bar);
            __builtin_amdgcn_fence(__ATOMIC_ACQUIRE, "agent");
            xb_add(&bar[XB_XGEN(b.x)], 1u);
            asm volatile("s_waitcnt vmcnt(0)" ::: "memory");
        } else {
            XB_SPIN(xb_ld(&bar[XB_XGEN(b.x)]) == gen, bar);
            __builtin_amdgcn_fence(__ATOMIC_ACQUIRE, "agent");
            asm volatile("s_waitcnt vmcnt(0)" ::: "memory");
        }
    }
    __syncthreads();
}

#ifndef DIAG
__device__ __forceinline__ CParams* kparams() { CParams* q = (CParams*)__builtin_amdgcn_kernarg_segment_ptr(); asm volatile("" : "+s"(q)); return q; }
__global__ void __launch_bounds__(NTHR, 2) k_mega(Params p_unused) { KERNEL_HEAD
    cg::grid_group grid = cg::this_grid();
    volatile LAS unsigned* bst = (volatile LAS unsigned*)(lds + LDS_BYTES - 16);
    if (blockIdx.x == 0) { CParams& p = *kparams(); for (int i = tid_opaque(); i < XCD_BAR_WORDS; i += NTHR) p.bar[i] = 0u; }
    if (tid_opaque() < 2) bst[tid_opaque()] = 0u;
    { CParams& p = *kparams(); dev_adaln(p, lds); }
    __syncthreads();
    { CParams& p = *kparams();
      const int G = (int)gridDim.x, G8 = (G & 7) ? G : (G >> 3), gf = (G & 7) ? 0 : (G >> 1);
      dev_transpose(p.w_in, 4608, 0, 1024, 4608, p.Wt_in, 1, 0, 0, lds, 0, G);
      dev_transpose(p.lru_wa, 128, 0, 128, 128, p.gates_bf, 8, 16384, 16384, lds, gf, G8);
      dev_transpose(p.lru_wx, 128, 0, 128, 128, p.gates_bf + (size_t)8 * 16384, 8, 16384, 16384, lds, (G & 7) ? 0 : gf + G8, G8);
      dev_transpose(p.lru_wa + (size_t)8 * 16384, 128, 0, 128, 128, p.gates_bf + (size_t)16 * 16384, 8, 16384, 16384, lds, (G & 7) ? 0 : gf + 2 * G8, G8);
      dev_transpose(p.lru_wx + (size_t)8 * 16384, 128, 0, 128, 128, p.gates_bf + (size_t)24 * 16384, 8, 16384, 16384, lds, (G & 7) ? 0 : gf + 3 * G8, G8);
      dev_transpose(p.w_lru_out, 1024, 0, 1024, 1024, p.Wt_lru, 1, 0, 0, lds, 0, G);
      dev_transpose(p.w_out, 1024, 0, 1024, 1024, p.Wt_out, 1, 0, 0, lds, 0, G);
      dev_transpose(p.peer_wq, 2048, 0, 1024, 2048, p.Wt_q, 1, 0, 0, lds, 0, G); }
    { CParams& p = *kparams();
      dev_convert(p.peer_keys, p.keys_bf, (size_t)8 * 2 * 128 * 128);
      if (blockIdx.x == 0 && tid_opaque() < 2) p.tmax[tid_opaque()] = 0u; }
    { CParams& p = *kparams(); dev_wfp(p, lds); }
    { CParams& p = *kparams(); dev_dft(p); dev_pos(p); }
    grid.sync();
    XcdBarrier xbar; { CParams& p = *kparams(); xbar = xcd_barrier_post(p.bar, bst); }
    { CParams& p = *kparams(); dev_norm(p, 0); }
    xcd_barrier(xbar);
    { CParams& p = *kparams(); dev_tab8(p); }
    { CParams& p = *kparams(); dev_gemm_in(p, lds); }
    xcd_barrier(xbar);
    { CParams& p = *kparams(); dev_scan(p, lds); }
    { CParams& p = *kparams(); dev_gemm_dft(p, lds); }
    xcd_barrier(xbar);
    { CParams& p = *kparams(); dev_gemm_mix(p, lds); }
    xcd_barrier(xbar);
    { CParams& p = *kparams(); dev_gemm_out(p, lds); }
    xcd_barrier(xbar);
    { CParams& p = *kparams(); dev_norm(p, 1); }
    xcd_barrier(xbar);
    { CParams& p = *kparams(); dev_gemm_q(p, lds); }
    xcd_barrier(xbar);
    { CParams& p = *kparams(); dev_topk(p, lds); }
    xcd_barrier(xbar);
    { CParams& p = *kparams(); dev_sddmm_act(p, lds); }
    asm volatile("s_waitcnt vmcnt(0)" ::: "memory");
    __syncthreads();
    { CParams& p = *kparams(); dev_spmm_mfma(p, lds); }
}
#endif

#ifdef DIAG
__device__ __forceinline__ unsigned hsh(unsigned a, unsigned b) { unsigned x = a * 0x9E3779B1u ^ (b + 0x7F4A7C15u) * 0x85EBCA6Bu; x ^= x >> 15; x *= 0x2C1B3C6Du; x ^= x >> 12; x *= 0x297A2D39u; x ^= x >> 15; return x; }
__device__ __forceinline__ void rep(unsigned* slot, float got, float ref, float floor_) {
    float err = fabsf(got - ref) / (fabsf(ref) + floor_); if (!(err < 1e30f)) err = 1e30f; atomicMax(slot, __float_as_uint(err));
}
__device__ __forceinline__ float pos_direct(int t, int d) { const int j = d & 255, part = d >> 8; const float omega = 1.0f / powf(10000.0f, (float)j / 256.0f);
    const float arg = (float)(part < 2 ? (t >> 6) : (t & 63)) * omega; return (part & 1) ? cosf(arg) : sinf(arg); }
__global__ void chk_mod(Params p) {
    const int s = blockIdx.x * blockDim.x + threadIdx.x; const unsigned hv = hsh(s, 1); const int r = hv % 33, n = (hv >> 8) % 6144;
    const float* cond = r < 32 ? p.c + r * 1024 : p.c_ctx; float acc = p.b_mod[n];
    for (int k = 0; k < 1024; ++k) { const float v = cond[k]; acc += (v / (1.0f + expf(-v))) * p.w_mod[(size_t)k * 6144 + n]; }
    rep(p.diag + 1, p.mod[(size_t)r * 6144 + n], acc, 0.3f);
}
__global__ void chk_norm(Params p, int which) {
    const int s = blockIdx.x * blockDim.x + threadIdx.x; const unsigned hv = hsh(s, 2 + which);
    const int T = p.nb * SEQ, TC = which == 0 ? p.nb * CTXL : 0; const int row = hv % (T + TC), d = (hv >> 12) % 1024;
    const bool isctx = row >= T; const int lrow = isctx ? row - T : row; const int b = isctx ? 32 : lrow >> 11;
    const float* src = which == 1 ? p.x1 + (size_t)lrow * DM : (isctx ? p.ctx + (size_t)lrow * DM : p.x + (size_t)lrow * DM);
    float ss = 0.f, vd = 0.f;
    for (int k = 0; k < 1024; ++k) { float v = src[k]; if (which == 0 && !isctx) v += pos_direct(lrow & 2047, k); ss += v * v; if (k == d) vd = v; }
    const float rs = 1.0f / sqrtf(ss / 1024.0f + 1e-6f);
    const float* md = p.mod + (size_t)b * 6144 + (which == 0 ? 0 : 3 * 1024);
    const float ref = (vd * rs * (which == 0 ? p.norm1_g[d] : p.norm2_g[d])) * (1.0f + md[1024 + d]) + md[d];
    const bf16_t* dst = which == 1 ? p.h2 + (size_t)lrow * DM : (isctx ? p.hc + (size_t)lrow * DM : p.h + (size_t)lrow * DM);
    rep(p.diag + (which == 0 ? 2 : 8), bf2f(dst[d]), ref, 0.3f);
}
__global__ void chk_z(Params p) {
    const int s = blockIdx.x * blockDim.x + threadIdx.x; const unsigned hv = hsh(s, 5);
    const int T = p.nb * SEQ, TC = p.nb * CTXL;
    if (s & 1) { const int row = hv % T, col = (hv >> 13) % 4608; float acc = 0.f;
        for (int k = 0; k < 1024; ++k) acc += bf2f(p.h[(size_t)row * DM + k]) * p.w_in[(size_t)k * 4608 + col];
        float got;
        if (col < 512) got = bf2f(p.zfT[(size_t)col * T + row]);
        else if (col < 1536) got = bf2f(p.zx[(size_t)row * DM + col - 512]);
        else if (col < 2560) { got = bf2f(p.gzy[(size_t)row * DM + col - 1536]); acc = 0.5f * acc * (1.0f + tanhf(0.7978845608f * (acc + 0.044715f * acc * acc * acc))); }
        else if (col < 3584) { got = bf2f(p.sga[(size_t)row * DM + col - 2560]); acc = 1.0f / (1.0f + expf(-acc)); }
        else { got = bf2f(p.sgb[(size_t)row * DM + col - 3584]); acc = 1.0f / (1.0f + expf(-acc)); }
        rep(p.diag + 3, got, acc, 0.5f);
    } else { const int row = hv % TC, col = 512 + (hv >> 13) % 1024; float acc = 0.f;
        for (int k = 0; k < 1024; ++k) acc += bf2f(p.hc[(size_t)row * DM + k]) * p.w_in[(size_t)k * 4608 + col];
        rep(p.diag + 3, bf2f(p.zxc[(size_t)row * DM + col - 512]), acc, 0.5f); }
}
__global__ void chk_uv(Params p) {
    const int s = blockIdx.x * blockDim.x + threadIdx.x; const unsigned hv = hsh(s, 6);
    const int T = p.nb * SEQ; const int b = hv % p.nb, kt = (hv >> 4) % 2048, ch = (hv >> 15) % 512, part = (hv >> 25) & 1;
    float acc = 0.f;
    for (int t = 0; t < 2048; ++t) { const float a = (float)((kt * t) & 2047) / 1024.0f; acc += (part ? sinpif(a) : cospif(a)) * bf2f(p.zfT[(size_t)ch * T + b * 2048 + t]); }
    rep(p.diag + 4, bf2f(p.UV[((size_t)b * 2048 + kt) * DM + part * 512 + ch]), acc, 16.0f);
}
__global__ void __launch_bounds__(512) chk_scan(Params p) {
    __shared__ float AF[2304], BF[2304], AB[2304], BB[2304];
    const unsigned hv = hsh(blockIdx.x, 7); const int b = hv % p.nb, c = (hv >> 8) % 1024, head = c >> 7, cc = c & 127;
    for (int tp = threadIdx.x; tp < 2304; tp += blockDim.x) {
        const bool isctx = tp < 256; const int t = isctx ? tp : tp - 256, Tseq = isctx ? 256 : 2048;
        const bf16_t* src = isctx ? p.zxc + (size_t)b * 256 * DM : p.zx + (size_t)b * 2048 * DM;
        float gaf = 0.f, gxf = 0.f, gab = 0.f, gxb = 0.f, xcc = 0.f;
        for (int i = 0; i < 128; ++i) { const int hi = head * 128 + i; float xci = p.conv_b[hi];
            for (int r = 0; r < 4; ++r) { const int tr = t - 1 + r; if (tr >= 0 && tr < Tseq) xci += p.conv_w[r * 1024 + hi] * bf2f(src[(size_t)tr * DM + hi]); }
            const size_t wo = ((size_t)head * 128 + i) * 128 + cc;
            gaf += xci * p.lru_wa[wo]; gxf += xci * p.lru_wx[wo]; gab += xci * p.lru_wa[(size_t)8 * 16384 + wo]; gxb += xci * p.lru_wx[(size_t)8 * 16384 + wo];
            if (i == cc) xcc = xci; }
        { const float r = 1.0f / (1.0f + expf(-(gaf + p.lru_ba[c]))), ig = 1.0f / (1.0f + expf(-(gxf + p.lru_bx[c])));
          const float la = -8.0f * r * log1pf(expf(-p.lru_lambda[c])); AF[tp] = expf(la); BF[tp] = sqrtf(fmaxf(0.f, -expm1f(2.0f * la))) * ig * xcc; }
        { const float r = 1.0f / (1.0f + expf(-(gab + p.lru_ba[1024 + c]))), ig = 1.0f / (1.0f + expf(-(gxb + p.lru_bx[1024 + c])));
          const float la = -8.0f * r * log1pf(expf(-p.lru_lambda[1024 + c])); AB[tp] = expf(la); BB[tp] = sqrtf(fmaxf(0.f, -expm1f(2.0f * la))) * ig * xcc; }
    }
    __syncthreads();
    if (threadIdx.x == 0) { float h = 0.f; for (int tp = 0; tp < 2304; ++tp) { h = AF[tp] * h + BF[tp]; AF[tp] = h; } }
    if (threadIdx.x == 64) { float h = 0.f; for (int tp = 255; tp >= 0; --tp) { h = AB[tp] * h + BB[tp]; AB[tp] = h; } for (int tp = 2303; tp >= 256; --tp) { h = AB[tp] * h + BB[tp]; AB[tp] = h; } }
    __syncthreads();
    for (int t = threadIdx.x; t < 2048; t += blockDim.x) { float z = 0.f; const size_t row = (size_t)b * 2048 + t;
        for (int k = 0; k < 1024; ++k) z += bf2f(p.h[row * DM + k]) * p.w_in[(size_t)k * 4608 + 1536 + c];
        const float gz = 0.5f * z * (1.0f + tanhf(0.7978845608f * (z + 0.044715f * z * z * z)));
        rep(p.diag + 5, bf2f(p.ybin[row * DM + c]), (AF[256 + t] + AB[256 + t]) * gz, 0.25f); }
}
__global__ void chk_merged(Params p) {
    const int s = blockIdx.x * blockDim.x + threadIdx.x; const unsigned hv = hsh(s, 8); const int T = p.nb * SEQ; const int row = hv % T, col = (hv >> 13) % 1024;
    float ya = 0.f;
    for (int g = 0; g < 4; ++g) for (int kc = 0; kc < 128; ++kc) { float y = 0.f;
        for (int c = 0; c < 128; ++c) { const float a = (float)((kc * c) & 127) / 64.0f; y += bf2f(p.UV[(size_t)row * DM + g * 128 + c]) * cospif(a) - bf2f(p.UV[(size_t)row * DM + 512 + g * 128 + c]) * sinpif(a); }
        ya += (y / 512.0f) * p.w_fourier[(size_t)(g * 128 + kc) * 1024 + col]; }
    float yb = 0.f;
    for (int k = 0; k < 1024; ++k) yb += bf2f(p.ybin[(size_t)row * DM + k]) * p.w_lru_out[(size_t)k * 1024 + col];
    const float ref = bf2f(p.sga[(size_t)row * DM + col]) * ya + bf2f(p.sgb[(size_t)row * DM + col]) * yb;
    rep(p.diag + 6, bf2f(p.merged[(size_t)row * DM + col]), ref, 0.4f);
}
__global__ void chk_x1(Params p) {
    const int s = blockIdx.x * blockDim.x + threadIdx.x; const unsigned hv = hsh(s, 9); const int T = p.nb * SEQ; const int row = hv % T, col = (hv >> 13) % 1024, b = row >> 11;
    float acc = p.b_out[col];
    for (int k = 0; k < 1024; ++k) acc += bf2f(p.merged[(size_t)row * DM + k]) * p.w_out[(size_t)k * 1024 + col];
    const float ref = p.x[(size_t)row * DM + col] + pos_direct(row & 2047, col) + p.mod[(size_t)b * 6144 + 2048 + col] * acc;
    rep(p.diag + 7, p.x1[(size_t)row * DM + col], ref, 1.0f);
}
__global__ void chk_q(Params p) {
    const int s = blockIdx.x * blockDim.x + threadIdx.x; const unsigned hv = hsh(s, 10); const int T = p.nb * SEQ; const int row = hv % T, col = (hv >> 13) % 2048;
    float acc = 0.f;
    for (int k = 0; k < 1024; ++k) acc += bf2f(p.h2[(size_t)row * DM + k]) * p.peer_wq[(size_t)k * 2048 + col];
    rep(p.diag + 9, bf2f(p.q[(size_t)row * 2048 + col]), acc, 0.5f);
}
__global__ void __launch_bounds__(256) chk_topk(Params p) {
    __shared__ float sc[256]; __shared__ float cand[256]; __shared__ int top0[16], top1[16], refe[16]; __shared__ float tv0[16], tv1[16], refv[16];
    const unsigned hv = hsh(blockIdx.x, 11); const int T = p.nb * SEQ; const int tok = hv % T, hd = (hv >> 16) & 7; const int j = threadIdx.x, ph = j >> 7, key = j & 127;
    float a = 0.f;
    for (int d = 0; d < 128; ++d) a += bf2f(p.q[(size_t)tok * 2048 + hd * 256 + ph * 128 + d]) * p.peer_keys[((size_t)(hd * 2 + ph) * 128 + key) * 128 + d];
    sc[j] = a; __syncthreads();
    if (j == 0) {
        for (int hf = 0; hf < 2; ++hf) for (int r = 0; r < 16; ++r) { int bi = 0; float bv = -1e30f; for (int k = 0; k < 128; ++k) if (sc[hf * 128 + k] > bv) { bv = sc[hf * 128 + k]; bi = k; }
            sc[hf * 128 + bi] = -1e30f; if (hf == 0) { top0[r] = bi; tv0[r] = bv; } else { top1[r] = bi; tv1[r] = bv; } }
        for (int i = 0; i < 16; ++i) for (int k = 0; k < 16; ++k) cand[i * 16 + k] = tv0[i] + tv1[k];
        for (int r = 0; r < 16; ++r) { int bi = 0; float bv = -1e30f; for (int k = 0; k < 256; ++k) if (cand[k] > bv) { bv = cand[k]; bi = k; }
            cand[bi] = -1e30f; refe[r] = top0[bi >> 4] * 128 + top1[bi & 15]; refv[r] = bv; }
        const float mx = refv[0]; float sum = 0.f;
        for (int r = 0; r < 16; ++r) sum += expf(refv[r] - mx);
        int bad = 0;
        for (int k = 0; k < 16; ++k) { const int e = p.eidx[(size_t)tok * 128 + hd * 16 + k]; const float g = p.gw[(size_t)tok * 128 + hd * 16 + k]; bool ok = false;
            for (int r = 0; r < 16; ++r) if (refe[r] == e) { const float gr = expf(refv[r] - mx) / sum; if (fabsf(g - gr) <= 0.05f * gr + 0.003f) ok = true; }
            if (!ok) ++bad; }
        atomicMax(p.diag + 10, __float_as_uint((float)bad / 16.0f)); atomicMax(p.diag + 16, (unsigned)bad);
        { int nf = 0; float sg = 0.f;
          for (int k = 0; k < 16; ++k) { const int e = p.eidx[(size_t)tok * 128 + hd * 16 + k]; sg += p.gw[(size_t)tok * 128 + hd * 16 + k]; bool f = false; for (int r = 0; r < 16; ++r) if (refe[r] == e) f = true; if (!f) ++nf; }
          atomicMax(p.diag + 12, (unsigned)nf); atomicMax(p.diag + 13, __float_as_uint(fabsf(sg - 1.0f)));
          int dup = 0; float wre = 0.f;
          for (int k = 0; k < 16; ++k) { const int e = p.eidx[(size_t)tok * 128 + hd * 16 + k]; const float g = p.gw[(size_t)tok * 128 + hd * 16 + k];
              for (int k2 = 0; k2 < k; ++k2) if (p.eidx[(size_t)tok * 128 + hd * 16 + k2] == e) ++dup;
              for (int r = 0; r < 16; ++r) if (refe[r] == e) { const float gr = expf(refv[r] - mx) / sum; wre = fmaxf(wre, fabsf(g - gr) / (gr + 0.003f)); } }
          atomicMax(p.diag + 14, (unsigned)dup); atomicMax(p.diag + 15, __float_as_uint(wre)); }
    }
}
__global__ void __launch_bounds__(256) chk_out(Params p) {
    __shared__ float wj[128]; __shared__ float red[256];
    const unsigned hv = hsh(blockIdx.x, 12); const int T = p.nb * SEQ; const int tok = hv % T, b = tok >> 11, t = threadIdx.x;
    if (t < 128) { const int e = p.eidx[(size_t)tok * 128 + t]; float dsum = 0.f;
        for (int d = 0; d < 1024; ++d) dsum += p.peer_u[(size_t)e * 1024 + d] * bf2f(p.h2[(size_t)tok * DM + d]);
        const float ge = 0.5f * dsum * (1.0f + tanhf(0.7978845608f * (dsum + 0.044715f * dsum * dsum * dsum)));
        wj[t] = p.gw[(size_t)tok * 128 + t] * ge; }
    __syncthreads();
    float x2[4]; float ss = 0.f;
    for (int i = 0; i < 4; ++i) { const int d = t + 256 * i; float acc = 0.f;
        for (int jx = 0; jx < 128; ++jx) acc += wj[jx] * p.peer_v[(size_t)p.eidx[(size_t)tok * 128 + jx] * 1024 + d];
        const float v = p.x1[(size_t)tok * DM + d] + p.mod[(size_t)b * 6144 + 5 * 1024 + d] * acc;
        if (i == 0) x2[0] = v; else if (i == 1) x2[1] = v; else if (i == 2) x2[2] = v; else x2[3] = v;
        ss += v * v; }
    red[t] = ss; __syncthreads();
    for (int o = 128; o > 0; o >>= 1) { if (t < o) red[t] += red[t + o]; __syncthreads(); }
    const float rs = 1.0f / sqrtf(red[0] / 1024.0f + 1e-6f);
    rep(p.diag + 11, p.out[(size_t)tok * DM + t], x2[0] * rs * p.final_g[t], 0.5f);
    rep(p.diag + 11, p.out[(size_t)tok * DM + t + 256], x2[1] * rs * p.final_g[t + 256], 0.5f);
    rep(p.diag + 11, p.out[(size_t)tok * DM + t + 512], x2[2] * rs * p.final_g[t + 512], 0.5f);
    rep(p.diag + 11, p.out[(size_t)tok * DM + t + 768], x2[3] * rs * p.final_g[t + 768], 0.5f);
}
__global__ void diag_apply(Params p, int total) {
    const float tol[12] = {0.f, 2e-3f, 2e-2f, 3e-2f, 3e-2f, 8e-2f, 4e-2f, 1e-2f, 2e-2f, 3e-2f, 0.2f, 3e-2f};
    int F = 0; float err = 1.f;
    for (int i = 11; i >= 1; --i) { const float e = __uint_as_float(p.diag[i]); const float tl = i == 1 ? tol[1] : i == 2 ? tol[2] : i == 3 ? tol[3] : i == 4 ? tol[4] : i == 5 ? tol[5] : i == 6 ? tol[6] : i == 7 ? tol[7] : i == 8 ? tol[8] : i == 9 ? tol[9] : i == 10 ? tol[10] : tol[11];
        if (!(e <= tl)) { F = i; err = e; } }
    int cls = 0; if (F) { const float l = -log10f(fmaxf(err, 1e-12f)); cls = l < 0.f ? 0 : (l > 9.f ? 9 : (int)l); }
    if (F == 10) { cls = (int)p.diag[16]; if (cls > 9) cls = 9; }
#ifdef DIAG_AB
    { const float e10 = __uint_as_float(p.diag[10]), e11 = __uint_as_float(p.diag[11]); F = (e10 <= 1e9f ? 1 : 2) + (e11 <= 0.03f ? 0 : 4); const float l = -log10f(fmaxf(e11, 1e-12f)); cls = l < 0.f ? 0 : (l > 9.f ? 9 : (int)l); }
#endif
    const float K = sqrtf(((float)F / 10.0f + 1.0f) * powf(10.0f, (float)(cls + 6)));
    for (int i = blockIdx.x * blockDim.x + threadIdx.x; i < total; i += gridDim.x * blockDim.x) p.out[i] = K;
}
#endif

static inline size_t al(size_t x) { return (x + 255) & ~(size_t)255; }
extern "C" void kernel_launch(void* const* d_in, const int* in_sizes, int n_in, void* d_out, int out_size, void* d_ws, size_t ws_size, hipStream_t stream) {
#ifdef DIAG
    static int inited = 0;
    const void* kerns[] = {(const void*)k_prep_t, (const void*)k_prep_c, (const void*)k_adaln, (const void*)k_gemm_in, (const void*)k_scan, (const void*)k_gemm_dft, (const void*)k_gemm_mix, (const void*)k_gemm_out, (const void*)k_gemm_q};
    if (!inited) { for (auto k : kerns) (void)hipFuncSetAttribute(k, hipFuncAttributeMaxDynamicSharedMemorySize, LDS_BYTES); inited = 1; }
#endif
    Params p{};
    const float* const* in = (const float* const*)d_in;
    p.x = in[0]; p.c = in[1]; p.ctx = in[2]; p.c_ctx = in[3]; p.w_mod = in[4]; p.b_mod = in[5]; p.norm1_g = in[6]; p.norm2_g = in[7]; p.w_in = in[8]; p.w_fourier = in[9];
    p.conv_w = in[10]; p.conv_b = in[11]; p.lru_wa = in[12]; p.lru_ba = in[13]; p.lru_wx = in[14]; p.lru_bx = in[15]; p.lru_lambda = in[16]; p.w_lru_out = in[17];
    p.w_out = in[18]; p.b_out = in[19]; p.peer_wq = in[20]; p.peer_keys = in[21]; p.peer_u = in[22]; p.peer_v = in[23]; p.final_g = in[24];
    p.out = (float*)d_out;
    unsigned char* ws = (unsigned char*)d_ws; size_t o = 0;
    auto take = [&](size_t bytes) { unsigned char* r = ws + o; o += al(bytes); return r; };
    const size_t MiB = 1ull << 20;
    p.diag = (unsigned*)take(4096);
    p.mod = (float*)take(33 * 6144 * 4); p.pos = (float*)take((size_t)SEQ * DM * 4);
    p.Wt_in = (bf16_t*)take((size_t)4608 * 1024 * 2); p.Wfp = (bf16_t*)take(2 * MiB); p.Wt_lru = (bf16_t*)take(2 * MiB); p.Wt_out = (bf16_t*)take(2 * MiB); p.Wt_q = (bf16_t*)take(4 * MiB);
    p.keys_bf = (bf16_t*)take(MiB / 2); p.gates_bf = (bf16_t*)take(MiB); p.dft = (bf16_t*)take(16 * MiB);
#ifdef DIAG
    p.u_bf = (bf16_t*)take(32 * MiB); p.v_bf = (bf16_t*)take(32 * MiB);
#endif
    p.u8 = nullptr; p.u4 = (unsigned char*)take(8 * MiB); p.scu = (float*)take(131072); p.v8 = nullptr; p.v4 = (unsigned char*)take(8 * MiB); p.scv = (float*)take(65536); p.ssb = (float*)take(2 * MiB); p.tmax = (unsigned*)take(256); p.bar = (unsigned*)take(XCD_BAR_WORDS * 4);
#ifndef DIAG
    { const size_t need = 864 * MiB; if (ws_size > o + need + MiB) o = (ws_size - need) & ~((size_t)4095); }
    unsigned char* R8 = take(128 * MiB);
    unsigned char* R45 = take(256 * MiB);
    unsigned char* R67 = take(256 * MiB);
    unsigned char* R3 = take(64 * MiB);
    p.zxc = (bf16_t*)take(16 * MiB); p.hc = (bf16_t*)take(16 * MiB);
    unsigned char* R0 = take(128 * MiB);
    p.h = (bf16_t*)R0; p.hf = (bf16_t*)R0; p.h2 = (bf16_t*)R0;
    p.zfT = (bf16_t*)R3; p.eidx = (int*)R3; p.gw = (float*)(R3 + 32 * MiB); p.su = (float*)(R45 + 128 * MiB);
    p.zx = (bf16_t*)R45; p.gzy = (bf16_t*)(R45 + 128 * MiB); p.ybin = p.gzy; p.x1 = (float*)R45; p.x1b = (bf16_t*)R45;
    p.sga = (bf16_t*)R67; p.Pb = p.sga; p.sgb = (bf16_t*)(R67 + 128 * MiB); p.merged = (bf16_t*)R0; p.q = (bf16_t*)R67;
    p.UV = (bf16_t*)R8; p.pd = (float*)R67; p.h8 = R8; p.peer16 = (bf16_t*)R0; p.w8 = R0; p.wsc = p.ssb;
    p.zseg = (size_t)64 * MiB; p.nb = NBATCH; p.pad = 0;
#else
    const int NBD = 4; const size_t U = (size_t)NBD * SEQ * DM * 2;
    p.h = (bf16_t*)take(U); p.hc = (bf16_t*)take(U / 8); p.zxc = (bf16_t*)take(U / 8); p.zfT = (bf16_t*)take(U / 2);
    p.zx = (bf16_t*)take(U); p.gzy = (bf16_t*)take(U); p.sga = (bf16_t*)take(U); p.sgb = (bf16_t*)take(U);
    p.hf = (bf16_t*)take(U); p.ybin = (bf16_t*)take(U); p.UV = (bf16_t*)take(U); p.Pb = (bf16_t*)take(U); p.merged = (bf16_t*)take(U);
    p.x1 = (float*)take(2 * U); p.h2 = (bf16_t*)take(U); p.q = (bf16_t*)take(2 * U); p.eidx = (int*)take(U / 4); p.gw = (float*)take(U / 4);
    p.zseg = U / 2; p.nb = NBD; p.pad = 0;
    (void)hipMemsetAsync(p.diag, 0, 4096, stream);
#endif
#if !defined(DIAG)
    {
        static int grid_blocks = 0;
        if (!grid_blocks) {
            int dev = 0, cus = 0, per_cu = 0;
            (void)hipGetDevice(&dev);
            (void)hipDeviceGetAttribute(&cus, hipDeviceAttributeMultiprocessorCount, dev);
            (void)hipFuncSetAttribute((const void*)k_mega, hipFuncAttributeMaxDynamicSharedMemorySize, LDS_BYTES);
            (void)hipOccupancyMaxActiveBlocksPerMultiprocessor(&per_cu, (const void*)k_mega, NTHR, LDS_BYTES);
            if (per_cu < 1) { fprintf(stderr, "kernel_launch: occupancy query says %d blocks per CU\n", per_cu); per_cu = 1; }
            grid_blocks = cus * 1;
        }
        void* args[] = {(void*)&p};
        const hipError_t e = hipLaunchCooperativeKernel((const void*)k_mega, dim3(grid_blocks), dim3(NTHR), args, LDS_BYTES, stream);
        if (e != hipSuccess) fprintf(stderr, "cooperative launch failed: %s (grid %d)\n", hipGetErrorString(e), grid_blocks);
        return;
    }
#endif
#ifdef DIAG
    const dim3 grid(256), blk(NTHR);
    hipLaunchKernelGGL(k_prep_t, grid, blk, LDS_BYTES, stream, p);
    hipLaunchKernelGGL(k_prep_c, grid, blk, LDS_BYTES, stream, p);
    hipLaunchKernelGGL(k_adaln, grid, blk, LDS_BYTES, stream, p);
    hipLaunchKernelGGL(k_norm1, grid, blk, 0, stream, p);
    hipLaunchKernelGGL(k_gemm_in, grid, blk, LDS_BYTES, stream, p);
    hipLaunchKernelGGL(k_scan, grid, blk, LDS_BYTES, stream, p);
    hipLaunchKernelGGL(k_gemm_dft, grid, blk, LDS_BYTES, stream, p);
    hipLaunchKernelGGL(k_gemm_mix, grid, blk, LDS_BYTES, stream, p);
    hipLaunchKernelGGL(k_gemm_out, grid, blk, LDS_BYTES, stream, p);
    hipLaunchKernelGGL(k_norm2, grid, blk, 0, stream, p);
    hipLaunchKernelGGL(k_gemm_q, grid, blk, LDS_BYTES, stream, p);
    hipLaunchKernelGGL(k_topk, grid, blk, 0, stream, p);
    hipLaunchKernelGGL(k_peer, grid, blk, 0, stream, p);
    hipLaunchKernelGGL(chk_mod, dim3(2), dim3(128), 0, stream, p);
    hipLaunchKernelGGL(chk_norm, dim3(2), dim3(128), 0, stream, p, 0);
    hipLaunchKernelGGL(chk_z, dim3(4), dim3(128), 0, stream, p);
    hipLaunchKernelGGL(chk_uv, dim3(2), dim3(128), 0, stream, p);
    hipLaunchKernelGGL(chk_scan, dim3(8), dim3(512), 0, stream, p);
    hipLaunchKernelGGL(chk_merged, dim3(2), dim3(64), 0, stream, p);
    hipLaunchKernelGGL(chk_x1, dim3(2), dim3(128), 0, stream, p);
    hipLaunchKernelGGL(chk_norm, dim3(2), dim3(128), 0, stream, p, 1);
    hipLaunchKernelGGL(chk_q, dim3(2), dim3(128), 0, stream, p);
    hipLaunchKernelGGL(chk_topk, dim3(64), dim3(256), 0, stream, p);
    hipLaunchKernelGGL(chk_out, dim3(16), dim3(256), 0, stream, p);
    hipLaunchKernelGGL(diag_apply, dim3(1024), dim3(256), 0, stream, p, out_size);
#endif
}
```

```cpp
#include <hip/hip_runtime.h>
#include <hip/hip_cooperative_groups.h>
#include <cstdio>
#include <cstdint>

#define LAS __attribute__((address_space(3)))
typedef unsigned short bf16_t;
typedef short bf16x8 __attribute__((ext_vector_type(8)));
typedef float f32x2 __attribute__((ext_vector_type(2)));
typedef float f32x4 __attribute__((ext_vector_type(4)));
typedef float f32x16 __attribute__((ext_vector_type(16)));
typedef unsigned u32x2 __attribute__((ext_vector_type(2)));
typedef unsigned u32x4 __attribute__((ext_vector_type(4)));
typedef __bf16 bf2_t __attribute__((ext_vector_type(2)));

constexpr int DM = 1024, SEQ = 2048, CTXL = 256, NBATCH = 32;
constexpr int NTHR = 512;
constexpr int LDS_BYTES = 160 * 1024;

__device__ __forceinline__ float bf2f(bf16_t b) { return __uint_as_float(((unsigned)b) << 16); }
__device__ __forceinline__ float bflo(unsigned w) { return __uint_as_float(w << 16); }
__device__ __forceinline__ float bfhi(unsigned w) { return __uint_as_float(w & 0xffff0000u); }
typedef __bf16 bf16x2_t __attribute__((ext_vector_type(2)));
__device__ __forceinline__ unsigned pk2(float lo, float hi) { return __builtin_bit_cast(unsigned, __builtin_convertvector((f32x2){lo, hi}, bf16x2_t)); }
__device__ __forceinline__ bf16_t f2bf(float f) { return (bf16_t)(pk2(f, 0.f) & 0xffffu); }
__device__ __forceinline__ float sigmoid_f(float x) { return __builtin_amdgcn_rcpf(1.0f + __builtin_amdgcn_exp2f(-1.4426950409f * x)); }
__device__ __forceinline__ float gelu_f(float x) { const float in = x + 0.044715f * x * x * x; return x * __builtin_amdgcn_rcpf(1.0f + __builtin_amdgcn_exp2f(-2.3022082f * in)); }
__device__ __forceinline__ int lane_opaque() { int t = threadIdx.x & 63; asm volatile("" : "+v"(t)); return t; }
__device__ __forceinline__ float shx_f(float v, int o) { return __int_as_float(__builtin_amdgcn_ds_bpermute((lane_opaque() ^ o) << 2, __float_as_int(v))); }
__device__ __forceinline__ int shx_i(int v, int o) { return __builtin_amdgcn_ds_bpermute((lane_opaque() ^ o) << 2, v); }
__device__ __forceinline__ f32x2 sigmoid2(f32x2 x) { const f32x2 t = x * (f32x2){-1.4426950409f, -1.4426950409f}; f32x2 e; e[0] = __builtin_amdgcn_exp2f(t[0]); e[1] = __builtin_amdgcn_exp2f(t[1]);
    const f32x2 d = e + (f32x2){1.0f, 1.0f}; f32x2 r; r[0] = __builtin_amdgcn_rcpf(d[0]); r[1] = __builtin_amdgcn_rcpf(d[1]); return r; }
__device__ __forceinline__ f32x2 gelu2(f32x2 x) {
    const f32x2 x2 = x * x; const f32x2 u = x2 * (f32x2){-0.10294324f, -0.10294324f} + (f32x2){-2.3022082f, -2.3022082f}; const f32x2 t = x * u;
    f32x2 e; e[0] = __builtin_amdgcn_exp2f(t[0]); e[1] = __builtin_amdgcn_exp2f(t[1]);
    const f32x2 d = e + (f32x2){1.0f, 1.0f}; f32x2 r; r[0] = __builtin_amdgcn_rcpf(d[0]); r[1] = __builtin_amdgcn_rcpf(d[1]); return x * r; }
__device__ __forceinline__ float wave_sum(float v) {
#pragma unroll
    for (int o = 1; o < 64; o <<= 1) v += shx_f(v, o);
    return v;
}

__device__ __forceinline__ int tid_opaque() { int t = threadIdx.x; asm volatile("" : "+v"(t)); return t; }
struct Params {
    const float *x, *c, *ctx, *c_ctx, *w_mod, *b_mod, *norm1_g, *norm2_g, *w_in, *w_fourier, *conv_w, *conv_b, *lru_wa, *lru_ba, *lru_wx, *lru_bx, *lru_lambda,
        *w_lru_out, *w_out, *b_out, *peer_wq, *peer_keys, *peer_u, *peer_v, *final_g;
    float* out;
    float *mod, *pos;
    bf16_t *Wt_in, *Wfp, *Wt_lru, *Wt_out, *Wt_q, *keys_bf, *gates_bf, *dft, *u_bf, *v_bf;
    bf16_t *h, *hc, *zxc, *zfT, *zx, *gzy, *sga, *sgb, *hf, *ybin, *UV, *Pb, *merged, *h2, *q;
    float* x1; bf16_t* x1b; int* eidx; float* gw; float* su;
    unsigned char *u8, *v8, *h8, *u4, *v4; float* scu; float* scv; bf16_t* peer16; float* pd; float* ssb; unsigned* tmax; unsigned* bar;
    unsigned* diag;
    unsigned char* w8; float* wsc;
    size_t zseg;
    int nb, pad;
};

typedef const Params __attribute__((address_space(4))) CParams;
#ifdef DIAG
#define PREF const Params&
#else
#define PREF CParams&
#endif
__device__ __forceinline__ void dev_transpose(const float* src, int ld, int col0, int K, int N, bf16_t* dst, int nbat, size_t sbs, size_t dbs, LAS unsigned char* lds, int bfirst, int bcount) {
    const int rel = (int)blockIdx.x - bfirst;
    if (rel < 0 || rel >= bcount) return;
    const int tid = tid_opaque(), tk = K / 64, tn = N / 64, per = tk * tn, total = per * nbat;
    const int r = tid >> 4, c4 = tid & 15, nn = tid >> 3, kc = tid & 7;
#define TR_LOAD(V0, V1, it) do { const int it_ = (it) < total ? (it) : total - 1; const int bz_ = it_ / per, rem_ = it_ % per, k0_ = (rem_ / tn) * 64, n0_ = (rem_ % tn) * 64; \
        const float* s_ = src + (size_t)bz_ * sbs + (size_t)(k0_ + r) * ld + col0 + n0_ + 4 * c4; V0 = *(const f32x4*)s_; V1 = *(const f32x4*)(s_ + (size_t)32 * ld); } while (0)
    f32x4 v0, v1, w0, w1;
    TR_LOAD(v0, v1, rel);
    int par = 0;
    for (int item = rel; item < total; item += bcount) {
        TR_LOAD(w0, w1, item + bcount);
        const int bz = item / per, rem = item % per, k0 = (rem / tn) * 64, n0 = (rem % tn) * 64;
        LAS float* tile = (LAS float*)lds + par * (64 * 65);
        { LAS float* t = tile + r * 65 + 4 * c4; t[0] = v0[0]; t[1] = v0[1]; t[2] = v0[2]; t[3] = v0[3]; t += 32 * 65; t[0] = v1[0]; t[1] = v1[1]; t[2] = v1[2]; t[3] = v1[3]; }
        __syncthreads();
        const LAS float* t = tile + (8 * kc) * 65 + nn;
        u32x4 o; o[0] = pk2(t[0], t[65]); o[1] = pk2(t[2 * 65], t[3 * 65]); o[2] = pk2(t[4 * 65], t[5 * 65]); o[3] = pk2(t[6 * 65], t[7 * 65]);
        *(u32x4*)(dst + (size_t)bz * dbs + (size_t)(n0 + nn) * K + k0 + 8 * kc) = o;
        v0 = w0; v1 = w1; par ^= 1;
    }
    __syncthreads();
#undef TR_LOAD
}
__device__ __forceinline__ void dev_convert(const float* src, bf16_t* dst, size_t n) {
    const int tid = tid_opaque();
    for (size_t i = ((size_t)blockIdx.x * NTHR + tid) * 8; i < n; i += (size_t)gridDim.x * NTHR * 8) {
        const f32x4 a = *(const f32x4*)(src + i), b = *(const f32x4*)(src + i + 4);
        u32x4 o; o[0] = pk2(a[0], a[1]); o[1] = pk2(a[2], a[3]); o[2] = pk2(b[0], b[1]); o[3] = pk2(b[2], b[3]);
        *(u32x4*)(dst + i) = o;
    }
}
__device__ __forceinline__ void dev_wfp(PREF p, LAS unsigned char* lds) {
    LAS float* cs = (LAS float*)lds; LAS float* sn = cs + 128;
    const int tid = tid_opaque();
    if (tid < 128) { cs[tid] = cospif((float)tid * (1.0f / 64.0f)); sn[tid] = sinpif((float)tid * (1.0f / 64.0f)); }
    __syncthreads();
    for (int idx = blockIdx.x * NTHR + tid; idx < 1024 * 1024; idx += gridDim.x * NTHR) {
        const int d = idx >> 10, kap = idx & 1023, g = (kap & 511) >> 7, cc = kap & 127, iss = kap >> 9;
        const LAS float* tab = iss ? sn : cs; const float* wf = p.w_fourier + (size_t)(g * 128) * 1024 + d;
        float acc = 0.f;
        for (int kc = 0; kc < 128; ++kc) acc += tab[(kc * cc) & 127] * wf[(size_t)kc * 1024];
        p.Wfp[idx] = f2bf(acc * (iss ? -1.0f / 512.0f : 1.0f / 512.0f));
    }
    __syncthreads();
}
__device__ __forceinline__ void dev_dft(PREF p) {
    const int tid = tid_opaque();
    for (int i8 = blockIdx.x * NTHR + tid; i8 < 2048 * 2048 / 8; i8 += gridDim.x * NTHR) {
        const int m = i8 >> 8, t0 = (i8 & 255) * 8, mm = m & 1023, iss = m >> 10;
        float v[8];
#pragma unroll
        for (int j = 0; j < 8; ++j) { const int kk = (iss && mm == 0) ? 1024 : mm; const float a = (float)((kk * (t0 + j)) & 2047) * (1.0f / 2048.0f);
            v[j] = (iss && mm != 0) ? __builtin_amdgcn_sinf(a) : __builtin_amdgcn_cosf(a); }
        u32x4 o; o[0] = pk2(v[0], v[1]); o[1] = pk2(v[2], v[3]); o[2] = pk2(v[4], v[5]); o[3] = pk2(v[6], v[7]);
        *(u32x4*)(p.dft + (size_t)i8 * 8) = o;
    }
}
__device__ __forceinline__ void dev_pos(PREF p) {
    const int tid = tid_opaque();
    for (int idx = blockIdx.x * NTHR + tid; idx < SEQ * 512; idx += gridDim.x * NTHR) {
        const int t = idx >> 9, half = (idx >> 8) & 1, j = idx & 255;
        const float omega = 1.0f / powf(10000.0f, (float)j * (1.0f / 256.0f));
        const float arg = (float)(half == 0 ? (t >> 6) : (t & 63)) * omega;
        float* d = p.pos + (size_t)t * DM + half * 512 + j;
        d[0] = sinf(arg); d[256] = cosf(arg);
    }
}
__device__ __forceinline__ void dev_adaln(PREF p, LAS unsigned char* lds) {
    constexpr int SROW = 1032;
    LAS bf16_t* Sh = (LAS bf16_t*)lds; LAS bf16_t* Sl = Sh + 33 * SROW;
    const int tid = tid_opaque(), w = tid >> 6, l = tid & 63, c16 = l & 15, g = l >> 4;
    if ((int)blockIdx.x < 192) {
        for (int i = tid; i < 33 * 1024; i += NTHR) { const float v = (i < 32 * 1024) ? p.c[i] : p.c_ctx[i - 32 * 1024]; const float sv = v * sigmoid_f(v);
            const unsigned hi = pk2(sv, 0.f) & 0xffffu; const unsigned lo = pk2(sv - bflo(hi), 0.f) & 0xffffu; const int r = i >> 10, k = i & 1023;
            Sh[r * SROW + k] = (bf16_t)hi; Sl[r * SROW + k] = (bf16_t)lo; }
        __syncthreads();
        const int nt = w & 1, kq = w >> 1, n0 = blockIdx.x * 32 + nt * 16;
        f32x4 acc[3];
#pragma unroll
        for (int mt = 0; mt < 3; ++mt) acc[mt] = (f32x4){0.f, 0.f, 0.f, 0.f};
#pragma unroll
        for (int ks = 0; ks < 8; ++ks) { const int k0 = kq * 256 + ks * 32 + 8 * g;
            float wv[8];
#pragma unroll
            for (int j = 0; j < 8; ++j) wv[j] = p.w_mod[(size_t)(k0 + j) * 6144 + n0 + c16];
            u32x4 bh, bl;
#pragma unroll
            for (int j = 0; j < 4; ++j) { bh[j] = pk2(wv[2 * j], wv[2 * j + 1]); bl[j] = pk2(wv[2 * j] - bflo(bh[j]), wv[2 * j + 1] - bfhi(bh[j])); }
            const bf16x8 Bh = __builtin_bit_cast(bf16x8, bh), Bl = __builtin_bit_cast(bf16x8, bl);
#pragma unroll
            for (int mt = 0; mt < 3; ++mt) { const int row = min(mt * 16 + c16, 32);
                const bf16x8 Ah = *(const LAS bf16x8*)(Sh + row * SROW + k0), Al = *(const LAS bf16x8*)(Sl + row * SROW + k0);
                acc[mt] = __builtin_amdgcn_mfma_f32_16x16x32_bf16(Ah, Bh, acc[mt], 0, 0, 0);
                acc[mt] = __builtin_amdgcn_mfma_f32_16x16x32_bf16(Ah, Bl, acc[mt], 0, 0, 0);
                acc[mt] = __builtin_amdgcn_mfma_f32_16x16x32_bf16(Al, Bh, acc[mt], 0, 0, 0); }
        }
        __syncthreads();
        LAS float* red = (LAS float*)lds;
#pragma unroll
        for (int mt = 0; mt < 3; ++mt)
#pragma unroll
            for (int reg = 0; reg < 4; ++reg) red[(kq * 48 + mt * 16 + 4 * g + reg) * 32 + nt * 16 + c16] = acc[mt][reg];
        __syncthreads();
        for (int o = tid; o < 33 * 32; o += NTHR) { const int r = o >> 5, n = o & 31;
            const float sum = (red[(0 * 48 + r) * 32 + n] + red[(1 * 48 + r) * 32 + n]) + (red[(2 * 48 + r) * 32 + n] + red[(3 * 48 + r) * 32 + n]);
            p.mod[(size_t)r * 6144 + blockIdx.x * 32 + n] = sum + p.b_mod[blockIdx.x * 32 + n]; }
        __syncthreads();
    }
}

__device__ __forceinline__ void dev_norm(PREF p, int which, int rfirst = -1, int rstride = 0, int rend = 0) {
    const int tid = tid_opaque(); const int w = tid >> 6, lane = tid & 63;
    const int T = p.nb * SEQ, TC = (which == 0) ? p.nb * CTXL : 0, NR = T + TC;
    const int first = (rfirst >= 0 ? rfirst : (int)blockIdx.x * 8) + w, stride = rfirst >= 0 ? rstride : (int)gridDim.x * 8, REND = rfirst >= 0 ? rend : NR;
#define NORM_LOAD(XV, PV, r) do { const int r_ = (r) < NR ? (r) : NR - 1; const bool c_ = r_ >= T; const int lr_ = c_ ? r_ - T : r_; \
        const float* s_ = c_ ? p.ctx + (size_t)lr_ * DM : p.x + (size_t)lr_ * DM; \
        _Pragma("unroll") for (int i_ = 0; i_ < 4; ++i_) { const int d_ = 4 * lane + 256 * i_; \
            if (which == 1) { const u32x2 q_ = *(const u32x2*)(p.x1b + (size_t)lr_ * DM + d_); XV[i_] = (f32x4){bflo(q_[0]), bfhi(q_[0]), bflo(q_[1]), bfhi(q_[1])}; } else XV[i_] = __builtin_nontemporal_load((const f32x4*)(s_ + d_)); \
            PV[i_] = (which == 0 && !c_) ? (pos_fixed ? pfix[i_] : *(const f32x4*)(p.pos + (size_t)(lr_ & 2047) * DM + d_)) : (f32x4){0.f, 0.f, 0.f, 0.f}; } } while (0)
    const bool pos_fixed = (which == 0) && (stride % SEQ == 0) && (first < T);
    f32x4 pfix[4];
#pragma unroll
    for (int i = 0; i < 4; ++i) pfix[i] = pos_fixed ? *(const f32x4*)(p.pos + (size_t)(first & 2047) * DM + 4 * lane + 256 * i) : (f32x4){0.f, 0.f, 0.f, 0.f};
    f32x4 xv[4], pv[4], xn[4], pn[4];
    if (first < NR) NORM_LOAD(xv, pv, first);
    for (int row = first; row < REND; row += stride) {
        NORM_LOAD(xn, pn, row + stride);
        const bool isctx = row >= T; const int lrow = isctx ? row - T : row;
        const int b = isctx ? 32 : (lrow >> 11);
        const float* g = (which == 0) ? p.norm1_g : p.norm2_g;
        const float* md = p.mod + (size_t)b * 6144 + (which == 0 ? 0 : 3 * 1024);
        bf16_t* dst = (which == 1) ? p.h2 + (size_t)lrow * DM : (isctx ? p.hc + (size_t)lrow * DM : p.h + (size_t)lrow * DM);
        f32x4 v[4]; float ss = 0.f;
#pragma unroll
        for (int i = 0; i < 4; ++i) { v[i] = xv[i] + pv[i];
            ss += (v[i][0] * v[i][0] + v[i][1] * v[i][1]) + (v[i][2] * v[i][2] + v[i][3] * v[i][3]); }
        ss = wave_sum(ss);
        const float rs = rsqrtf(ss * (1.0f / 1024.0f) + 1e-6f);
#pragma unroll
        for (int i = 0; i < 4; ++i) { const int d = 4 * lane + 256 * i;
            const f32x4 gg = *(const f32x4*)(g + d), sh = *(const f32x4*)(md + d), sc = *(const f32x4*)(md + 1024 + d);
            f32x4 y;
#pragma unroll
            for (int j = 0; j < 4; ++j) y[j] = (v[i][j] * rs * gg[j]) * (1.0f + sc[j]) + sh[j];
            u32x2 o; o[0] = pk2(y[0], y[1]); o[1] = pk2(y[2], y[3]);
            *(u32x2*)(dst + d) = o;
            if (which == 1) { int w8 = 0; w8 = __builtin_amdgcn_cvt_pk_fp8_f32(y[0] * 4.0f, y[1] * 4.0f, w8, false); w8 = __builtin_amdgcn_cvt_pk_fp8_f32(y[2] * 4.0f, y[3] * 4.0f, w8, true);
                *(unsigned*)(p.h8 + (size_t)lrow * DM + d) = (unsigned)w8; } }
#pragma unroll
        for (int i = 0; i < 4; ++i) { xv[i] = xn[i]; pv[i] = pn[i]; }
    }
#undef NORM_LOAD
}

namespace pg8 {
constexpr int BM = 256, BK = 64, HALF = 128, HTB = HALF * BK * 2, STAGE_BYTES = 8 * HTB, NXCD = 8, WGM = 8;
__host__ __device__ __forceinline__ int lds_byte(int r, int c) { const int st = (r >> 4) * 2 + (c >> 5), rr = r & 15, cc = c & 31, ob = rr * 64 + cc * 2; return st * 1024 + (ob ^ (((ob >> 9) & 1) << 5)); }
__host__ __device__ __forceinline__ void stage_rc(int b, int& R, int& C) { const int st = b / 1024, sb = b % 1024, swz = sb ^ (((sb >> 9) & 1) << 5); R = (st >> 1) * 16 + swz / 64; C = (st & 1) * 32 + (swz % 64) / 2; }
__host__ __device__ __forceinline__ int perm32(int rho) { const int n = rho >> 4, i = rho & 15; return 8 * (i >> 2) + 4 * n + (i & 3); }
struct Unit { int pm, pn, z; };
struct Gemm { const bf16_t* A; const bf16_t* Bt; int K, lda, ldb; long aZ, bZ; int natA = 0, natB = 0; };
struct StaticOrder {
    int nM, nN, nwg, G, c;
    __device__ void init(int M, int N, int G_, int c_) { nM = M / BM; nN = N / BM; nwg = nM * nN; G = G_; c = c_; }
    __device__ bool next(int i, Unit& u) const {
        const long L = (long)i * G + c; if (L >= nwg) return false;
        int wgid = (int)L; { const int q = nwg / NXCD, r = nwg % NXCD, xcd = wgid % NXCD, off = wgid / NXCD; wgid = (xcd < r ? xcd * (q + 1) : r * (q + 1) + (xcd - r) * q) + off; }
        const int nig = WGM * nN, gid = wgid / nig, fm = gid * WGM, gsz = (nM - fm) < WGM ? (nM - fm) : WGM;
        u.pm = fm + ((wgid % nig) % gsz); u.pn = (wgid % nig) / gsz; u.z = 0; return true;
    }
};
struct BatchOrder {
    int nM, nN, nz, G, c;
    __device__ void init(int M, int N, int nz_, int G_, int c_) { nM = M / BM; nN = N / BM; nz = nz_; G = G_; c = c_; }
    __device__ bool next(int i, Unit& u) const {
        const long L = (long)i * G + c; const int per = nM * nN; if (L >= (long)per * nz) return false;
        u.z = (int)(L / per); const int r = (int)(L % per); u.pm = r % nM; u.pn = r / nM; return true;
    }
};

template <class Epi, class Sched>
__device__ __forceinline__ void gemm_phase(LAS unsigned char* lds, const Gemm g, const Sched& S, const Epi& E) {
    const int tid = tid_opaque(), wid = __builtin_amdgcn_readfirstlane(tid >> 6), lane = tid & 63, wr = wid >> 2, wc = wid & 3, fr = lane & 15, fq = lane >> 4;
    const int K = g.K, nt = K / BK;
    unsigned voffA[2], voffB[2];
#pragma unroll
    for (int i = 0; i < 2; ++i) { int R, C; stage_rc(tid * 16 + i * 8192, R, C); const int Rb = Epi::PERM ? ((R & ~31) + perm32(R & 31)) : R;
#define PG8_NATOFF(R_, C_) ((unsigned)(((((R_) >> 6) & 1) * 4 + ((C_) >> 5)) * 8192 + ((((R_) >> 4) & 3) * 2) * 512 + (((R_) & 15) + 16 * (((C_) >> 3) & 3)) * 8) * 2u)
        voffA[i] = g.natA ? PG8_NATOFF(R, C) : (unsigned)(R * g.lda + C) * 2u; voffB[i] = g.natB ? PG8_NATOFF(Rb, C) : (unsigned)(Rb * g.ldb + C) * 2u; }
#undef PG8_NATOFF
    const int s0A = g.natA ? 32768 : BK * 2, s1A = g.natA ? 1024 : BK * 4, s2A = g.natA ? 131072 : BK * 8;
    const int s0B = g.natB ? 32768 : BK * 2, s1B = g.natB ? 1024 : BK * 4, s2B = g.natB ? 131072 : BK * 8;
    const size_t hstepA = g.natA ? (size_t)8192 : (size_t)HALF * g.lda * 2, hstepB = g.natB ? (size_t)8192 : (size_t)HALF * g.ldb * 2;
    const size_t tstepA = (size_t)BM * g.lda * 2, tstepB = (size_t)BM * g.ldb * 2;
    const unsigned ldsw = (unsigned)wid * 1024u;
    const int aoff = lds_byte(wr * 64 + fr, fq * 8), boff = lds_byte(wc * 32 + fr, fq * 8);
#define PG8_SA(b, h) (((b) * 2 + (h)) * HTB)
#define PG8_SB(b, h) ((4 + (b) * 2 + (h)) * HTB)
#define PG8_STAGE(bufoff, gbase, voff) do { _Pragma("unroll") for (int _i = 0; _i < 2; ++_i) \
        __builtin_amdgcn_global_load_lds((const unsigned*)((const char*)(gbase) + (voff)[_i]), (LAS unsigned*)(lds + (bufoff) + ldsw + _i * 8192), 16, 0, 0); } while (0)
#define PG8_LDA(dst, b, h) do { _Pragma("unroll") for (int m = 0; m < 4; ++m) _Pragma("unroll") for (int k = 0; k < 2; ++k) dst[m][k] = *(const LAS bf16x8*)(lds + PG8_SA(b, h) + aoff + m * 2048 + k * 1024); } while (0)
#define PG8_LDB(dst, b, h) do { _Pragma("unroll") for (int n = 0; n < 2; ++n) _Pragma("unroll") for (int k = 0; k < 2; ++k) dst[n][k] = *(const LAS bf16x8*)(lds + PG8_SB(b, h) + boff + n * 2048 + k * 1024); } while (0)
#define PG8_MMA(ai, bj, At, Bt) do { __builtin_amdgcn_s_setprio(1); _Pragma("unroll") for (int m = 0; m < 4; ++m) _Pragma("unroll") for (int n = 0; n < 2; ++n) _Pragma("unroll") for (int k = 0; k < 2; ++k) \
        acc[ai][bj][m][n] = __builtin_amdgcn_mfma_f32_16x16x32_bf16(Bt[n][k], At[m][k], acc[ai][bj][m][n], 0, 0, 0); __builtin_amdgcn_s_setprio(0); } while (0)
#define PG8_WAIT_V(n) asm volatile("s_waitcnt vmcnt(" #n ")" ::: "memory")
#define PG8_WAIT_L(n) asm volatile("s_waitcnt lgkmcnt(" #n ")" ::: "memory")
#define PG8_BAR __builtin_amdgcn_s_barrier()
#define PG8_SCHED __builtin_amdgcn_sched_barrier(0)
    Unit cur, nxt; int ui = 0;
    if (!S.next(0, cur)) return;
    f32x4 acc[2][2][4][2];
#pragma unroll
    for (int a = 0; a < 2; ++a)
#pragma unroll
        for (int b = 0; b < 2; ++b)
#pragma unroll
            for (int m = 0; m < 4; ++m)
#pragma unroll
                for (int n = 0; n < 2; ++n) acc[a][b][m][n] = (f32x4){0.f, 0.f, 0.f, 0.f};
    bf16x8 At[4][2], B0[2][2], B1[2][2];
    const char* cA = (const char*)g.A + (size_t)cur.pm * tstepA + (size_t)cur.z * g.aZ * 2; const char* cB = (const char*)g.Bt + (size_t)cur.pn * tstepB + (size_t)cur.z * g.bZ * 2;
    PG8_STAGE(PG8_SB(0, 0), cB, voffB); PG8_STAGE(PG8_SA(0, 0), cA, voffA); PG8_STAGE(PG8_SB(0, 1), cB + hstepB, voffB); PG8_STAGE(PG8_SA(0, 1), cA + hstepA, voffA);
    if (wr == 1) PG8_BAR;
    PG8_WAIT_V(4); PG8_BAR;
    PG8_STAGE(PG8_SB(1, 0), cB + s0B, voffB); PG8_STAGE(PG8_SA(1, 0), cA + s0A, voffA); PG8_STAGE(PG8_SB(1, 1), cB + hstepB + s0B, voffB);
    PG8_WAIT_V(6); PG8_BAR;
    for (;;) {
        const bool has_next = S.next(ui + 1, nxt);
        const char* nA = has_next ? (const char*)g.A + (size_t)nxt.pm * tstepA + (size_t)nxt.z * g.aZ * 2 : cA;
        const char* nB = has_next ? (const char*)g.Bt + (size_t)nxt.pn * tstepB + (size_t)nxt.z * g.bZ * 2 : cB;
        for (int t = 0; t < nt; t += 2) {
            const bool last = (t == nt - 2);
            const int th = t >> 1, tn = th + 1;
            const char* a1 = cA + (size_t)(th >> 1) * s2A + (th & 1) * s1A + s0A;
            const char* a2 = last ? nA : cA + (size_t)(tn >> 1) * s2A + (tn & 1) * s1A; const char* b2 = last ? nB : cB + (size_t)(tn >> 1) * s2B + (tn & 1) * s1B;
            const char* a3 = a2 + s0A; const char* b3 = b2 + s0B;
            PG8_LDB(B0, 0, 0); PG8_SCHED; PG8_LDA(At, 0, 0); PG8_STAGE(PG8_SA(1, 1), a1 + hstepA, voffA);
            PG8_WAIT_L(8); PG8_BAR; PG8_WAIT_L(0); PG8_MMA(0, 0, At, B0); PG8_BAR; PG8_SCHED;
            PG8_LDB(B1, 0, 1); PG8_STAGE(PG8_SB(0, 0), b2, voffB);
            PG8_BAR; PG8_WAIT_L(0); PG8_MMA(0, 1, At, B1); PG8_BAR;
            PG8_LDA(At, 0, 1); PG8_STAGE(PG8_SA(0, 0), a2, voffA);
            PG8_BAR; PG8_WAIT_L(0); PG8_MMA(1, 0, At, B0); PG8_BAR; PG8_SCHED;
            PG8_STAGE(PG8_SB(0, 1), b2 + hstepB, voffB);
            PG8_WAIT_V(6); PG8_BAR; PG8_MMA(1, 1, At, B1); PG8_BAR;
            PG8_LDB(B0, 1, 0); PG8_SCHED; PG8_LDA(At, 1, 0); PG8_STAGE(PG8_SA(0, 1), a2 + hstepA, voffA);
            PG8_WAIT_L(8); PG8_BAR; PG8_WAIT_L(0); PG8_MMA(0, 0, At, B0); PG8_BAR; PG8_SCHED;
            PG8_LDB(B1, 1, 1); PG8_STAGE(PG8_SB(1, 0), b3, voffB);
            PG8_BAR; PG8_WAIT_L(0); PG8_MMA(0, 1, At, B1); PG8_BAR;
            PG8_LDA(At, 1, 1); PG8_STAGE(PG8_SA(1, 0), a3, voffA);
            PG8_BAR; PG8_WAIT_L(0); PG8_MMA(1, 0, At, B0); PG8_BAR; PG8_SCHED;
            PG8_STAGE(PG8_SB(1, 1), b3 + hstepB, voffB);
            PG8_WAIT_V(6); PG8_BAR; PG8_MMA(1, 1, At, B1); PG8_BAR;
        }
        E(acc, cur, wr, wc, fr, fq);
        if (!has_next) break;
#pragma unroll
        for (int a = 0; a < 2; ++a)
#pragma unroll
            for (int b = 0; b < 2; ++b)
#pragma unroll
                for (int m = 0; m < 4; ++m)
#pragma unroll
                    for (int n = 0; n < 2; ++n) acc[a][b][m][n] = (f32x4){0.f, 0.f, 0.f, 0.f};
        cur = nxt; cA = nA; cB = nB; ++ui;
    }
    PG8_WAIT_V(0);
    if (wr == 0) PG8_BAR;
    PG8_BAR;
#undef PG8_SA
#undef PG8_SB
#undef PG8_STAGE
#undef PG8_LDA
#undef PG8_LDB
#undef PG8_MMA
#undef PG8_WAIT_V
#undef PG8_WAIT_L
#undef PG8_BAR
#undef PG8_SCHED
}

__device__ __forceinline__ u32x4 pack8(const f32x4 v0, const f32x4 v1) { u32x4 w; w[0] = pk2(v0[0], v0[1]); w[1] = pk2(v0[2], v0[3]); w[2] = pk2(v1[0], v1[1]); w[3] = pk2(v1[2], v1[3]); return w; }
struct EpiAct {
    static constexpr bool PERM = true;
    bf16_t* O; size_t segstride; int actmask; int segtiles; int ldc; int nt; int native;
    template <int ACT, bool NT, bool NATIVE>
    __device__ __forceinline__ void body(const f32x4 (&acc)[2][2][4][2], bf16_t* base, int row0, int col0, size_t toff) const {
#pragma unroll
        for (int ai = 0; ai < 2; ++ai)
#pragma unroll
            for (int m = 0; m < 4; ++m) { bf16_t* rowp = NATIVE ? base + toff + ((ai * 4 + m) * 2) * 512 : base + (size_t)(row0 + ai * HALF + m * 16) * ldc + col0;
#pragma unroll
                for (int bj = 0; bj < 2; ++bj) { f32x4 v0 = acc[ai][bj][m][0], v1 = acc[ai][bj][m][1];
                    if (ACT == 1) { const f32x2 a = gelu2((f32x2){v0[0], v0[1]}), b = gelu2((f32x2){v0[2], v0[3]}), c = gelu2((f32x2){v1[0], v1[1]}), d = gelu2((f32x2){v1[2], v1[3]});
                        v0 = (f32x4){a[0], a[1], b[0], b[1]}; v1 = (f32x4){c[0], c[1], d[0], d[1]}; }
                    else if (ACT == 2) { const f32x2 a = sigmoid2((f32x2){v0[0], v0[1]}), b = sigmoid2((f32x2){v0[2], v0[3]}), c = sigmoid2((f32x2){v1[0], v1[1]}), d = sigmoid2((f32x2){v1[2], v1[3]});
                        v0 = (f32x4){a[0], a[1], b[0], b[1]}; v1 = (f32x4){c[0], c[1], d[0], d[1]}; }
                    bf16_t* dp = NATIVE ? rowp + bj * 512 : rowp + bj * HALF;
                    if (NT) __builtin_nontemporal_store(pack8(v0, v1), (u32x4*)dp); else *(u32x4*)dp = pack8(v0, v1); } }
    }
    __device__ __forceinline__ void operator()(const f32x4 (&acc)[2][2][4][2], const Unit& u, int wr, int wc, int fr, int fq) const {
        const int seg = u.pn / segtiles, colt = (u.pn - seg * segtiles) * BM;
        bf16_t* base = O + (size_t)seg * segstride; const int act = seg < 8 ? ((actmask >> (4 * seg)) & 15) : 0;
        const int row0 = u.pm * BM + wr * 64 + fr, col0 = colt + wc * 32 + 8 * fq;
        const size_t toff = ((size_t)u.pm * (ldc >> 8) + (u.pn - seg * segtiles)) * 65536 + (size_t)(wr * 4 + wc) * 8192 + (size_t)(fr + 16 * fq) * 8;
        if (act == 1) body<1, true, false>(acc, base, row0, col0, 0); else if (act == 2) body<2, true, true>(acc, base, row0, col0, toff); else if (native) body<0, true, true>(acc, base, row0, col0, toff); else if (nt) body<0, true, false>(acc, base, row0, col0, 0); else body<0, false, false>(acc, base, row0, col0, 0);
    }
};
struct EpiUV {
    static constexpr bool PERM = true;
    bf16_t* UV;
    __device__ __forceinline__ void operator()(const f32x4 (&acc)[2][2][4][2], const Unit& u, int wr, int wc, int fr, int fq) const {
        const int isv = u.pm >> 2, mp0 = (u.pm & 3) * BM + wr * 64 + fr, colb = u.pn * BM + wc * 32 + 8 * fq;
        bf16_t* base = UV + (size_t)u.z * SEQ * DM;
#pragma unroll
        for (int ai = 0; ai < 2; ++ai)
#pragma unroll
            for (int m = 0; m < 4; ++m) { const int mp = mp0 + ai * HALF + m * 16;
#pragma unroll
                for (int bj = 0; bj < 2; ++bj) { const u32x4 v = pack8(acc[ai][bj][m][0], acc[ai][bj][m][1]); const int col = colb + bj * HALF;
                    if (!isv) { *(u32x4*)(base + (size_t)mp * DM + col) = v; if (mp) *(u32x4*)(base + (size_t)(SEQ - mp) * DM + col) = v; }
                    else if (mp == 0) { *(u32x4*)(base + (size_t)1024 * DM + col) = v; const u32x4 z = (u32x4){0u, 0u, 0u, 0u};
                        *(u32x4*)(base + 512 + col) = z; *(u32x4*)(base + (size_t)1024 * DM + 512 + col) = z; }
                    else { *(u32x4*)(base + (size_t)mp * DM + 512 + col) = v; const u32x4 nv = (u32x4){v[0] ^ 0x80008000u, v[1] ^ 0x80008000u, v[2] ^ 0x80008000u, v[3] ^ 0x80008000u};
                        *(u32x4*)(base + (size_t)(SEQ - mp) * DM + 512 + col) = nv; } } }
    }
};
struct EpiGate {
    static constexpr bool PERM = true;
    const bf16_t* gate; const bf16_t* addsrc; bf16_t* dst;
    __device__ __forceinline__ void operator()(const f32x4 (&acc)[2][2][4][2], const Unit& u, int wr, int wc, int fr, int fq) const {
        const size_t toff = ((size_t)u.pm * 4 + u.pn) * 65536 + (size_t)(wr * 4 + wc) * 8192 + (size_t)(fr + 16 * fq) * 8;
#pragma unroll
        for (int ai = 0; ai < 2; ++ai)
#pragma unroll
            for (int m = 0; m < 4; ++m) {
#pragma unroll
                for (int bj = 0; bj < 2; ++bj) { const size_t noff = toff + ((ai * 4 + m) * 2 + bj) * 512;
                    const u32x4 gv = __builtin_nontemporal_load((const u32x4*)(gate + noff));
                    f32x4 v0 = acc[ai][bj][m][0], v1 = acc[ai][bj][m][1];
                    v0[0] *= bflo(gv[0]); v0[1] *= bfhi(gv[0]); v0[2] *= bflo(gv[1]); v0[3] *= bfhi(gv[1]);
                    v1[0] *= bflo(gv[2]); v1[1] *= bfhi(gv[2]); v1[2] *= bflo(gv[3]); v1[3] *= bfhi(gv[3]);
                    if (addsrc) { const u32x4 av = *(const u32x4*)(addsrc + noff);
                        v0[0] += bflo(av[0]); v0[1] += bfhi(av[0]); v0[2] += bflo(av[1]); v0[3] += bfhi(av[1]);
                        v1[0] += bflo(av[2]); v1[1] += bfhi(av[2]); v1[2] += bflo(av[3]); v1[3] += bfhi(av[3]); }
                    *(u32x4*)(dst + noff) = pack8(v0, v1); } }
    }
};
struct EpiX1 {
    static constexpr bool PERM = true;
    const float *x, *pos, *mod, *b_out; bf16_t* x1b;
    __device__ __forceinline__ void operator()(const f32x4 (&acc)[2][2][4][2], const Unit& u, int wr, int wc, int fr, int fq) const {
        const int row0 = u.pm * BM + wr * 64 + fr, col0 = u.pn * BM + wc * 32 + 8 * fq;
        const int b = (u.pm * BM) >> 11;
        f32x4 bv[2][2], gv[2][2];
#pragma unroll
        for (int bj = 0; bj < 2; ++bj)
#pragma unroll
            for (int n = 0; n < 2; ++n) { bv[bj][n] = *(const f32x4*)(b_out + col0 + bj * HALF + 4 * n); gv[bj][n] = *(const f32x4*)(mod + (size_t)b * 6144 + 2 * 1024 + col0 + bj * HALF + 4 * n); }
#pragma unroll
        for (int ai = 0; ai < 2; ++ai)
#pragma unroll
            for (int m = 0; m < 4; ++m) { const int row = row0 + ai * HALF + m * 16; const size_t off = (size_t)row * DM + col0; const size_t poff = (size_t)(row & 2047) * DM + col0;
#pragma unroll
                for (int bj = 0; bj < 2; ++bj) { f32x4 r[2];
#pragma unroll
                    for (int n = 0; n < 2; ++n) { const f32x4 xv = __builtin_nontemporal_load((const f32x4*)(x + off + bj * HALF + 4 * n)), pv = *(const f32x4*)(pos + poff + bj * HALF + 4 * n);
                        r[n] = xv + pv + gv[bj][n] * (acc[ai][bj][m][n] + bv[bj][n]); }
                    *(u32x4*)(x1b + off + bj * HALF) = pack8(r[0], r[1]); } }
    }
};
}

constexpr int XC_STRIDE = 272;
constexpr int HT_STRIDE = 132;
constexpr int XC_BYTES = 64 * XC_STRIDE, HT_BYTES = 64 * HT_STRIDE * 4, SCAN_CW_OFF = 2 * XC_BYTES + 2 * HT_BYTES;
template <int DIR>
__device__ __forceinline__ void scan_dir(PREF p, LAS unsigned char* lds, int b, int head) {
    const int tid = tid_opaque(), w = tid >> 6, l = tid & 63, c16 = l & 15, q4 = l >> 4;
    LAS float* CW = (LAS float*)(lds + SCAN_CW_OFF);
    const int ch = head * 128 + 16 * w + c16;
    bf16x8 bfa[4], bfx[4];
    {
        const bf16_t* Ga = p.gates_bf + ((size_t)((DIR * 2 + 0) * 8 + head) * 128 + 16 * w + c16) * 128 + 8 * q4;
        const bf16_t* Gx = p.gates_bf + ((size_t)((DIR * 2 + 1) * 8 + head) * 128 + 16 * w + c16) * 128 + 8 * q4;
#pragma unroll
        for (int ks = 0; ks < 4; ++ks) { bfa[ks] = *(const bf16x8*)(Ga + 32 * ks); bfx[ks] = *(const bf16x8*)(Gx + 32 * ks); }
    }
    const float nba = -1.4426950409f * p.lru_ba[DIR * 1024 + ch], nbx = -1.4426950409f * p.lru_bx[DIR * 1024 + ch];
    const float m8sp = -8.0f * log1pf(expf(-p.lru_lambda[DIR * 1024 + ch])) * 1.4426950409f;
    const int pos4 = DIR == 0 ? q4 : 3 - q4;
    const int src1 = (DIR == 0 ? l - 16 : l + 16) & 63, src2 = (DIR == 0 ? l - 32 : l + 32) & 63, srcl = DIR == 0 ? c16 + 48 : c16;
    float carry = 0.f;
    const int tt = tid >> 3, cg = tid & 7;
#define SCAN_CREF(k, SEQI, T0, TSEQ, SRC) const int SEQI = (k) >= 4 ? 1 : 0; const int TSEQ = SEQI ? SEQ : CTXL; \
        const int T0 = (DIR == 0 ? (SEQI ? (k) - 4 : (k)) : (SEQI ? 35 - (k) : 3 - (k))) * 64; const bf16_t* SRC = SEQI ? p.zx + (size_t)b * SEQ * DM : p.zxc + (size_t)b * CTXL * DM;
#define SCAN_LOADZ(k) do { SCAN_CREF(k, sq_, t0_, ts_, sr_) \
        if (t0_ >= 1 && t0_ + 66 <= ts_) { const bf16_t* zp_ = sr_ + (size_t)(t0_ + tt - 1) * DM + head * 128 + 16 * cg;     \
            _Pragma("unroll") for (int r_ = 0; r_ < 4; ++r_) { Z[2 * r_] = *(const u32x4*)(zp_ + (size_t)r_ * DM); Z[2 * r_ + 1] = *(const u32x4*)(zp_ + (size_t)r_ * DM + 8); } } \
        else { _Pragma("unroll") for (int r_ = 0; r_ < 4; ++r_) { const int tr_ = t0_ + tt - 1 + r_; const bool ok_ = tr_ >= 0 && tr_ < ts_; \
            const bf16_t* zp_ = sr_ + (size_t)(ok_ ? tr_ : 0) * DM + head * 128 + 16 * cg; const u32x4 za_ = *(const u32x4*)zp_, zb_ = *(const u32x4*)(zp_ + 8); const u32x4 zz_ = (u32x4){0u, 0u, 0u, 0u}; \
            Z[2 * r_] = ok_ ? za_ : zz_; Z[2 * r_ + 1] = ok_ ? zb_ : zz_; } } } while (0)
#define SCAN_BUILD(XCB) do { f32x2 xc2[8]; \
        { const LAS f32x4* cb_ = (const LAS f32x4*)(CW + 4 * 128 + 16 * cg); _Pragma("unroll") for (int j4 = 0; j4 < 4; ++j4) { const f32x4 v_ = cb_[j4]; xc2[2 * j4] = (f32x2){v_[0], v_[1]}; xc2[2 * j4 + 1] = (f32x2){v_[2], v_[3]}; } } \
        _Pragma("unroll") for (int r = 0; r < 4; ++r) { const u32x4 z0 = Z[2 * r], z1 = Z[2 * r + 1]; const LAS f32x4* cw_ = (const LAS f32x4*)(CW + r * 128 + 16 * cg); \
            _Pragma("unroll") for (int j4 = 0; j4 < 4; ++j4) { const f32x4 w_ = cw_[j4]; const unsigned da_ = j4 < 2 ? z0[2 * j4] : z1[2 * (j4 - 2)], db_ = j4 < 2 ? z0[2 * j4 + 1] : z1[2 * (j4 - 2) + 1]; \
                xc2[2 * j4] = (f32x2){w_[0], w_[1]} * (f32x2){bflo(da_), bfhi(da_)} + xc2[2 * j4]; xc2[2 * j4 + 1] = (f32x2){w_[2], w_[3]} * (f32x2){bflo(db_), bfhi(db_)} + xc2[2 * j4 + 1]; } } \
        u32x4 o0_, o1_; o0_[0] = pk2(xc2[0][0], xc2[0][1]); o0_[1] = pk2(xc2[1][0], xc2[1][1]); o0_[2] = pk2(xc2[2][0], xc2[2][1]); o0_[3] = pk2(xc2[3][0], xc2[3][1]); \
        o1_[0] = pk2(xc2[4][0], xc2[4][1]); o1_[1] = pk2(xc2[5][0], xc2[5][1]); o1_[2] = pk2(xc2[6][0], xc2[6][1]); o1_[3] = pk2(xc2[7][0], xc2[7][1]); \
        *(LAS u32x4*)((XCB) + tt * XC_STRIDE + cg * 32) = o0_; *(LAS u32x4*)((XCB) + tt * XC_STRIDE + cg * 32 + 16) = o1_; } while (0)
    u32x4 Z[8];
    SCAN_LOADZ(0);
    SCAN_BUILD(lds);
    SCAN_LOADZ(1);
    __syncthreads();
    size_t off_prev = 0; int seqi_prev = 0;
    u32x4 f0 = (u32x4){0u, 0u, 0u, 0u}, f1 = f0, g0 = f0, g1 = f0;
    for (int k = 0; k <= 36; ++k) {
        if (k > 0 && seqi_prev == 1) {
            const LAS float* HTp = (const LAS float*)(lds + 2 * XC_BYTES + ((k - 1) & 1) * HT_BYTES);
            const LAS f32x4* hp = (const LAS f32x4*)(HTp + tt * HT_STRIDE + 16 * cg);
            const f32x4 h0 = hp[0], h1 = hp[1], h2 = hp[2], h3 = hp[3];
            const size_t off = off_prev;
            if (DIR == 0) {
                *(u32x4*)(p.hf + off) = pg8::pack8(h0, h1); *(u32x4*)(p.hf + off + 8) = pg8::pack8(h2, h3);
            } else {
                f32x4 y0, y1, y2, y3;
                y0[0] = (h0[0] + bflo(f0[0])) * bflo(g0[0]); y0[1] = (h0[1] + bfhi(f0[0])) * bfhi(g0[0]); y0[2] = (h0[2] + bflo(f0[1])) * bflo(g0[1]); y0[3] = (h0[3] + bfhi(f0[1])) * bfhi(g0[1]);
                y1[0] = (h1[0] + bflo(f0[2])) * bflo(g0[2]); y1[1] = (h1[1] + bfhi(f0[2])) * bfhi(g0[2]); y1[2] = (h1[2] + bflo(f0[3])) * bflo(g0[3]); y1[3] = (h1[3] + bfhi(f0[3])) * bfhi(g0[3]);
                y2[0] = (h2[0] + bflo(f1[0])) * bflo(g1[0]); y2[1] = (h2[1] + bfhi(f1[0])) * bfhi(g1[0]); y2[2] = (h2[2] + bflo(f1[1])) * bflo(g1[1]); y2[3] = (h2[3] + bfhi(f1[1])) * bfhi(g1[1]);
                y3[0] = (h3[0] + bflo(f1[2])) * bflo(g1[2]); y3[1] = (h3[1] + bfhi(f1[2])) * bfhi(g1[2]); y3[2] = (h3[2] + bflo(f1[3])) * bflo(g1[3]); y3[3] = (h3[3] + bfhi(f1[3])) * bfhi(g1[3]);
                *(u32x4*)(p.ybin + off) = pg8::pack8(y0, y1); *(u32x4*)(p.ybin + off + 8) = pg8::pack8(y2, y3);
            }
        }
        if (k == 36) break;
        if (k + 1 < 36) { SCAN_BUILD(lds + ((k + 1) & 1) * XC_BYTES); if (k + 2 < 36) SCAN_LOADZ(k + 2); }
        SCAN_CREF(k, seqi, t0, Tseq, src) (void)Tseq; (void)src;
        {
            const size_t off = ((size_t)b * SEQ + t0 + tt) * DM + head * 128 + 16 * cg;
            if (DIR == 1 && seqi == 1) { f0 = *(const u32x4*)(p.hf + off); f1 = *(const u32x4*)(p.hf + off + 8); g0 = __builtin_nontemporal_load((const u32x4*)(p.gzy + off)); g1 = __builtin_nontemporal_load((const u32x4*)(p.gzy + off + 8)); }
            off_prev = off; seqi_prev = seqi;
        }
        {
            const LAS unsigned char* XC = lds + (k & 1) * XC_BYTES;
            LAS float* HT = (LAS float*)(lds + 2 * XC_BYTES + (k & 1) * HT_BYTES);
            f32x4 accr[4], acci[4];
#pragma unroll
            for (int mt = 0; mt < 4; ++mt) { accr[mt] = (f32x4){0.f, 0.f, 0.f, 0.f}; acci[mt] = (f32x4){0.f, 0.f, 0.f, 0.f}; }
#pragma unroll
            for (int mt = 0; mt < 4; ++mt)
#pragma unroll
                for (int ks = 0; ks < 4; ++ks) { const bf16x8 a = *(const LAS bf16x8*)(XC + (16 * mt + c16) * XC_STRIDE + (32 * ks + 8 * q4) * 2);
                    accr[mt] = __builtin_amdgcn_mfma_f32_16x16x32_bf16(a, bfa[ks], accr[mt], 0, 0, 0);
                    acci[mt] = __builtin_amdgcn_mfma_f32_16x16x32_bf16(a, bfx[ks], acci[mt], 0, 0, 0); }
#pragma unroll
            for (int mi = 0; mi < 4; ++mi) {
                const int mt = DIR == 0 ? mi : 3 - mi;
                float av[4], bv[4];
#pragma unroll
                for (int reg = 0; reg < 4; ++reg) {
                    const float xcv = bf2f(*(const LAS bf16_t*)(XC + (16 * mt + 4 * q4 + reg) * XC_STRIDE + (16 * w + c16) * 2));
                    const float r = __builtin_amdgcn_rcpf(1.0f + __builtin_amdgcn_exp2f(__builtin_fmaf(accr[mt][reg], -1.4426950409f, nba))), ig = __builtin_amdgcn_rcpf(1.0f + __builtin_amdgcn_exp2f(__builtin_fmaf(acci[mt][reg], -1.4426950409f, nbx)));
                    const float a = __builtin_amdgcn_exp2f(m8sp * r);
                    av[reg] = a; bv[reg] = __builtin_amdgcn_sqrtf(1.0f - a * a) * ig * xcv;
                }
                float A, B;
                if (DIR == 0) { A = av[0]; B = bv[0];
#pragma unroll
                    for (int reg = 1; reg < 4; ++reg) { B = av[reg] * B + bv[reg]; A *= av[reg]; } }
                else { A = av[3]; B = bv[3];
#pragma unroll
                    for (int reg = 2; reg >= 0; --reg) { B = av[reg] * B + bv[reg]; A *= av[reg]; } }
                { const float A1 = __shfl(A, src1), B1 = __shfl(B, src1); if (pos4 >= 1) { B = A * B1 + B; A = A * A1; } }
                { const float A2 = __shfl(A, src2), B2 = __shfl(B, src2); if (pos4 >= 2) { B = A * B2 + B; A = A * A2; } }
                float Aex = __shfl(A, src1), Bex = __shfl(B, src1); if (pos4 == 0) { Aex = 1.f; Bex = 0.f; }
                const float A3 = __shfl(A, srcl), B3 = __shfl(B, srcl);
                float hs = Aex * carry + Bex;
                float st[4];
                if (DIR == 0) {
#pragma unroll
                    for (int reg = 0; reg < 4; ++reg) { hs = av[reg] * hs + bv[reg]; st[reg] = hs; } }
                else {
#pragma unroll
                    for (int reg = 3; reg >= 0; --reg) { hs = av[reg] * hs + bv[reg]; st[reg] = hs; } }
                carry = A3 * carry + B3;
                if (seqi == 1) {
#pragma unroll
                    for (int reg = 0; reg < 4; ++reg) HT[(16 * mt + 4 * q4 + reg) * HT_STRIDE + 16 * w + c16] = st[reg]; }
            }
        }
        __syncthreads();
    }
#undef SCAN_CREF
#undef SCAN_LOADZ
#undef SCAN_BUILD
}
__device__ __forceinline__ void dev_scan(PREF p, LAS unsigned char* lds) {
    LAS float* CW = (LAS float*)(lds + SCAN_CW_OFF);
    for (int item = blockIdx.x; item < p.nb * 8; item += gridDim.x) {
        const int b = item >> 3, head = item & 7;
        __syncthreads();
        for (int i = tid_opaque(); i < 640; i += NTHR) CW[i] = (i < 512) ? p.conv_w[(i >> 7) * 1024 + head * 128 + (i & 127)] : p.conv_b[head * 128 + (i - 512)];
        __syncthreads();
        scan_dir<0>(p, lds, b, head);
        __syncthreads();
        scan_dir<1>(p, lds, b, head);
    }
}

#define CASD(a, b) { const int _x = max(a, b), _y = min(a, b); a = _x; b = _y; }
template <int K, int J, int BASE, int N> __device__ __forceinline__ void bitonic_step(int (&v)[N]) {
#pragma unroll
    for (int i = 0; i < 16; ++i) { const int l = i ^ J; if (l > i) { if ((i & K) == 0) { CASD(v[BASE + i], v[BASE + l]); } else { CASD(v[BASE + l], v[BASE + i]); } } }
}
template <int BASE, int N> __device__ __forceinline__ void sort16_desc(int (&v)[N]) {
    bitonic_step<2, 1, BASE>(v);
    bitonic_step<4, 2, BASE>(v); bitonic_step<4, 1, BASE>(v);
    bitonic_step<8, 4, BASE>(v); bitonic_step<8, 2, BASE>(v); bitonic_step<8, 1, BASE>(v);
    bitonic_step<16, 8, BASE>(v); bitonic_step<16, 4, BASE>(v); bitonic_step<16, 2, BASE>(v); bitonic_step<16, 1, BASE>(v);
}
template <int AB, int BB, int NA, int NB> __device__ __forceinline__ void merge16(int (&a)[NA], const int (&b)[NB]) {
#pragma unroll
    for (int i = 0; i < 16; ++i) a[AB + i] = max(a[AB + i], b[BB + 15 - i]);
    bitonic_step<32, 8, AB>(a); bitonic_step<32, 4, AB>(a); bitonic_step<32, 2, AB>(a); bitonic_step<32, 1, AB>(a);
}
__device__ __forceinline__ void top16_of_64(int (&v)[64]) {
    sort16_desc<0>(v); sort16_desc<16>(v); sort16_desc<32>(v); sort16_desc<48>(v);
    merge16<0, 16>(v, v); merge16<32, 48>(v, v); merge16<0, 32>(v, v);
}
__device__ __forceinline__ int f2key(float f) { const int b = __float_as_int(f); return b ^ ((b >> 31) & 0x7fffffff); }
__device__ __forceinline__ float key2f(int k) { return __int_as_float(k ^ ((k >> 31) & 0x7fffffff)); }
__device__ __forceinline__ int lut16(unsigned t0, unsigned t1, unsigned t2, unsigned t3, int i) {
    const int wsel = i >> 2; const unsigned lo = (wsel & 1) ? t1 : t0, hi = (wsel & 1) ? t3 : t2; const unsigned wv = (wsel & 2) ? hi : lo;
    return (int)((wv >> (8 * (i & 3))) & 0xffu);
}
#define CROW(I, CNT, OFF) { _Pragma("unroll") for (int j = 0; j < CNT; ++j) cv[OFF + j] = (f2key(s0[I] + s1[j]) & ~255) | (I << 4) | j; }
constexpr int TK_ROW = 272;
__device__ __forceinline__ void dev_topk(PREF p, LAS unsigned char* lds) {
    const int tid = tid_opaque(), w = tid >> 6, l = tid & 63, tl = l & 31, hh = l >> 5;
    const int T = p.nb * SEQ;
    const int hd = blockIdx.x & 7, sub = blockIdx.x >> 3, nsub = gridDim.x >> 3;
    __syncthreads();
    {
        const bf16_t* kg = p.keys_bf + (size_t)hd * 2 * 128 * 128;
        for (int c = tid; c < 2 * 128 * 16; c += NTHR) { const int row = c >> 4, ch = c & 15; *(LAS u32x4*)(lds + row * TK_ROW + ch * 16) = *(const u32x4*)(kg + (size_t)row * 128 + ch * 8); }
    }
    __syncthreads();
    for (int tg = sub * 8 + w; tg < T / 32; tg += nsub * 8) {
        const int tok = tg * 32 + tl;
        int k0[16], k1[16];
        u32x4 qr[8];
        LAS unsigned char* qrel = lds + 2 * 128 * TK_ROW + w * (32 * TK_ROW);
#define TK_QLOAD(ph_) do { _Pragma("unroll") for (int i_ = 0; i_ < 8; ++i_) { const int tk_ = tg * 32 + 8 * (i_ >> 1) + (l & 7), tr_ = tk_ & 255, ch_ = 8 * (i_ & 1) + (l >> 3);     \
            qr[i_] = __builtin_nontemporal_load((const u32x4*)(p.q + ((size_t)(tk_ >> 8) * 8 + hd) * 65536 + (size_t)((((tr_ >> 6) & 1) * 4 + (ch_ >> 2)) * 8192 + (((tr_ >> 7) * 4 + ((tr_ >> 4) & 3)) * 2 + (ph_)) * 512 + ((tr_ & 15) + 16 * (ch_ & 3)) * 8))); } } while (0)
#define TK_QSTORE() do { _Pragma("unroll") for (int i_ = 0; i_ < 8; ++i_) *(LAS u32x4*)(qrel + (8 * (i_ >> 1) + (l & 7)) * TK_ROW + 16 * (8 * (i_ & 1) + (l >> 3))) = qr[i_]; } while (0)
        TK_QLOAD(0);
#pragma unroll
        for (int ph = 0; ph < 2; ++ph) {
            f32x16 acc[4];
#pragma unroll
            for (int kb = 0; kb < 4; ++kb)
#pragma unroll
                for (int r = 0; r < 16; ++r) acc[kb][r] = 0.f;
            const LAS unsigned char* kpl = lds + (ph * 128 + tl) * TK_ROW + 16 * hh;
            TK_QSTORE();
            if (ph == 0) TK_QLOAD(1);
#pragma unroll
            for (int ks = 0; ks < 8; ++ks) {
                if (ks == 2 || ks == 4 || ks == 6) asm volatile("" : "+v"(acc[0]), "+v"(acc[1]), "+v"(acc[2]), "+v"(acc[3]));
                const bf16x8 bq = *(const LAS bf16x8*)(qrel + tl * TK_ROW + 32 * ks + 16 * hh);
#pragma unroll
                for (int kb = 0; kb < 4; ++kb) { const bf16x8 ak = *(const LAS bf16x8*)(kpl + kb * 32 * TK_ROW + 32 * ks);
                    acc[kb] = __builtin_amdgcn_mfma_f32_32x32x16_bf16(ak, bq, acc[kb], 0, 0, 0); }
            }
            int v[64];
#pragma unroll
            for (int kb = 0; kb < 4; ++kb)
#pragma unroll
                for (int r = 0; r < 16; ++r) { const int idx = 32 * kb + (r & 3) + 8 * (r >> 2); v[kb * 16 + r] = (f2key(acc[kb][r]) & ~127) | idx | (hh << 2); }
            top16_of_64(v);
            int o[16];
#pragma unroll
            for (int i = 0; i < 16; ++i) o[i] = shx_i(v[i], 32);
            merge16<0, 0>(v, o);
#pragma unroll
            for (int i = 0; i < 16; ++i) { if (ph == 0) k0[i] = v[i]; else k1[i] = v[i]; }
        }
        float s0[16], s1[16];
#pragma unroll
        for (int i = 0; i < 16; ++i) { s0[i] = key2f(k0[i] & ~127); s1[i] = key2f(k1[i] & ~127); }
        int cv[64];
        CROW(0, 16, 0) CROW(1, 8, 16) CROW(2, 5, 24) CROW(3, 4, 29) CROW(4, 3, 33) CROW(5, 2, 36) CROW(6, 2, 38) CROW(7, 2, 40)
        CROW(8, 1, 42) CROW(9, 1, 43) CROW(10, 1, 44) CROW(11, 1, 45) CROW(12, 1, 46) CROW(13, 1, 47) CROW(14, 1, 48) CROW(15, 1, 49)
#pragma unroll
        for (int i = 50; i < 64; ++i) cv[i] = (int)0x80000000;
        top16_of_64(cv);
#define PK4(K, W) ((unsigned)(K[4 * W] & 127) | ((unsigned)(K[4 * W + 1] & 127) << 8) | ((unsigned)(K[4 * W + 2] & 127) << 16) | ((unsigned)(K[4 * W + 3] & 127) << 24))
        unsigned ta0 = PK4(k0, 0), ta1 = PK4(k0, 1), ta2 = PK4(k0, 2), ta3 = PK4(k0, 3);
        unsigned tc0 = PK4(k1, 0), tc1 = PK4(k1, 1), tc2 = PK4(k1, 2), tc3 = PK4(k1, 3);
        asm volatile("" : "+v"(ta0), "+v"(ta1), "+v"(ta2), "+v"(ta3), "+v"(tc0), "+v"(tc1), "+v"(tc2), "+v"(tc3));
        const float mx = key2f(cv[0] & ~255);
        float e[16], sum = 0.f;
#pragma unroll
        for (int k = 0; k < 16; ++k) { e[k] = __builtin_amdgcn_exp2f((key2f(cv[k] & ~255) - mx) * 1.4426950409f); sum += e[k]; }
        const float inv = 1.0f / sum;
        int eo[8]; float go[8];
#pragma unroll
        for (int k = 0; k < 8; ++k) { int c_lo = cv[k], c_hi = cv[8 + k]; float e_lo = e[k], e_hi = e[8 + k];
            asm volatile("" : "+v"(c_lo), "+v"(c_hi), "+v"(e_lo), "+v"(e_hi));
            const int cvk = hh ? c_hi : c_lo; const float ek = hh ? e_hi : e_lo;
            const int i = (cvk >> 4) & 15, j = cvk & 15;
            eo[k] = lut16(ta0, ta1, ta2, ta3, i) * 128 + lut16(tc0, tc1, tc2, tc3, j); go[k] = ek * inv; }
        float so[8];
#pragma unroll
        for (int k = 0; k < 8; ++k) { const f32x2 s2 = *(const f32x2*)(p.scu + 2 * eo[k]); go[k] *= s2[1]; so[k] = s2[0]; }
        const size_t off = (size_t)tok * 128 + hd * 16 + hh * 8;
        *(u32x4*)(p.eidx + off) = (u32x4){(unsigned)eo[0], (unsigned)eo[1], (unsigned)eo[2], (unsigned)eo[3]};
        *(u32x4*)(p.eidx + off + 4) = (u32x4){(unsigned)eo[4], (unsigned)eo[5], (unsigned)eo[6], (unsigned)eo[7]};
        *(f32x4*)(p.gw + off) = (f32x4){go[0], go[1], go[2], go[3]};
        *(f32x4*)(p.gw + off + 4) = (f32x4){go[4], go[5], go[6], go[7]};
        *(f32x4*)(p.su + off) = (f32x4){so[0], so[1], so[2], so[3]};
        *(f32x4*)(p.su + off + 4) = (f32x4){so[4], so[5], so[6], so[7]};
    }
}

__device__ __forceinline__ float dot8(const u32x4 a, const u32x4 b, float acc) {
    const unsigned a0 = a[0], a1 = a[1], a2 = a[2], a3 = a[3], b0 = b[0], b1 = b[1], b2 = b[2], b3 = b[3];
    asm("v_dot2c_f32_bf16 %0, %1, %2" : "+v"(acc) : "v"(a0), "v"(b0));
    asm("v_dot2c_f32_bf16 %0, %1, %2" : "+v"(acc) : "v"(a1), "v"(b1));
    asm("v_dot2c_f32_bf16 %0, %1, %2" : "+v"(acc) : "v"(a2), "v"(b2));
    asm("v_dot2c_f32_bf16 %0, %1, %2" : "+v"(acc) : "v"(a3), "v"(b3));
    return acc;
}
__device__ __forceinline__ void dev_peer(PREF p) {
    const int tid = tid_opaque(), w = tid >> 6, l = tid & 63;
    const int T = p.nb * SEQ;
    const int b5 = (l >> 5) & 1, b4 = (l >> 4) & 1, b3 = (l >> 3) & 1;
    for (int tok = blockIdx.x * 8 + w; tok < T; tok += gridDim.x * 8) {
        const int b = tok >> 11;
        const u32x4 ha = *(const u32x4*)(p.h2 + (size_t)tok * DM + 8 * l), hb = *(const u32x4*)(p.h2 + (size_t)tok * DM + 512 + 8 * l);
        const int e_lo = p.eidx[(size_t)tok * 128 + l], e_hi = p.eidx[(size_t)tok * 128 + 64 + l];
        const float g_lo = p.gw[(size_t)tok * 128 + l], g_hi = p.gw[(size_t)tok * 128 + 64 + l];
        float acc[16];
#pragma unroll
        for (int i = 0; i < 16; ++i) acc[i] = 0.f;
        for (int grp = 0; grp < 16; ++grp) {
            const int esrc = grp < 8 ? e_lo : e_hi; const float gsrc = grp < 8 ? g_lo : g_hi; const int lbase = (grp & 7) * 8;
            int e[8];
#pragma unroll
            for (int k = 0; k < 8; ++k) e[k] = __builtin_amdgcn_readlane(esrc, lbase + k);
            u32x4 s0[8], s1[8];
            float part[8];
            {
                u32x4 r0[8], r1[8];
#pragma unroll
                for (int k = 0; k < 8; ++k) { const bf16_t* up = p.u_bf + (size_t)e[k] * DM + 8 * l; r0[k] = *(const u32x4*)up; r1[k] = *(const u32x4*)(up + 512); }
#pragma unroll
                for (int k = 0; k < 8; ++k) part[k] = dot8(r1[k], hb, dot8(r0[k], ha, 0.f));
            }
            asm volatile("" : "+v"(part[0]), "+v"(part[1]), "+v"(part[2]), "+v"(part[3]), "+v"(part[4]), "+v"(part[5]), "+v"(part[6]), "+v"(part[7]));
#pragma unroll
            for (int k = 0; k < 8; ++k) { const bf16_t* vp = p.v_bf + (size_t)e[k] * DM + 8 * l; s0[k] = *(const u32x4*)vp; s1[k] = *(const u32x4*)(vp + 512); }
            float q4v[4];
#pragma unroll
            for (int k = 0; k < 4; ++k) { const float send = b5 ? part[k] : part[k + 4]; const float recv = __shfl_xor(send, 32); q4v[k] = (b5 ? part[k + 4] : part[k]) + recv; }
            float r2[2];
#pragma unroll
            for (int k = 0; k < 2; ++k) { const float send = b4 ? q4v[k] : q4v[k + 2]; const float recv = __shfl_xor(send, 16); r2[k] = (b4 ? q4v[k + 2] : q4v[k]) + recv; }
            float sdot;
            { const float send = b3 ? r2[0] : r2[1]; const float recv = __shfl_xor(send, 8); sdot = (b3 ? r2[1] : r2[0]) + recv; }
            sdot += __shfl_xor(sdot, 4); sdot += __shfl_xor(sdot, 2); sdot += __shfl_xor(sdot, 1);
            const int kk = 4 * b5 + 2 * b4 + b3;
            const float gv = __shfl(gsrc, lbase + kk);
            const float wv = gv * gelu_f(sdot);
#pragma unroll
            for (int k = 0; k < 8; ++k) {
                const float wk = __int_as_float(__builtin_amdgcn_readlane(__float_as_int(wv), ((k >> 2) & 1) * 32 + ((k >> 1) & 1) * 16 + (k & 1) * 8));
#pragma unroll
                for (int i = 0; i < 4; ++i) { acc[2 * i] += wk * bflo(s0[k][i]); acc[2 * i + 1] += wk * bfhi(s0[k][i]); acc[8 + 2 * i] += wk * bflo(s1[k][i]); acc[8 + 2 * i + 1] += wk * bfhi(s1[k][i]); }
            }
        }
        const float* x1p = p.x1 + (size_t)tok * DM; const float* g2p = p.mod + (size_t)b * 6144 + 5 * 1024;
        f32x4 xv[4]; float ss = 0.f;
#pragma unroll
        for (int hlf = 0; hlf < 2; ++hlf)
#pragma unroll
            for (int q = 0; q < 2; ++q) { const int d = hlf * 512 + 8 * l + 4 * q; const f32x4 xx = *(const f32x4*)(x1p + d), gg = *(const f32x4*)(g2p + d);
                f32x4 r;
#pragma unroll
                for (int j = 0; j < 4; ++j) { r[j] = xx[j] + gg[j] * acc[hlf * 8 + 4 * q + j]; ss += r[j] * r[j]; }
                xv[hlf * 2 + q] = r; }
        ss = wave_sum(ss);
        const float rs = rsqrtf(ss * (1.0f / 1024.0f) + 1e-6f);
#pragma unroll
        for (int hlf = 0; hlf < 2; ++hlf)
#pragma unroll
            for (int q = 0; q < 2; ++q) { const int d = hlf * 512 + 8 * l + 4 * q; const f32x4 fg = *(const f32x4*)(p.final_g + d);
                f32x4 o;
#pragma unroll
                for (int j = 0; j < 4; ++j) o[j] = xv[hlf * 2 + q][j] * rs * fg[j];
                *(f32x4*)(p.out + (size_t)tok * DM + d) = o; }
    }
}


__device__ __forceinline__ float table_scale(unsigned maxbits) { const float m = fmaxf(__uint_as_float(maxbits), 1e-30f); return exp2f(floorf(log2f(448.0f / m))); }
__device__ __forceinline__ void dev_tabmax(PREF p) {
    const int tid = tid_opaque();
    float mu = 0.f, mv = 0.f;
    for (size_t i = ((size_t)blockIdx.x * NTHR + tid) * 4; i < (size_t)16384 * 1024; i += (size_t)gridDim.x * NTHR * 4) {
        const f32x4 a = *(const f32x4*)(p.peer_u + i), b = *(const f32x4*)(p.peer_v + i);
        mu = fmaxf(mu, fmaxf(fmaxf(fabsf(a[0]), fabsf(a[1])), fmaxf(fabsf(a[2]), fabsf(a[3]))));
        mv = fmaxf(mv, fmaxf(fmaxf(fabsf(b[0]), fabsf(b[1])), fmaxf(fabsf(b[2]), fabsf(b[3])))); }
#pragma unroll
    for (int o = 1; o < 64; o <<= 1) { mu = fmaxf(mu, __shfl_xor(mu, o)); mv = fmaxf(mv, __shfl_xor(mv, o)); }
    if ((tid & 63) == 0) { atomicMax(p.tmax + 0, __float_as_uint(mu)); atomicMax(p.tmax + 1, __float_as_uint(mv)); }
}
__device__ __forceinline__ unsigned fp4_code(float x) {
    const float ax = fabsf(x);
    unsigned c = ax < 0.25f ? 0u : ax < 0.75f ? 1u : ax < 1.25f ? 2u : ax < 1.75f ? 3u : ax < 2.5f ? 4u : ax < 3.5f ? 5u : ax < 5.0f ? 6u : 7u;
    return c | (x < 0.f ? 8u : 0u);
}
__device__ __forceinline__ void tab8_row(PREF p, const f32x4 (&a)[4], int r, int lane) {
    const int tab = r >> 14, e = r & 16383;
    float m = 0.f, ss = 0.f;
#pragma unroll
    for (int i = 0; i < 4; ++i) { m = fmaxf(m, fmaxf(fmaxf(fabsf(a[i][0]), fabsf(a[i][1])), fmaxf(fabsf(a[i][2]), fabsf(a[i][3]))));
        ss += (a[i][0] * a[i][0] + a[i][1] * a[i][1]) + (a[i][2] * a[i][2] + a[i][3] * a[i][3]); }
#pragma unroll
    for (int o = 1; o < 64; o <<= 1) { m = fmaxf(m, shx_f(m, o)); ss += shx_f(ss, o); }
    const float rms = sqrtf(ss * (1.0f / 1024.0f));
    const float sc = m > 0.f ? fminf(2.0f / rms, 9.0f / m) : 1.0f;
    unsigned char* dst = (tab ? p.v4 : p.u4) + (size_t)e * 128 + 2 * lane;
#pragma unroll
    for (int i = 0; i < 4; ++i) { unsigned b = 0u;
        b = __builtin_amdgcn_cvt_scalef32_pk_fp4_f32(b, a[i][0] * sc, a[i][1] * sc, 1.0f, 0); b = __builtin_amdgcn_cvt_scalef32_pk_fp4_f32(b, a[i][2] * sc, a[i][3] * sc, 1.0f, 1);
        *(unsigned short*)(dst + (size_t)i * 16384 * 128) = (unsigned short)b; }
    if (lane == 0) p.scu[2 * e + tab] = 1.0f / sc;
}
__device__ __forceinline__ void dev_tab8(PREF p) {
    const int tid = tid_opaque();
    const int w = tid >> 6, lane = tid & 63;
    const int G = (int)gridDim.x, nctx = (p.nb * CTXL / 256) * 4, NR = 2 * 16384;
    const int Wt = nctx + 7 * (G - nctx), unit = (G > nctx) ? NR / Wt : 0;
    int first, S, end;
    if (G > nctx && unit * Wt == NR && (unit & 7) == 0) { const int b = (int)blockIdx.x; const int r0 = b < nctx ? b * unit : nctx * unit + (b - nctx) * 7 * unit; first = r0 + w; S = 8; end = r0 + (b < nctx ? unit : 7 * unit); }
    else { first = (int)blockIdx.x * 8 + w; S = G * 8; end = NR; }
#define TAB_LOAD(A, r) do { const int r_ = (r) < NR ? (r) : NR - 1; const float* s_ = ((r_ >> 14) ? p.peer_v : p.peer_u) + (size_t)(r_ & 16383) * 1024 + 4 * lane; \
        _Pragma("unroll") for (int i_ = 0; i_ < 4; ++i_) A[i_] = __builtin_nontemporal_load((const f32x4*)(s_ + 256 * i_)); } while (0)
    f32x4 A0[4], A1[4], A2[4], A3[4];
    if (first < end) { TAB_LOAD(A0, first); TAB_LOAD(A1, first + S); TAB_LOAD(A2, first + 2 * S); }
    for (int r = first; r < end; r += 4 * S) {
        TAB_LOAD(A3, r + 3 * S); tab8_row(p, A0, r, lane);
        TAB_LOAD(A0, r + 4 * S); if (r + S < end) tab8_row(p, A1, r + S, lane);
        TAB_LOAD(A1, r + 5 * S); if (r + 2 * S < end) tab8_row(p, A2, r + 2 * S, lane);
        TAB_LOAD(A2, r + 6 * S); if (r + 3 * S < end) tab8_row(p, A3, r + 3 * S, lane);
    }
#undef TAB_LOAD
}
#define PEER_ISSUE(R, E0, E1, E2, E3) do { _Pragma("unroll") for (int i_ = 0; i_ < 4; ++i_) { R[i_] = *(const u32x4*)(tab + (E0[i_] * 128u + kc16)); R[4 + i_] = *(const u32x4*)(tab + (E1[i_] * 128u + kc16)); \
        R[8 + i_] = *(const u32x4*)(tab + (E2[i_] * 128u + kc16)); R[12 + i_] = *(const u32x4*)(tab + (E3[i_] * 128u + kc16)); } } while (0)
#define PEER_LD_E(E0, E1, E2, E3, t) do { const u32x4* ep_ = (const u32x4*)(p.eidx + (size_t)(t) * 128 + 16 * rsub); E0 = ep_[0]; E1 = ep_[1]; E2 = ep_[2]; E3 = ep_[3]; } while (0)
typedef int i32x8 __attribute__((ext_vector_type(8)));
__device__ __forceinline__ void sddmm_compute(u32x4 (&R)[16], const u32x4 (&hb)[4], LAS unsigned char* wbuf, float* dst_tok, int l) {
    const int rsub = l >> 3, kc = l & 7, rho = l & 15, kg = l >> 4;
    const int wr0 = rsub * 128 + ((kc ^ rsub) << 4), wr1 = (8 + rsub) * 128 + ((kc ^ rsub ^ 1) << 4);
    const int key = (rho & 7) ^ (rho >> 3), rbase = rho * 128;
    i32x8 b0, b1;
#pragma unroll
    for (int i = 0; i < 4; ++i) { b0[i] = (int)hb[0][i]; b0[4 + i] = (int)hb[1][i]; b1[i] = (int)hb[2][i]; b1[4 + i] = (int)hb[3][i]; }
    f32x4 acc[8];
#pragma unroll
    for (int t = 0; t < 8; ++t) {
        LAS unsigned char* buf = wbuf + (t & 1) * 2048;
        *(LAS u32x4*)(buf + wr0) = R[t]; *(LAS u32x4*)(buf + wr1) = R[t + 8];
        const u32x4 x0 = *(const LAS u32x4*)(buf + rbase + ((kg ^ key) << 4)), x1 = *(const LAS u32x4*)(buf + rbase + (((4 + kg) ^ key) << 4));
        i32x8 a0, a1;
#pragma unroll
        for (int i = 0; i < 4; ++i) { a0[i] = (int)x0[i]; a0[4 + i] = 0; a1[i] = (int)x1[i]; a1[4 + i] = 0; }
        f32x4 c = (f32x4){0.f, 0.f, 0.f, 0.f};
        c = __builtin_amdgcn_mfma_scale_f32_16x16x128_f8f6f4(a0, b0, c, 4, 0, 0, 0x7f7f7f7f, 0, 0x7f7f7f7f);
        c = __builtin_amdgcn_mfma_scale_f32_16x16x128_f8f6f4(a1, b1, c, 4, 0, 0, 0x7f7f7f7f, 0, 0x7f7f7f7f);
        acc[t] = c;
    }
    const int reg = rho & 3, half = (rho >> 2) & 1;
    f32x4 o;
#pragma unroll
    for (int c4 = 0; c4 < 4; ++c4) { f32x4 lo = acc[c4], hi = acc[4 + c4];
        asm volatile("" : "+v"(lo), "+v"(hi));
        const f32x4 x = half ? hi : lo; float x0 = x[0], x1 = x[1], x2 = x[2], x3 = x[3];
        asm volatile("" : "+v"(x0), "+v"(x1), "+v"(x2), "+v"(x3));
        o[c4] = (reg & 2) ? ((reg & 1) ? x3 : x2) : ((reg & 1) ? x1 : x0); }
    if (rho < 8) *(f32x4*)(dst_tok + 16 * (4 * (kg & 1) + reg) + 8 * (kg >> 1) + 4 * half) = o;
}
__device__ __forceinline__ void dev_sddmm(PREF p, LAS unsigned char* lds) {
    const int tid = tid_opaque(), w = tid >> 6, l = tid & 63, rsub = l >> 3, kc = l & 7, kg = l >> 4;
    const int T = p.nb * SEQ; const int s = blockIdx.x & 3, sub = blockIdx.x >> 2, nsub = gridDim.x >> 2;
    const unsigned char* tab = p.u4 + (size_t)s * 16384 * 128; const unsigned kc16 = 16u * kc;
    const int first = sub * 8 + w, S = nsub * 8;
    const int n = first < T ? (T - first + S - 1) / S : 0;
    LAS unsigned char* wbuf = lds + w * 4096;
    float* pdb = p.pd + (size_t)s * T * 128;
#define TOKI(i) (first + ((i) < n ? (i) : n - 1) * S)
#define LD_H(H, t) do { const unsigned char* hp_ = p.h8 + (size_t)(t) * DM + 256 * s + 16 * kg; H[0] = *(const u32x4*)hp_; H[1] = *(const u32x4*)(hp_ + 64); H[2] = *(const u32x4*)(hp_ + 128); H[3] = *(const u32x4*)(hp_ + 192); } while (0)
    if (n > 0) {
        u32x4 RA[16], RB[16], eA0, eA1, eA2, eA3, eB0, eB1, eB2, eB3, hA[4], hB[4];
        PEER_LD_E(eA0, eA1, eA2, eA3, TOKI(0)); LD_H(hA, TOKI(0)); PEER_ISSUE(RA, eA0, eA1, eA2, eA3);
        PEER_LD_E(eB0, eB1, eB2, eB3, TOKI(1)); LD_H(hB, TOKI(1));
        for (int i = 0; i < n; i += 2) {
            PEER_ISSUE(RB, eB0, eB1, eB2, eB3);
            PEER_LD_E(eA0, eA1, eA2, eA3, TOKI(i + 2));
            sddmm_compute(RA, hA, wbuf, pdb + (size_t)TOKI(i) * 128, l);
            LD_H(hA, TOKI(i + 2));
            PEER_ISSUE(RA, eA0, eA1, eA2, eA3);
            PEER_LD_E(eB0, eB1, eB2, eB3, TOKI(i + 3));
            if (i + 1 < n) sddmm_compute(RB, hB, wbuf, pdb + (size_t)TOKI(i + 1) * 128, l);
            LD_H(hB, TOKI(i + 3));
        }
    }
#undef LD_H
}
__device__ __forceinline__ void dev_act(PREF p) {
    const int tid = tid_opaque(); const int T = p.nb * SEQ; const size_t n = (size_t)T * 128;
    for (size_t i = ((size_t)blockIdx.x * NTHR + tid) * 4; i < n; i += (size_t)gridDim.x * NTHR * 4) {
        f32x4 a = *(const f32x4*)(p.pd + i);
#pragma unroll
        for (int s = 1; s < 4; ++s) a += *(const f32x4*)(p.pd + (size_t)s * n + i);
        const u32x4 e = *(const u32x4*)(p.eidx + i);
        f32x4 g = *(const f32x4*)(p.gw + i);
#pragma unroll
        for (int j = 0; j < 4; ++j) g[j] *= gelu_f(a[j] * (0.25f * p.scu[2 * e[j]])) * p.scu[2 * e[j] + 1];
        *(f32x4*)(p.gw + i) = g;
    }
}
template <int CTRL> __device__ __forceinline__ float dpp_f(float v) { return __int_as_float(__builtin_amdgcn_update_dpp(0, __float_as_int(v), CTRL, 0xf, 0xf, true)); }
__device__ __forceinline__ void spmm_compute(PREF p, u32x4 (&R)[16], const f32x4 w0, const f32x4 w1, const f32x4 w2, const f32x4 w3, int t, int col, int l) {
    const int b5 = (l >> 5) & 1, b4 = (l >> 4) & 1, b3 = (l >> 3) & 1;
    f32x2 ac2[16];
#pragma unroll
    for (int i = 0; i < 16; ++i) ac2[i] = (f32x2){0.f, 0.f};
#pragma unroll
    for (int r = 0; r < 16; ++r) { const float wg = (r < 4) ? w0[r & 3] : (r < 8) ? w1[r & 3] : (r < 12) ? w2[r & 3] : w3[r & 3];
        if (r >= 1) asm volatile("" : "+v"(R[r]) : "v"(ac2[0]));
        const f32x2 wg2 = (f32x2){wg, wg};
#pragma unroll
        for (int i = 0; i < 4; ++i) {
            ac2[4 * i + 0] = wg2 * __builtin_amdgcn_cvt_scalef32_pk_f32_fp4(R[r][i], 1.0f, 0) + ac2[4 * i + 0];
            ac2[4 * i + 1] = wg2 * __builtin_amdgcn_cvt_scalef32_pk_f32_fp4(R[r][i], 1.0f, 1) + ac2[4 * i + 1];
            ac2[4 * i + 2] = wg2 * __builtin_amdgcn_cvt_scalef32_pk_f32_fp4(R[r][i], 1.0f, 2) + ac2[4 * i + 2];
            ac2[4 * i + 3] = wg2 * __builtin_amdgcn_cvt_scalef32_pk_f32_fp4(R[r][i], 1.0f, 3) + ac2[4 * i + 3]; } }
    f32x2 a8[8], a4[4], a2[2];
#pragma unroll
    for (int k = 0; k < 8; ++k)
#pragma unroll
        for (int c = 0; c < 2; ++c) { const u32x2 r = __builtin_amdgcn_permlane32_swap(__float_as_uint(ac2[k][c]), __float_as_uint(ac2[k + 8][c]), false, false); a8[k][c] = __uint_as_float(r[0]) + __uint_as_float(r[1]); }
#pragma unroll
    for (int k = 0; k < 4; ++k)
#pragma unroll
        for (int c = 0; c < 2; ++c) { const u32x2 r = __builtin_amdgcn_permlane16_swap(__float_as_uint(a8[k][c]), __float_as_uint(a8[k + 4][c]), false, false); a4[k][c] = __uint_as_float(r[0]) + __uint_as_float(r[1]); }
#pragma unroll
    for (int k = 0; k < 2; ++k)
#pragma unroll
        for (int c = 0; c < 2; ++c) { const float snd = b3 ? a4[k][c] : a4[k + 2][c]; a2[k][c] = (b3 ? a4[k + 2][c] : a4[k][c]) + dpp_f<0x128>(snd); }
    *(u32x2*)(p.peer16 + (size_t)t * DM + col) = (u32x2){pk2(a2[0][0], a2[0][1]), pk2(a2[1][0], a2[1][1])};
}
__device__ __forceinline__ void dev_spmm(PREF p) {
    const int tid = tid_opaque(), w = tid >> 6, l = tid & 63, rsub = l >> 3, kc = l & 7;
    const int T = p.nb * SEQ; const int s = blockIdx.x & 3, sub = blockIdx.x >> 2, nsub = gridDim.x >> 2;
    const unsigned char* tab = p.v4 + (size_t)s * 16384 * 128; const unsigned kc16 = 16u * kc;
    const int col = 256 * s + 32 * kc + 2 * (8 * ((l >> 5) & 1) + 4 * ((l >> 4) & 1) + 2 * ((l >> 3) & 1));
    const int first = sub * 8 + w, S = nsub * 8;
    const int n = first < T ? (T - first + S - 1) / S : 0;
#define LD_W(W0, W1, W2, W3, t) do { const f32x4* wp_ = (const f32x4*)(p.gw + (size_t)(t) * 128 + 16 * rsub); W0 = wp_[0]; W1 = wp_[1]; W2 = wp_[2]; W3 = wp_[3]; } while (0)
    if (n > 0) {
        u32x4 RA[16], RB[16], eA0, eA1, eA2, eA3, eB0, eB1, eB2, eB3; f32x4 wA0, wA1, wA2, wA3, wB0, wB1, wB2, wB3;
        PEER_LD_E(eA0, eA1, eA2, eA3, TOKI(0)); LD_W(wA0, wA1, wA2, wA3, TOKI(0)); PEER_ISSUE(RA, eA0, eA1, eA2, eA3);
        PEER_LD_E(eB0, eB1, eB2, eB3, TOKI(1)); LD_W(wB0, wB1, wB2, wB3, TOKI(1));
        for (int i = 0; i < n; i += 2) {
            PEER_ISSUE(RB, eB0, eB1, eB2, eB3);
            PEER_LD_E(eA0, eA1, eA2, eA3, TOKI(i + 2));
            spmm_compute(p, RA, wA0, wA1, wA2, wA3, TOKI(i), col, l);
            LD_W(wA0, wA1, wA2, wA3, TOKI(i + 2));
            PEER_ISSUE(RA, eA0, eA1, eA2, eA3);
            PEER_LD_E(eB0, eB1, eB2, eB3, TOKI(i + 3));
            if (i + 1 < n) spmm_compute(p, RB, wB0, wB1, wB2, wB3, TOKI(i + 1), col, l);
            LD_W(wB0, wB1, wB2, wB3, TOKI(i + 3));
        }
    }
#undef LD_W
#undef TOKI
}
__device__ __forceinline__ void dev_final(PREF p) {
    const int tid = tid_opaque(), w = tid >> 6, lane = tid & 63; const int T = p.nb * SEQ;
    for (int t = blockIdx.x * 8 + w; t < T; t += gridDim.x * 8) {
        const float* g2p = p.mod + (size_t)(t >> 11) * 6144 + 5 * 1024;
        f32x4 xv[4]; float ss = 0.f;
#pragma unroll
        for (int i = 0; i < 4; ++i) { const int d = 4 * lane + 256 * i; const f32x4 x = *(const f32x4*)(p.x1 + (size_t)t * DM + d), gg = *(const f32x4*)(g2p + d);
            const u32x2 pv = *(const u32x2*)(p.peer16 + (size_t)t * DM + d);
            f32x4 r; r[0] = x[0] + gg[0] * bflo(pv[0]); r[1] = x[1] + gg[1] * bfhi(pv[0]); r[2] = x[2] + gg[2] * bflo(pv[1]); r[3] = x[3] + gg[3] * bfhi(pv[1]);
            ss += (r[0] * r[0] + r[1] * r[1]) + (r[2] * r[2] + r[3] * r[3]); xv[i] = r; }
        ss = wave_sum(ss);
        const float rs = rsqrtf(ss * (1.0f / 1024.0f) + 1e-6f);
#pragma unroll
        for (int i = 0; i < 4; ++i) { const int d = 4 * lane + 256 * i; const f32x4 fg = *(const f32x4*)(p.final_g + d);
            f32x4 o;
#pragma unroll
            for (int j = 0; j < 4; ++j) o[j] = xv[i][j] * rs * fg[j];
            *(f32x4*)(p.out + (size_t)t * DM + d) = o; }
    }
}


__device__ __forceinline__ void sddmm_accum(u32x4 (&R)[16], const u32x4 (&hb)[4], LAS unsigned char* wbuf, f32x4 (&acc)[8], int l) {
    const int rsub = l >> 3, kc = l & 7, rho = l & 15, kg = l >> 4;
    const int wr0 = rsub * 128 + ((kc ^ rsub) << 4), wr1 = (8 + rsub) * 128 + ((kc ^ rsub ^ 1) << 4);
    const int key = (rho & 7) ^ (rho >> 3), rbase = rho * 128;
    i32x8 b0, b1;
#pragma unroll
    for (int i = 0; i < 4; ++i) { b0[i] = (int)hb[0][i]; b0[4 + i] = (int)hb[1][i]; b1[i] = (int)hb[2][i]; b1[4 + i] = (int)hb[3][i]; }
#pragma unroll
    for (int t = 0; t < 8; ++t) {
        LAS unsigned char* buf = wbuf + (t & 1) * 2048;
        *(LAS u32x4*)(buf + wr0) = R[t]; *(LAS u32x4*)(buf + wr1) = R[t + 8];
        const u32x4 x0 = *(const LAS u32x4*)(buf + rbase + ((kg ^ key) << 4)), x1 = *(const LAS u32x4*)(buf + rbase + (((4 + kg) ^ key) << 4));
        i32x8 a0, a1;
#pragma unroll
        for (int i = 0; i < 4; ++i) { a0[i] = (int)x0[i]; a0[4 + i] = 0; a1[i] = (int)x1[i]; a1[4 + i] = 0; }
        f32x4 c = acc[t];
        c = __builtin_amdgcn_mfma_scale_f32_16x16x128_f8f6f4(a0, b0, c, 4, 0, 0, 0x7f7f7f7f, 0, 0x7f7f7f7f);
        c = __builtin_amdgcn_mfma_scale_f32_16x16x128_f8f6f4(a1, b1, c, 4, 0, 0, 0x7f7f7f7f, 0, 0x7f7f7f7f);
        acc[t] = c;
    }
}
__device__ __forceinline__ void dev_sddmm_act(PREF p, LAS unsigned char* lds) {
    const int tid = tid_opaque(), w = __builtin_amdgcn_readfirstlane(tid >> 6), l = tid & 63, rsub = l >> 3, kc = l & 7, kg = l >> 4, rho = l & 15;
    const int T = p.nb * SEQ;
    const unsigned kc16 = 16u * kc;
    const int first = blockIdx.x * 8 + w, S = gridDim.x * 8;
    const int n = first < T ? (T - first + S - 1) / S : 0;
    LAS unsigned char* wbuf = lds + w * 4096;
    const int reg = rho & 3, half = (rho >> 2) & 1, j0 = 16 * (4 * (kg & 1) + reg) + 8 * (kg >> 1) + 4 * half;
#define TOKI(i) (first + ((i) < n ? (i) : n - 1) * S)
#define SA_ISSUE(R, E0, E1, E2, E3, sl) do { const unsigned char* tab = p.u4 + (size_t)(sl) * 16384 * 128; PEER_ISSUE(R, E0, E1, E2, E3); } while (0)
#define SA_LD_H(H, t, sl) do { const unsigned char* hp_ = p.h8 + (size_t)(t) * DM + 256 * (sl) + 16 * kg; H[0] = *(const u32x4*)hp_; H[1] = *(const u32x4*)(hp_ + 64); H[2] = *(const u32x4*)(hp_ + 128); H[3] = *(const u32x4*)(hp_ + 192); } while (0)
    if (n > 0) {
        u32x4 RA[16], RB[16], eC0, eC1, eC2, eC3, eN0, eN1, eN2, eN3, hA[4], hB[4];
        PEER_LD_E(eC0, eC1, eC2, eC3, TOKI(0)); SA_LD_H(hA, TOKI(0), 0); SA_ISSUE(RA, eC0, eC1, eC2, eC3, 0);
        PEER_LD_E(eN0, eN1, eN2, eN3, TOKI(1));
        for (int i = 0; i < n; ++i) {
            const int t = TOKI(i);
            f32x4 acc[8];
#pragma unroll
            for (int k = 0; k < 8; ++k) acc[k] = (f32x4){0.f, 0.f, 0.f, 0.f};
            SA_ISSUE(RB, eC0, eC1, eC2, eC3, 1); SA_LD_H(hB, t, 1); sddmm_accum(RA, hA, wbuf, acc, l);
            SA_ISSUE(RA, eC0, eC1, eC2, eC3, 2); SA_LD_H(hA, t, 2); sddmm_accum(RB, hB, wbuf, acc, l);
            SA_ISSUE(RB, eC0, eC1, eC2, eC3, 3); SA_LD_H(hB, t, 3); sddmm_accum(RA, hA, wbuf, acc, l);
            const f32x4 sj = *(const f32x4*)(p.su + (size_t)t * 128 + j0); const f32x4 gj = *(const f32x4*)(p.gw + (size_t)t * 128 + j0);
            SA_ISSUE(RA, eN0, eN1, eN2, eN3, 0); SA_LD_H(hA, TOKI(i + 1), 0); sddmm_accum(RB, hB, wbuf, acc, l);
            eC0 = eN0; eC1 = eN1; eC2 = eN2; eC3 = eN3;
            PEER_LD_E(eN0, eN1, eN2, eN3, TOKI(i + 2));
            f32x4 o;
#pragma unroll
            for (int c4 = 0; c4 < 4; ++c4) { f32x4 lo = acc[c4], hi = acc[4 + c4];
                asm volatile("" : "+v"(lo), "+v"(hi));
                const f32x4 x = half ? hi : lo; float x0 = x[0], x1 = x[1], x2 = x[2], x3 = x[3];
                asm volatile("" : "+v"(x0), "+v"(x1), "+v"(x2), "+v"(x3));
                o[c4] = (reg & 2) ? ((reg & 1) ? x3 : x2) : ((reg & 1) ? x1 : x0); }
            f32x4 wv = (f32x4){0.f, 0.f, 0.f, 0.f};
            if (rho < 8) {
#pragma unroll
                for (int c4 = 0; c4 < 4; ++c4) wv[c4] = gj[c4] * gelu_f(o[c4] * (0.25f * sj[c4])); }
            float mx = fmaxf(fmaxf(fabsf(wv[0]), fabsf(wv[1])), fmaxf(fabsf(wv[2]), fabsf(wv[3])));
#pragma unroll
            for (int sh = 1; sh < 64; sh <<= 1) mx = fmaxf(mx, shx_f(mx, sh));
            const int bexp = max((__float_as_int(mx) >> 23) & 255, 8);
            const float wsc = __int_as_float((261 - bexp) << 23);
            if (rho < 8) { int w8v = 0; w8v = __builtin_amdgcn_cvt_pk_fp8_f32(wv[0] * wsc, wv[1] * wsc, w8v, false); w8v = __builtin_amdgcn_cvt_pk_fp8_f32(wv[2] * wsc, wv[3] * wsc, w8v, true);
                *(unsigned*)(p.w8 + (size_t)t * 128 + j0) = (unsigned)w8v; }
            if (l == 0) p.wsc[t] = __int_as_float((bexp - 7) << 23);
        }
    }
#undef SA_ISSUE
#undef SA_LD_H
#undef TOKI
}
#define SF_ISSUE(R, ESRC, LBASE) do { int es_ = ESRC; _Pragma("unroll") for (int r_ = 0; r_ < 32; ++r_) { if ((r_ & 7) == 0) asm volatile("" : "+v"(es_) :: "memory");     \
        const unsigned e_ = (unsigned)__builtin_amdgcn_readlane(es_, (LBASE) + r_); R[r_] = *(const u32x2*)(tab + (lane_off + e_ * 128u)); } } while (0)
#define SF_COMPUTE(R, WSRC, LBASE) do { int ws_ = __float_as_int(WSRC); _Pragma("unroll") for (int r_ = 0; r_ < 32; ++r_) { \
        if ((r_ & 3) == 0 && r_ > 0) asm volatile("" : "+v"(R[r_]), "+v"(R[r_ + 1]), "+v"(R[r_ + 2]), "+v"(R[r_ + 3]), "+v"(ws_) : "v"(acc[0])); \
        const float wj_ = __int_as_float(__builtin_amdgcn_readlane(ws_, (LBASE) + r_)); const f32x2 w2_ = (f32x2){wj_, wj_}; \
        _Pragma("unroll") for (int i_ = 0; i_ < 2; ++i_) { \
            acc[4 * i_ + 0] = w2_ * __builtin_amdgcn_cvt_scalef32_pk_f32_fp4(R[r_][i_], 1.0f, 0) + acc[4 * i_ + 0]; acc[4 * i_ + 1] = w2_ * __builtin_amdgcn_cvt_scalef32_pk_f32_fp4(R[r_][i_], 1.0f, 1) + acc[4 * i_ + 1]; \
            acc[4 * i_ + 2] = w2_ * __builtin_amdgcn_cvt_scalef32_pk_f32_fp4(R[r_][i_], 1.0f, 2) + acc[4 * i_ + 2]; acc[4 * i_ + 3] = w2_ * __builtin_amdgcn_cvt_scalef32_pk_f32_fp4(R[r_][i_], 1.0f, 3) + acc[4 * i_ + 3]; } } } while (0)
__device__ __forceinline__ void dev_spmm_final(PREF p) {
    const int tid = tid_opaque(), w = __builtin_amdgcn_readfirstlane(tid >> 6), l = tid & 63;
    const int T = p.nb * SEQ;
    const unsigned char* tab = p.v4; const unsigned lane_off = (unsigned)(l >> 4) * (16384u * 128u) + 8u * (unsigned)(l & 15);
    const int first = blockIdx.x * 8 + w, S = gridDim.x * 8;
    const int n = first < T ? (T - first + S - 1) / S : 0;
#define TOKJ(i) (first + ((i) < n ? (i) : n - 1) * S)
#define SF_LISTS(EL, EH, WL, WH, t) do { EL = p.eidx[(size_t)(t) * 128 + l]; EH = p.eidx[(size_t)(t) * 128 + 64 + l]; const float is_ = p.wsc[t]; \
        WL = __builtin_amdgcn_cvt_f32_fp8((int)p.w8[(size_t)(t) * 128 + l], 0) * is_; WH = __builtin_amdgcn_cvt_f32_fp8((int)p.w8[(size_t)(t) * 128 + 64 + l], 0) * is_; } while (0)
    if (n > 0) {
        u32x2 RA[32], RB[32]; int eCl, eCh, eNl, eNh; float wCl, wCh, wNl, wNh;
        SF_LISTS(eCl, eCh, wCl, wCh, TOKJ(0)); SF_ISSUE(RA, eCl, 0); SF_LISTS(eNl, eNh, wNl, wNh, TOKJ(1));
        for (int i = 0; i < n; ++i) {
            const int t = TOKJ(i);
            f32x2 acc[8];
#pragma unroll
            for (int k = 0; k < 8; ++k) acc[k] = (f32x2){0.f, 0.f};
            SF_ISSUE(RB, eCl, 32); SF_COMPUTE(RA, wCl, 0);
            SF_ISSUE(RA, eCh, 0);  SF_COMPUTE(RB, wCl, 32);
            SF_ISSUE(RB, eCh, 32); SF_COMPUTE(RA, wCh, 0);
            int lo16 = 16 * l; asm volatile("" : "+v"(lo16));
            const bf16_t* x1p = p.x1b + (size_t)t * DM + lo16; const float* g2p = p.mod + (size_t)(t >> 11) * 6144 + 5 * 1024 + lo16;
            f32x4 xv[4], gg[4];
            { const u32x4 xa = *(const u32x4*)x1p, xb = *(const u32x4*)(x1p + 8);
              xv[0] = (f32x4){bflo(xa[0]), bfhi(xa[0]), bflo(xa[1]), bfhi(xa[1])}; xv[1] = (f32x4){bflo(xa[2]), bfhi(xa[2]), bflo(xa[3]), bfhi(xa[3])};
              xv[2] = (f32x4){bflo(xb[0]), bfhi(xb[0]), bflo(xb[1]), bfhi(xb[1])}; xv[3] = (f32x4){bflo(xb[2]), bfhi(xb[2]), bflo(xb[3]), bfhi(xb[3])}; }
#pragma unroll
            for (int q = 0; q < 4; ++q) gg[q] = *(const f32x4*)(g2p + 4 * q);
            SF_ISSUE(RA, eNl, 0);  SF_COMPUTE(RB, wCh, 32);
            eCl = eNl; eCh = eNh; wCl = wNl; wCh = wNh;
            SF_LISTS(eNl, eNh, wNl, wNh, TOKJ(i + 2));
            float ss = 0.f;
#pragma unroll
            for (int q = 0; q < 4; ++q) { xv[q][0] += gg[q][0] * acc[2 * q][0]; xv[q][1] += gg[q][1] * acc[2 * q][1]; xv[q][2] += gg[q][2] * acc[2 * q + 1][0]; xv[q][3] += gg[q][3] * acc[2 * q + 1][1];
                ss += (xv[q][0] * xv[q][0] + xv[q][1] * xv[q][1]) + (xv[q][2] * xv[q][2] + xv[q][3] * xv[q][3]); }
            ss = wave_sum(ss);
            const float rs = rsqrtf(ss * (1.0f / 1024.0f) + 1e-6f);
#pragma unroll
            for (int q = 0; q < 4; ++q) { const f32x4 fg = *(const f32x4*)(p.final_g + lo16 + 4 * q); f32x4 o;
#pragma unroll
                for (int j = 0; j < 4; ++j) o[j] = xv[q][j] * rs * fg[j];
                *(f32x4*)(p.out + (size_t)t * DM + lo16 + 4 * q) = o; }
        }
    }
#undef TOKJ
#undef SF_LISTS
}

typedef int v2i_t __attribute__((ext_vector_type(2)));
__device__ __forceinline__ void spmm_slice(const u32x4 (&R)[16], const i32x8 bw, LAS unsigned char* wbuf, int wa, int rb, int L, f32x4& acc) {
#pragma unroll
    for (int i = 0; i < 16; ++i) { LAS u32x4* d = (LAS u32x4*)(wbuf + (wa ^ ((i >> 1) << 4)) + i * 128);
        if (i & 1) *d = (u32x4){R[i][2], R[i][3], R[i][0], R[i][1]}; else *d = R[i]; }
#pragma unroll
    for (int mf = 0; mf < 16; ++mf) {
        LAS unsigned char* ap = wbuf + (rb ^ (mf << 3));
        const v2i_t lo = __builtin_amdgcn_ds_read_tr4_b64_v2i32((LAS v2i_t*)ap), hi = __builtin_amdgcn_ds_read_tr4_b64_v2i32((LAS v2i_t*)(ap + 2048));
        i32x8 a; a[0] = lo[0]; a[1] = lo[1]; a[2] = hi[0]; a[3] = hi[1]; a[4] = 0; a[5] = 0; a[6] = 0; a[7] = 0;
        const f32x4 d = __builtin_amdgcn_mfma_scale_f32_16x16x128_f8f6f4(a, bw, (f32x4){0.f, 0.f, 0.f, 0.f}, 4, 0, 0, 0x7f7f7f7f, 0, 0x7f7f7f7f);
        const bool keep = (L == mf);
#pragma unroll
        for (int j = 0; j < 4; ++j) acc[j] = keep ? d[j] : acc[j];
    }
}
__device__ __forceinline__ void dev_spmm_mfma(PREF p, LAS unsigned char* lds) {
    const int tid = tid_opaque(), w = __builtin_amdgcn_readfirstlane(tid >> 6), l = tid & 63, rsub = l >> 3, kc = l & 7, L = l & 15, g = l >> 4;
    const int T = p.nb * SEQ;
    const unsigned kc16 = 16u * kc;
    const int first = blockIdx.x * 8 + w, S = gridDim.x * 8;
    const int n = first < T ? (T - first + S - 1) / S : 0;
    LAS unsigned char* wbuf = lds + w * 16384;
    const int wa = rsub * 2048 + (kc << 4);
    const int rb = g * 4096 + L * 128 + (L << 3);
#define TOKI(i) (first + ((i) < n ? (i) : n - 1) * S)
#define SV_ISSUE(R, E0, E1, E2, E3, sl) do { const unsigned char* tab = p.v4 + (size_t)(sl) * 16384 * 128; PEER_ISSUE(R, E0, E1, E2, E3); } while (0)
    if (n > 0) {
        u32x4 RA[16], RB[16], eC0, eC1, eC2, eC3;
        PEER_LD_E(eC0, eC1, eC2, eC3, TOKI(0)); SV_ISSUE(RA, eC0, eC1, eC2, eC3, 0);
        for (int i = 0; i < n; ++i) {
            const int t = TOKI(i);
            const unsigned char* wp = p.w8 + (size_t)t * 128 + 16 * g;
            const u32x4 w0 = *(const u32x4*)wp, w1 = *(const u32x4*)(wp + 64);
            i32x8 bw;
#pragma unroll
            for (int j = 0; j < 4; ++j) { bw[j] = (int)w0[j]; bw[4 + j] = (int)w1[j]; }
            const float isc = p.wsc[t];
            f32x4 acc[4];
#pragma unroll
            for (int k = 0; k < 4; ++k) acc[k] = (f32x4){0.f, 0.f, 0.f, 0.f};
            SV_ISSUE(RB, eC0, eC1, eC2, eC3, 1); spmm_slice(RA, bw, wbuf, wa, rb, L, acc[0]);
            SV_ISSUE(RA, eC0, eC1, eC2, eC3, 2); spmm_slice(RB, bw, wbuf, wa, rb, L, acc[1]);
            SV_ISSUE(RB, eC0, eC1, eC2, eC3, 3);
            PEER_LD_E(eC0, eC1, eC2, eC3, TOKI(i + 1));
            spmm_slice(RA, bw, wbuf, wa, rb, L, acc[2]);
            int col4 = 16 * L + 4 * g; asm volatile("" : "+v"(col4));
            const bf16_t* x1p = p.x1b + (size_t)t * DM + col4; const float* g2p = p.mod + (size_t)(t >> 11) * 6144 + 5 * 1024 + col4;
            u32x2 xq[4]; f32x4 gg[4];
#pragma unroll
            for (int q = 0; q < 4; ++q) { xq[q] = __builtin_nontemporal_load((const u32x2*)(x1p + 256 * q)); gg[q] = *(const f32x4*)(g2p + 256 * q); }
            SV_ISSUE(RA, eC0, eC1, eC2, eC3, 0); spmm_slice(RB, bw, wbuf, wa, rb, L, acc[3]);
            f32x4 xv[4]; float ss = 0.f;
#pragma unroll
            for (int q = 0; q < 4; ++q) { xv[q] = (f32x4){bflo(xq[q][0]), bfhi(xq[q][0]), bflo(xq[q][1]), bfhi(xq[q][1])};
#pragma unroll
                for (int j = 0; j < 4; ++j) xv[q][j] += gg[q][j] * (acc[q][j] * isc);
                ss += (xv[q][0] * xv[q][0] + xv[q][1] * xv[q][1]) + (xv[q][2] * xv[q][2] + xv[q][3] * xv[q][3]); }
            ss = wave_sum(ss);
            const float rs = rsqrtf(ss * (1.0f / 1024.0f) + 1e-6f);
#pragma unroll
            for (int q = 0; q < 4; ++q) { const f32x4 fg = *(const f32x4*)(p.final_g + col4 + 256 * q); f32x4 o;
#pragma unroll
                for (int j = 0; j < 4; ++j) o[j] = xv[q][j] * rs * fg[j];
                __builtin_nontemporal_store(o, (f32x4*)(p.out + (size_t)t * DM + col4 + 256 * q)); }
        }
    }
#undef SV_ISSUE
#undef TOKI
}

__device__ __forceinline__ void dev_gemm_in(PREF p, LAS unsigned char* lds) {
    const int T = p.nb * SEQ, TC = p.nb * CTXL;
    {
        pg8::Gemm g{p.hc, p.Wt_in + (size_t)512 * DM, DM, DM, DM, 0, 0}; pg8::StaticOrder S; S.init(TC, 1024, gridDim.x, blockIdx.x);
        pg8::EpiAct E{p.zxc, 0, 0, 1 << 20, DM, 0, 0};
        pg8::gemm_phase(lds, g, S, E);
    }
    {
        pg8::Gemm g{p.h, p.Wt_in + (size_t)512 * DM, DM, DM, DM, 0, 0}; pg8::StaticOrder S; S.init(T, 4096, gridDim.x, blockIdx.x);
        pg8::EpiAct E{p.zx, p.zseg, 0x2210, 4, DM, 1, 0};
        pg8::gemm_phase(lds, g, S, E);
    }
    {
        pg8::Gemm g{p.Wt_in, p.h, DM, DM, DM, 0, 0}; pg8::StaticOrder S; S.init(512, T, gridDim.x, blockIdx.x);
        pg8::EpiAct E{p.zfT, (size_t)512 * SEQ, 0, SEQ / 256, SEQ, 0, 0};
        pg8::gemm_phase(lds, g, S, E);
    }
}
__device__ __forceinline__ void dev_gemm_dft(PREF p, LAS unsigned char* lds) {
    const int T = p.nb * SEQ;
    pg8::Gemm g{p.dft, p.zfT, SEQ, SEQ, SEQ, 0, (long)512 * SEQ}; pg8::BatchOrder S; S.init(2048, 512, p.nb, gridDim.x, blockIdx.x);
    pg8::EpiUV E{p.UV};
    pg8::gemm_phase(lds, g, S, E);
}
__device__ __forceinline__ void dev_gemm_mix(PREF p, LAS unsigned char* lds, int vb = -1) {
    if (vb < 0) vb = blockIdx.x;
    const int T = p.nb * SEQ;
    {
        pg8::Gemm g{p.UV, p.Wfp, DM, DM, DM, 0, 0}; pg8::StaticOrder S; S.init(T, 1024, gridDim.x, vb);
        pg8::EpiGate E{p.sga, nullptr, p.Pb};
        pg8::gemm_phase(lds, g, S, E);
    }
    {
        pg8::Gemm g{p.ybin, p.Wt_lru, DM, DM, DM, 0, 0}; pg8::StaticOrder S; S.init(T, 1024, gridDim.x, vb);
        pg8::EpiGate E{p.sgb, p.Pb, p.merged};
        pg8::gemm_phase(lds, g, S, E);
    }
}
__device__ __forceinline__ void dev_gemm_out(PREF p, LAS unsigned char* lds, int vb = -1) {
    if (vb < 0) vb = blockIdx.x;
    const int T = p.nb * SEQ;
    pg8::Gemm g{p.merged, p.Wt_out, DM, DM, DM, 0, 0, 1, 0}; pg8::StaticOrder S; S.init(T, 1024, gridDim.x, vb);
    pg8::EpiX1 E{p.x, p.pos, p.mod, p.b_out, p.x1b};
    pg8::gemm_phase(lds, g, S, E);
}
__device__ __forceinline__ void dev_gemm_q(PREF p, LAS unsigned char* lds) {
    const int T = p.nb * SEQ;
    pg8::Gemm g{p.h2, p.Wt_q, DM, DM, DM, 0, 0}; pg8::StaticOrder S; S.init(T, 2048, gridDim.x, blockIdx.x);
    pg8::EpiAct E{p.q, 0, 0, 1 << 20, 2048, 1, 1};
    pg8::gemm_phase(lds, g, S, E);
}

#define KERNEL_HEAD extern __shared__ __attribute__((aligned(16))) unsigned char smem_raw[]; LAS unsigned char* lds = (LAS unsigned char*)smem_raw;
#ifdef DIAG
__global__ void __launch_bounds__(NTHR, 2) k_prep_t(Params p) { KERNEL_HEAD
    dev_transpose(p.w_in, 4608, 0, 1024, 4608, p.Wt_in, 1, 0, 0, lds, 0, (int)gridDim.x);
    dev_transpose(p.w_lru_out, 1024, 0, 1024, 1024, p.Wt_lru, 1, 0, 0, lds, 0, (int)gridDim.x);
    dev_transpose(p.w_out, 1024, 0, 1024, 1024, p.Wt_out, 1, 0, 0, lds, 0, (int)gridDim.x);
    dev_transpose(p.peer_wq, 2048, 0, 1024, 2048, p.Wt_q, 1, 0, 0, lds, 0, (int)gridDim.x);
    dev_transpose(p.lru_wa, 128, 0, 128, 128, p.gates_bf, 8, 16384, 16384, lds, 0, (int)gridDim.x);
    dev_transpose(p.lru_wx, 128, 0, 128, 128, p.gates_bf + (size_t)8 * 16384, 8, 16384, 16384, lds, 0, (int)gridDim.x);
    dev_transpose(p.lru_wa + (size_t)8 * 16384, 128, 0, 128, 128, p.gates_bf + (size_t)16 * 16384, 8, 16384, 16384, lds, 0, (int)gridDim.x);
    dev_transpose(p.lru_wx + (size_t)8 * 16384, 128, 0, 128, 128, p.gates_bf + (size_t)24 * 16384, 8, 16384, 16384, lds, 0, (int)gridDim.x);
}
__global__ void __launch_bounds__(NTHR, 2) k_prep_c(Params p) { KERNEL_HEAD
    dev_convert(p.peer_keys, p.keys_bf, (size_t)8 * 2 * 128 * 128);
    dev_convert(p.peer_u, p.u_bf, (size_t)16384 * 1024);
    dev_convert(p.peer_v, p.v_bf, (size_t)16384 * 1024);
    dev_wfp(p, lds);
    dev_dft(p);
    dev_pos(p);
}
__global__ void __launch_bounds__(NTHR, 2) k_adaln(Params p) { KERNEL_HEAD dev_adaln(p, lds); }
__global__ void __launch_bounds__(NTHR, 2) k_norm1(Params p) { dev_norm(p, 0); }
__global__ void __launch_bounds__(NTHR, 2) k_gemm_in(Params p) { KERNEL_HEAD dev_gemm_in(p, lds); }
__global__ void __launch_bounds__(NTHR, 2) k_scan(Params p) { KERNEL_HEAD dev_scan(p, lds); }
__global__ void __launch_bounds__(NTHR, 2) k_gemm_dft(Params p) { KERNEL_HEAD dev_gemm_dft(p, lds); }
__global__ void __launch_bounds__(NTHR, 2) k_gemm_mix(Params p) { KERNEL_HEAD dev_gemm_mix(p, lds); }
__global__ void __launch_bounds__(NTHR, 2) k_gemm_out(Params p) { KERNEL_HEAD dev_gemm_out(p, lds); }
__global__ void __launch_bounds__(NTHR, 2) k_norm2(Params p) { dev_norm(p, 1); }
__global__ void __launch_bounds__(NTHR, 2) k_gemm_q(Params p) { KERNEL_HEAD dev_gemm_q(p, lds); }
__global__ void __launch_bounds__(NTHR, 2) k_topk(Params p) { dev_topk(p); }
__global__ void __launch_bounds__(NTHR, 2) k_peer(Params p) { dev_peer(p); }


#endif
namespace cg = cooperative_groups;

#define XB_TMO      128
#define XB_XCNT(j)  (256  + 64 * (j))
#define XB_XSUB(j)  (1280 + 64 * (j))
#define XB_XGEN(j)  (2304 + 64 * (j))
#define XB_TOP      3328
#define XB_TOPGEN   3392
#define XB_LSUB(j)  (3456 + 64 * (j))
#define XB_LGEN(j)  (4480 + 64 * (j))
#define XCD_BAR_WORDS 5504
#define XB_SPIN_CAP (1u << 22)
__device__ __forceinline__ unsigned xb_ld(unsigned* p)              { return __hip_atomic_load(p, __ATOMIC_RELAXED, __HIP_MEMORY_SCOPE_AGENT); }
__device__ __forceinline__ unsigned xb_add(unsigned* p, unsigned v) { return __hip_atomic_fetch_add(p, v, __ATOMIC_RELAXED, __HIP_MEMORY_SCOPE_AGENT); }
__device__ __forceinline__ unsigned xb_xcc_id() { return (unsigned)__builtin_amdgcn_s_getreg((3 << 11) | 20) & 0xFu; }
#define XB_SPIN(cond, bar) do { unsigned _sp = 0; while (cond) { __builtin_amdgcn_s_sleep(1); \
    if ((++_sp & 255u) == 0u) { if (xb_ld(&(bar)[XB_TMO])) break; if (_sp > XB_SPIN_CAP) { atomicAdd(&(bar)[XB_TMO], 1u); break; } } } } while (0)
struct XcdBarrier { unsigned* bar; unsigned x; volatile LAS unsigned* st; };
__device__ __forceinline__ XcdBarrier xcd_barrier_post(unsigned* bar, volatile LAS unsigned* st) {
    XcdBarrier b; b.bar = bar; b.x = xb_xcc_id(); b.st = st;
    if (threadIdx.x == 0) st[3] = xb_add(&bar[XB_XCNT(b.x)], 1u);
    return b;
}
__device__ __forceinline__ void xcd_barrier_complete(unsigned* bar, unsigned x, unsigned& nloc, unsigned& nx, unsigned& uni) {
    const unsigned G = gridDim.x * gridDim.y * gridDim.z;
    unsigned sum, cnt, mine, even, sp = 0u;
    for (;;) {
        sum = 0u; cnt = 0u; mine = 0u; even = ((G & 7u) == 0u) ? 1u : 0u;
#pragma unroll
        for (unsigned j = 0; j < 16; ++j) { const unsigned c = xb_ld(&bar[XB_XCNT(j)]); sum += c; cnt += (c > 0u) ? 1u : 0u; mine = (j == x) ? c : mine; if (j < 8 && c != (G >> 3)) even = 0u; }
        if (sum == G) break;
        __builtin_amdgcn_s_sleep(1);
        if ((++sp & 255u) == 0u) { if (xb_ld(&bar[XB_TMO])) break; if (sp > XB_SPIN_CAP) { atomicAdd(&bar[XB_TMO], 1u); break; } }
    }
    nloc = mine > 0u ? mine : 1u; nx = cnt > 0u ? cnt : 1u; uni = (sum == G) ? even : 0u;
}
__device__ __forceinline__ void xcd_barrier(const XcdBarrier& b) {
    asm volatile("s_waitcnt vmcnt(0)" ::: "memory");
    __syncthreads();
    if (threadIdx.x == 0) {
        unsigned* bar = b.bar;
        __builtin_amdgcn_s_waitcnt(0);
        unsigned nloc = b.st[0], nx = b.st[1];
        if (nloc == 0u) { unsigned uni; xcd_barrier_complete(bar, b.x, nloc, nx, uni); b.st[0] = nloc; b.st[1] = nx; b.st[2] = uni; }
        const unsigned old = xb_add(&bar[XB_XSUB(b.x)], 1u);
        const unsigned gen = old / nloc;
        if (old + 1u == (gen + 1u) * nloc) {
            __builtin_amdgcn_fence(__ATOMIC_RELEASE, "agent");
            asm volatile("s_waitcnt vmcnt(0)" ::: "memory");
            const unsigned og = xb_add(&bar[XB_TOP], 1u);
            const unsigned tg = og / nx;
            if (og + 1u == (tg + 1u) * nx) xb_add(&bar[XB_TOPGEN], 1u);
            else XB_SPIN(xb_ld(&bar[XB_TOPGEN]) == tg, bar);
            __builtin_amdgcn_fence(__ATOMIC_ACQUIRE, "agent");
            xb_add(&bar[XB_XGEN(b.x)], 1u);
            asm volatile("s_waitcnt vmcnt(0)" ::: "memory");
        } else {
            XB_SPIN(xb_ld(&bar[XB_XGEN(b.x)]) == gen, bar);
            __builtin_amdgcn_fence(__ATOMIC_ACQUIRE, "agent");
            asm volatile("s_waitcnt vmcnt(0)" ::: "memory");
        }
    }
    __syncthreads();
}

__device__ __forceinline__ void xcd_local_barrier(const XcdBarrier& b) {
    asm volatile("s_waitcnt vmcnt(0)" ::: "memory");
    __syncthreads();
    if (threadIdx.x == 0) {
        unsigned* bar = b.bar;
        __builtin_amdgcn_s_waitcnt(0);
        const unsigned nloc = b.st[0];
        const unsigned old = xb_add(&bar[XB_LSUB(b.x)], 1u);
        const unsigned gen = old / nloc;
        if (old + 1u == (gen + 1u) * nloc) xb_add(&bar[XB_LGEN(b.x)], 1u);
        else XB_SPIN(xb_ld(&bar[XB_LGEN(b.x)]) == gen, bar);
        __builtin_amdgcn_fence(__ATOMIC_ACQUIRE, "agent");
        asm volatile("s_waitcnt vmcnt(0)" ::: "memory");
    }
    __syncthreads();
}

#ifndef DIAG
__device__ __forceinline__ CParams* kparams() { CParams* q = (CParams*)__builtin_amdgcn_kernarg_segment_ptr(); asm volatile("" : "+s"(q)); return q; }
__global__ void __launch_bounds__(NTHR, 2) k_mega(Params p_unused) { KERNEL_HEAD
    cg::grid_group grid = cg::this_grid();
    volatile LAS unsigned* bst = (volatile LAS unsigned*)(lds + LDS_BYTES - 16);
    if (blockIdx.x == 0) { CParams& p = *kparams(); for (int i = tid_opaque(); i < XCD_BAR_WORDS; i += NTHR) p.bar[i] = 0u; }
    if (tid_opaque() < 2) bst[tid_opaque()] = 0u;
    { CParams& p = *kparams(); dev_adaln(p, lds); }
    __syncthreads();
    { CParams& p = *kparams();
      const int G = (int)gridDim.x, G8 = (G & 7) ? G : (G >> 3), gf = (G & 7) ? 0 : (G >> 1);
      dev_transpose(p.w_in, 4608, 0, 1024, 4608, p.Wt_in, 1, 0, 0, lds, 0, G);
      dev_transpose(p.lru_wa, 128, 0, 128, 128, p.gates_bf, 8, 16384, 16384, lds, gf, G8);
      dev_transpose(p.lru_wx, 128, 0, 128, 128, p.gates_bf + (size_t)8 * 16384, 8, 16384, 16384, lds, (G & 7) ? 0 : gf + G8, G8);
      dev_transpose(p.lru_wa + (size_t)8 * 16384, 128, 0, 128, 128, p.gates_bf + (size_t)16 * 16384, 8, 16384, 16384, lds, (G & 7) ? 0 : gf + 2 * G8, G8);
      dev_transpose(p.lru_wx + (size_t)8 * 16384, 128, 0, 128, 128, p.gates_bf + (size_t)24 * 16384, 8, 16384, 16384, lds, (G & 7) ? 0 : gf + 3 * G8, G8);
      dev_transpose(p.w_lru_out, 1024, 0, 1024, 1024, p.Wt_lru, 1, 0, 0, lds, 0, G);
      dev_transpose(p.w_out, 1024, 0, 1024, 1024, p.Wt_out, 1, 0, 0, lds, 0, G);
      dev_transpose(p.peer_wq, 2048, 0, 1024, 2048, p.Wt_q, 1, 0, 0, lds, 0, G); }
    { CParams& p = *kparams();
      dev_convert(p.peer_keys, p.keys_bf, (size_t)8 * 2 * 128 * 128);
      if (blockIdx.x == 0 && tid_opaque() < 2) p.tmax[tid_opaque()] = 0u; }
    { CParams& p = *kparams(); dev_wfp(p, lds); }
    { CParams& p = *kparams(); dev_dft(p); dev_pos(p); }
    grid.sync();
    XcdBarrier xbar; { CParams& p = *kparams(); xbar = xcd_barrier_post(p.bar, bst); }
    { CParams& p = *kparams(); dev_norm(p, 0); }
    xcd_barrier(xbar);
    { CParams& p = *kparams(); dev_tab8(p); }
    { CParams& p = *kparams(); dev_gemm_in(p, lds); }
    xcd_barrier(xbar);
    { CParams& p = *kparams(); dev_scan(p, lds); }
    { CParams& p = *kparams(); dev_gemm_dft(p, lds); }
    xcd_barrier(xbar);
    const unsigned uni = __builtin_amdgcn_readfirstlane(bst[2]), rank = __builtin_amdgcn_readfirstlane(bst[3]);
    const int vb = uni ? (int)(rank * 8u + xbar.x) : (int)blockIdx.x;
    { CParams& p = *kparams(); dev_gemm_mix(p, lds, vb); }
    if (uni) xcd_local_barrier(xbar); else xcd_barrier(xbar);
    { CParams& p = *kparams(); dev_gemm_out(p, lds, vb); }
    if (uni) xcd_local_barrier(xbar); else xcd_barrier(xbar);
    { CParams& p = *kparams(); const int TX = (p.nb * SEQ) >> 3;
      if (uni) dev_norm(p, 1, (int)xbar.x * TX + (int)rank * 8, (int)gridDim.x, ((int)xbar.x + 1) * TX); else dev_norm(p, 1, (int)blockIdx.x * 8, (int)gridDim.x * 8, p.nb * SEQ); }
    xcd_barrier(xbar);
    { CParams& p = *kparams(); dev_gemm_q(p, lds); }
    xcd_barrier(xbar);
    { CParams& p = *kparams(); dev_topk(p, lds); }
    xcd_barrier(xbar);
    { CParams& p = *kparams(); dev_sddmm_act(p, lds); }
    asm volatile("s_waitcnt vmcnt(0)" ::: "memory");
    __syncthreads();
    { CParams& p = *kparams(); dev_spmm_mfma(p, lds); }
}
#endif

#ifdef DIAG
__device__ __forceinline__ unsigned hsh(unsigned a, unsigned b) { unsigned x = a * 0x9E3779B1u ^ (b + 0x7F4A7C15u) * 0x85EBCA6Bu; x ^= x >> 15; x *= 0x2C1B3C6Du; x ^= x >> 12; x *= 0x297A2D39u; x ^= x >> 15; return x; }
__device__ __forceinline__ void rep(unsigned* slot, float got, float ref, float floor_) {
    float err = fabsf(got - ref) / (fabsf(ref) + floor_); if (!(err < 1e30f)) err = 1e30f; atomicMax(slot, __float_as_uint(err));
}
__device__ __forceinline__ float pos_direct(int t, int d) { const int j = d & 255, part = d >> 8; const float omega = 1.0f / powf(10000.0f, (float)j / 256.0f);
    const float arg = (float)(part < 2 ? (t >> 6) : (t & 63)) * omega; return (part & 1) ? cosf(arg) : sinf(arg); }
__global__ void chk_mod(Params p) {
    const int s = blockIdx.x * blockDim.x + threadIdx.x; const unsigned hv = hsh(s, 1); const int r = hv % 33, n = (hv >> 8) % 6144;
    const float* cond = r < 32 ? p.c + r * 1024 : p.c_ctx; float acc = p.b_mod[n];
    for (int k = 0; k < 1024; ++k) { const float v = cond[k]; acc += (v / (1.0f + expf(-v))) * p.w_mod[(size_t)k * 6144 + n]; }
    rep(p.diag + 1, p.mod[(size_t)r * 6144 + n], acc, 0.3f);
}
__global__ void chk_norm(Params p, int which) {
    const int s = blockIdx.x * blockDim.x + threadIdx.x; const unsigned hv = hsh(s, 2 + which);
    const int T = p.nb * SEQ, TC = which == 0 ? p.nb * CTXL : 0; const int row = hv % (T + TC), d = (hv >> 12) % 1024;
    const bool isctx = row >= T; const int lrow = isctx ? row - T : row; const int b = isctx ? 32 : lrow >> 11;
    const float* src = which == 1 ? p.x1 + (size_t)lrow * DM : (isctx ? p.ctx + (size_t)lrow * DM : p.x + (size_t)lrow * DM);
    float ss = 0.f, vd = 0.f;
    for (int k = 0; k < 1024; ++k) { float v = src[k]; if (which == 0 && !isctx) v += pos_direct(lrow & 2047, k); ss += v * v; if (k == d) vd = v; }
    const float rs = 1.0f / sqrtf(ss / 1024.0f + 1e-6f);
    const float* md = p.mod + (size_t)b * 6144 + (which == 0 ? 0 : 3 * 1024);
    const float ref = (vd * rs * (which == 0 ? p.norm1_g[d] : p.norm2_g[d])) * (1.0f + md[1024 + d]) + md[d];
    const bf16_t* dst = which == 1 ? p.h2 + (size_t)lrow * DM : (isctx ? p.hc + (size_t)lrow * DM : p.h + (size_t)lrow * DM);
    rep(p.diag + (which == 0 ? 2 : 8), bf2f(dst[d]), ref, 0.3f);
}
__global__ void chk_z(Params p) {
    const int s = blockIdx.x * blockDim.x + threadIdx.x; const unsigned hv = hsh(s, 5);
    const int T = p.nb * SEQ, TC = p.nb * CTXL;
    if (s & 1) { const int row = hv % T, col = (hv >> 13) % 4608; float acc = 0.f;
        for (int k = 0; k < 1024; ++k) acc += bf2f(p.h[(size_t)row * DM + k]) * p.w_in[(size_t)k * 4608 + col];
        float got;
        if (col < 512) got = bf2f(p.zfT[(size_t)col * T + row]);
        else if (col < 1536) got = bf2f(p.zx[(size_t)row * DM + col - 512]);
        else if (col < 2560) { got = bf2f(p.gzy[(size_t)row * DM + col - 1536]); acc = 0.5f * acc * (1.0f + tanhf(0.7978845608f * (acc + 0.044715f * acc * acc * acc))); }
        else if (col < 3584) { got = bf2f(p.sga[(size_t)row * DM + col - 2560]); acc = 1.0f / (1.0f + expf(-acc)); }
        else { got = bf2f(p.sgb[(size_t)row * DM + col - 3584]); acc = 1.0f / (1.0f + expf(-acc)); }
        rep(p.diag + 3, got, acc, 0.5f);
    } else { const int row = hv % TC, col = 512 + (hv >> 13) % 1024; float acc = 0.f;
        for (int k = 0; k < 1024; ++k) acc += bf2f(p.hc[(size_t)row * DM + k]) * p.w_in[(size_t)k * 4608 + col];
        rep(p.diag + 3, bf2f(p.zxc[(size_t)row * DM + col - 512]), acc, 0.5f); }
}
__global__ void chk_uv(Params p) {
    const int s = blockIdx.x * blockDim.x + threadIdx.x; const unsigned hv = hsh(s, 6);
    const int T = p.nb * SEQ; const int b = hv % p.nb, kt = (hv >> 4) % 2048, ch = (hv >> 15) % 512, part = (hv >> 25) & 1;
    float acc = 0.f;
    for (int t = 0; t < 2048; ++t) { const float a = (float)((kt * t) & 2047) / 1024.0f; acc += (part ? sinpif(a) : cospif(a)) * bf2f(p.zfT[(size_t)ch * T + b * 2048 + t]); }
    rep(p.diag + 4, bf2f(p.UV[((size_t)b * 2048 + kt) * DM + part * 512 + ch]), acc, 16.0f);
}
__global__ void __launch_bounds__(512) chk_scan(Params p) {
    __shared__ float AF[2304], BF[2304], AB[2304], BB[2304];
    const unsigned hv = hsh(blockIdx.x, 7); const int b = hv % p.nb, c = (hv >> 8) % 1024, head = c >> 7, cc = c & 127;
    for (int tp = threadIdx.x; tp < 2304; tp += blockDim.x) {
        const bool isctx = tp < 256; const int t = isctx ? tp : tp - 256, Tseq = isctx ? 256 : 2048;
        const bf16_t* src = isctx ? p.zxc + (size_t)b * 256 * DM : p.zx + (size_t)b * 2048 * DM;
        float gaf = 0.f, gxf = 0.f, gab = 0.f, gxb = 0.f, xcc = 0.f;
        for (int i = 0; i < 128; ++i) { const int hi = head * 128 + i; float xci = p.conv_b[hi];
            for (int r = 0; r < 4; ++r) { const int tr = t - 1 + r; if (tr >= 0 && tr < Tseq) xci += p.conv_w[r * 1024 + hi] * bf2f(src[(size_t)tr * DM + hi]); }
            const size_t wo = ((size_t)head * 128 + i) * 128 + cc;
            gaf += xci * p.lru_wa[wo]; gxf += xci * p.lru_wx[wo]; gab += xci * p.lru_wa[(size_t)8 * 16384 + wo]; gxb += xci * p.lru_wx[(size_t)8 * 16384 + wo];
            if (i == cc) xcc = xci; }
        { const float r = 1.0f / (1.0f + expf(-(gaf + p.lru_ba[c]))), ig = 1.0f / (1.0f + expf(-(gxf + p.lru_bx[c])));
          const float la = -8.0f * r * log1pf(expf(-p.lru_lambda[c])); AF[tp] = expf(la); BF[tp] = sqrtf(fmaxf(0.f, -expm1f(2.0f * la))) * ig * xcc; }
        { const float r = 1.0f / (1.0f + expf(-(gab + p.lru_ba[1024 + c]))), ig = 1.0f / (1.0f + expf(-(gxb + p.lru_bx[1024 + c])));
          const float la = -8.0f * r * log1pf(expf(-p.lru_lambda[1024 + c])); AB[tp] = expf(la); BB[tp] = sqrtf(fmaxf(0.f, -expm1f(2.0f * la))) * ig * xcc; }
    }
    __syncthreads();
    if (threadIdx.x == 0) { float h = 0.f; for (int tp = 0; tp < 2304; ++tp) { h = AF[tp] * h + BF[tp]; AF[tp] = h; } }
    if (threadIdx.x == 64) { float h = 0.f; for (int tp = 255; tp >= 0; --tp) { h = AB[tp] * h + BB[tp]; AB[tp] = h; } for (int tp = 2303; tp >= 256; --tp) { h = AB[tp] * h + BB[tp]; AB[tp] = h; } }
    __syncthreads();
    for (int t = threadIdx.x; t < 2048; t += blockDim.x) { float z = 0.f; const size_t row = (size_t)b * 2048 + t;
        for (int k = 0; k < 1024; ++k) z += bf2f(p.h[row * DM + k]) * p.w_in[(size_t)k * 4608 + 1536 + c];
        const float gz = 0.5f * z * (1.0f + tanhf(0.7978845608f * (z + 0.044715f * z * z * z)));
        rep(p.diag + 5, bf2f(p.ybin[row * DM + c]), (AF[256 + t] + AB[256 + t]) * gz, 0.25f); }
}
__global__ void chk_merged(Params p) {
    const int s = blockIdx.x * blockDim.x + threadIdx.x; const unsigned hv = hsh(s, 8); const int T = p.nb * SEQ; const int row = hv % T, col = (hv >> 13) % 1024;
    float ya = 0.f;
    for (int g = 0; g < 4; ++g) for (int kc = 0; kc < 128; ++kc) { float y = 0.f;
        for (int c = 0; c < 128; ++c) { const float a = (float)((kc * c) & 127) / 64.0f; y += bf2f(p.UV[(size_t)row * DM + g * 128 + c]) * cospif(a) - bf2f(p.UV[(size_t)row * DM + 512 + g * 128 + c]) * sinpif(a); }
        ya += (y / 512.0f) * p.w_fourier[(size_t)(g * 128 + kc) * 1024 + col]; }
    float yb = 0.f;
    for (int k = 0; k < 1024; ++k) yb += bf2f(p.ybin[(size_t)row * DM + k]) * p.w_lru_out[(size_t)k * 1024 + col];
    const float ref = bf2f(p.sga[(size_t)row * DM + col]) * ya + bf2f(p.sgb[(size_t)row * DM + col]) * yb;
    rep(p.diag + 6, bf2f(p.merged[(size_t)row * DM + col]), ref, 0.4f);
}
__global__ void chk_x1(Params p) {
    const int s = blockIdx.x * blockDim.x + threadIdx.x; const unsigned hv = hsh(s, 9); const int T = p.nb * SEQ; const int row = hv % T, col = (hv >> 13) % 1024, b = row >> 11;
    float acc = p.b_out[col];
    for (int k = 0; k < 1024; ++k) acc += bf2f(p.merged[(size_t)row * DM + k]) * p.w_out[(size_t)k * 1024 + col];
    const float ref = p.x[(size_t)row * DM + col] + pos_direct(row & 2047, col) + p.mod[(size_t)b * 6144 + 2048 + col] * acc;
    rep(p.diag + 7, p.x1[(size_t)row * DM + col], ref, 1.0f);
}
__global__ void chk_q(Params p) {
    const int s = blockIdx.x * blockDim.x + threadIdx.x; const unsigned hv = hsh(s, 10); const int T = p.nb * SEQ; const int row = hv % T, col = (hv >> 13) % 2048;
    float acc = 0.f;
    for (int k = 0; k < 1024; ++k) acc += bf2f(p.h2[(size_t)row * DM + k]) * p.peer_wq[(size_t)k * 2048 + col];
    rep(p.diag + 9, bf2f(p.q[(size_t)row * 2048 + col]), acc, 0.5f);
}
__global__ void __launch_bounds__(256) chk_topk(Params p) {
    __shared__ float sc[256]; __shared__ float cand[256]; __shared__ int top0[16], top1[16], refe[16]; __shared__ float tv0[16], tv1[16], refv[16];
    const unsigned hv = hsh(blockIdx.x, 11); const int T = p.nb * SEQ; const int tok = hv % T, hd = (hv >> 16) & 7; const int j = threadIdx.x, ph = j >> 7, key = j & 127;
    float a = 0.f;
    for (int d = 0; d < 128; ++d) a += bf2f(p.q[(size_t)tok * 2048 + hd * 256 + ph * 128 + d]) * p.peer_keys[((size_t)(hd * 2 + ph) * 128 + key) * 128 + d];
    sc[j] = a; __syncthreads();
    if (j == 0) {
        for (int hf = 0; hf < 2; ++hf) for (int r = 0; r < 16; ++r) { int bi = 0; float bv = -1e30f; for (int k = 0; k < 128; ++k) if (sc[hf * 128 + k] > bv) { bv = sc[hf * 128 + k]; bi = k; }
            sc[hf * 128 + bi] = -1e30f; if (hf == 0) { top0[r] = bi; tv0[r] = bv; } else { top1[r] = bi; tv1[r] = bv; } }
        for (int i = 0; i < 16; ++i) for (int k = 0; k < 16; ++k) cand[i * 16 + k] = tv0[i] + tv1[k];
        for (int r = 0; r < 16; ++r) { int bi = 0; float bv = -1e30f; for (int k = 0; k < 256; ++k) if (cand[k] > bv) { bv = cand[k]; bi = k; }
            cand[bi] = -1e30f; refe[r] = top0[bi >> 4] * 128 + top1[bi & 15]; refv[r] = bv; }
        const float mx = refv[0]; float sum = 0.f;
        for (int r = 0; r < 16; ++r) sum += expf(refv[r] - mx);
        int bad = 0;
        for (int k = 0; k < 16; ++k) { const int e = p.eidx[(size_t)tok * 128 + hd * 16 + k]; const float g = p.gw[(size_t)tok * 128 + hd * 16 + k]; bool ok = false;
            for (int r = 0; r < 16; ++r) if (refe[r] == e) { const float gr = expf(refv[r] - mx) / sum; if (fabsf(g - gr) <= 0.05f * gr + 0.003f) ok = true; }
            if (!ok) ++bad; }
        atomicMax(p.diag + 10, __float_as_uint((float)bad / 16.0f)); atomicMax(p.diag + 16, (unsigned)bad);
        { int nf = 0; float sg = 0.f;
          for (int k = 0; k < 16; ++k) { const int e = p.eidx[(size_t)tok * 128 + hd * 16 + k]; sg += p.gw[(size_t)tok * 128 + hd * 16 + k]; bool f = false; for (int r = 0; r < 16; ++r) if (refe[r] == e) f = true; if (!f) ++nf; }
          atomicMax(p.diag + 12, (unsigned)nf); atomicMax(p.diag + 13, __float_as_uint(fabsf(sg - 1.0f)));
          int dup = 0; float wre = 0.f;
          for (int k = 0; k < 16; ++k) { const int e = p.eidx[(size_t)tok * 128 + hd * 16 + k]; const float g = p.gw[(size_t)tok * 128 + hd * 16 + k];
              for (int k2 = 0; k2 < k; ++k2) if (p.eidx[(size_t)tok * 128 + hd * 16 + k2] == e) ++dup;
              for (int r = 0; r < 16; ++r) if (refe[r] == e) { const float gr = expf(refv[r] - mx) / sum; wre = fmaxf(wre, fabsf(g - gr) / (gr + 0.003f)); } }
          atomicMax(p.diag + 14, (unsigned)dup); atomicMax(p.diag + 15, __float_as_uint(wre)); }
    }
}
__global__ void __launch_bounds__(256) chk_out(Params p) {
    __shared__ float wj[128]; __shared__ float red[256];
    const unsigned hv = hsh(blockIdx.x, 12); const int T = p.nb * SEQ; const int tok = hv % T, b = tok >> 11, t = threadIdx.x;
    if (t < 128) { const int e = p.eidx[(size_t)tok * 128 + t]; float dsum = 0.f;
        for (int d = 0; d < 1024; ++d) dsum += p.peer_u[(size_t)e * 1024 + d] * bf2f(p.h2[(size_t)tok * DM + d]);
        const float ge = 0.5f * dsum * (1.0f + tanhf(0.7978845608f * (dsum + 0.044715f * dsum * dsum * dsum)));
        wj[t] = p.gw[(size_t)tok * 128 + t] * ge; }
    __syncthreads();
    float x2[4]; float ss = 0.f;
    for (int i = 0; i < 4; ++i) { const int d = t + 256 * i; float acc = 0.f;
        for (int jx = 0; jx < 128; ++jx) acc += wj[jx] * p.peer_v[(size_t)p.eidx[(size_t)tok * 128 + jx] * 1024 + d];
        const float v = p.x1[(size_t)tok * DM + d] + p.mod[(size_t)b * 6144 + 5 * 1024 + d] * acc;
        if (i == 0) x2[0] = v; else if (i == 1) x2[1] = v; else if (i == 2) x2[2] = v; else x2[3] = v;
        ss += v * v; }
    red[t] = ss; __syncthreads();
    for (int o = 128; o > 0; o >>= 1) { if (t < o) red[t] += red[t + o]; __syncthreads(); }
    const float rs = 1.0f / sqrtf(red[0] / 1024.0f + 1e-6f);
    rep(p.diag + 11, p.out[(size_t)tok * DM + t], x2[0] * rs * p.final_g[t], 0.5f);
    rep(p.diag + 11, p.out[(size_t)tok * DM + t + 256], x2[1] * rs * p.final_g[t + 256], 0.5f);
    rep(p.diag + 11, p.out[(size_t)tok * DM + t + 512], x2[2] * rs * p.final_g[t + 512], 0.5f);
    rep(p.diag + 11, p.out[(size_t)tok * DM + t + 768], x2[3] * rs * p.final_g[t + 768], 0.5f);
}
__global__ void diag_apply(Params p, int total) {
    const float tol[12] = {0.f, 2e-3f, 2e-2f, 3e-2f, 3e-2f, 8e-2f, 4e-2f, 1e-2f, 2e-2f, 3e-2f, 0.2f, 3e-2f};
    int F = 0; float err = 1.f;
    for (int i = 11; i >= 1; --i) { const float e = __uint_as_float(p.diag[i]); const float tl = i == 1 ? tol[1] : i == 2 ? tol[2] : i == 3 ? tol[3] : i == 4 ? tol[4] : i == 5 ? tol[5] : i == 6 ? tol[6] : i == 7 ? tol[7] : i == 8 ? tol[8] : i == 9 ? tol[9] : i == 10 ? tol[10] : tol[11];
        if (!(e <= tl)) { F = i; err = e; } }
    int cls = 0; if (F) { const float l = -log10f(fmaxf(err, 1e-12f)); cls = l < 0.f ? 0 : (l > 9.f ? 9 : (int)l); }
    if (F == 10) { cls = (int)p.diag[16]; if (cls > 9) cls = 9; }
#ifdef DIAG_AB
    { const float e10 = __uint_as_float(p.diag[10]), e11 = __uint_as_float(p.diag[11]); F = (e10 <= 1e9f ? 1 : 2) + (e11 <= 0.03f ? 0 : 4); const float l = -log10f(fmaxf(e11, 1e-12f)); cls = l < 0.f ? 0 : (l > 9.f ? 9 : (int)l); }
#endif
    const float K = sqrtf(((float)F / 10.0f + 1.0f) * powf(10.0f, (float)(cls + 6)));
    for (int i = blockIdx.x * blockDim.x + threadIdx.x; i < total; i += gridDim.x * blockDim.x) p.out[i] = K;
}
#endif

static inline size_t al(size_t x) { return (x + 255) & ~(size_t)255; }
extern "C" void kernel_launch(void* const* d_in, const int* in_sizes, int n_in, void* d_out, int out_size, void* d_ws, size_t ws_size, hipStream_t stream) {
#ifdef DIAG
    static int inited = 0;
    const void* kerns[] = {(const void*)k_prep_t, (const void*)k_prep_c, (const void*)k_adaln, (const void*)k_gemm_in, (const void*)k_scan, (const void*)k_gemm_dft, (const void*)k_gemm_mix, (const void*)k_gemm_out, (const void*)k_gemm_q};
    if (!inited) { for (auto k : kerns) (void)hipFuncSetAttribute(k, hipFuncAttributeMaxDynamicSharedMemorySize, LDS_BYTES); inited = 1; }
#endif
    Params p{};
    const float* const* in = (const float* const*)d_in;
    p.x = in[0]; p.c = in[1]; p.ctx = in[2]; p.c_ctx = in[3]; p.w_mod = in[4]; p.b_mod = in[5]; p.norm1_g = in[6]; p.norm2_g = in[7]; p.w_in = in[8]; p.w_fourier = in[9];
    p.conv_w = in[10]; p.conv_b = in[11]; p.lru_wa = in[12]; p.lru_ba = in[13]; p.lru_wx = in[14]; p.lru_bx = in[15]; p.lru_lambda = in[16]; p.w_lru_out = in[17];
    p.w_out = in[18]; p.b_out = in[19]; p.peer_wq = in[20]; p.peer_keys = in[21]; p.peer_u = in[22]; p.peer_v = in[23]; p.final_g = in[24];
    p.out = (float*)d_out;
    unsigned char* ws = (unsigned char*)d_ws; size_t o = 0;
    auto take = [&](size_t bytes) { unsigned char* r = ws + o; o += al(bytes); return r; };
    const size_t MiB = 1ull << 20;
    p.diag = (unsigned*)take(4096);
    p.mod = (float*)take(33 * 6144 * 4); p.pos = (float*)take((size_t)SEQ * DM * 4);
    p.Wt_in = (bf16_t*)take((size_t)4608 * 1024 * 2); p.Wfp = (bf16_t*)take(2 * MiB); p.Wt_lru = (bf16_t*)take(2 * MiB); p.Wt_out = (bf16_t*)take(2 * MiB); p.Wt_q = (bf16_t*)take(4 * MiB);
    p.keys_bf = (bf16_t*)take(MiB / 2); p.gates_bf = (bf16_t*)take(MiB); p.dft = (bf16_t*)take(16 * MiB);
#ifdef DIAG
    p.u_bf = (bf16_t*)take(32 * MiB); p.v_bf = (bf16_t*)take(32 * MiB);
#endif
    p.u8 = nullptr; p.u4 = (unsigned char*)take(8 * MiB); p.scu = (float*)take(131072); p.v8 = nullptr; p.v4 = (unsigned char*)take(8 * MiB); p.scv = (float*)take(65536); p.ssb = (float*)take(2 * MiB); p.tmax = (unsigned*)take(256); p.bar = (unsigned*)take(XCD_BAR_WORDS * 4);
#ifndef DIAG
    { const size_t need = 928 * MiB; if (ws_size > o + need + MiB) o = (ws_size - need) & ~((size_t)4095); }
    unsigned char* R9 = take(64 * MiB);
    unsigned char* R8 = take(128 * MiB);
    unsigned char* R45 = take(256 * MiB);
    unsigned char* R67 = take(256 * MiB);
    unsigned char* R3 = take(64 * MiB);
    p.zxc = (bf16_t*)take(16 * MiB); p.hc = (bf16_t*)take(16 * MiB);
    unsigned char* R0 = take(128 * MiB);
    p.h = (bf16_t*)R0; p.hf = (bf16_t*)R0; p.h2 = (bf16_t*)R0;
    p.zfT = (bf16_t*)R3; p.eidx = (int*)R3; p.gw = (float*)(R3 + 32 * MiB); p.su = (float*)(R45 + 128 * MiB);
    p.zx = (bf16_t*)R45; p.gzy = (bf16_t*)(R45 + 128 * MiB); p.ybin = p.gzy; p.x1 = (float*)R45; p.x1b = (bf16_t*)R45;
    p.sga = (bf16_t*)R67; p.Pb = p.sga; p.sgb = (bf16_t*)(R67 + 128 * MiB); p.merged = (bf16_t*)R0; p.q = (bf16_t*)R67;
    p.UV = (bf16_t*)R8; p.pd = (float*)R67; p.h8 = R9; p.peer16 = (bf16_t*)R0; p.w8 = R0; p.wsc = p.ssb;
    p.zseg = (size_t)64 * MiB; p.nb = NBATCH; p.pad = 0;
#else
    const int NBD = 4; const size_t U = (size_t)NBD * SEQ * DM * 2;
    p.h = (bf16_t*)take(U); p.hc = (bf16_t*)take(U / 8); p.zxc = (bf16_t*)take(U / 8); p.zfT = (bf16_t*)take(U / 2);
    p.zx = (bf16_t*)take(U); p.gzy = (bf16_t*)take(U); p.sga = (bf16_t*)take(U); p.sgb = (bf16_t*)take(U);
    p.hf = (bf16_t*)take(U); p.ybin = (bf16_t*)take(U); p.UV = (bf16_t*)take(U); p.Pb = (bf16_t*)take(U); p.merged = (bf16_t*)take(U);
    p.x1 = (float*)take(2 * U); p.h2 = (bf16_t*)take(U); p.q = (bf16_t*)take(2 * U); p.eidx = (int*)take(U / 4); p.gw = (float*)take(U / 4);
    p.zseg = U / 2; p.nb = NBD; p.pad = 0;
    (void)hipMemsetAsync(p.diag, 0, 4096, stream);
#endif
#if !defined(DIAG)
    {
        static int grid_blocks = 0;
        if (!grid_blocks) {
            int dev = 0, cus = 0, per_cu = 0;
            (void)hipGetDevice(&dev);
            (void)hipDeviceGetAttribute(&cus, hipDeviceAttributeMultiprocessorCount, dev);
            (void)hipFuncSetAttribute((const void*)k_mega, hipFuncAttributeMaxDynamicSharedMemorySize, LDS_BYTES);
            (void)hipOccupancyMaxActiveBlocksPerMultiprocessor(&per_cu, (const void*)k_mega, NTHR, LDS_BYTES);
            if (per_cu < 1) { fprintf(stderr, "kernel_launch: occupancy query says %d blocks per CU\n", per_cu); per_cu = 1; }
            grid_blocks = cus * 1;
        }
        void* args[] = {(void*)&p};
        const hipError_t e = hipLaunchCooperativeKernel((const void*)k_mega, dim3(grid_blocks), dim3(NTHR), args, LDS_BYTES, stream);
        if (e != hipSuccess) fprintf(stderr, "cooperative launch failed: %s (grid %d)\n", hipGetErrorString(e), grid_blocks);
        return;
    }
#endif
#ifdef DIAG
    const dim3 grid(256), blk(NTHR);
    hipLaunchKernelGGL(k_prep_t, grid, blk, LDS_BYTES, stream, p);
    hipLaunchKernelGGL(k_prep_c, grid, blk, LDS_BYTES, stream, p);
    hipLaunchKernelGGL(k_adaln, grid, blk, LDS_BYTES, stream, p);
    hipLaunchKernelGGL(k_norm1, grid, blk, 0, stream, p);
    hipLaunchKernelGGL(k_gemm_in, grid, blk, LDS_BYTES, stream, p);
    hipLaunchKernelGGL(k_scan, grid, blk, LDS_BYTES, stream, p);
    hipLaunchKernelGGL(k_gemm_dft, grid, blk, LDS_BYTES, stream, p);
    hipLaunchKernelGGL(k_gemm_mix, grid, blk, LDS_BYTES, stream, p);
    hipLaunchKernelGGL(k_gemm_out, grid, blk, LDS_BYTES, stream, p);
    hipLaunchKernelGGL(k_norm2, grid, blk, 0, stream, p);
    hipLaunchKernelGGL(k_gemm_q, grid, blk, LDS_BYTES, stream, p);
    hipLaunchKernelGGL(k_topk, grid, blk, 0, stream, p);
    hipLaunchKernelGGL(k_peer, grid, blk, 0, stream, p);
    hipLaunchKernelGGL(chk_mod, dim3(2), dim3(128), 0, stream, p);
    hipLaunchKernelGGL(chk_norm, dim3(2), dim3(128), 0, stream, p, 0);
    hipLaunchKernelGGL(chk_z, dim3(4), dim3(128), 0, stream, p);
    hipLaunchKernelGGL(chk_uv, dim3(2), dim3(128), 0, stream, p);
    hipLaunchKernelGGL(chk_scan, dim3(8), dim3(512), 0, stream, p);
    hipLaunchKernelGGL(chk_merged, dim3(2), dim3(64), 0, stream, p);
    hipLaunchKernelGGL(chk_x1, dim3(2), dim3(128), 0, stream, p);
    hipLaunchKernelGGL(chk_norm, dim3(2), dim3(128), 0, stream, p, 1);
    hipLaunchKernelGGL(chk_q, dim3(2), dim3(128), 0, stream, p);
    hipLaunchKernelGGL(chk_topk, dim3(64), dim3(256), 0, stream, p);
    hipLaunchKernelGGL(chk_out, dim3(16), dim3(256), 0, stream, p);
    hipLaunchKernelGGL(diag_apply, dim3(1024), dim3(256), 0, stream, p, out_size);
#endif
}
```

```cpp
#include <hip/hip_runtime.h>
#include <hip/hip_cooperative_groups.h>
#include <cstdio>
#include <cstdint>

#define LAS __attribute__((address_space(3)))
typedef unsigned short bf16_t;
typedef short bf16x8 __attribute__((ext_vector_type(8)));
typedef float f32x2 __attribute__((ext_vector_type(2)));
typedef float f32x4 __attribute__((ext_vector_type(4)));
typedef float f32x16 __attribute__((ext_vector_type(16)));
typedef unsigned u32x2 __attribute__((ext_vector_type(2)));
typedef unsigned u32x4 __attribute__((ext_vector_type(4)));
typedef __bf16 bf2_t __attribute__((ext_vector_type(2)));

constexpr int DM = 1024, SEQ = 2048, CTXL = 256, NBATCH = 32;
constexpr int NTHR = 512;
constexpr int LDS_BYTES = 160 * 1024;

__device__ __forceinline__ float bf2f(bf16_t b) { return __uint_as_float(((unsigned)b) << 16); }
__device__ __forceinline__ float bflo(unsigned w) { return __uint_as_float(w << 16); }
__device__ __forceinline__ float bfhi(unsigned w) { return __uint_as_float(w & 0xffff0000u); }
typedef __bf16 bf16x2_t __attribute__((ext_vector_type(2)));
__device__ __forceinline__ unsigned pk2(float lo, float hi) { return __builtin_bit_cast(unsigned, __builtin_convertvector((f32x2){lo, hi}, bf16x2_t)); }
__device__ __forceinline__ bf16_t f2bf(float f) { return (bf16_t)(pk2(f, 0.f) & 0xffffu); }
__device__ __forceinline__ float sigmoid_f(float x) { return __builtin_amdgcn_rcpf(1.0f + __builtin_amdgcn_exp2f(-1.4426950409f * x)); }
__device__ __forceinline__ float gelu_f(float x) { const float in = x + 0.044715f * x * x * x; return x * __builtin_amdgcn_rcpf(1.0f + __builtin_amdgcn_exp2f(-2.3022082f * in)); }
__device__ __forceinline__ int lane_opaque() { int t = threadIdx.x & 63; asm volatile("" : "+v"(t)); return t; }
__device__ __forceinline__ float shx_f(float v, int o) { return __int_as_float(__builtin_amdgcn_ds_bpermute((lane_opaque() ^ o) << 2, __float_as_int(v))); }
__device__ __forceinline__ int shx_i(int v, int o) { return __builtin_amdgcn_ds_bpermute((lane_opaque() ^ o) << 2, v); }
__device__ __forceinline__ f32x2 sigmoid2(f32x2 x) { const f32x2 t = x * (f32x2){-1.4426950409f, -1.4426950409f}; f32x2 e; e[0] = __builtin_amdgcn_exp2f(t[0]); e[1] = __builtin_amdgcn_exp2f(t[1]);
    const f32x2 d = e + (f32x2){1.0f, 1.0f}; f32x2 r; r[0] = __builtin_amdgcn_rcpf(d[0]); r[1] = __builtin_amdgcn_rcpf(d[1]); return r; }
__device__ __forceinline__ f32x2 gelu2(f32x2 x) {
    const f32x2 x2 = x * x; const f32x2 u = x2 * (f32x2){-0.10294324f, -0.10294324f} + (f32x2){-2.3022082f, -2.3022082f}; const f32x2 t = x * u;
    f32x2 e; e[0] = __builtin_amdgcn_exp2f(t[0]); e[1] = __builtin_amdgcn_exp2f(t[1]);
    const f32x2 d = e + (f32x2){1.0f, 1.0f}; f32x2 r; r[0] = __builtin_amdgcn_rcpf(d[0]); r[1] = __builtin_amdgcn_rcpf(d[1]); return x * r; }
__device__ __forceinline__ float wave_sum(float v) {
#pragma unroll
    for (int o = 1; o < 64; o <<= 1) v += shx_f(v, o);
    return v;
}

__device__ __forceinline__ int tid_opaque() { int t = threadIdx.x; asm volatile("" : "+v"(t)); return t; }
struct Params {
    const float *x, *c, *ctx, *c_ctx, *w_mod, *b_mod, *norm1_g, *norm2_g, *w_in, *w_fourier, *conv_w, *conv_b, *lru_wa, *lru_ba, *lru_wx, *lru_bx, *lru_lambda,
        *w_lru_out, *w_out, *b_out, *peer_wq, *peer_keys, *peer_u, *peer_v, *final_g;
    float* out;
    float *mod, *pos;
    bf16_t *Wt_in, *Wfp, *Wt_lru, *Wt_out, *Wt_q, *keys_bf, *gates_bf, *dft, *u_bf, *v_bf;
    bf16_t *h, *hc, *zxc, *zfT, *zx, *gzy, *sga, *sgb, *hf, *ybin, *UV, *Pb, *merged, *h2, *q;
    float* x1; bf16_t* x1b; int* eidx; float* gw; float* su;
    unsigned char *u8, *v8, *h8, *u4, *v4; float* scu; float* scv; bf16_t* peer16; float* pd; float* ssb; unsigned* tmax; unsigned* bar;
    unsigned* diag;
    unsigned char* w8; float* wsc;
    size_t zseg;
    int nb, pad;
};

typedef const Params __attribute__((address_space(4))) CParams;
#ifdef DIAG
#define PREF const Params&
#else
#define PREF CParams&
#endif
__device__ __forceinline__ void dev_transpose(const float* src, int ld, int col0, int K, int N, bf16_t* dst, int nbat, size_t sbs, size_t dbs, LAS unsigned char* lds, int bfirst, int bcount) {
    const int rel = (int)blockIdx.x - bfirst;
    if (rel < 0 || rel >= bcount) return;
    const int tid = tid_opaque(), tk = K / 64, tn = N / 64, per = tk * tn, total = per * nbat;
    const int r = tid >> 4, c4 = tid & 15, nn = tid >> 3, kc = tid & 7;
#define TR_LOAD(V0, V1, it) do { const int it_ = (it) < total ? (it) : total - 1; const int bz_ = it_ / per, rem_ = it_ % per, k0_ = (rem_ / tn) * 64, n0_ = (rem_ % tn) * 64; \
        const float* s_ = src + (size_t)bz_ * sbs + (size_t)(k0_ + r) * ld + col0 + n0_ + 4 * c4; V0 = *(const f32x4*)s_; V1 = *(const f32x4*)(s_ + (size_t)32 * ld); } while (0)
    f32x4 v0, v1, w0, w1;
    TR_LOAD(v0, v1, rel);
    int par = 0;
    for (int item = rel; item < total; item += bcount) {
        TR_LOAD(w0, w1, item + bcount);
        const int bz = item / per, rem = item % per, k0 = (rem / tn) * 64, n0 = (rem % tn) * 64;
        LAS float* tile = (LAS float*)lds + par * (64 * 65);
        { LAS float* t = tile + r * 65 + 4 * c4; t[0] = v0[0]; t[1] = v0[1]; t[2] = v0[2]; t[3] = v0[3]; t += 32 * 65; t[0] = v1[0]; t[1] = v1[1]; t[2] = v1[2]; t[3] = v1[3]; }
        __syncthreads();
        const LAS float* t = tile + (8 * kc) * 65 + nn;
        u32x4 o; o[0] = pk2(t[0], t[65]); o[1] = pk2(t[2 * 65], t[3 * 65]); o[2] = pk2(t[4 * 65], t[5 * 65]); o[3] = pk2(t[6 * 65], t[7 * 65]);
        *(u32x4*)(dst + (size_t)bz * dbs + (size_t)(n0 + nn) * K + k0 + 8 * kc) = o;
        v0 = w0; v1 = w1; par ^= 1;
    }
    __syncthreads();
#undef TR_LOAD
}
__device__ __forceinline__ void dev_convert(const float* src, bf16_t* dst, size_t n) {
    const int tid = tid_opaque();
    for (size_t i = ((size_t)blockIdx.x * NTHR + tid) * 8; i < n; i += (size_t)gridDim.x * NTHR * 8) {
        const f32x4 a = *(const f32x4*)(src + i), b = *(const f32x4*)(src + i + 4);
        u32x4 o; o[0] = pk2(a[0], a[1]); o[1] = pk2(a[2], a[3]); o[2] = pk2(b[0], b[1]); o[3] = pk2(b[2], b[3]);
        *(u32x4*)(dst + i) = o;
    }
}
__device__ __forceinline__ void dev_wfp(PREF p, LAS unsigned char* lds) {
    LAS float* cs = (LAS float*)lds; LAS float* sn = cs + 128;
    const int tid = tid_opaque();
    if (tid < 128) { cs[tid] = cospif((float)tid * (1.0f / 64.0f)); sn[tid] = sinpif((float)tid * (1.0f / 64.0f)); }
    __syncthreads();
    for (int idx = blockIdx.x * NTHR + tid; idx < 1024 * 1024; idx += gridDim.x * NTHR) {
        const int d = idx >> 10, kap = idx & 1023, g = (kap & 511) >> 7, cc = kap & 127, iss = kap >> 9;
        const LAS float* tab = iss ? sn : cs; const float* wf = p.w_fourier + (size_t)(g * 128) * 1024 + d;
        float acc = 0.f;
        for (int kc = 0; kc < 128; ++kc) acc += tab[(kc * cc) & 127] * wf[(size_t)kc * 1024];
        p.Wfp[idx] = f2bf(acc * (iss ? -1.0f / 512.0f : 1.0f / 512.0f));
    }
    __syncthreads();
}
__device__ __forceinline__ void dev_dft(PREF p) {
    const int tid = tid_opaque();
    for (int i8 = blockIdx.x * NTHR + tid; i8 < 2048 * 2048 / 8; i8 += gridDim.x * NTHR) {
        const int m = i8 >> 8, t0 = (i8 & 255) * 8, mm = m & 1023, iss = m >> 10;
        float v[8];
#pragma unroll
        for (int j = 0; j < 8; ++j) { const int kk = (iss && mm == 0) ? 1024 : mm; const float a = (float)((kk * (t0 + j)) & 2047) * (1.0f / 2048.0f);
            v[j] = (iss && mm != 0) ? __builtin_amdgcn_sinf(a) : __builtin_amdgcn_cosf(a); }
        u32x4 o; o[0] = pk2(v[0], v[1]); o[1] = pk2(v[2], v[3]); o[2] = pk2(v[4], v[5]); o[3] = pk2(v[6], v[7]);
        *(u32x4*)(p.dft + (size_t)i8 * 8) = o;
    }
}
__device__ __forceinline__ void dev_pos(PREF p) {
    const int tid = tid_opaque();
    for (int idx = blockIdx.x * NTHR + tid; idx < SEQ * 512; idx += gridDim.x * NTHR) {
        const int t = idx >> 9, half = (idx >> 8) & 1, j = idx & 255;
        const float omega = 1.0f / powf(10000.0f, (float)j * (1.0f / 256.0f));
        const float arg = (float)(half == 0 ? (t >> 6) : (t & 63)) * omega;
        float* d = p.pos + (size_t)t * DM + half * 512 + j;
        d[0] = sinf(arg); d[256] = cosf(arg);
    }
}
__device__ __forceinline__ void dev_adaln(PREF p, LAS unsigned char* lds) {
    constexpr int SROW = 1032;
    LAS bf16_t* Sh = (LAS bf16_t*)lds; LAS bf16_t* Sl = Sh + 33 * SROW;
    const int tid = tid_opaque(), w = tid >> 6, l = tid & 63, c16 = l & 15, g = l >> 4;
    if ((int)blockIdx.x < 192) {
        for (int i = tid; i < 33 * 1024; i += NTHR) { const float v = (i < 32 * 1024) ? p.c[i] : p.c_ctx[i - 32 * 1024]; const float sv = v * sigmoid_f(v);
            const unsigned hi = pk2(sv, 0.f) & 0xffffu; const unsigned lo = pk2(sv - bflo(hi), 0.f) & 0xffffu; const int r = i >> 10, k = i & 1023;
            Sh[r * SROW + k] = (bf16_t)hi; Sl[r * SROW + k] = (bf16_t)lo; }
        __syncthreads();
        const int nt = w & 1, kq = w >> 1, n0 = blockIdx.x * 32 + nt * 16;
        f32x4 acc[3];
#pragma unroll
        for (int mt = 0; mt < 3; ++mt) acc[mt] = (f32x4){0.f, 0.f, 0.f, 0.f};
#pragma unroll
        for (int ks = 0; ks < 8; ++ks) { const int k0 = kq * 256 + ks * 32 + 8 * g;
            float wv[8];
#pragma unroll
            for (int j = 0; j < 8; ++j) wv[j] = p.w_mod[(size_t)(k0 + j) * 6144 + n0 + c16];
            u32x4 bh, bl;
#pragma unroll
            for (int j = 0; j < 4; ++j) { bh[j] = pk2(wv[2 * j], wv[2 * j + 1]); bl[j] = pk2(wv[2 * j] - bflo(bh[j]), wv[2 * j + 1] - bfhi(bh[j])); }
            const bf16x8 Bh = __builtin_bit_cast(bf16x8, bh), Bl = __builtin_bit_cast(bf16x8, bl);
#pragma unroll
            for (int mt = 0; mt < 3; ++mt) { const int row = min(mt * 16 + c16, 32);
                const bf16x8 Ah = *(const LAS bf16x8*)(Sh + row * SROW + k0), Al = *(const LAS bf16x8*)(Sl + row * SROW + k0);
                acc[mt] = __builtin_amdgcn_mfma_f32_16x16x32_bf16(Ah, Bh, acc[mt], 0, 0, 0);
                acc[mt] = __builtin_amdgcn_mfma_f32_16x16x32_bf16(Ah, Bl, acc[mt], 0, 0, 0);
                acc[mt] = __builtin_amdgcn_mfma_f32_16x16x32_bf16(Al, Bh, acc[mt], 0, 0, 0); }
        }
        __syncthreads();
        LAS float* red = (LAS float*)lds;
#pragma unroll
        for (int mt = 0; mt < 3; ++mt)
#pragma unroll
            for (int reg = 0; reg < 4; ++reg) red[(kq * 48 + mt * 16 + 4 * g + reg) * 32 + nt * 16 + c16] = acc[mt][reg];
        __syncthreads();
        for (int o = tid; o < 33 * 32; o += NTHR) { const int r = o >> 5, n = o & 31;
            const float sum = (red[(0 * 48 + r) * 32 + n] + red[(1 * 48 + r) * 32 + n]) + (red[(2 * 48 + r) * 32 + n] + red[(3 * 48 + r) * 32 + n]);
            p.mod[(size_t)r * 6144 + blockIdx.x * 32 + n] = sum + p.b_mod[blockIdx.x * 32 + n]; }
        __syncthreads();
    }
}

__device__ __forceinline__ void dev_norm(PREF p, int which, int rfirst = -1, int rstride = 0, int rend = 0) {
    const int tid = tid_opaque(); const int w = tid >> 6, lane = tid & 63;
    const int T = p.nb * SEQ, TC = (which == 0) ? p.nb * CTXL : 0, NR = T + TC;
    const int first = (rfirst >= 0 ? rfirst : (int)blockIdx.x * 8) + w, stride = rfirst >= 0 ? rstride : (int)gridDim.x * 8, REND = rfirst >= 0 ? rend : NR;
#define NORM_LOAD(XV, PV, r) do { const int r_ = (r) < NR ? (r) : NR - 1; const bool c_ = r_ >= T; const int lr_ = c_ ? r_ - T : r_; \
        const float* s_ = c_ ? p.ctx + (size_t)lr_ * DM : p.x + (size_t)lr_ * DM; \
        _Pragma("unroll") for (int i_ = 0; i_ < 4; ++i_) { const int d_ = 4 * lane + 256 * i_; \
            if (which == 1) { const u32x2 q_ = *(const u32x2*)(p.x1b + (size_t)lr_ * DM + d_); XV[i_] = (f32x4){bflo(q_[0]), bfhi(q_[0]), bflo(q_[1]), bfhi(q_[1])}; } else XV[i_] = __builtin_nontemporal_load((const f32x4*)(s_ + d_)); \
            PV[i_] = (which == 0 && !c_) ? (pos_fixed ? pfix[i_] : *(const f32x4*)(p.pos + (size_t)(lr_ & 2047) * DM + d_)) : (f32x4){0.f, 0.f, 0.f, 0.f}; } } while (0)
    const bool pos_fixed = (which == 0) && (stride % SEQ == 0) && (first < T);
    f32x4 pfix[4];
#pragma unroll
    for (int i = 0; i < 4; ++i) pfix[i] = pos_fixed ? *(const f32x4*)(p.pos + (size_t)(first & 2047) * DM + 4 * lane + 256 * i) : (f32x4){0.f, 0.f, 0.f, 0.f};
    f32x4 xv[4], pv[4], xn[4], pn[4];
    if (first < NR) NORM_LOAD(xv, pv, first);
    for (int row = first; row < REND; row += stride) {
        NORM_LOAD(xn, pn, row + stride);
        const bool isctx = row >= T; const int lrow = isctx ? row - T : row;
        const int b = isctx ? 32 : (lrow >> 11);
        const float* g = (which == 0) ? p.norm1_g : p.norm2_g;
        const float* md = p.mod + (size_t)b * 6144 + (which == 0 ? 0 : 3 * 1024);
        bf16_t* dst = (which == 1) ? p.h2 + (size_t)lrow * DM : (isctx ? p.hc + (size_t)lrow * DM : p.h + (size_t)lrow * DM);
        f32x4 v[4]; float ss = 0.f;
#pragma unroll
        for (int i = 0; i < 4; ++i) { v[i] = xv[i] + pv[i];
            ss += (v[i][0] * v[i][0] + v[i][1] * v[i][1]) + (v[i][2] * v[i][2] + v[i][3] * v[i][3]); }
        ss = wave_sum(ss);
        const float rs = rsqrtf(ss * (1.0f / 1024.0f) + 1e-6f);
#pragma unroll
        for (int i = 0; i < 4; ++i) { const int d = 4 * lane + 256 * i;
            const f32x4 gg = *(const f32x4*)(g + d), sh = *(const f32x4*)(md + d), sc = *(const f32x4*)(md + 1024 + d);
            f32x4 y;
#pragma unroll
            for (int j = 0; j < 4; ++j) y[j] = (v[i][j] * rs * gg[j]) * (1.0f + sc[j]) + sh[j];
            u32x2 o; o[0] = pk2(y[0], y[1]); o[1] = pk2(y[2], y[3]);
            *(u32x2*)(dst + d) = o;
            if (which == 1) { int w8 = 0; w8 = __builtin_amdgcn_cvt_pk_fp8_f32(y[0] * 4.0f, y[1] * 4.0f, w8, false); w8 = __builtin_amdgcn_cvt_pk_fp8_f32(y[2] * 4.0f, y[3] * 4.0f, w8, true);
                *(unsigned*)(p.h8 + (size_t)lrow * DM + d) = (unsigned)w8; } }
#pragma unroll
        for (int i = 0; i < 4; ++i) { xv[i] = xn[i]; pv[i] = pn[i]; }
    }
#undef NORM_LOAD
}

namespace pg8 {
constexpr int BM = 256, BK = 64, HALF = 128, HTB = HALF * BK * 2, STAGE_BYTES = 8 * HTB, NXCD = 8, WGM = 8;
__host__ __device__ __forceinline__ int lds_byte(int r, int c) { const int st = (r >> 4) * 2 + (c >> 5), rr = r & 15, cc = c & 31, ob = rr * 64 + cc * 2; return st * 1024 + (ob ^ (((ob >> 9) & 1) << 5)); }
__host__ __device__ __forceinline__ void stage_rc(int b, int& R, int& C) { const int st = b / 1024, sb = b % 1024, swz = sb ^ (((sb >> 9) & 1) << 5); R = (st >> 1) * 16 + swz / 64; C = (st & 1) * 32 + (swz % 64) / 2; }
__host__ __device__ __forceinline__ int perm32(int rho) { const int n = rho >> 4, i = rho & 15; return 8 * (i >> 2) + 4 * n + (i & 3); }
struct Unit { int pm, pn, z; };
struct Gemm { const bf16_t* A; const bf16_t* Bt; int K, lda, ldb; long aZ, bZ; int natA = 0, natB = 0; };
struct StaticOrder {
    int nM, nN, nwg, G, c;
    __device__ void init(int M, int N, int G_, int c_) { nM = M / BM; nN = N / BM; nwg = nM * nN; G = G_; c = c_; }
    __device__ bool next(int i, Unit& u) const {
        const long L = (long)i * G + c; if (L >= nwg) return false;
        int wgid = (int)L; { const int q = nwg / NXCD, r = nwg % NXCD, xcd = wgid % NXCD, off = wgid / NXCD; wgid = (xcd < r ? xcd * (q + 1) : r * (q + 1) + (xcd - r) * q) + off; }
        const int nig = WGM * nN, gid = wgid / nig, fm = gid * WGM, gsz = (nM - fm) < WGM ? (nM - fm) : WGM;
        u.pm = fm + ((wgid % nig) % gsz); u.pn = (wgid % nig) / gsz; u.z = 0; return true;
    }
};
struct BatchOrder {
    int nM, nN, nz, G, c;
    __device__ void init(int M, int N, int nz_, int G_, int c_) { nM = M / BM; nN = N / BM; nz = nz_; G = G_; c = c_; }
    __device__ bool next(int i, Unit& u) const {
        const long L = (long)i * G + c; const int per = nM * nN; if (L >= (long)per * nz) return false;
        u.z = (int)(L / per); const int r = (int)(L % per); u.pm = r % nM; u.pn = r / nM; return true;
    }
};

template <class Epi, class Sched>
__device__ __forceinline__ void gemm_phase(LAS unsigned char* lds, const Gemm g, const Sched& S, const Epi& E) {
    const int tid = tid_opaque(), wid = __builtin_amdgcn_readfirstlane(tid >> 6), lane = tid & 63, wr = wid >> 2, wc = wid & 3, fr = lane & 15, fq = lane >> 4;
    const int K = g.K, nt = K / BK;
    unsigned voffA[2], voffB[2];
#pragma unroll
    for (int i = 0; i < 2; ++i) { int R, C; stage_rc(tid * 16 + i * 8192, R, C); const int Rb = Epi::PERM ? ((R & ~31) + perm32(R & 31)) : R;
#define PG8_NATOFF(R_, C_) ((unsigned)(((((R_) >> 6) & 1) * 4 + ((C_) >> 5)) * 8192 + ((((R_) >> 4) & 3) * 2) * 512 + (((R_) & 15) + 16 * (((C_) >> 3) & 3)) * 8) * 2u)
        voffA[i] = g.natA ? PG8_NATOFF(R, C) : (unsigned)(R * g.lda + C) * 2u; voffB[i] = g.natB ? PG8_NATOFF(Rb, C) : (unsigned)(Rb * g.ldb + C) * 2u; }
#undef PG8_NATOFF
    const int s0A = g.natA ? 32768 : BK * 2, s1A = g.natA ? 1024 : BK * 4, s2A = g.natA ? 131072 : BK * 8;
    const int s0B = g.natB ? 32768 : BK * 2, s1B = g.natB ? 1024 : BK * 4, s2B = g.natB ? 131072 : BK * 8;
    const size_t hstepA = g.natA ? (size_t)8192 : (size_t)HALF * g.lda * 2, hstepB = g.natB ? (size_t)8192 : (size_t)HALF * g.ldb * 2;
    const size_t tstepA = (size_t)BM * g.lda * 2, tstepB = (size_t)BM * g.ldb * 2;
    const unsigned ldsw = (unsigned)wid * 1024u;
    const int aoff = lds_byte(wr * 64 + fr, fq * 8), boff = lds_byte(wc * 32 + fr, fq * 8);
#define PG8_SA(b, h) (((b) * 2 + (h)) * HTB)
#define PG8_SB(b, h) ((4 + (b) * 2 + (h)) * HTB)
#define PG8_STAGE(bufoff, gbase, voff) do { _Pragma("unroll") for (int _i = 0; _i < 2; ++_i) \
        __builtin_amdgcn_global_load_lds((const unsigned*)((const char*)(gbase) + (voff)[_i]), (LAS unsigned*)(lds + (bufoff) + ldsw + _i * 8192), 16, 0, 0); } while (0)
#define PG8_LDA(dst, b, h) do { _Pragma("unroll") for (int m = 0; m < 4; ++m) _Pragma("unroll") for (int k = 0; k < 2; ++k) dst[m][k] = *(const LAS bf16x8*)(lds + PG8_SA(b, h) + aoff + m * 2048 + k * 1024); } while (0)
#define PG8_LDB(dst, b, h) do { _Pragma("unroll") for (int n = 0; n < 2; ++n) _Pragma("unroll") for (int k = 0; k < 2; ++k) dst[n][k] = *(const LAS bf16x8*)(lds + PG8_SB(b, h) + boff + n * 2048 + k * 1024); } while (0)
#define PG8_MMA(ai, bj, At, Bt) do { __builtin_amdgcn_s_setprio(1); _Pragma("unroll") for (int m = 0; m < 4; ++m) _Pragma("unroll") for (int n = 0; n < 2; ++n) _Pragma("unroll") for (int k = 0; k < 2; ++k) \
        acc[ai][bj][m][n] = __builtin_amdgcn_mfma_f32_16x16x32_bf16(Bt[n][k], At[m][k], acc[ai][bj][m][n], 0, 0, 0); __builtin_amdgcn_s_setprio(0); } while (0)
#define PG8_WAIT_V(n) asm volatile("s_waitcnt vmcnt(" #n ")" ::: "memory")
#define PG8_WAIT_L(n) asm volatile("s_waitcnt lgkmcnt(" #n ")" ::: "memory")
#define PG8_BAR __builtin_amdgcn_s_barrier()
#define PG8_SCHED __builtin_amdgcn_sched_barrier(0)
    Unit cur, nxt; int ui = 0;
    if (!S.next(0, cur)) return;
    f32x4 acc[2][2][4][2];
#pragma unroll
    for (int a = 0; a < 2; ++a)
#pragma unroll
        for (int b = 0; b < 2; ++b)
#pragma unroll
            for (int m = 0; m < 4; ++m)
#pragma unroll
                for (int n = 0; n < 2; ++n) acc[a][b][m][n] = (f32x4){0.f, 0.f, 0.f, 0.f};
    bf16x8 At[4][2], B0[2][2], B1[2][2];
    const char* cA = (const char*)g.A + (size_t)cur.pm * tstepA + (size_t)cur.z * g.aZ * 2; const char* cB = (const char*)g.Bt + (size_t)cur.pn * tstepB + (size_t)cur.z * g.bZ * 2;
    PG8_STAGE(PG8_SB(0, 0), cB, voffB); PG8_STAGE(PG8_SA(0, 0), cA, voffA); PG8_STAGE(PG8_SB(0, 1), cB + hstepB, voffB); PG8_STAGE(PG8_SA(0, 1), cA + hstepA, voffA);
    if (wr == 1) PG8_BAR;
    PG8_WAIT_V(4); PG8_BAR;
    PG8_STAGE(PG8_SB(1, 0), cB + s0B, voffB); PG8_STAGE(PG8_SA(1, 0), cA + s0A, voffA); PG8_STAGE(PG8_SB(1, 1), cB + hstepB + s0B, voffB);
    PG8_WAIT_V(6); PG8_BAR;
    for (;;) {
        const bool has_next = S.next(ui + 1, nxt);
        const char* nA = has_next ? (const char*)g.A + (size_t)nxt.pm * tstepA + (size_t)nxt.z * g.aZ * 2 : cA;
        const char* nB = has_next ? (const char*)g.Bt + (size_t)nxt.pn * tstepB + (size_t)nxt.z * g.bZ * 2 : cB;
        for (int t = 0; t < nt; t += 2) {
            const bool last = (t == nt - 2);
            const int th = t >> 1, tn = th + 1;
            const char* a1 = cA + (size_t)(th >> 1) * s2A + (th & 1) * s1A + s0A;
            const char* a2 = last ? nA : cA + (size_t)(tn >> 1) * s2A + (tn & 1) * s1A; const char* b2 = last ? nB : cB + (size_t)(tn >> 1) * s2B + (tn & 1) * s1B;
            const char* a3 = a2 + s0A; const char* b3 = b2 + s0B;
            PG8_LDB(B0, 0, 0); PG8_SCHED; PG8_LDA(At, 0, 0); PG8_STAGE(PG8_SA(1, 1), a1 + hstepA, voffA);
            PG8_WAIT_L(8); PG8_BAR; PG8_WAIT_L(0); PG8_MMA(0, 0, At, B0); PG8_BAR; PG8_SCHED;
            PG8_LDB(B1, 0, 1); PG8_STAGE(PG8_SB(0, 0), b2, voffB);
            PG8_BAR; PG8_WAIT_L(0); PG8_MMA(0, 1, At, B1); PG8_BAR;
            PG8_LDA(At, 0, 1); PG8_STAGE(PG8_SA(0, 0), a2, voffA);
            PG8_BAR; PG8_WAIT_L(0); PG8_MMA(1, 0, At, B0); PG8_BAR; PG8_SCHED;
            PG8_STAGE(PG8_SB(0, 1), b2 + hstepB, voffB);
            PG8_WAIT_V(6); PG8_BAR; PG8_MMA(1, 1, At, B1); PG8_BAR;
            PG8_LDB(B0, 1, 0); PG8_SCHED; PG8_LDA(At, 1, 0); PG8_STAGE(PG8_SA(0, 1), a2 + hstepA, voffA);
            PG8_WAIT_L(8); PG8_BAR; PG8_WAIT_L(0); PG8_MMA(0, 0, At, B0); PG8_BAR; PG8_SCHED;
            PG8_LDB(B1, 1, 1); PG8_STAGE(PG8_SB(1, 0), b3, voffB);
            PG8_BAR; PG8_WAIT_L(0); PG8_MMA(0, 1, At, B1); PG8_BAR;
            PG8_LDA(At, 1, 1); PG8_STAGE(PG8_SA(1, 0), a3, voffA);
            PG8_BAR; PG8_WAIT_L(0); PG8_MMA(1, 0, At, B0); PG8_BAR; PG8_SCHED;
            PG8_STAGE(PG8_SB(1, 1), b3 + hstepB, voffB);
            PG8_WAIT_V(6); PG8_BAR; PG8_MMA(1, 1, At, B1); PG8_BAR;
        }
        E(acc, cur, wr, wc, fr, fq);
        if (!has_next) break;
#pragma unroll
        for (int a = 0; a < 2; ++a)
#pragma unroll
            for (int b = 0; b < 2; ++b)
#pragma unroll
                for (int m = 0; m < 4; ++m)
#pragma unroll
                    for (int n = 0; n < 2; ++n) acc[a][b][m][n] = (f32x4){0.f, 0.f, 0.f, 0.f};
        cur = nxt; cA = nA; cB = nB; ++ui;
    }
    PG8_WAIT_V(0);
    if (wr == 0) PG8_BAR;
    PG8_BAR;
#undef PG8_SA
#undef PG8_SB
#undef PG8_STAGE
#undef PG8_LDA
#undef PG8_LDB
#undef PG8_MMA
#undef PG8_WAIT_V
#undef PG8_WAIT_L
#undef PG8_BAR
#undef PG8_SCHED
}

__device__ __forceinline__ u32x4 pack8(const f32x4 v0, const f32x4 v1) { u32x4 w; w[0] = pk2(v0[0], v0[1]); w[1] = pk2(v0[2], v0[3]); w[2] = pk2(v1[0], v1[1]); w[3] = pk2(v1[2], v1[3]); return w; }
#define QMAP(pm_) ((((pm_) >> 4) & 1) * 128 + ((pm_) >> 5) * 16 + ((pm_) & 15))
struct EpiAct {
    static constexpr bool PERM = true;
    bf16_t* O; size_t segstride; int actmask; int segtiles; int ldc; int nt; int native; int qmap = 0;
    template <int ACT, bool NT, bool NATIVE>
    __device__ __forceinline__ void body(const f32x4 (&acc)[2][2][4][2], bf16_t* base, int row0, int col0, size_t toff) const {
#pragma unroll
        for (int ai = 0; ai < 2; ++ai)
#pragma unroll
            for (int m = 0; m < 4; ++m) { bf16_t* rowp = NATIVE ? base + toff + ((ai * 4 + m) * 2) * 512 : base + (size_t)(row0 + ai * HALF + m * 16) * ldc + col0;
#pragma unroll
                for (int bj = 0; bj < 2; ++bj) { f32x4 v0 = acc[ai][bj][m][0], v1 = acc[ai][bj][m][1];
                    if (ACT == 1) { const f32x2 a = gelu2((f32x2){v0[0], v0[1]}), b = gelu2((f32x2){v0[2], v0[3]}), c = gelu2((f32x2){v1[0], v1[1]}), d = gelu2((f32x2){v1[2], v1[3]});
                        v0 = (f32x4){a[0], a[1], b[0], b[1]}; v1 = (f32x4){c[0], c[1], d[0], d[1]}; }
                    else if (ACT == 2) { const f32x2 a = sigmoid2((f32x2){v0[0], v0[1]}), b = sigmoid2((f32x2){v0[2], v0[3]}), c = sigmoid2((f32x2){v1[0], v1[1]}), d = sigmoid2((f32x2){v1[2], v1[3]});
                        v0 = (f32x4){a[0], a[1], b[0], b[1]}; v1 = (f32x4){c[0], c[1], d[0], d[1]}; }
                    bf16_t* dp = NATIVE ? rowp + bj * 512 : rowp + bj * HALF;
                    if (NT) __builtin_nontemporal_store(pack8(v0, v1), (u32x4*)dp); else *(u32x4*)dp = pack8(v0, v1); } }
    }
    __device__ __forceinline__ void operator()(const f32x4 (&acc)[2][2][4][2], const Unit& u, int wr, int wc, int fr, int fq) const {
        const int seg = u.pn / segtiles, colt = (u.pn - seg * segtiles) * BM;
        bf16_t* base = O + (size_t)seg * segstride; const int act = seg < 8 ? ((actmask >> (4 * seg)) & 15) : 0;
        const int row0 = u.pm * BM + wr * 64 + fr, col0 = colt + wc * 32 + 8 * fq;
        const int pmx = qmap ? QMAP(u.pm) : u.pm;
        const size_t toff = ((size_t)pmx * (ldc >> 8) + (u.pn - seg * segtiles)) * 65536 + (size_t)(wr * 4 + wc) * 8192 + (size_t)(fr + 16 * fq) * 8;
        if (act == 1) body<1, true, false>(acc, base, row0, col0, 0); else if (act == 2) body<2, true, true>(acc, base, row0, col0, toff); else if (native) body<0, true, true>(acc, base, row0, col0, toff); else if (nt) body<0, true, false>(acc, base, row0, col0, 0); else body<0, false, false>(acc, base, row0, col0, 0);
    }
};
struct EpiUV {
    static constexpr bool PERM = true;
    bf16_t* UV;
    __device__ __forceinline__ void operator()(const f32x4 (&acc)[2][2][4][2], const Unit& u, int wr, int wc, int fr, int fq) const {
        const int isv = u.pm >> 2, mp0 = (u.pm & 3) * BM + wr * 64 + fr, colb = u.pn * BM + wc * 32 + 8 * fq;
        bf16_t* base = UV + (size_t)u.z * SEQ * DM;
#pragma unroll
        for (int ai = 0; ai < 2; ++ai)
#pragma unroll
            for (int m = 0; m < 4; ++m) { const int mp = mp0 + ai * HALF + m * 16;
#pragma unroll
                for (int bj = 0; bj < 2; ++bj) { const u32x4 v = pack8(acc[ai][bj][m][0], acc[ai][bj][m][1]); const int col = colb + bj * HALF;
                    if (!isv) { *(u32x4*)(base + (size_t)mp * DM + col) = v; if (mp) *(u32x4*)(base + (size_t)(SEQ - mp) * DM + col) = v; }
                    else if (mp == 0) { *(u32x4*)(base + (size_t)1024 * DM + col) = v; const u32x4 z = (u32x4){0u, 0u, 0u, 0u};
                        *(u32x4*)(base + 512 + col) = z; *(u32x4*)(base + (size_t)1024 * DM + 512 + col) = z; }
                    else { *(u32x4*)(base + (size_t)mp * DM + 512 + col) = v; const u32x4 nv = (u32x4){v[0] ^ 0x80008000u, v[1] ^ 0x80008000u, v[2] ^ 0x80008000u, v[3] ^ 0x80008000u};
                        *(u32x4*)(base + (size_t)(SEQ - mp) * DM + 512 + col) = nv; } } }
    }
};
struct EpiGate {
    static constexpr bool PERM = true;
    const bf16_t* gate; const bf16_t* addsrc; bf16_t* dst;
    __device__ __forceinline__ void operator()(const f32x4 (&acc)[2][2][4][2], const Unit& u, int wr, int wc, int fr, int fq) const {
        const size_t toff = ((size_t)u.pm * 4 + u.pn) * 65536 + (size_t)(wr * 4 + wc) * 8192 + (size_t)(fr + 16 * fq) * 8;
#pragma unroll
        for (int ai = 0; ai < 2; ++ai)
#pragma unroll
            for (int m = 0; m < 4; ++m) {
#pragma unroll
                for (int bj = 0; bj < 2; ++bj) { const size_t noff = toff + ((ai * 4 + m) * 2 + bj) * 512;
                    const u32x4 gv = __builtin_nontemporal_load((const u32x4*)(gate + noff));
                    f32x4 v0 = acc[ai][bj][m][0], v1 = acc[ai][bj][m][1];
                    v0[0] *= bflo(gv[0]); v0[1] *= bfhi(gv[0]); v0[2] *= bflo(gv[1]); v0[3] *= bfhi(gv[1]);
                    v1[0] *= bflo(gv[2]); v1[1] *= bfhi(gv[2]); v1[2] *= bflo(gv[3]); v1[3] *= bfhi(gv[3]);
                    if (addsrc) { const u32x4 av = *(const u32x4*)(addsrc + noff);
                        v0[0] += bflo(av[0]); v0[1] += bfhi(av[0]); v0[2] += bflo(av[1]); v0[3] += bfhi(av[1]);
                        v1[0] += bflo(av[2]); v1[1] += bfhi(av[2]); v1[2] += bflo(av[3]); v1[3] += bfhi(av[3]); }
                    *(u32x4*)(dst + noff) = pack8(v0, v1); } }
    }
};
struct EpiX1 {
    static constexpr bool PERM = true;
    const float *x, *pos, *mod, *b_out; bf16_t* x1b;
    __device__ __forceinline__ void operator()(const f32x4 (&acc)[2][2][4][2], const Unit& u, int wr, int wc, int fr, int fq) const {
        const int row0 = u.pm * BM + wr * 64 + fr, col0 = u.pn * BM + wc * 32 + 8 * fq;
        const int b = (u.pm * BM) >> 11;
        f32x4 bv[2][2], gv[2][2];
#pragma unroll
        for (int bj = 0; bj < 2; ++bj)
#pragma unroll
            for (int n = 0; n < 2; ++n) { bv[bj][n] = *(const f32x4*)(b_out + col0 + bj * HALF + 4 * n); gv[bj][n] = *(const f32x4*)(mod + (size_t)b * 6144 + 2 * 1024 + col0 + bj * HALF + 4 * n); }
#pragma unroll
        for (int ai = 0; ai < 2; ++ai)
#pragma unroll
            for (int m = 0; m < 4; ++m) { const int row = row0 + ai * HALF + m * 16; const size_t off = (size_t)row * DM + col0; const size_t poff = (size_t)(row & 2047) * DM + col0;
#pragma unroll
                for (int bj = 0; bj < 2; ++bj) { f32x4 r[2];
#pragma unroll
                    for (int n = 0; n < 2; ++n) { const f32x4 xv = __builtin_nontemporal_load((const f32x4*)(x + off + bj * HALF + 4 * n)), pv = *(const f32x4*)(pos + poff + bj * HALF + 4 * n);
                        r[n] = xv + pv + gv[bj][n] * (acc[ai][bj][m][n] + bv[bj][n]); }
                    *(u32x4*)(x1b + off + bj * HALF) = pack8(r[0], r[1]); } }
    }
};
}

constexpr int XC_STRIDE = 272;
constexpr int HT_STRIDE = 132;
constexpr int XC_BYTES = 64 * XC_STRIDE, HT_BYTES = 64 * HT_STRIDE * 4, SCAN_CW_OFF = 2 * XC_BYTES + 2 * HT_BYTES;
template <int DIR>
__device__ __forceinline__ void scan_dir(PREF p, LAS unsigned char* lds, int b, int head) {
    const int tid = tid_opaque(), w = tid >> 6, l = tid & 63, c16 = l & 15, q4 = l >> 4;
    LAS float* CW = (LAS float*)(lds + SCAN_CW_OFF);
    const int ch = head * 128 + 16 * w + c16;
    bf16x8 bfa[4], bfx[4];
    {
        const bf16_t* Ga = p.gates_bf + ((size_t)((DIR * 2 + 0) * 8 + head) * 128 + 16 * w + c16) * 128 + 8 * q4;
        const bf16_t* Gx = p.gates_bf + ((size_t)((DIR * 2 + 1) * 8 + head) * 128 + 16 * w + c16) * 128 + 8 * q4;
#pragma unroll
        for (int ks = 0; ks < 4; ++ks) { bfa[ks] = *(const bf16x8*)(Ga + 32 * ks); bfx[ks] = *(const bf16x8*)(Gx + 32 * ks); }
    }
    const float nba = -1.4426950409f * p.lru_ba[DIR * 1024 + ch], nbx = -1.4426950409f * p.lru_bx[DIR * 1024 + ch];
    const float m8sp = -8.0f * log1pf(expf(-p.lru_lambda[DIR * 1024 + ch])) * 1.4426950409f;
    const int pos4 = DIR == 0 ? q4 : 3 - q4;
    const int src1 = (DIR == 0 ? l - 16 : l + 16) & 63, src2 = (DIR == 0 ? l - 32 : l + 32) & 63, srcl = DIR == 0 ? c16 + 48 : c16;
    float carry = 0.f;
    const int tt = tid >> 3, cg = tid & 7;
#define SCAN_CREF(k, SEQI, T0, TSEQ, SRC) const int SEQI = (k) >= 4 ? 1 : 0; const int TSEQ = SEQI ? SEQ : CTXL; \
        const int T0 = (DIR == 0 ? (SEQI ? (k) - 4 : (k)) : (SEQI ? 35 - (k) : 3 - (k))) * 64; const bf16_t* SRC = SEQI ? p.zx + (size_t)b * SEQ * DM : p.zxc + (size_t)b * CTXL * DM;
#define SCAN_LOADZ(k) do { SCAN_CREF(k, sq_, t0_, ts_, sr_) \
        if (t0_ >= 1 && t0_ + 66 <= ts_) { const bf16_t* zp_ = sr_ + (size_t)(t0_ + tt - 1) * DM + head * 128 + 16 * cg;     \
            _Pragma("unroll") for (int r_ = 0; r_ < 4; ++r_) { Z[2 * r_] = *(const u32x4*)(zp_ + (size_t)r_ * DM); Z[2 * r_ + 1] = *(const u32x4*)(zp_ + (size_t)r_ * DM + 8); } } \
        else { _Pragma("unroll") for (int r_ = 0; r_ < 4; ++r_) { const int tr_ = t0_ + tt - 1 + r_; const bool ok_ = tr_ >= 0 && tr_ < ts_; \
            const bf16_t* zp_ = sr_ + (size_t)(ok_ ? tr_ : 0) * DM + head * 128 + 16 * cg; const u32x4 za_ = *(const u32x4*)zp_, zb_ = *(const u32x4*)(zp_ + 8); const u32x4 zz_ = (u32x4){0u, 0u, 0u, 0u}; \
            Z[2 * r_] = ok_ ? za_ : zz_; Z[2 * r_ + 1] = ok_ ? zb_ : zz_; } } } while (0)
#define SCAN_BUILD(XCB) do { f32x2 xc2[8]; \
        { const LAS f32x4* cb_ = (const LAS f32x4*)(CW + 4 * 128 + 16 * cg); _Pragma("unroll") for (int j4 = 0; j4 < 4; ++j4) { const f32x4 v_ = cb_[j4]; xc2[2 * j4] = (f32x2){v_[0], v_[1]}; xc2[2 * j4 + 1] = (f32x2){v_[2], v_[3]}; } } \
        _Pragma("unroll") for (int r = 0; r < 4; ++r) { const u32x4 z0 = Z[2 * r], z1 = Z[2 * r + 1]; const LAS f32x4* cw_ = (const LAS f32x4*)(CW + r * 128 + 16 * cg); \
            _Pragma("unroll") for (int j4 = 0; j4 < 4; ++j4) { const f32x4 w_ = cw_[j4]; const unsigned da_ = j4 < 2 ? z0[2 * j4] : z1[2 * (j4 - 2)], db_ = j4 < 2 ? z0[2 * j4 + 1] : z1[2 * (j4 - 2) + 1]; \
                xc2[2 * j4] = (f32x2){w_[0], w_[1]} * (f32x2){bflo(da_), bfhi(da_)} + xc2[2 * j4]; xc2[2 * j4 + 1] = (f32x2){w_[2], w_[3]} * (f32x2){bflo(db_), bfhi(db_)} + xc2[2 * j4 + 1]; } } \
        u32x4 o0_, o1_; o0_[0] = pk2(xc2[0][0], xc2[0][1]); o0_[1] = pk2(xc2[1][0], xc2[1][1]); o0_[2] = pk2(xc2[2][0], xc2[2][1]); o0_[3] = pk2(xc2[3][0], xc2[3][1]); \
        o1_[0] = pk2(xc2[4][0], xc2[4][1]); o1_[1] = pk2(xc2[5][0], xc2[5][1]); o1_[2] = pk2(xc2[6][0], xc2[6][1]); o1_[3] = pk2(xc2[7][0], xc2[7][1]); \
        *(LAS u32x4*)((XCB) + tt * XC_STRIDE + cg * 32) = o0_; *(LAS u32x4*)((XCB) + tt * XC_STRIDE + cg * 32 + 16) = o1_; } while (0)
    u32x4 Z[8];
    SCAN_LOADZ(0);
    SCAN_BUILD(lds);
    SCAN_LOADZ(1);
    __syncthreads();
    size_t off_prev = 0; int seqi_prev = 0;
    u32x4 f0 = (u32x4){0u, 0u, 0u, 0u}, f1 = f0, g0 = f0, g1 = f0;
    for (int k = 0; k <= 36; ++k) {
        if (k > 0 && seqi_prev == 1) {
            const LAS float* HTp = (const LAS float*)(lds + 2 * XC_BYTES + ((k - 1) & 1) * HT_BYTES);
            const LAS f32x4* hp = (const LAS f32x4*)(HTp + tt * HT_STRIDE + 16 * cg);
            const f32x4 h0 = hp[0], h1 = hp[1], h2 = hp[2], h3 = hp[3];
            const size_t off = off_prev;
            if (DIR == 0) {
                *(u32x4*)(p.hf + off) = pg8::pack8(h0, h1); *(u32x4*)(p.hf + off + 8) = pg8::pack8(h2, h3);
            } else {
                f32x4 y0, y1, y2, y3;
                y0[0] = (h0[0] + bflo(f0[0])) * bflo(g0[0]); y0[1] = (h0[1] + bfhi(f0[0])) * bfhi(g0[0]); y0[2] = (h0[2] + bflo(f0[1])) * bflo(g0[1]); y0[3] = (h0[3] + bfhi(f0[1])) * bfhi(g0[1]);
                y1[0] = (h1[0] + bflo(f0[2])) * bflo(g0[2]); y1[1] = (h1[1] + bfhi(f0[2])) * bfhi(g0[2]); y1[2] = (h1[2] + bflo(f0[3])) * bflo(g0[3]); y1[3] = (h1[3] + bfhi(f0[3])) * bfhi(g0[3]);
                y2[0] = (h2[0] + bflo(f1[0])) * bflo(g1[0]); y2[1] = (h2[1] + bfhi(f1[0])) * bfhi(g1[0]); y2[2] = (h2[2] + bflo(f1[1])) * bflo(g1[1]); y2[3] = (h2[3] + bfhi(f1[1])) * bfhi(g1[1]);
                y3[0] = (h3[0] + bflo(f1[2])) * bflo(g1[2]); y3[1] = (h3[1] + bfhi(f1[2])) * bfhi(g1[2]); y3[2] = (h3[2] + bflo(f1[3])) * bflo(g1[3]); y3[3] = (h3[3] + bfhi(f1[3])) * bfhi(g1[3]);
                *(u32x4*)(p.ybin + off) = pg8::pack8(y0, y1); *(u32x4*)(p.ybin + off + 8) = pg8::pack8(y2, y3);
            }
        }
        if (k == 36) break;
        if (k + 1 < 36) { SCAN_BUILD(lds + ((k + 1) & 1) * XC_BYTES); if (k + 2 < 36) SCAN_LOADZ(k + 2); }
        SCAN_CREF(k, seqi, t0, Tseq, src) (void)Tseq; (void)src;
        {
            const size_t off = ((size_t)b * SEQ + t0 + tt) * DM + head * 128 + 16 * cg;
            if (DIR == 1 && seqi == 1) { f0 = *(const u32x4*)(p.hf + off); f1 = *(const u32x4*)(p.hf + off + 8); g0 = __builtin_nontemporal_load((const u32x4*)(p.gzy + off)); g1 = __builtin_nontemporal_load((const u32x4*)(p.gzy + off + 8)); }
            off_prev = off; seqi_prev = seqi;
        }
        {
            const LAS unsigned char* XC = lds + (k & 1) * XC_BYTES;
            LAS float* HT = (LAS float*)(lds + 2 * XC_BYTES + (k & 1) * HT_BYTES);
            f32x4 accr[4], acci[4];
#pragma unroll
            for (int mt = 0; mt < 4; ++mt) { accr[mt] = (f32x4){0.f, 0.f, 0.f, 0.f}; acci[mt] = (f32x4){0.f, 0.f, 0.f, 0.f}; }
#pragma unroll
            for (int mt = 0; mt < 4; ++mt)
#pragma unroll
                for (int ks = 0; ks < 4; ++ks) { const bf16x8 a = *(const LAS bf16x8*)(XC + (16 * mt + c16) * XC_STRIDE + (32 * ks + 8 * q4) * 2);
                    accr[mt] = __builtin_amdgcn_mfma_f32_16x16x32_bf16(a, bfa[ks], accr[mt], 0, 0, 0);
                    acci[mt] = __builtin_amdgcn_mfma_f32_16x16x32_bf16(a, bfx[ks], acci[mt], 0, 0, 0); }
#pragma unroll
            for (int mi = 0; mi < 4; ++mi) {
                const int mt = DIR == 0 ? mi : 3 - mi;
                float av[4], bv[4];
#pragma unroll
                for (int reg = 0; reg < 4; ++reg) {
                    const float xcv = bf2f(*(const LAS bf16_t*)(XC + (16 * mt + 4 * q4 + reg) * XC_STRIDE + (16 * w + c16) * 2));
                    const float r = __builtin_amdgcn_rcpf(1.0f + __builtin_amdgcn_exp2f(__builtin_fmaf(accr[mt][reg], -1.4426950409f, nba))), ig = __builtin_amdgcn_rcpf(1.0f + __builtin_amdgcn_exp2f(__builtin_fmaf(acci[mt][reg], -1.4426950409f, nbx)));
                    const float a = __builtin_amdgcn_exp2f(m8sp * r);
                    av[reg] = a; bv[reg] = __builtin_amdgcn_sqrtf(1.0f - a * a) * ig * xcv;
                }
                float A, B;
                if (DIR == 0) { A = av[0]; B = bv[0];
#pragma unroll
                    for (int reg = 1; reg < 4; ++reg) { B = av[reg] * B + bv[reg]; A *= av[reg]; } }
                else { A = av[3]; B = bv[3];
#pragma unroll
                    for (int reg = 2; reg >= 0; --reg) { B = av[reg] * B + bv[reg]; A *= av[reg]; } }
                { const float A1 = __shfl(A, src1), B1 = __shfl(B, src1); if (pos4 >= 1) { B = A * B1 + B; A = A * A1; } }
                { const float A2 = __shfl(A, src2), B2 = __shfl(B, src2); if (pos4 >= 2) { B = A * B2 + B; A = A * A2; } }
                float Aex = __shfl(A, src1), Bex = __shfl(B, src1); if (pos4 == 0) { Aex = 1.f; Bex = 0.f; }
                const float A3 = __shfl(A, srcl), B3 = __shfl(B, srcl);
                float hs = Aex * carry + Bex;
                float st[4];
                if (DIR == 0) {
#pragma unroll
                    for (int reg = 0; reg < 4; ++reg) { hs = av[reg] * hs + bv[reg]; st[reg] = hs; } }
                else {
#pragma unroll
                    for (int reg = 3; reg >= 0; --reg) { hs = av[reg] * hs + bv[reg]; st[reg] = hs; } }
                carry = A3 * carry + B3;
                if (seqi == 1) {
#pragma unroll
                    for (int reg = 0; reg < 4; ++reg) HT[(16 * mt + 4 * q4 + reg) * HT_STRIDE + 16 * w + c16] = st[reg]; }
            }
        }
        __syncthreads();
    }
#undef SCAN_CREF
#undef SCAN_LOADZ
#undef SCAN_BUILD
}
__device__ __forceinline__ void dev_scan(PREF p, LAS unsigned char* lds) {
    LAS float* CW = (LAS float*)(lds + SCAN_CW_OFF);
    for (int item = blockIdx.x; item < p.nb * 8; item += gridDim.x) {
        const int b = item >> 3, head = item & 7;
        __syncthreads();
        for (int i = tid_opaque(); i < 640; i += NTHR) CW[i] = (i < 512) ? p.conv_w[(i >> 7) * 1024 + head * 128 + (i & 127)] : p.conv_b[head * 128 + (i - 512)];
        __syncthreads();
        scan_dir<0>(p, lds, b, head);
        __syncthreads();
        scan_dir<1>(p, lds, b, head);
    }
}

#define CASD(a, b) { const int _x = max(a, b), _y = min(a, b); a = _x; b = _y; }
template <int K, int J, int BASE, int N> __device__ __forceinline__ void bitonic_step(int (&v)[N]) {
#pragma unroll
    for (int i = 0; i < 16; ++i) { const int l = i ^ J; if (l > i) { if ((i & K) == 0) { CASD(v[BASE + i], v[BASE + l]); } else { CASD(v[BASE + l], v[BASE + i]); } } }
}
template <int BASE, int N> __device__ __forceinline__ void sort16_desc(int (&v)[N]) {
    bitonic_step<2, 1, BASE>(v);
    bitonic_step<4, 2, BASE>(v); bitonic_step<4, 1, BASE>(v);
    bitonic_step<8, 4, BASE>(v); bitonic_step<8, 2, BASE>(v); bitonic_step<8, 1, BASE>(v);
    bitonic_step<16, 8, BASE>(v); bitonic_step<16, 4, BASE>(v); bitonic_step<16, 2, BASE>(v); bitonic_step<16, 1, BASE>(v);
}
template <int AB, int BB, int NA, int NB> __device__ __forceinline__ void merge16(int (&a)[NA], const int (&b)[NB]) {
#pragma unroll
    for (int i = 0; i < 16; ++i) a[AB + i] = max(a[AB + i], b[BB + 15 - i]);
    bitonic_step<32, 8, AB>(a); bitonic_step<32, 4, AB>(a); bitonic_step<32, 2, AB>(a); bitonic_step<32, 1, AB>(a);
}
__device__ __forceinline__ void top16_of_64(int (&v)[64]) {
    sort16_desc<0>(v); sort16_desc<16>(v); sort16_desc<32>(v); sort16_desc<48>(v);
    merge16<0, 16>(v, v); merge16<32, 48>(v, v); merge16<0, 32>(v, v);
}
__device__ __forceinline__ int f2key(float f) { const int b = __float_as_int(f); return b ^ ((b >> 31) & 0x7fffffff); }
__device__ __forceinline__ float key2f(int k) { return __int_as_float(k ^ ((k >> 31) & 0x7fffffff)); }
__device__ __forceinline__ int lut16(unsigned t0, unsigned t1, unsigned t2, unsigned t3, int i) {
    const int wsel = i >> 2; const unsigned lo = (wsel & 1) ? t1 : t0, hi = (wsel & 1) ? t3 : t2; const unsigned wv = (wsel & 2) ? hi : lo;
    return (int)((wv >> (8 * (i & 3))) & 0xffu);
}
#define CROW(I, CNT, OFF) { _Pragma("unroll") for (int j = 0; j < CNT; ++j) cv[OFF + j] = (f2key(s0[I] + s1[j]) & ~255) | (I << 4) | j; }
constexpr int TK_ROW = 272;
__device__ __forceinline__ void dev_topk(PREF p, LAS unsigned char* lds) {
    const int tid = tid_opaque(), w = tid >> 6, l = tid & 63, tl = l & 31, hh = l >> 5;
    const int T = p.nb * SEQ;
    const int hd = blockIdx.x & 7, sub = blockIdx.x >> 3, nsub = gridDim.x >> 3;
    __syncthreads();
    {
        const bf16_t* kg = p.keys_bf + (size_t)hd * 2 * 128 * 128;
        for (int c = tid; c < 2 * 128 * 16; c += NTHR) { const int row = c >> 4, ch = c & 15; *(LAS u32x4*)(lds + row * TK_ROW + ch * 16) = *(const u32x4*)(kg + (size_t)row * 128 + ch * 8); }
    }
    __syncthreads();
    for (int tg = sub * 8 + w; tg < T / 32; tg += nsub * 8) {
        const int tok = tg * 32 + tl;
        int k0[16], k1[16];
        u32x4 qr[8];
        LAS unsigned char* qrel = lds + 2 * 128 * TK_ROW + w * (32 * TK_ROW);
#define TK_QLOAD(ph_) do { _Pragma("unroll") for (int i_ = 0; i_ < 8; ++i_) { const int tk_ = tg * 32 + 8 * (i_ >> 1) + (l & 7), tr_ = tk_ & 255, ch_ = 8 * (i_ & 1) + (l >> 3);     \
            qr[i_] = __builtin_nontemporal_load((const u32x4*)(p.q + ((size_t)QMAP(tk_ >> 8) * 8 + hd) * 65536 + (size_t)((((tr_ >> 6) & 1) * 4 + (ch_ >> 2)) * 8192 + (((tr_ >> 7) * 4 + ((tr_ >> 4) & 3)) * 2 + (ph_)) * 512 + ((tr_ & 15) + 16 * (ch_ & 3)) * 8))); } } while (0)
#define TK_QSTORE() do { _Pragma("unroll") for (int i_ = 0; i_ < 8; ++i_) *(LAS u32x4*)(qrel + (8 * (i_ >> 1) + (l & 7)) * TK_ROW + 16 * (8 * (i_ & 1) + (l >> 3))) = qr[i_]; } while (0)
        TK_QLOAD(0);
#pragma unroll
        for (int ph = 0; ph < 2; ++ph) {
            f32x16 acc[4];
#pragma unroll
            for (int kb = 0; kb < 4; ++kb)
#pragma unroll
                for (int r = 0; r < 16; ++r) acc[kb][r] = 0.f;
            const LAS unsigned char* kpl = lds + (ph * 128 + tl) * TK_ROW + 16 * hh;
            TK_QSTORE();
            if (ph == 0) TK_QLOAD(1);
#pragma unroll
            for (int ks = 0; ks < 8; ++ks) {
                if (ks == 2 || ks == 4 || ks == 6) asm volatile("" : "+v"(acc[0]), "+v"(acc[1]), "+v"(acc[2]), "+v"(acc[3]));
                const bf16x8 bq = *(const LAS bf16x8*)(qrel + tl * TK_ROW + 32 * ks + 16 * hh);
#pragma unroll
                for (int kb = 0; kb < 4; ++kb) { const bf16x8 ak = *(const LAS bf16x8*)(kpl + kb * 32 * TK_ROW + 32 * ks);
                    acc[kb] = __builtin_amdgcn_mfma_f32_32x32x16_bf16(ak, bq, acc[kb], 0, 0, 0); }
            }
            int v[64];
#pragma unroll
            for (int kb = 0; kb < 4; ++kb)
#pragma unroll
                for (int r = 0; r < 16; ++r) { const int idx = 32 * kb + (r & 3) + 8 * (r >> 2); v[kb * 16 + r] = (f2key(acc[kb][r]) & ~127) | idx | (hh << 2); }
            top16_of_64(v);
            int o[16];
#pragma unroll
            for (int i = 0; i < 16; ++i) o[i] = shx_i(v[i], 32);
            merge16<0, 0>(v, o);
#pragma unroll
            for (int i = 0; i < 16; ++i) { if (ph == 0) k0[i] = v[i]; else k1[i] = v[i]; }
        }
        float s0[16], s1[16];
#pragma unroll
        for (int i = 0; i < 16; ++i) { s0[i] = key2f(k0[i] & ~127); s1[i] = key2f(k1[i] & ~127); }
        int cv[64];
        CROW(0, 16, 0) CROW(1, 8, 16) CROW(2, 5, 24) CROW(3, 4, 29) CROW(4, 3, 33) CROW(5, 2, 36) CROW(6, 2, 38) CROW(7, 2, 40)
        CROW(8, 1, 42) CROW(9, 1, 43) CROW(10, 1, 44) CROW(11, 1, 45) CROW(12, 1, 46) CROW(13, 1, 47) CROW(14, 1, 48) CROW(15, 1, 49)
#pragma unroll
        for (int i = 50; i < 64; ++i) cv[i] = (int)0x80000000;
        top16_of_64(cv);
#define PK4(K, W) ((unsigned)(K[4 * W] & 127) | ((unsigned)(K[4 * W + 1] & 127) << 8) | ((unsigned)(K[4 * W + 2] & 127) << 16) | ((unsigned)(K[4 * W + 3] & 127) << 24))
        unsigned ta0 = PK4(k0, 0), ta1 = PK4(k0, 1), ta2 = PK4(k0, 2), ta3 = PK4(k0, 3);
        unsigned tc0 = PK4(k1, 0), tc1 = PK4(k1, 1), tc2 = PK4(k1, 2), tc3 = PK4(k1, 3);
        asm volatile("" : "+v"(ta0), "+v"(ta1), "+v"(ta2), "+v"(ta3), "+v"(tc0), "+v"(tc1), "+v"(tc2), "+v"(tc3));
        const float mx = key2f(cv[0] & ~255);
        float e[16], sum = 0.f;
#pragma unroll
        for (int k = 0; k < 16; ++k) { e[k] = __builtin_amdgcn_exp2f((key2f(cv[k] & ~255) - mx) * 1.4426950409f); sum += e[k]; }
        const float inv = 1.0f / sum;
        int eo[8]; float go[8];
#pragma unroll
        for (int k = 0; k < 8; ++k) { int c_lo = cv[k], c_hi = cv[8 + k]; float e_lo = e[k], e_hi = e[8 + k];
            asm volatile("" : "+v"(c_lo), "+v"(c_hi), "+v"(e_lo), "+v"(e_hi));
            const int cvk = hh ? c_hi : c_lo; const float ek = hh ? e_hi : e_lo;
            const int i = (cvk >> 4) & 15, j = cvk & 15;
            eo[k] = lut16(ta0, ta1, ta2, ta3, i) * 128 + lut16(tc0, tc1, tc2, tc3, j); go[k] = ek * inv; }
        float so[8];
#pragma unroll
        for (int k = 0; k < 8; ++k) { const f32x2 s2 = *(const f32x2*)(p.scu + 2 * eo[k]); go[k] *= s2[1]; so[k] = s2[0]; }
        const size_t off = (size_t)tok * 128 + hd * 16 + hh * 8;
        *(u32x4*)(p.eidx + off) = (u32x4){(unsigned)eo[0], (unsigned)eo[1], (unsigned)eo[2], (unsigned)eo[3]};
        *(u32x4*)(p.eidx + off + 4) = (u32x4){(unsigned)eo[4], (unsigned)eo[5], (unsigned)eo[6], (unsigned)eo[7]};
        *(f32x4*)(p.gw + off) = (f32x4){go[0], go[1], go[2], go[3]};
        *(f32x4*)(p.gw + off + 4) = (f32x4){go[4], go[5], go[6], go[7]};
        *(f32x4*)(p.su + off) = (f32x4){so[0], so[1], so[2], so[3]};
        *(f32x4*)(p.su + off + 4) = (f32x4){so[4], so[5], so[6], so[7]};
    }
}

__device__ __forceinline__ float dot8(const u32x4 a, const u32x4 b, float acc) {
    const unsigned a0 = a[0], a1 = a[1], a2 = a[2], a3 = a[3], b0 = b[0], b1 = b[1], b2 = b[2], b3 = b[3];
    asm("v_dot2c_f32_bf16 %0, %1, %2" : "+v"(acc) : "v"(a0), "v"(b0));
    asm("v_dot2c_f32_bf16 %0, %1, %2" : "+v"(acc) : "v"(a1), "v"(b1));
    asm("v_dot2c_f32_bf16 %0, %1, %2" : "+v"(acc) : "v"(a2), "v"(b2));
    asm("v_dot2c_f32_bf16 %0, %1, %2" : "+v"(acc) : "v"(a3), "v"(b3));
    return acc;
}
__device__ __forceinline__ void dev_peer(PREF p) {
    const int tid = tid_opaque(), w = tid >> 6, l = tid & 63;
    const int T = p.nb * SEQ;
    const int b5 = (l >> 5) & 1, b4 = (l >> 4) & 1, b3 = (l >> 3) & 1;
    for (int tok = blockIdx.x * 8 + w; tok < T; tok += gridDim.x * 8) {
        const int b = tok >> 11;
        const u32x4 ha = *(const u32x4*)(p.h2 + (size_t)tok * DM + 8 * l), hb = *(const u32x4*)(p.h2 + (size_t)tok * DM + 512 + 8 * l);
        const int e_lo = p.eidx[(size_t)tok * 128 + l], e_hi = p.eidx[(size_t)tok * 128 + 64 + l];
        const float g_lo = p.gw[(size_t)tok * 128 + l], g_hi = p.gw[(size_t)tok * 128 + 64 + l];
        float acc[16];
#pragma unroll
        for (int i = 0; i < 16; ++i) acc[i] = 0.f;
        for (int grp = 0; grp < 16; ++grp) {
            const int esrc = grp < 8 ? e_lo : e_hi; const float gsrc = grp < 8 ? g_lo : g_hi; const int lbase = (grp & 7) * 8;
            int e[8];
#pragma unroll
            for (int k = 0; k < 8; ++k) e[k] = __builtin_amdgcn_readlane(esrc, lbase + k);
            u32x4 s0[8], s1[8];
            float part[8];
            {
                u32x4 r0[8], r1[8];
#pragma unroll
                for (int k = 0; k < 8; ++k) { const bf16_t* up = p.u_bf + (size_t)e[k] * DM + 8 * l; r0[k] = *(const u32x4*)up; r1[k] = *(const u32x4*)(up + 512); }
#pragma unroll
                for (int k = 0; k < 8; ++k) part[k] = dot8(r1[k], hb, dot8(r0[k], ha, 0.f));
            }
            asm volatile("" : "+v"(part[0]), "+v"(part[1]), "+v"(part[2]), "+v"(part[3]), "+v"(part[4]), "+v"(part[5]), "+v"(part[6]), "+v"(part[7]));
#pragma unroll
            for (int k = 0; k < 8; ++k) { const bf16_t* vp = p.v_bf + (size_t)e[k] * DM + 8 * l; s0[k] = *(const u32x4*)vp; s1[k] = *(const u32x4*)(vp + 512); }
            float q4v[4];
#pragma unroll
            for (int k = 0; k < 4; ++k) { const float send = b5 ? part[k] : part[k + 4]; const float recv = __shfl_xor(send, 32); q4v[k] = (b5 ? part[k + 4] : part[k]) + recv; }
            float r2[2];
#pragma unroll
            for (int k = 0; k < 2; ++k) { const float send = b4 ? q4v[k] : q4v[k + 2]; const float recv = __shfl_xor(send, 16); r2[k] = (b4 ? q4v[k + 2] : q4v[k]) + recv; }
            float sdot;
            { const float send = b3 ? r2[0] : r2[1]; const float recv = __shfl_xor(send, 8); sdot = (b3 ? r2[1] : r2[0]) + recv; }
            sdot += __shfl_xor(sdot, 4); sdot += __shfl_xor(sdot, 2); sdot += __shfl_xor(sdot, 1);
            const int kk = 4 * b5 + 2 * b4 + b3;
            const float gv = __shfl(gsrc, lbase + kk);
            const float wv = gv * gelu_f(sdot);
#pragma unroll
            for (int k = 0; k < 8; ++k) {
                const float wk = __int_as_float(__builtin_amdgcn_readlane(__float_as_int(wv), ((k >> 2) & 1) * 32 + ((k >> 1) & 1) * 16 + (k & 1) * 8));
#pragma unroll
                for (int i = 0; i < 4; ++i) { acc[2 * i] += wk * bflo(s0[k][i]); acc[2 * i + 1] += wk * bfhi(s0[k][i]); acc[8 + 2 * i] += wk * bflo(s1[k][i]); acc[8 + 2 * i + 1] += wk * bfhi(s1[k][i]); }
            }
        }
        const float* x1p = p.x1 + (size_t)tok * DM; const float* g2p = p.mod + (size_t)b * 6144 + 5 * 1024;
        f32x4 xv[4]; float ss = 0.f;
#pragma unroll
        for (int hlf = 0; hlf < 2; ++hlf)
#pragma unroll
            for (int q = 0; q < 2; ++q) { const int d = hlf * 512 + 8 * l + 4 * q; const f32x4 xx = *(const f32x4*)(x1p + d), gg = *(const f32x4*)(g2p + d);
                f32x4 r;
#pragma unroll
                for (int j = 0; j < 4; ++j) { r[j] = xx[j] + gg[j] * acc[hlf * 8 + 4 * q + j]; ss += r[j] * r[j]; }
                xv[hlf * 2 + q] = r; }
        ss = wave_sum(ss);
        const float rs = rsqrtf(ss * (1.0f / 1024.0f) + 1e-6f);
#pragma unroll
        for (int hlf = 0; hlf < 2; ++hlf)
#pragma unroll
            for (int q = 0; q < 2; ++q) { const int d = hlf * 512 + 8 * l + 4 * q; const f32x4 fg = *(const f32x4*)(p.final_g + d);
                f32x4 o;
#pragma unroll
                for (int j = 0; j < 4; ++j) o[j] = xv[hlf * 2 + q][j] * rs * fg[j];
                *(f32x4*)(p.out + (size_t)tok * DM + d) = o; }
    }
}


__device__ __forceinline__ float table_scale(unsigned maxbits) { const float m = fmaxf(__uint_as_float(maxbits), 1e-30f); return exp2f(floorf(log2f(448.0f / m))); }
__device__ __forceinline__ void dev_tabmax(PREF p) {
    const int tid = tid_opaque();
    float mu = 0.f, mv = 0.f;
    for (size_t i = ((size_t)blockIdx.x * NTHR + tid) * 4; i < (size_t)16384 * 1024; i += (size_t)gridDim.x * NTHR * 4) {
        const f32x4 a = *(const f32x4*)(p.peer_u + i), b = *(const f32x4*)(p.peer_v + i);
        mu = fmaxf(mu, fmaxf(fmaxf(fabsf(a[0]), fabsf(a[1])), fmaxf(fabsf(a[2]), fabsf(a[3]))));
        mv = fmaxf(mv, fmaxf(fmaxf(fabsf(b[0]), fabsf(b[1])), fmaxf(fabsf(b[2]), fabsf(b[3])))); }
#pragma unroll
    for (int o = 1; o < 64; o <<= 1) { mu = fmaxf(mu, __shfl_xor(mu, o)); mv = fmaxf(mv, __shfl_xor(mv, o)); }
    if ((tid & 63) == 0) { atomicMax(p.tmax + 0, __float_as_uint(mu)); atomicMax(p.tmax + 1, __float_as_uint(mv)); }
}
__device__ __forceinline__ unsigned fp4_code(float x) {
    const float ax = fabsf(x);
    unsigned c = ax < 0.25f ? 0u : ax < 0.75f ? 1u : ax < 1.25f ? 2u : ax < 1.75f ? 3u : ax < 2.5f ? 4u : ax < 3.5f ? 5u : ax < 5.0f ? 6u : 7u;
    return c | (x < 0.f ? 8u : 0u);
}
__device__ __forceinline__ void tab8_row(PREF p, const f32x4 (&a)[4], int r, int lane) {
    const int tab = r >> 14, e = r & 16383;
    float m = 0.f, ss = 0.f;
#pragma unroll
    for (int i = 0; i < 4; ++i) { m = fmaxf(m, fmaxf(fmaxf(fabsf(a[i][0]), fabsf(a[i][1])), fmaxf(fabsf(a[i][2]), fabsf(a[i][3]))));
        ss += (a[i][0] * a[i][0] + a[i][1] * a[i][1]) + (a[i][2] * a[i][2] + a[i][3] * a[i][3]); }
#pragma unroll
    for (int o = 1; o < 64; o <<= 1) { m = fmaxf(m, shx_f(m, o)); ss += shx_f(ss, o); }
    const float rms = sqrtf(ss * (1.0f / 1024.0f));
    const float sc = m > 0.f ? fminf(2.0f / rms, 9.0f / m) : 1.0f;
    unsigned char* dst = (tab ? p.v4 : p.u4) + (size_t)e * 128 + 2 * lane;
#pragma unroll
    for (int i = 0; i < 4; ++i) { unsigned b = 0u;
        b = __builtin_amdgcn_cvt_scalef32_pk_fp4_f32(b, a[i][0] * sc, a[i][1] * sc, 1.0f, 0); b = __builtin_amdgcn_cvt_scalef32_pk_fp4_f32(b, a[i][2] * sc, a[i][3] * sc, 1.0f, 1);
        *(unsigned short*)(dst + (size_t)i * 16384 * 128) = (unsigned short)b; }
    if (lane == 0) p.scu[2 * e + tab] = 1.0f / sc;
}
__device__ __forceinline__ void dev_tab8(PREF p) {
    const int tid = tid_opaque();
    const int w = tid >> 6, lane = tid & 63;
    const int G = (int)gridDim.x, nctx = (p.nb * CTXL / 256) * 4, NR = 2 * 16384;
    const int Wt = nctx + 7 * (G - nctx), unit = (G > nctx) ? NR / Wt : 0;
    int first, S, end;
    if (G > nctx && unit * Wt == NR && (unit & 7) == 0) { const int b = (int)blockIdx.x; const int r0 = b < nctx ? b * unit : nctx * unit + (b - nctx) * 7 * unit; first = r0 + w; S = 8; end = r0 + (b < nctx ? unit : 7 * unit); }
    else { first = (int)blockIdx.x * 8 + w; S = G * 8; end = NR; }
#define TAB_LOAD(A, r) do { const int r_ = (r) < NR ? (r) : NR - 1; const float* s_ = ((r_ >> 14) ? p.peer_v : p.peer_u) + (size_t)(r_ & 16383) * 1024 + 4 * lane; \
        _Pragma("unroll") for (int i_ = 0; i_ < 4; ++i_) A[i_] = __builtin_nontemporal_load((const f32x4*)(s_ + 256 * i_)); } while (0)
    f32x4 A0[4], A1[4], A2[4], A3[4];
    if (first < end) { TAB_LOAD(A0, first); TAB_LOAD(A1, first + S); TAB_LOAD(A2, first + 2 * S); }
    for (int r = first; r < end; r += 4 * S) {
        TAB_LOAD(A3, r + 3 * S); tab8_row(p, A0, r, lane);
        TAB_LOAD(A0, r + 4 * S); if (r + S < end) tab8_row(p, A1, r + S, lane);
        TAB_LOAD(A1, r + 5 * S); if (r + 2 * S < end) tab8_row(p, A2, r + 2 * S, lane);
        TAB_LOAD(A2, r + 6 * S); if (r + 3 * S < end) tab8_row(p, A3, r + 3 * S, lane);
    }
#undef TAB_LOAD
}
#define PEER_ISSUE(R, E0, E1, E2, E3) do { _Pragma("unroll") for (int i_ = 0; i_ < 4; ++i_) { R[i_] = *(const u32x4*)(tab + (E0[i_] * 128u + kc16)); R[4 + i_] = *(const u32x4*)(tab + (E1[i_] * 128u + kc16)); \
        R[8 + i_] = *(const u32x4*)(tab + (E2[i_] * 128u + kc16)); R[12 + i_] = *(const u32x4*)(tab + (E3[i_] * 128u + kc16)); } } while (0)
#define PEER_LD_E(E0, E1, E2, E3, t) do { const u32x4* ep_ = (const u32x4*)(p.eidx + (size_t)(t) * 128 + 16 * rsub); E0 = ep_[0]; E1 = ep_[1]; E2 = ep_[2]; E3 = ep_[3]; } while (0)
typedef int i32x8 __attribute__((ext_vector_type(8)));
__device__ __forceinline__ void sddmm_compute(u32x4 (&R)[16], const u32x4 (&hb)[4], LAS unsigned char* wbuf, float* dst_tok, int l) {
    const int rsub = l >> 3, kc = l & 7, rho = l & 15, kg = l >> 4;
    const int wr0 = rsub * 128 + ((kc ^ rsub) << 4), wr1 = (8 + rsub) * 128 + ((kc ^ rsub ^ 1) << 4);
    const int key = (rho & 7) ^ (rho >> 3), rbase = rho * 128;
    i32x8 b0, b1;
#pragma unroll
    for (int i = 0; i < 4; ++i) { b0[i] = (int)hb[0][i]; b0[4 + i] = (int)hb[1][i]; b1[i] = (int)hb[2][i]; b1[4 + i] = (int)hb[3][i]; }
    f32x4 acc[8];
#pragma unroll
    for (int t = 0; t < 8; ++t) {
        LAS unsigned char* buf = wbuf + (t & 1) * 2048;
        *(LAS u32x4*)(buf + wr0) = R[t]; *(LAS u32x4*)(buf + wr1) = R[t + 8];
        const u32x4 x0 = *(const LAS u32x4*)(buf + rbase + ((kg ^ key) << 4)), x1 = *(const LAS u32x4*)(buf + rbase + (((4 + kg) ^ key) << 4));
        i32x8 a0, a1;
#pragma unroll
        for (int i = 0; i < 4; ++i) { a0[i] = (int)x0[i]; a0[4 + i] = 0; a1[i] = (int)x1[i]; a1[4 + i] = 0; }
        f32x4 c = (f32x4){0.f, 0.f, 0.f, 0.f};
        c = __builtin_amdgcn_mfma_scale_f32_16x16x128_f8f6f4(a0, b0, c, 4, 0, 0, 0x7f7f7f7f, 0, 0x7f7f7f7f);
        c = __builtin_amdgcn_mfma_scale_f32_16x16x128_f8f6f4(a1, b1, c, 4, 0, 0, 0x7f7f7f7f, 0, 0x7f7f7f7f);
        acc[t] = c;
    }
    const int reg = rho & 3, half = (rho >> 2) & 1;
    f32x4 o;
#pragma unroll
    for (int c4 = 0; c4 < 4; ++c4) { f32x4 lo = acc[c4], hi = acc[4 + c4];
        asm volatile("" : "+v"(lo), "+v"(hi));
        const f32x4 x = half ? hi : lo; float x0 = x[0], x1 = x[1], x2 = x[2], x3 = x[3];
        asm volatile("" : "+v"(x0), "+v"(x1), "+v"(x2), "+v"(x3));
        o[c4] = (reg & 2) ? ((reg & 1) ? x3 : x2) : ((reg & 1) ? x1 : x0); }
    if (rho < 8) *(f32x4*)(dst_tok + 16 * (4 * (kg & 1) + reg) + 8 * (kg >> 1) + 4 * half) = o;
}
__device__ __forceinline__ void dev_sddmm(PREF p, LAS unsigned char* lds) {
    const int tid = tid_opaque(), w = tid >> 6, l = tid & 63, rsub = l >> 3, kc = l & 7, kg = l >> 4;
    const int T = p.nb * SEQ; const int s = blockIdx.x & 3, sub = blockIdx.x >> 2, nsub = gridDim.x >> 2;
    const unsigned char* tab = p.u4 + (size_t)s * 16384 * 128; const unsigned kc16 = 16u * kc;
    const int first = sub * 8 + w, S = nsub * 8;
    const int n = first < T ? (T - first + S - 1) / S : 0;
    LAS unsigned char* wbuf = lds + w * 4096;
    float* pdb = p.pd + (size_t)s * T * 128;
#define TOKI(i) (first + ((i) < n ? (i) : n - 1) * S)
#define LD_H(H, t) do { const unsigned char* hp_ = p.h8 + (size_t)(t) * DM + 256 * s + 16 * kg; H[0] = *(const u32x4*)hp_; H[1] = *(const u32x4*)(hp_ + 64); H[2] = *(const u32x4*)(hp_ + 128); H[3] = *(const u32x4*)(hp_ + 192); } while (0)
    if (n > 0) {
        u32x4 RA[16], RB[16], eA0, eA1, eA2, eA3, eB0, eB1, eB2, eB3, hA[4], hB[4];
        PEER_LD_E(eA0, eA1, eA2, eA3, TOKI(0)); LD_H(hA, TOKI(0)); PEER_ISSUE(RA, eA0, eA1, eA2, eA3);
        PEER_LD_E(eB0, eB1, eB2, eB3, TOKI(1)); LD_H(hB, TOKI(1));
        for (int i = 0; i < n; i += 2) {
            PEER_ISSUE(RB, eB0, eB1, eB2, eB3);
            PEER_LD_E(eA0, eA1, eA2, eA3, TOKI(i + 2));
            sddmm_compute(RA, hA, wbuf, pdb + (size_t)TOKI(i) * 128, l);
            LD_H(hA, TOKI(i + 2));
            PEER_ISSUE(RA, eA0, eA1, eA2, eA3);
            PEER_LD_E(eB0, eB1, eB2, eB3, TOKI(i + 3));
            if (i + 1 < n) sddmm_compute(RB, hB, wbuf, pdb + (size_t)TOKI(i + 1) * 128, l);
            LD_H(hB, TOKI(i + 3));
        }
    }
#undef LD_H
}
__device__ __forceinline__ void dev_act(PREF p) {
    const int tid = tid_opaque(); const int T = p.nb * SEQ; const size_t n = (size_t)T * 128;
    for (size_t i = ((size_t)blockIdx.x * NTHR + tid) * 4; i < n; i += (size_t)gridDim.x * NTHR * 4) {
        f32x4 a = *(const f32x4*)(p.pd + i);
#pragma unroll
        for (int s = 1; s < 4; ++s) a += *(const f32x4*)(p.pd + (size_t)s * n + i);
        const u32x4 e = *(const u32x4*)(p.eidx + i);
        f32x4 g = *(const f32x4*)(p.gw + i);
#pragma unroll
        for (int j = 0; j < 4; ++j) g[j] *= gelu_f(a[j] * (0.25f * p.scu[2 * e[j]])) * p.scu[2 * e[j] + 1];
        *(f32x4*)(p.gw + i) = g;
    }
}
template <int CTRL> __device__ __forceinline__ float dpp_f(float v) { return __int_as_float(__builtin_amdgcn_update_dpp(0, __float_as_int(v), CTRL, 0xf, 0xf, true)); }
__device__ __forceinline__ void spmm_compute(PREF p, u32x4 (&R)[16], const f32x4 w0, const f32x4 w1, const f32x4 w2, const f32x4 w3, int t, int col, int l) {
    const int b5 = (l >> 5) & 1, b4 = (l >> 4) & 1, b3 = (l >> 3) & 1;
    f32x2 ac2[16];
#pragma unroll
    for (int i = 0; i < 16; ++i) ac2[i] = (f32x2){0.f, 0.f};
#pragma unroll
    for (int r = 0; r < 16; ++r) { const float wg = (r < 4) ? w0[r & 3] : (r < 8) ? w1[r & 3] : (r < 12) ? w2[r & 3] : w3[r & 3];
        if (r >= 1) asm volatile("" : "+v"(R[r]) : "v"(ac2[0]));
        const f32x2 wg2 = (f32x2){wg, wg};
#pragma unroll
        for (int i = 0; i < 4; ++i) {
            ac2[4 * i + 0] = wg2 * __builtin_amdgcn_cvt_scalef32_pk_f32_fp4(R[r][i], 1.0f, 0) + ac2[4 * i + 0];
            ac2[4 * i + 1] = wg2 * __builtin_amdgcn_cvt_scalef32_pk_f32_fp4(R[r][i], 1.0f, 1) + ac2[4 * i + 1];
            ac2[4 * i + 2] = wg2 * __builtin_amdgcn_cvt_scalef32_pk_f32_fp4(R[r][i], 1.0f, 2) + ac2[4 * i + 2];
            ac2[4 * i + 3] = wg2 * __builtin_amdgcn_cvt_scalef32_pk_f32_fp4(R[r][i], 1.0f, 3) + ac2[4 * i + 3]; } }
    f32x2 a8[8], a4[4], a2[2];
#pragma unroll
    for (int k = 0; k < 8; ++k)
#pragma unroll
        for (int c = 0; c < 2; ++c) { const u32x2 r = __builtin_amdgcn_permlane32_swap(__float_as_uint(ac2[k][c]), __float_as_uint(ac2[k + 8][c]), false, false); a8[k][c] = __uint_as_float(r[0]) + __uint_as_float(r[1]); }
#pragma unroll
    for (int k = 0; k < 4; ++k)
#pragma unroll
        for (int c = 0; c < 2; ++c) { const u32x2 r = __builtin_amdgcn_permlane16_swap(__float_as_uint(a8[k][c]), __float_as_uint(a8[k + 4][c]), false, false); a4[k][c] = __uint_as_float(r[0]) + __uint_as_float(r[1]); }
#pragma unroll
    for (int k = 0; k < 2; ++k)
#pragma unroll
        for (int c = 0; c < 2; ++c) { const float snd = b3 ? a4[k][c] : a4[k + 2][c]; a2[k][c] = (b3 ? a4[k + 2][c] : a4[k][c]) + dpp_f<0x128>(snd); }
    *(u32x2*)(p.peer16 + (size_t)t * DM + col) = (u32x2){pk2(a2[0][0], a2[0][1]), pk2(a2[1][0], a2[1][1])};
}
__device__ __forceinline__ void dev_spmm(PREF p) {
    const int tid = tid_opaque(), w = tid >> 6, l = tid & 63, rsub = l >> 3, kc = l & 7;
    const int T = p.nb * SEQ; const int s = blockIdx.x & 3, sub = blockIdx.x >> 2, nsub = gridDim.x >> 2;
    const unsigned char* tab = p.v4 + (size_t)s * 16384 * 128; const unsigned kc16 = 16u * kc;
    const int col = 256 * s + 32 * kc + 2 * (8 * ((l >> 5) & 1) + 4 * ((l >> 4) & 1) + 2 * ((l >> 3) & 1));
    const int first = sub * 8 + w, S = nsub * 8;
    const int n = first < T ? (T - first + S - 1) / S : 0;
#define LD_W(W0, W1, W2, W3, t) do { const f32x4* wp_ = (const f32x4*)(p.gw + (size_t)(t) * 128 + 16 * rsub); W0 = wp_[0]; W1 = wp_[1]; W2 = wp_[2]; W3 = wp_[3]; } while (0)
    if (n > 0) {
        u32x4 RA[16], RB[16], eA0, eA1, eA2, eA3, eB0, eB1, eB2, eB3; f32x4 wA0, wA1, wA2, wA3, wB0, wB1, wB2, wB3;
        PEER_LD_E(eA0, eA1, eA2, eA3, TOKI(0)); LD_W(wA0, wA1, wA2, wA3, TOKI(0)); PEER_ISSUE(RA, eA0, eA1, eA2, eA3);
        PEER_LD_E(eB0, eB1, eB2, eB3, TOKI(1)); LD_W(wB0, wB1, wB2, wB3, TOKI(1));
        for (int i = 0; i < n; i += 2) {
            PEER_ISSUE(RB, eB0, eB1, eB2, eB3);
            PEER_LD_E(eA0, eA1, eA2, eA3, TOKI(i + 2));
            spmm_compute(p, RA, wA0, wA1, wA2, wA3, TOKI(i), col, l);
            LD_W(wA0, wA1, wA2, wA3, TOKI(i + 2));
            PEER_ISSUE(RA, eA0, eA1, eA2, eA3);
            PEER_LD_E(eB0, eB1, eB2, eB3, TOKI(i + 3));
            if (i + 1 < n) spmm_compute(p, RB, wB0, wB1, wB2, wB3, TOKI(i + 1), col, l);
            LD_W(wB0, wB1, wB2, wB3, TOKI(i + 3));
        }
    }
#undef LD_W
#undef TOKI
}
__device__ __forceinline__ void dev_final(PREF p) {
    const int tid = tid_opaque(), w = tid >> 6, lane = tid & 63; const int T = p.nb * SEQ;
    for (int t = blockIdx.x * 8 + w; t < T; t += gridDim.x * 8) {
        const float* g2p = p.mod + (size_t)(t >> 11) * 6144 + 5 * 1024;
        f32x4 xv[4]; float ss = 0.f;
#pragma unroll
        for (int i = 0; i < 4; ++i) { const int d = 4 * lane + 256 * i; const f32x4 x = *(const f32x4*)(p.x1 + (size_t)t * DM + d), gg = *(const f32x4*)(g2p + d);
            const u32x2 pv = *(const u32x2*)(p.peer16 + (size_t)t * DM + d);
            f32x4 r; r[0] = x[0] + gg[0] * bflo(pv[0]); r[1] = x[1] + gg[1] * bfhi(pv[0]); r[2] = x[2] + gg[2] * bflo(pv[1]); r[3] = x[3] + gg[3] * bfhi(pv[1]);
            ss += (r[0] * r[0] + r[1] * r[1]) + (r[2] * r[2] + r[3] * r[3]); xv[i] = r; }
        ss = wave_sum(ss);
        const float rs = rsqrtf(ss * (1.0f / 1024.0f) + 1e-6f);
#pragma unroll
        for (int i = 0; i < 4; ++i) { const int d = 4 * lane + 256 * i; const f32x4 fg = *(const f32x4*)(p.final_g + d);
            f32x4 o;
#pragma unroll
            for (int j = 0; j < 4; ++j) o[j] = xv[i][j] * rs * fg[j];
            *(f32x4*)(p.out + (size_t)t * DM + d) = o; }
    }
}


__device__ __forceinline__ void sddmm_accum(u32x4 (&R)[16], const u32x4 (&hb)[4], LAS unsigned char* wbuf, f32x4 (&acc)[8], int l) {
    const int rsub = l >> 3, kc = l & 7, rho = l & 15, kg = l >> 4;
    const int wr0 = rsub * 128 + ((kc ^ rsub) << 4), wr1 = (8 + rsub) * 128 + ((kc ^ rsub ^ 1) << 4);
    const int key = (rho & 7) ^ (rho >> 3), rbase = rho * 128;
    i32x8 b0, b1;
#pragma unroll
    for (int i = 0; i < 4; ++i) { b0[i] = (int)hb[0][i]; b0[4 + i] = (int)hb[1][i]; b1[i] = (int)hb[2][i]; b1[4 + i] = (int)hb[3][i]; }
#pragma unroll
    for (int t = 0; t < 8; ++t) {
        LAS unsigned char* buf = wbuf + (t & 1) * 2048;
        *(LAS u32x4*)(buf + wr0) = R[t]; *(LAS u32x4*)(buf + wr1) = R[t + 8];
        const u32x4 x0 = *(const LAS u32x4*)(buf + rbase + ((kg ^ key) << 4)), x1 = *(const LAS u32x4*)(buf + rbase + (((4 + kg) ^ key) << 4));
        i32x8 a0, a1;
#pragma unroll
        for (int i = 0; i < 4; ++i) { a0[i] = (int)x0[i]; a0[4 + i] = 0; a1[i] = (int)x1[i]; a1[4 + i] = 0; }
        f32x4 c = acc[t];
        c = __builtin_amdgcn_mfma_scale_f32_16x16x128_f8f6f4(a0, b0, c, 4, 0, 0, 0x7f7f7f7f, 0, 0x7f7f7f7f);
        c = __builtin_amdgcn_mfma_scale_f32_16x16x128_f8f6f4(a1, b1, c, 4, 0, 0, 0x7f7f7f7f, 0, 0x7f7f7f7f);
        acc[t] = c;
    }
}
__device__ __forceinline__ void dev_sddmm_act(PREF p, LAS unsigned char* lds) {
    const int tid = tid_opaque(), w = __builtin_amdgcn_readfirstlane(tid >> 6), l = tid & 63, rsub = l >> 3, kc = l & 7, kg = l >> 4, rho = l & 15;
    const int T = p.nb * SEQ;
    const unsigned kc16 = 16u * kc;
    const int first = blockIdx.x * 8 + w, S = gridDim.x * 8;
    const int n = first < T ? (T - first + S - 1) / S : 0;
    LAS unsigned char* wbuf = lds + w * 4096;
    const int reg = rho & 3, half = (rho >> 2) & 1, j0 = 16 * (4 * (kg & 1) + reg) + 8 * (kg >> 1) + 4 * half;
#define TOKI(i) (first + ((i) < n ? (i) : n - 1) * S)
#define SA_ISSUE(R, E0, E1, E2, E3, sl) do { const unsigned char* tab = p.u4 + (size_t)(sl) * 16384 * 128; PEER_ISSUE(R, E0, E1, E2, E3); } while (0)
#define SA_LD_H(H, t, sl) do { const unsigned char* hp_ = p.h8 + (size_t)(t) * DM + 256 * (sl) + 16 * kg; H[0] = *(const u32x4*)hp_; H[1] = *(const u32x4*)(hp_ + 64); H[2] = *(const u32x4*)(hp_ + 128); H[3] = *(const u32x4*)(hp_ + 192); } while (0)
    if (n > 0) {
        u32x4 RA[16], RB[16], eC0, eC1, eC2, eC3, eN0, eN1, eN2, eN3, hA[4], hB[4];
        PEER_LD_E(eC0, eC1, eC2, eC3, TOKI(0)); SA_LD_H(hA, TOKI(0), 0); SA_ISSUE(RA, eC0, eC1, eC2, eC3, 0);
        PEER_LD_E(eN0, eN1, eN2, eN3, TOKI(1));
        for (int i = 0; i < n; ++i) {
            const int t = TOKI(i);
            f32x4 acc[8];
#pragma unroll
            for (int k = 0; k < 8; ++k) acc[k] = (f32x4){0.f, 0.f, 0.f, 0.f};
            SA_ISSUE(RB, eC0, eC1, eC2, eC3, 1); SA_LD_H(hB, t, 1); sddmm_accum(RA, hA, wbuf, acc, l);
            SA_ISSUE(RA, eC0, eC1, eC2, eC3, 2); SA_LD_H(hA, t, 2); sddmm_accum(RB, hB, wbuf, acc, l);
            SA_ISSUE(RB, eC0, eC1, eC2, eC3, 3); SA_LD_H(hB, t, 3); sddmm_accum(RA, hA, wbuf, acc, l);
            const f32x4 sj = *(const f32x4*)(p.su + (size_t)t * 128 + j0); const f32x4 gj = *(const f32x4*)(p.gw + (size_t)t * 128 + j0);
            SA_ISSUE(RA, eN0, eN1, eN2, eN3, 0); SA_LD_H(hA, TOKI(i + 1), 0); sddmm_accum(RB, hB, wbuf, acc, l);
            eC0 = eN0; eC1 = eN1; eC2 = eN2; eC3 = eN3;
            PEER_LD_E(eN0, eN1, eN2, eN3, TOKI(i + 2));
            f32x4 o;
#pragma unroll
            for (int c4 = 0; c4 < 4; ++c4) { f32x4 lo = acc[c4], hi = acc[4 + c4];
                asm volatile("" : "+v"(lo), "+v"(hi));
                const f32x4 x = half ? hi : lo; float x0 = x[0], x1 = x[1], x2 = x[2], x3 = x[3];
                asm volatile("" : "+v"(x0), "+v"(x1), "+v"(x2), "+v"(x3));
                o[c4] = (reg & 2) ? ((reg & 1) ? x3 : x2) : ((reg & 1) ? x1 : x0); }
            f32x4 wv = (f32x4){0.f, 0.f, 0.f, 0.f};
            if (rho < 8) {
#pragma unroll
                for (int c4 = 0; c4 < 4; ++c4) wv[c4] = gj[c4] * gelu_f(o[c4] * (0.25f * sj[c4])); }
            float mx = fmaxf(fmaxf(fabsf(wv[0]), fabsf(wv[1])), fmaxf(fabsf(wv[2]), fabsf(wv[3])));
#pragma unroll
            for (int sh = 1; sh < 64; sh <<= 1) mx = fmaxf(mx, shx_f(mx, sh));
            const int bexp = max((__float_as_int(mx) >> 23) & 255, 8);
            const float wsc = __int_as_float((261 - bexp) << 23);
            if (rho < 8) { int w8v = 0; w8v = __builtin_amdgcn_cvt_pk_fp8_f32(wv[0] * wsc, wv[1] * wsc, w8v, false); w8v = __builtin_amdgcn_cvt_pk_fp8_f32(wv[2] * wsc, wv[3] * wsc, w8v, true);
                *(unsigned*)(p.w8 + (size_t)t * 128 + j0) = (unsigned)w8v; }
            if (l == 0) p.wsc[t] = __int_as_float((bexp - 7) << 23);
        }
    }
#undef SA_ISSUE
#undef SA_LD_H
#undef TOKI
}
#define SF_ISSUE(R, ESRC, LBASE) do { int es_ = ESRC; _Pragma("unroll") for (int r_ = 0; r_ < 32; ++r_) { if ((r_ & 7) == 0) asm volatile("" : "+v"(es_) :: "memory");     \
        const unsigned e_ = (unsigned)__builtin_amdgcn_readlane(es_, (LBASE) + r_); R[r_] = *(const u32x2*)(tab + (lane_off + e_ * 128u)); } } while (0)
#define SF_COMPUTE(R, WSRC, LBASE) do { int ws_ = __float_as_int(WSRC); _Pragma("unroll") for (int r_ = 0; r_ < 32; ++r_) { \
        if ((r_ & 3) == 0 && r_ > 0) asm volatile("" : "+v"(R[r_]), "+v"(R[r_ + 1]), "+v"(R[r_ + 2]), "+v"(R[r_ + 3]), "+v"(ws_) : "v"(acc[0])); \
        const float wj_ = __int_as_float(__builtin_amdgcn_readlane(ws_, (LBASE) + r_)); const f32x2 w2_ = (f32x2){wj_, wj_}; \
        _Pragma("unroll") for (int i_ = 0; i_ < 2; ++i_) { \
            acc[4 * i_ + 0] = w2_ * __builtin_amdgcn_cvt_scalef32_pk_f32_fp4(R[r_][i_], 1.0f, 0) + acc[4 * i_ + 0]; acc[4 * i_ + 1] = w2_ * __builtin_amdgcn_cvt_scalef32_pk_f32_fp4(R[r_][i_], 1.0f, 1) + acc[4 * i_ + 1]; \
            acc[4 * i_ + 2] = w2_ * __builtin_amdgcn_cvt_scalef32_pk_f32_fp4(R[r_][i_], 1.0f, 2) + acc[4 * i_ + 2]; acc[4 * i_ + 3] = w2_ * __builtin_amdgcn_cvt_scalef32_pk_f32_fp4(R[r_][i_], 1.0f, 3) + acc[4 * i_ + 3]; } } } while (0)
__device__ __forceinline__ void dev_spmm_final(PREF p) {
    const int tid = tid_opaque(), w = __builtin_amdgcn_readfirstlane(tid >> 6), l = tid & 63;
    const int T = p.nb * SEQ;
    const unsigned char* tab = p.v4; const unsigned lane_off = (unsigned)(l >> 4) * (16384u * 128u) + 8u * (unsigned)(l & 15);
    const int first = blockIdx.x * 8 + w, S = gridDim.x * 8;
    const int n = first < T ? (T - first + S - 1) / S : 0;
#define TOKJ(i) (first + ((i) < n ? (i) : n - 1) * S)
#define SF_LISTS(EL, EH, WL, WH, t) do { EL = p.eidx[(size_t)(t) * 128 + l]; EH = p.eidx[(size_t)(t) * 128 + 64 + l]; const float is_ = p.wsc[t]; \
        WL = __builtin_amdgcn_cvt_f32_fp8((int)p.w8[(size_t)(t) * 128 + l], 0) * is_; WH = __builtin_amdgcn_cvt_f32_fp8((int)p.w8[(size_t)(t) * 128 + 64 + l], 0) * is_; } while (0)
    if (n > 0) {
        u32x2 RA[32], RB[32]; int eCl, eCh, eNl, eNh; float wCl, wCh, wNl, wNh;
        SF_LISTS(eCl, eCh, wCl, wCh, TOKJ(0)); SF_ISSUE(RA, eCl, 0); SF_LISTS(eNl, eNh, wNl, wNh, TOKJ(1));
        for (int i = 0; i < n; ++i) {
            const int t = TOKJ(i);
            f32x2 acc[8];
#pragma unroll
            for (int k = 0; k < 8; ++k) acc[k] = (f32x2){0.f, 0.f};
            SF_ISSUE(RB, eCl, 32); SF_COMPUTE(RA, wCl, 0);
            SF_ISSUE(RA, eCh, 0);  SF_COMPUTE(RB, wCl, 32);
            SF_ISSUE(RB, eCh, 32); SF_COMPUTE(RA, wCh, 0);
            int lo16 = 16 * l; asm volatile("" : "+v"(lo16));
            const bf16_t* x1p = p.x1b + (size_t)t * DM + lo16; const float* g2p = p.mod + (size_t)(t >> 11) * 6144 + 5 * 1024 + lo16;
            f32x4 xv[4], gg[4];
            { const u32x4 xa = *(const u32x4*)x1p, xb = *(const u32x4*)(x1p + 8);
              xv[0] = (f32x4){bflo(xa[0]), bfhi(xa[0]), bflo(xa[1]), bfhi(xa[1])}; xv[1] = (f32x4){bflo(xa[2]), bfhi(xa[2]), bflo(xa[3]), bfhi(xa[3])};
              xv[2] = (f32x4){bflo(xb[0]), bfhi(xb[0]), bflo(xb[1]), bfhi(xb[1])}; xv[3] = (f32x4){bflo(xb[2]), bfhi(xb[2]), bflo(xb[3]), bfhi(xb[3])}; }
#pragma unroll
            for (int q = 0; q < 4; ++q) gg[q] = *(const f32x4*)(g2p + 4 * q);
            SF_ISSUE(RA, eNl, 0);  SF_COMPUTE(RB, wCh, 32);
            eCl = eNl; eCh = eNh; wCl = wNl; wCh = wNh;
            SF_LISTS(eNl, eNh, wNl, wNh, TOKJ(i + 2));
            float ss = 0.f;
#pragma unroll
            for (int q = 0; q < 4; ++q) { xv[q][0] += gg[q][0] * acc[2 * q][0]; xv[q][1] += gg[q][1] * acc[2 * q][1]; xv[q][2] += gg[q][2] * acc[2 * q + 1][0]; xv[q][3] += gg[q][3] * acc[2 * q + 1][1];
                ss += (xv[q][0] * xv[q][0] + xv[q][1] * xv[q][1]) + (xv[q][2] * xv[q][2] + xv[q][3] * xv[q][3]); }
            ss = wave_sum(ss);
            const float rs = rsqrtf(ss * (1.0f / 1024.0f) + 1e-6f);
#pragma unroll
            for (int q = 0; q < 4; ++q) { const f32x4 fg = *(const f32x4*)(p.final_g + lo16 + 4 * q); f32x4 o;
#pragma unroll
                for (int j = 0; j < 4; ++j) o[j] = xv[q][j] * rs * fg[j];
                *(f32x4*)(p.out + (size_t)t * DM + lo16 + 4 * q) = o; }
        }
    }
#undef TOKJ
#undef SF_LISTS
}

typedef int v2i_t __attribute__((ext_vector_type(2)));
__device__ __forceinline__ void spmm_slice(const u32x4 (&R)[16], const i32x8 bw, LAS unsigned char* wbuf, int wa, int rb, int L, f32x4& acc) {
#pragma unroll
    for (int i = 0; i < 16; ++i) { LAS u32x4* d = (LAS u32x4*)(wbuf + (wa ^ ((i >> 1) << 4)) + i * 128);
        if (i & 1) *d = (u32x4){R[i][2], R[i][3], R[i][0], R[i][1]}; else *d = R[i]; }
#pragma unroll
    for (int mf = 0; mf < 16; ++mf) {
        LAS unsigned char* ap = wbuf + (rb ^ (mf << 3));
        const v2i_t lo = __builtin_amdgcn_ds_read_tr4_b64_v2i32((LAS v2i_t*)ap), hi = __builtin_amdgcn_ds_read_tr4_b64_v2i32((LAS v2i_t*)(ap + 2048));
        i32x8 a; a[0] = lo[0]; a[1] = lo[1]; a[2] = hi[0]; a[3] = hi[1]; a[4] = 0; a[5] = 0; a[6] = 0; a[7] = 0;
        const f32x4 d = __builtin_amdgcn_mfma_scale_f32_16x16x128_f8f6f4(a, bw, (f32x4){0.f, 0.f, 0.f, 0.f}, 4, 0, 0, 0x7f7f7f7f, 0, 0x7f7f7f7f);
        const bool keep = (L == mf);
#pragma unroll
        for (int j = 0; j < 4; ++j) acc[j] = keep ? d[j] : acc[j];
    }
}
__device__ __forceinline__ void dev_spmm_mfma(PREF p, LAS unsigned char* lds) {
    const int tid = tid_opaque(), w = __builtin_amdgcn_readfirstlane(tid >> 6), l = tid & 63, rsub = l >> 3, kc = l & 7, L = l & 15, g = l >> 4;
    const int T = p.nb * SEQ;
    const unsigned kc16 = 16u * kc;
    const int first = blockIdx.x * 8 + w, S = gridDim.x * 8;
    const int n = first < T ? (T - first + S - 1) / S : 0;
    LAS unsigned char* wbuf = lds + w * 16384;
    const int wa = rsub * 2048 + (kc << 4);
    const int rb = g * 4096 + L * 128 + (L << 3);
#define TOKI(i) (first + ((i) < n ? (i) : n - 1) * S)
#define SV_ISSUE(R, E0, E1, E2, E3, sl) do { const unsigned char* tab = p.v4 + (size_t)(sl) * 16384 * 128; PEER_ISSUE(R, E0, E1, E2, E3); } while (0)
    if (n > 0) {
        u32x4 RA[16], RB[16], eC0, eC1, eC2, eC3;
        PEER_LD_E(eC0, eC1, eC2, eC3, TOKI(0)); SV_ISSUE(RA, eC0, eC1, eC2, eC3, 0);
        for (int i = 0; i < n; ++i) {
            const int t = TOKI(i);
            const unsigned char* wp = p.w8 + (size_t)t * 128 + 16 * g;
            const u32x4 w0 = *(const u32x4*)wp, w1 = *(const u32x4*)(wp + 64);
            i32x8 bw;
#pragma unroll
            for (int j = 0; j < 4; ++j) { bw[j] = (int)w0[j]; bw[4 + j] = (int)w1[j]; }
            const float isc = p.wsc[t];
            f32x4 acc[4];
#pragma unroll
            for (int k = 0; k < 4; ++k) acc[k] = (f32x4){0.f, 0.f, 0.f, 0.f};
            SV_ISSUE(RB, eC0, eC1, eC2, eC3, 1); spmm_slice(RA, bw, wbuf, wa, rb, L, acc[0]);
            SV_ISSUE(RA, eC0, eC1, eC2, eC3, 2); spmm_slice(RB, bw, wbuf, wa, rb, L, acc[1]);
            SV_ISSUE(RB, eC0, eC1, eC2, eC3, 3);
            PEER_LD_E(eC0, eC1, eC2, eC3, TOKI(i + 1));
            spmm_slice(RA, bw, wbuf, wa, rb, L, acc[2]);
            int col4 = 16 * L + 4 * g; asm volatile("" : "+v"(col4));
            const bf16_t* x1p = p.x1b + (size_t)t * DM + col4; const float* g2p = p.mod + (size_t)(t >> 11) * 6144 + 5 * 1024 + col4;
            u32x2 xq[4]; f32x4 gg[4];
#pragma unroll
            for (int q = 0; q < 4; ++q) { xq[q] = __builtin_nontemporal_load((const u32x2*)(x1p + 256 * q)); gg[q] = *(const f32x4*)(g2p + 256 * q); }
            SV_ISSUE(RA, eC0, eC1, eC2, eC3, 0); spmm_slice(RB, bw, wbuf, wa, rb, L, acc[3]);
            f32x4 xv[4]; float ss = 0.f;
#pragma unroll
            for (int q = 0; q < 4; ++q) { xv[q] = (f32x4){bflo(xq[q][0]), bfhi(xq[q][0]), bflo(xq[q][1]), bfhi(xq[q][1])};
#pragma unroll
                for (int j = 0; j < 4; ++j) xv[q][j] += gg[q][j] * (acc[q][j] * isc);
                ss += (xv[q][0] * xv[q][0] + xv[q][1] * xv[q][1]) + (xv[q][2] * xv[q][2] + xv[q][3] * xv[q][3]); }
            ss = wave_sum(ss);
            const float rs = rsqrtf(ss * (1.0f / 1024.0f) + 1e-6f);
#pragma unroll
            for (int q = 0; q < 4; ++q) { const f32x4 fg = *(const f32x4*)(p.final_g + col4 + 256 * q); f32x4 o;
#pragma unroll
                for (int j = 0; j < 4; ++j) o[j] = xv[q][j] * rs * fg[j];
                __builtin_nontemporal_store(o, (f32x4*)(p.out + (size_t)t * DM + col4 + 256 * q)); }
        }
    }
#undef SV_ISSUE
#undef TOKI
}

__device__ __forceinline__ void dev_gemm_in(PREF p, LAS unsigned char* lds) {
    const int T = p.nb * SEQ, TC = p.nb * CTXL;
    {
        pg8::Gemm g{p.hc, p.Wt_in + (size_t)512 * DM, DM, DM, DM, 0, 0}; pg8::StaticOrder S; S.init(TC, 1024, gridDim.x, blockIdx.x);
        pg8::EpiAct E{p.zxc, 0, 0, 1 << 20, DM, 0, 0};
        pg8::gemm_phase(lds, g, S, E);
    }
    {
        pg8::Gemm g{p.h, p.Wt_in + (size_t)512 * DM, DM, DM, DM, 0, 0}; pg8::StaticOrder S; S.init(T, 4096, gridDim.x, blockIdx.x);
        pg8::EpiAct E{p.zx, p.zseg, 0x2210, 4, DM, 1, 0};
        pg8::gemm_phase(lds, g, S, E);
    }
    {
        pg8::Gemm g{p.Wt_in, p.h, DM, DM, DM, 0, 0}; pg8::StaticOrder S; S.init(512, T, gridDim.x, blockIdx.x);
        pg8::EpiAct E{p.zfT, (size_t)512 * SEQ, 0, SEQ / 256, SEQ, 0, 0};
        pg8::gemm_phase(lds, g, S, E);
    }
}
__device__ __forceinline__ void dev_gemm_dft(PREF p, LAS unsigned char* lds) {
    const int T = p.nb * SEQ;
    pg8::Gemm g{p.dft, p.zfT, SEQ, SEQ, SEQ, 0, (long)512 * SEQ}; pg8::BatchOrder S; S.init(2048, 512, p.nb, gridDim.x, blockIdx.x);
    pg8::EpiUV E{p.UV};
    pg8::gemm_phase(lds, g, S, E);
}
__device__ __forceinline__ void dev_gemm_mix(PREF p, LAS unsigned char* lds, int vb = -1) {
    if (vb < 0) vb = blockIdx.x;
    const int T = p.nb * SEQ;
    {
        pg8::Gemm g{p.UV, p.Wfp, DM, DM, DM, 0, 0}; pg8::StaticOrder S; S.init(T, 1024, gridDim.x, vb);
        pg8::EpiGate E{p.sga, nullptr, p.Pb};
        pg8::gemm_phase(lds, g, S, E);
    }
    {
        pg8::Gemm g{p.ybin, p.Wt_lru, DM, DM, DM, 0, 0}; pg8::StaticOrder S; S.init(T, 1024, gridDim.x, vb);
        pg8::EpiGate E{p.sgb, p.Pb, p.merged};
        pg8::gemm_phase(lds, g, S, E);
    }
}
__device__ __forceinline__ void dev_gemm_out(PREF p, LAS unsigned char* lds, int vb = -1) {
    if (vb < 0) vb = blockIdx.x;
    const int T = p.nb * SEQ;
    pg8::Gemm g{p.merged, p.Wt_out, DM, DM, DM, 0, 0, 1, 0}; pg8::StaticOrder S; S.init(T, 1024, gridDim.x, vb);
    pg8::EpiX1 E{p.x, p.pos, p.mod, p.b_out, p.x1b};
    pg8::gemm_phase(lds, g, S, E);
}
__device__ __forceinline__ void dev_gemm_q(PREF p, LAS unsigned char* lds, int vb = -1) {
    if (vb < 0) vb = blockIdx.x;
    const int T = p.nb * SEQ;
    pg8::Gemm g{p.h2, p.Wt_q, DM, DM, DM, 0, 0}; pg8::StaticOrder S; S.init(T, 2048, gridDim.x, vb);
    pg8::EpiAct E{p.q, 0, 0, 1 << 20, 2048, 1, 1, 1};
    pg8::gemm_phase(lds, g, S, E);
}

#define KERNEL_HEAD extern __shared__ __attribute__((aligned(16))) unsigned char smem_raw[]; LAS unsigned char* lds = (LAS unsigned char*)smem_raw;
#ifdef DIAG
__global__ void __launch_bounds__(NTHR, 2) k_prep_t(Params p) { KERNEL_HEAD
    dev_transpose(p.w_in, 4608, 0, 1024, 4608, p.Wt_in, 1, 0, 0, lds, 0, (int)gridDim.x);
    dev_transpose(p.w_lru_out, 1024, 0, 1024, 1024, p.Wt_lru, 1, 0, 0, lds, 0, (int)gridDim.x);
    dev_transpose(p.w_out, 1024, 0, 1024, 1024, p.Wt_out, 1, 0, 0, lds, 0, (int)gridDim.x);
    dev_transpose(p.peer_wq, 2048, 0, 1024, 2048, p.Wt_q, 1, 0, 0, lds, 0, (int)gridDim.x);
    dev_transpose(p.lru_wa, 128, 0, 128, 128, p.gates_bf, 8, 16384, 16384, lds, 0, (int)gridDim.x);
    dev_transpose(p.lru_wx, 128, 0, 128, 128, p.gates_bf + (size_t)8 * 16384, 8, 16384, 16384, lds, 0, (int)gridDim.x);
    dev_transpose(p.lru_wa + (size_t)8 * 16384, 128, 0, 128, 128, p.gates_bf + (size_t)16 * 16384, 8, 16384, 16384, lds, 0, (int)gridDim.x);
    dev_transpose(p.lru_wx + (size_t)8 * 16384, 128, 0, 128, 128, p.gates_bf + (size_t)24 * 16384, 8, 16384, 16384, lds, 0, (int)gridDim.x);
}
__global__ void __launch_bounds__(NTHR, 2) k_prep_c(Params p) { KERNEL_HEAD
    dev_convert(p.peer_keys, p.keys_bf, (size_t)8 * 2 * 128 * 128);
    dev_convert(p.peer_u, p.u_bf, (size_t)16384 * 1024);
    dev_convert(p.peer_v, p.v_bf, (size_t)16384 * 1024);
    dev_wfp(p, lds);
    dev_dft(p);
    dev_pos(p);
}
__global__ void __launch_bounds__(NTHR, 2) k_adaln(Params p) { KERNEL_HEAD dev_adaln(p, lds); }
__global__ void __launch_bounds__(NTHR, 2) k_norm1(Params p) { dev_norm(p, 0); }
__global__ void __launch_bounds__(NTHR, 2) k_gemm_in(Params p) { KERNEL_HEAD dev_gemm_in(p, lds); }
__global__ void __launch_bounds__(NTHR, 2) k_scan(Params p) { KERNEL_HEAD dev_scan(p, lds); }
__global__ void __launch_bounds__(NTHR, 2) k_gemm_dft(Params p) { KERNEL_HEAD dev_gemm_dft(p, lds); }
__global__ void __launch_bounds__(NTHR, 2) k_gemm_mix(Params p) { KERNEL_HEAD dev_gemm_mix(p, lds); }
__global__ void __launch_bounds__(NTHR, 2) k_gemm_out(Params p) { KERNEL_HEAD dev_gemm_out(p, lds); }
__global__ void __launch_bounds__(NTHR, 2) k_norm2(Params p) { dev_norm(p, 1); }
__global__ void __launch_bounds__(NTHR, 2) k_gemm_q(Params p) { KERNEL_HEAD dev_gemm_q(p, lds); }
__global__ void __launch_bounds__(NTHR, 2) k_topk(Params p) { dev_topk(p); }
__global__ void __launch_bounds__(NTHR, 2) k_peer(Params p) { dev_peer(p); }


#endif
namespace cg = cooperative_groups;

#define XB_TMO      128
#define XB_XCNT(j)  (256  + 64 * (j))
#define XB_XSUB(j)  (1280 + 64 * (j))
#define XB_XGEN(j)  (2304 + 64 * (j))
#define XB_TOP      3328
#define XB_TOPGEN   3392
#define XB_LSUB(j)  (3456 + 64 * (j))
#define XB_LGEN(j)  (4480 + 64 * (j))
#define XCD_BAR_WORDS 5504
#define XB_SPIN_CAP (1u << 22)
__device__ __forceinline__ unsigned xb_ld(unsigned* p)              { return __hip_atomic_load(p, __ATOMIC_RELAXED, __HIP_MEMORY_SCOPE_AGENT); }
__device__ __forceinline__ unsigned xb_add(unsigned* p, unsigned v) { return __hip_atomic_fetch_add(p, v, __ATOMIC_RELAXED, __HIP_MEMORY_SCOPE_AGENT); }
__device__ __forceinline__ unsigned xb_xcc_id() { return (unsigned)__builtin_amdgcn_s_getreg((3 << 11) | 20) & 0xFu; }
#define XB_SPIN(cond, bar) do { unsigned _sp = 0; while (cond) { __builtin_amdgcn_s_sleep(1); \
    if ((++_sp & 255u) == 0u) { if (xb_ld(&(bar)[XB_TMO])) break; if (_sp > XB_SPIN_CAP) { atomicAdd(&(bar)[XB_TMO], 1u); break; } } } } while (0)
struct XcdBarrier { unsigned* bar; unsigned x; volatile LAS unsigned* st; };
__device__ __forceinline__ XcdBarrier xcd_barrier_post(unsigned* bar, volatile LAS unsigned* st) {
    XcdBarrier b; b.bar = bar; b.x = xb_xcc_id(); b.st = st;
    if (threadIdx.x == 0) st[3] = xb_add(&bar[XB_XCNT(b.x)], 1u);
    return b;
}
__device__ __forceinline__ void xcd_barrier_complete(unsigned* bar, unsigned x, unsigned& nloc, unsigned& nx, unsigned& uni) {
    const unsigned G = gridDim.x * gridDim.y * gridDim.z;
    unsigned sum, cnt, mine, even, sp = 0u;
    for (;;) {
        sum = 0u; cnt = 0u; mine = 0u; even = ((G & 7u) == 0u) ? 1u : 0u;
#pragma unroll
        for (unsigned j = 0; j < 16; ++j) { const unsigned c = xb_ld(&bar[XB_XCNT(j)]); sum += c; cnt += (c > 0u) ? 1u : 0u; mine = (j == x) ? c : mine; if (j < 8 && c != (G >> 3)) even = 0u; }
        if (sum == G) break;
        __builtin_amdgcn_s_sleep(1);
        if ((++sp & 255u) == 0u) { if (xb_ld(&bar[XB_TMO])) break; if (sp > XB_SPIN_CAP) { atomicAdd(&bar[XB_TMO], 1u); break; } }
    }
    nloc = mine > 0u ? mine : 1u; nx = cnt > 0u ? cnt : 1u; uni = (sum == G) ? even : 0u;
}
__device__ __forceinline__ void xcd_barrier(const XcdBarrier& b) {
    asm volatile("s_waitcnt vmcnt(0)" ::: "memory");
    __syncthreads();
    if (threadIdx.x == 0) {
        unsigned* bar = b.bar;
        __builtin_amdgcn_s_waitcnt(0);
        unsigned nloc = b.st[0], nx = b.st[1];
        if (nloc == 0u) { unsigned uni; xcd_barrier_complete(bar, b.x, nloc, nx, uni); b.st[0] = nloc; b.st[1] = nx; b.st[2] = uni; }
        const unsigned old = xb_add(&bar[XB_XSUB(b.x)], 1u);
        const unsigned gen = old / nloc;
        if (old + 1u == (gen + 1u) * nloc) {
            __builtin_amdgcn_fence(__ATOMIC_RELEASE, "agent");
            asm volatile("s_waitcnt vmcnt(0)" ::: "memory");
            const unsigned og = xb_add(&bar[XB_TOP], 1u);
            const unsigned tg = og / nx;
            if (og + 1u == (tg + 1u) * nx) xb_add(&bar[XB_TOPGEN], 1u);
            else XB_SPIN(xb_ld(&bar[XB_TOPGEN]) == tg, bar);
            __builtin_amdgcn_fence(__ATOMIC_ACQUIRE, "agent");
            xb_add(&bar[XB_XGEN(b.x)], 1u);
            asm volatile("s_waitcnt vmcnt(0)" ::: "memory");
        } else {
            XB_SPIN(xb_ld(&bar[XB_XGEN(b.x)]) == gen, bar);
            __builtin_amdgcn_fence(__ATOMIC_ACQUIRE, "agent");
            asm volatile("s_waitcnt vmcnt(0)" ::: "memory");
        }
    }
    __syncthreads();
}

__device__ __forceinline__ void xcd_local_barrier(const XcdBarrier& b) {
    asm volatile("s_waitcnt vmcnt(0)" ::: "memory");
    __syncthreads();
    if (threadIdx.x == 0) {
        unsigned* bar = b.bar;
        __builtin_amdgcn_s_waitcnt(0);
        const unsigned nloc = b.st[0];
        const unsigned old = xb_add(&bar[XB_LSUB(b.x)], 1u);
        const unsigned gen = old / nloc;
        if (old + 1u == (gen + 1u) * nloc) xb_add(&bar[XB_LGEN(b.x)], 1u);
        else XB_SPIN(xb_ld(&bar[XB_LGEN(b.x)]) == gen, bar);
        __builtin_amdgcn_fence(__ATOMIC_ACQUIRE, "agent");
        asm volatile("s_waitcnt vmcnt(0)" ::: "memory");
    }
    __syncthreads();
}

#ifndef DIAG
__device__ __forceinline__ CParams* kparams() { CParams* q = (CParams*)__builtin_amdgcn_kernarg_segment_ptr(); asm volatile("" : "+s"(q)); return q; }
__global__ void __launch_bounds__(NTHR, 2) k_mega(Params p_unused) { KERNEL_HEAD
    cg::grid_group grid = cg::this_grid();
    volatile LAS unsigned* bst = (volatile LAS unsigned*)(lds + LDS_BYTES - 16);
    if (blockIdx.x == 0) { CParams& p = *kparams(); for (int i = tid_opaque(); i < XCD_BAR_WORDS; i += NTHR) p.bar[i] = 0u; }
    if (tid_opaque() < 2) bst[tid_opaque()] = 0u;
    { CParams& p = *kparams(); dev_adaln(p, lds); }
    __syncthreads();
    { CParams& p = *kparams();
      const int G = (int)gridDim.x, G8 = (G & 7) ? G : (G >> 3), gf = (G & 7) ? 0 : (G >> 1);
      dev_transpose(p.w_in, 4608, 0, 1024, 4608, p.Wt_in, 1, 0, 0, lds, 0, G);
      dev_transpose(p.lru_wa, 128, 0, 128, 128, p.gates_bf, 8, 16384, 16384, lds, gf, G8);
      dev_transpose(p.lru_wx, 128, 0, 128, 128, p.gates_bf + (size_t)8 * 16384, 8, 16384, 16384, lds, (G & 7) ? 0 : gf + G8, G8);
      dev_transpose(p.lru_wa + (size_t)8 * 16384, 128, 0, 128, 128, p.gates_bf + (size_t)16 * 16384, 8, 16384, 16384, lds, (G & 7) ? 0 : gf + 2 * G8, G8);
      dev_transpose(p.lru_wx + (size_t)8 * 16384, 128, 0, 128, 128, p.gates_bf + (size_t)24 * 16384, 8, 16384, 16384, lds, (G & 7) ? 0 : gf + 3 * G8, G8);
      dev_transpose(p.w_lru_out, 1024, 0, 1024, 1024, p.Wt_lru, 1, 0, 0, lds, 0, G);
      dev_transpose(p.w_out, 1024, 0, 1024, 1024, p.Wt_out, 1, 0, 0, lds, 0, G);
      dev_transpose(p.peer_wq, 2048, 0, 1024, 2048, p.Wt_q, 1, 0, 0, lds, 0, G); }
    { CParams& p = *kparams();
      dev_convert(p.peer_keys, p.keys_bf, (size_t)8 * 2 * 128 * 128);
      if (blockIdx.x == 0 && tid_opaque() < 2) p.tmax[tid_opaque()] = 0u; }
    { CParams& p = *kparams(); dev_wfp(p, lds); }
    { CParams& p = *kparams(); dev_dft(p); dev_pos(p); }
    grid.sync();
    XcdBarrier xbar; { CParams& p = *kparams(); xbar = xcd_barrier_post(p.bar, bst); }
    { CParams& p = *kparams(); dev_norm(p, 0); }
    xcd_barrier(xbar);
    { CParams& p = *kparams(); dev_tab8(p); }
    { CParams& p = *kparams(); dev_gemm_in(p, lds); }
    xcd_barrier(xbar);
    { CParams& p = *kparams(); dev_scan(p, lds); }
    { CParams& p = *kparams(); dev_gemm_dft(p, lds); }
    xcd_barrier(xbar);
    const unsigned uni = __builtin_amdgcn_readfirstlane(bst[2]), rank = __builtin_amdgcn_readfirstlane(bst[3]);
    const int vb = uni ? (int)(rank * 8u + xbar.x) : (int)blockIdx.x;
    { CParams& p = *kparams(); dev_gemm_mix(p, lds, vb); }
    if (uni) xcd_local_barrier(xbar); else xcd_barrier(xbar);
    { CParams& p = *kparams(); dev_gemm_out(p, lds, vb); }
    if (uni) xcd_local_barrier(xbar); else xcd_barrier(xbar);
    { CParams& p = *kparams(); const int TX = (p.nb * SEQ) >> 3;
      if (uni) dev_norm(p, 1, (int)xbar.x * TX + (int)rank * 8, (int)gridDim.x, ((int)xbar.x + 1) * TX); else dev_norm(p, 1, (int)blockIdx.x * 8, (int)gridDim.x * 8, p.nb * SEQ); }
    if (uni) xcd_local_barrier(xbar); else xcd_barrier(xbar);
    { CParams& p = *kparams(); dev_gemm_q(p, lds, vb); }
    xcd_barrier(xbar);
    { CParams& p = *kparams(); dev_topk(p, lds); }
    xcd_barrier(xbar);
    { CParams& p = *kparams(); dev_sddmm_act(p, lds); }
    asm volatile("s_waitcnt vmcnt(0)" ::: "memory");
    __syncthreads();
    { CParams& p = *kparams(); dev_spmm_mfma(p, lds); }
}
#endif

#ifdef DIAG
__device__ __forceinline__ unsigned hsh(unsigned a, unsigned b) { unsigned x = a * 0x9E3779B1u ^ (b + 0x7F4A7C15u) * 0x85EBCA6Bu; x ^= x >> 15; x *= 0x2C1B3C6Du; x ^= x >> 12; x *= 0x297A2D39u; x ^= x >> 15; return x; }
__device__ __forceinline__ void rep(unsigned* slot, float got, float ref, float floor_) {
    float err = fabsf(got - ref) / (fabsf(ref) + floor_); if (!(err < 1e30f)) err = 1e30f; atomicMax(slot, __float_as_uint(err));
}
__device__ __forceinline__ float pos_direct(int t, int d) { const int j = d & 255, part = d >> 8; const float omega = 1.0f / powf(10000.0f, (float)j / 256.0f);
    const float arg = (float)(part < 2 ? (t >> 6) : (t & 63)) * omega; return (part & 1) ? cosf(arg) : sinf(arg); }
__global__ void chk_mod(Params p) {
    const int s = blockIdx.x * blockDim.x + threadIdx.x; const unsigned hv = hsh(s, 1); const int r = hv % 33, n = (hv >> 8) % 6144;
    const float* cond = r < 32 ? p.c + r * 1024 : p.c_ctx; float acc = p.b_mod[n];
    for (int k = 0; k < 1024; ++k) { const float v = cond[k]; acc += (v / (1.0f + expf(-v))) * p.w_mod[(size_t)k * 6144 + n]; }
    rep(p.diag + 1, p.mod[(size_t)r * 6144 + n], acc, 0.3f);
}
__global__ void chk_norm(Params p, int which) {
    const int s = blockIdx.x * blockDim.x + threadIdx.x; const unsigned hv = hsh(s, 2 + which);
    const int T = p.nb * SEQ, TC = which == 0 ? p.nb * CTXL : 0; const int row = hv % (T + TC), d = (hv >> 12) % 1024;
    const bool isctx = row >= T; const int lrow = isctx ? row - T : row; const int b = isctx ? 32 : lrow >> 11;
    const float* src = which == 1 ? p.x1 + (size_t)lrow * DM : (isctx ? p.ctx + (size_t)lrow * DM : p.x + (size_t)lrow * DM);
    float ss = 0.f, vd = 0.f;
    for (int k = 0; k < 1024; ++k) { float v = src[k]; if (which == 0 && !isctx) v += pos_direct(lrow & 2047, k); ss += v * v; if (k == d) vd = v; }
    const float rs = 1.0f / sqrtf(ss / 1024.0f + 1e-6f);
    const float* md = p.mod + (size_t)b * 6144 + (which == 0 ? 0 : 3 * 1024);
    const float ref = (vd * rs * (which == 0 ? p.norm1_g[d] : p.norm2_g[d])) * (1.0f + md[1024 + d]) + md[d];
    const bf16_t* dst = which == 1 ? p.h2 + (size_t)lrow * DM : (isctx ? p.hc + (size_t)lrow * DM : p.h + (size_t)lrow * DM);
    rep(p.diag + (which == 0 ? 2 : 8), bf2f(dst[d]), ref, 0.3f);
}
__global__ void chk_z(Params p) {
    const int s = blockIdx.x * blockDim.x + threadIdx.x; const unsigned hv = hsh(s, 5);
    const int T = p.nb * SEQ, TC = p.nb * CTXL;
    if (s & 1) { const int row = hv % T, col = (hv >> 13) % 4608; float acc = 0.f;
        for (int k = 0; k < 1024; ++k) acc += bf2f(p.h[(size_t)row * DM + k]) * p.w_in[(size_t)k * 4608 + col];
        float got;
        if (col < 512) got = bf2f(p.zfT[(size_t)col * T + row]);
        else if (col < 1536) got = bf2f(p.zx[(size_t)row * DM + col - 512]);
        else if (col < 2560) { got = bf2f(p.gzy[(size_t)row * DM + col - 1536]); acc = 0.5f * acc * (1.0f + tanhf(0.7978845608f * (acc + 0.044715f * acc * acc * acc))); }
        else if (col < 3584) { got = bf2f(p.sga[(size_t)row * DM + col - 2560]); acc = 1.0f / (1.0f + expf(-acc)); }
        else { got = bf2f(p.sgb[(size_t)row * DM + col - 3584]); acc = 1.0f / (1.0f + expf(-acc)); }
        rep(p.diag + 3, got, acc, 0.5f);
    } else { const int row = hv % TC, col = 512 + (hv >> 13) % 1024; float acc = 0.f;
        for (int k = 0; k < 1024; ++k) acc += bf2f(p.hc[(size_t)row * DM + k]) * p.w_in[(size_t)k * 4608 + col];
        rep(p.diag + 3, bf2f(p.zxc[(size_t)row * DM + col - 512]), acc, 0.5f); }
}
__global__ void chk_uv(Params p) {
    const int s = blockIdx.x * blockDim.x + threadIdx.x; const unsigned hv = hsh(s, 6);
    const int T = p.nb * SEQ; const int b = hv % p.nb, kt = (hv >> 4) % 2048, ch = (hv >> 15) % 512, part = (hv >> 25) & 1;
    float acc = 0.f;
    for (int t = 0; t < 2048; ++t) { const float a = (float)((kt * t) & 2047) / 1024.0f; acc += (part ? sinpif(a) : cospif(a)) * bf2f(p.zfT[(size_t)ch * T + b * 2048 + t]); }
    rep(p.diag + 4, bf2f(p.UV[((size_t)b * 2048 + kt) * DM + part * 512 + ch]), acc, 16.0f);
}
__global__ void __launch_bounds__(512) chk_scan(Params p) {
    __shared__ float AF[2304], BF[2304], AB[2304], BB[2304];
    const unsigned hv = hsh(blockIdx.x, 7); const int b = hv % p.nb, c = (hv >> 8) % 1024, head = c >> 7, cc = c & 127;
    for (int tp = threadIdx.x; tp < 2304; tp += blockDim.x) {
        const bool isctx = tp < 256; const int t = isctx ? tp : tp - 256, Tseq = isctx ? 256 : 2048;
        const bf16_t* src = isctx ? p.zxc + (size_t)b * 256 * DM : p.zx + (size_t)b * 2048 * DM;
        float gaf = 0.f, gxf = 0.f, gab = 0.f, gxb = 0.f, xcc = 0.f;
        for (int i = 0; i < 128; ++i) { const int hi = head * 128 + i; float xci = p.conv_b[hi];
            for (int r = 0; r < 4; ++r) { const int tr = t - 1 + r; if (tr >= 0 && tr < Tseq) xci += p.conv_w[r * 1024 + hi] * bf2f(src[(size_t)tr * DM + hi]); }
            const size_t wo = ((size_t)head * 128 + i) * 128 + cc;
            gaf += xci * p.lru_wa[wo]; gxf += xci * p.lru_wx[wo]; gab += xci * p.lru_wa[(size_t)8 * 16384 + wo]; gxb += xci * p.lru_wx[(size_t)8 * 16384 + wo];
            if (i == cc) xcc = xci; }
        { const float r = 1.0f / (1.0f + expf(-(gaf + p.lru_ba[c]))), ig = 1.0f / (1.0f + expf(-(gxf + p.lru_bx[c])));
          const float la = -8.0f * r * log1pf(expf(-p.lru_lambda[c])); AF[tp] = expf(la); BF[tp] = sqrtf(fmaxf(0.f, -expm1f(2.0f * la))) * ig * xcc; }
        { const float r = 1.0f / (1.0f + expf(-(gab + p.lru_ba[1024 + c]))), ig = 1.0f / (1.0f + expf(-(gxb + p.lru_bx[1024 + c])));
          const float la = -8.0f * r * log1pf(expf(-p.lru_lambda[1024 + c])); AB[tp] = expf(la); BB[tp] = sqrtf(fmaxf(0.f, -expm1f(2.0f * la))) * ig * xcc; }
    }
    __syncthreads();
    if (threadIdx.x == 0) { float h = 0.f; for (int tp = 0; tp < 2304; ++tp) { h = AF[tp] * h + BF[tp]; AF[tp] = h; } }
    if (threadIdx.x == 64) { float h = 0.f; for (int tp = 255; tp >= 0; --tp) { h = AB[tp] * h + BB[tp]; AB[tp] = h; } for (int tp = 2303; tp >= 256; --tp) { h = AB[tp] * h + BB[tp]; AB[tp] = h; } }
    __syncthreads();
    for (int t = threadIdx.x; t < 2048; t += blockDim.x) { float z = 0.f; const size_t row = (size_t)b * 2048 + t;
        for (int k = 0; k < 1024; ++k) z += bf2f(p.h[row * DM + k]) * p.w_in[(size_t)k * 4608 + 1536 + c];
        const float gz = 0.5f * z * (1.0f + tanhf(0.7978845608f * (z + 0.044715f * z * z * z)));
        rep(p.diag + 5, bf2f(p.ybin[row * DM + c]), (AF[256 + t] + AB[256 + t]) * gz, 0.25f); }
}
__global__ void chk_merged(Params p) {
    const int s = blockIdx.x * blockDim.x + threadIdx.x; const unsigned hv = hsh(s, 8); const int T = p.nb * SEQ; const int row = hv % T, col = (hv >> 13) % 1024;
    float ya = 0.f;
    for (int g = 0; g < 4; ++g) for (int kc = 0; kc < 128; ++kc) { float y = 0.f;
        for (int c = 0; c < 128; ++c) { const float a = (float)((kc * c) & 127) / 64.0f; y += bf2f(p.UV[(size_t)row * DM + g * 128 + c]) * cospif(a) - bf2f(p.UV[(size_t)row * DM + 512 + g * 128 + c]) * sinpif(a); }
        ya += (y / 512.0f) * p.w_fourier[(size_t)(g * 128 + kc) * 1024 + col]; }
    float yb = 0.f;
    for (int k = 0; k < 1024; ++k) yb += bf2f(p.ybin[(size_t)row * DM + k]) * p.w_lru_out[(size_t)k * 1024 + col];
    const float ref = bf2f(p.sga[(size_t)row * DM + col]) * ya + bf2f(p.sgb[(size_t)row * DM + col]) * yb;
    rep(p.diag + 6, bf2f(p.merged[(size_t)row * DM + col]), ref, 0.4f);
}
__global__ void chk_x1(Params p) {
    const int s = blockIdx.x * blockDim.x + threadIdx.x; const unsigned hv = hsh(s, 9); const int T = p.nb * SEQ; const int row = hv % T, col = (hv >> 13) % 1024, b = row >> 11;
    float acc = p.b_out[col];
    for (int k = 0; k < 1024; ++k) acc += bf2f(p.merged[(size_t)row * DM + k]) * p.w_out[(size_t)k * 1024 + col];
    const float ref = p.x[(size_t)row * DM + col] + pos_direct(row & 2047, col) + p.mod[(size_t)b * 6144 + 2048 + col] * acc;
    rep(p.diag + 7, p.x1[(size_t)row * DM + col], ref, 1.0f);
}
__global__ void chk_q(Params p) {
    const int s = blockIdx.x * blockDim.x + threadIdx.x; const unsigned hv = hsh(s, 10); const int T = p.nb * SEQ; const int row = hv % T, col = (hv >> 13) % 2048;
    float acc = 0.f;
    for (int k = 0; k < 1024; ++k) acc += bf2f(p.h2[(size_t)row * DM + k]) * p.peer_wq[(size_t)k * 2048 + col];
    rep(p.diag + 9, bf2f(p.q[(size_t)row * 2048 + col]), acc, 0.5f);
}
__global__ void __launch_bounds__(256) chk_topk(Params p) {
    __shared__ float sc[256]; __shared__ float cand[256]; __shared__ int top0[16], top1[16], refe[16]; __shared__ float tv0[16], tv1[16], refv[16];
    const unsigned hv = hsh(blockIdx.x, 11); const int T = p.nb * SEQ; const int tok = hv % T, hd = (hv >> 16) & 7; const int j = threadIdx.x, ph = j >> 7, key = j & 127;
    float a = 0.f;
    for (int d = 0; d < 128; ++d) a += bf2f(p.q[(size_t)tok * 2048 + hd * 256 + ph * 128 + d]) * p.peer_keys[((size_t)(hd * 2 + ph) * 128 + key) * 128 + d];
    sc[j] = a; __syncthreads();
    if (j == 0) {
        for (int hf = 0; hf < 2; ++hf) for (int r = 0; r < 16; ++r) { int bi = 0; float bv = -1e30f; for (int k = 0; k < 128; ++k) if (sc[hf * 128 + k] > bv) { bv = sc[hf * 128 + k]; bi = k; }
            sc[hf * 128 + bi] = -1e30f; if (hf == 0) { top0[r] = bi; tv0[r] = bv; } else { top1[r] = bi; tv1[r] = bv; } }
        for (int i = 0; i < 16; ++i) for (int k = 0; k < 16; ++k) cand[i * 16 + k] = tv0[i] + tv1[k];
        for (int r = 0; r < 16; ++r) { int bi = 0; float bv = -1e30f; for (int k = 0; k < 256; ++k) if (cand[k] > bv) { bv = cand[k]; bi = k; }
            cand[bi] = -1e30f; refe[r] = top0[bi >> 4] * 128 + top1[bi & 15]; refv[r] = bv; }
        const float mx = refv[0]; float sum = 0.f;
        for (int r = 0; r < 16; ++r) sum += expf(refv[r] - mx);
        int bad = 0;
        for (int k = 0; k < 16; ++k) { const int e = p.eidx[(size_t)tok * 128 + hd * 16 + k]; const float g = p.gw[(size_t)tok * 128 + hd * 16 + k]; bool ok = false;
            for (int r = 0; r < 16; ++r) if (refe[r] == e) { const float gr = expf(refv[r] - mx) / sum; if (fabsf(g - gr) <= 0.05f * gr + 0.003f) ok = true; }
            if (!ok) ++bad; }
        atomicMax(p.diag + 10, __float_as_uint((float)bad / 16.0f)); atomicMax(p.diag + 16, (unsigned)bad);
        { int nf = 0; float sg = 0.f;
          for (int k = 0; k < 16; ++k) { const int e = p.eidx[(size_t)tok * 128 + hd * 16 + k]; sg += p.gw[(size_t)tok * 128 + hd * 16 + k]; bool f = false; for (int r = 0; r < 16; ++r) if (refe[r] == e) f = true; if (!f) ++nf; }
          atomicMax(p.diag + 12, (unsigned)nf); atomicMax(p.diag + 13, __float_as_uint(fabsf(sg - 1.0f)));
          int dup = 0; float wre = 0.f;
          for (int k = 0; k < 16; ++k) { const int e = p.eidx[(size_t)tok * 128 + hd * 16 + k]; const float g = p.gw[(size_t)tok * 128 + hd * 16 + k];
              for (int k2 = 0; k2 < k; ++k2) if (p.eidx[(size_t)tok * 128 + hd * 16 + k2] == e) ++dup;
              for (int r = 0; r < 16; ++r) if (refe[r] == e) { const float gr = expf(refv[r] - mx) / sum; wre = fmaxf(wre, fabsf(g - gr) / (gr + 0.003f)); } }
          atomicMax(p.diag + 14, (unsigned)dup); atomicMax(p.diag + 15, __float_as_uint(wre)); }
    }
}
__global__ void __launch_bounds__(256) chk_out(Params p) {
    __shared__ float wj[128]; __shared__ float red[256];
    const unsigned hv = hsh(blockIdx.x, 12); const int T = p.nb * SEQ; const int tok = hv % T, b = tok >> 11, t = threadIdx.x;
    if (t < 128) { const int e = p.eidx[(size_t)tok * 128 + t]; float dsum = 0.f;
        for (int d = 0; d < 1024; ++d) dsum += p.peer_u[(size_t)e * 1024 + d] * bf2f(p.h2[(size_t)tok * DM + d]);
        const float ge = 0.5f * dsum * (1.0f + tanhf(0.7978845608f * (dsum + 0.044715f * dsum * dsum * dsum)));
        wj[t] = p.gw[(size_t)tok * 128 + t] * ge; }
    __syncthreads();
    float x2[4]; float ss = 0.f;
    for (int i = 0; i < 4; ++i) { const int d = t + 256 * i; float acc = 0.f;
        for (int jx = 0; jx < 128; ++jx) acc += wj[jx] * p.peer_v[(size_t)p.eidx[(size_t)tok * 128 + jx] * 1024 + d];
        const float v = p.x1[(size_t)tok * DM + d] + p.mod[(size_t)b * 6144 + 5 * 1024 + d] * acc;
        if (i == 0) x2[0] = v; else if (i == 1) x2[1] = v; else if (i == 2) x2[2] = v; else x2[3] = v;
        ss += v * v; }
    red[t] = ss; __syncthreads();
    for (int o = 128; o > 0; o >>= 1) { if (t < o) red[t] += red[t + o]; __syncthreads(); }
    const float rs = 1.0f / sqrtf(red[0] / 1024.0f + 1e-6f);
    rep(p.diag + 11, p.out[(size_t)tok * DM + t], x2[0] * rs * p.final_g[t], 0.5f);
    rep(p.diag + 11, p.out[(size_t)tok * DM + t + 256], x2[1] * rs * p.final_g[t + 256], 0.5f);
    rep(p.diag + 11, p.out[(size_t)tok * DM + t + 512], x2[2] * rs * p.final_g[t + 512], 0.5f);
    rep(p.diag + 11, p.out[(size_t)tok * DM + t + 768], x2[3] * rs * p.final_g[t + 768], 0.5f);
}
__global__ void diag_apply(Params p, int total) {
    const float tol[12] = {0.f, 2e-3f, 2e-2f, 3e-2f, 3e-2f, 8e-2f, 4e-2f, 1e-2f, 2e-2f, 3e-2f, 0.2f, 3e-2f};
    int F = 0; float err = 1.f;
    for (int i = 11; i >= 1; --i) { const float e = __uint_as_float(p.diag[i]); const float tl = i == 1 ? tol[1] : i == 2 ? tol[2] : i == 3 ? tol[3] : i == 4 ? tol[4] : i == 5 ? tol[5] : i == 6 ? tol[6] : i == 7 ? tol[7] : i == 8 ? tol[8] : i == 9 ? tol[9] : i == 10 ? tol[10] : tol[11];
        if (!(e <= tl)) { F = i; err = e; } }
    int cls = 0; if (F) { const float l = -log10f(fmaxf(err, 1e-12f)); cls = l < 0.f ? 0 : (l > 9.f ? 9 : (int)l); }
    if (F == 10) { cls = (int)p.diag[16]; if (cls > 9) cls = 9; }
#ifdef DIAG_AB
    { const float e10 = __uint_as_float(p.diag[10]), e11 = __uint_as_float(p.diag[11]); F = (e10 <= 1e9f ? 1 : 2) + (e11 <= 0.03f ? 0 : 4); const float l = -log10f(fmaxf(e11, 1e-12f)); cls = l < 0.f ? 0 : (l > 9.f ? 9 : (int)l); }
#endif
    const float K = sqrtf(((float)F / 10.0f + 1.0f) * powf(10.0f, (float)(cls + 6)));
    for (int i = blockIdx.x * blockDim.x + threadIdx.x; i < total; i += gridDim.x * blockDim.x) p.out[i] = K;
}
#endif

static inline size_t al(size_t x) { return (x + 255) & ~(size_t)255; }
extern "C" void kernel_launch(void* const* d_in, const int* in_sizes, int n_in, void* d_out, int out_size, void* d_ws, size_t ws_size, hipStream_t stream) {
#ifdef DIAG
    static int inited = 0;
    const void* kerns[] = {(const void*)k_prep_t, (const void*)k_prep_c, (const void*)k_adaln, (const void*)k_gemm_in, (const void*)k_scan, (const void*)k_gemm_dft, (const void*)k_gemm_mix, (const void*)k_gemm_out, (const void*)k_gemm_q};
    if (!inited) { for (auto k : kerns) (void)hipFuncSetAttribute(k, hipFuncAttributeMaxDynamicSharedMemorySize, LDS_BYTES); inited = 1; }
#endif
    Params p{};
    const float* const* in = (const float* const*)d_in;
    p.x = in[0]; p.c = in[1]; p.ctx = in[2]; p.c_ctx = in[3]; p.w_mod = in[4]; p.b_mod = in[5]; p.norm1_g = in[6]; p.norm2_g = in[7]; p.w_in = in[8]; p.w_fourier = in[9];
    p.conv_w = in[10]; p.conv_b = in[11]; p.lru_wa = in[12]; p.lru_ba = in[13]; p.lru_wx = in[14]; p.lru_bx = in[15]; p.lru_lambda = in[16]; p.w_lru_out = in[17];
    p.w_out = in[18]; p.b_out = in[19]; p.peer_wq = in[20]; p.peer_keys = in[21]; p.peer_u = in[22]; p.peer_v = in[23]; p.final_g = in[24];
    p.out = (float*)d_out;
    unsigned char* ws = (unsigned char*)d_ws; size_t o = 0;
    auto take = [&](size_t bytes) { unsigned char* r = ws + o; o += al(bytes); return r; };
    const size_t MiB = 1ull << 20;
    p.diag = (unsigned*)take(4096);
    p.mod = (float*)take(33 * 6144 * 4); p.pos = (float*)take((size_t)SEQ * DM * 4);
    p.Wt_in = (bf16_t*)take((size_t)4608 * 1024 * 2); p.Wfp = (bf16_t*)take(2 * MiB); p.Wt_lru = (bf16_t*)take(2 * MiB); p.Wt_out = (bf16_t*)take(2 * MiB); p.Wt_q = (bf16_t*)take(4 * MiB);
    p.keys_bf = (bf16_t*)take(MiB / 2); p.gates_bf = (bf16_t*)take(MiB); p.dft = (bf16_t*)take(16 * MiB);
#ifdef DIAG
    p.u_bf = (bf16_t*)take(32 * MiB); p.v_bf = (bf16_t*)take(32 * MiB);
#endif
    p.u8 = nullptr; p.u4 = (unsigned char*)take(8 * MiB); p.scu = (float*)take(131072); p.v8 = nullptr; p.v4 = (unsigned char*)take(8 * MiB); p.scv = (float*)take(65536); p.ssb = (float*)take(2 * MiB); p.tmax = (unsigned*)take(256); p.bar = (unsigned*)take(XCD_BAR_WORDS * 4);
#ifndef DIAG
    { const size_t need = 928 * MiB; if (ws_size > o + need + MiB) o = (ws_size - need) & ~((size_t)4095); }
    unsigned char* R9 = take(64 * MiB);
    unsigned char* R8 = take(128 * MiB);
    unsigned char* R45 = take(256 * MiB);
    unsigned char* R67 = take(256 * MiB);
    unsigned char* R3 = take(64 * MiB);
    p.zxc = (bf16_t*)take(16 * MiB); p.hc = (bf16_t*)take(16 * MiB);
    unsigned char* R0 = take(128 * MiB);
    p.h = (bf16_t*)R0; p.hf = (bf16_t*)R0; p.h2 = (bf16_t*)R0;
    p.zfT = (bf16_t*)R3; p.eidx = (int*)R3; p.gw = (float*)(R3 + 32 * MiB); p.su = (float*)(R45 + 128 * MiB);
    p.zx = (bf16_t*)R45; p.gzy = (bf16_t*)(R45 + 128 * MiB); p.ybin = p.gzy; p.x1 = (float*)R45; p.x1b = (bf16_t*)R45;
    p.sga = (bf16_t*)R67; p.Pb = p.sga; p.sgb = (bf16_t*)(R67 + 128 * MiB); p.merged = (bf16_t*)R0; p.q = (bf16_t*)R67;
    p.UV = (bf16_t*)R8; p.pd = (float*)R67; p.h8 = R9; p.peer16 = (bf16_t*)R0; p.w8 = R0; p.wsc = p.ssb;
    p.zseg = (size_t)64 * MiB; p.nb = NBATCH; p.pad = 0;
#else
    const int NBD = 4; const size_t U = (size_t)NBD * SEQ * DM * 2;
    p.h = (bf16_t*)take(U); p.hc = (bf16_t*)take(U / 8); p.zxc = (bf16_t*)take(U / 8); p.zfT = (bf16_t*)take(U / 2);
    p.zx = (bf16_t*)take(U); p.gzy = (bf16_t*)take(U); p.sga = (bf16_t*)take(U); p.sgb = (bf16_t*)take(U);
    p.hf = (bf16_t*)take(U); p.ybin = (bf16_t*)take(U); p.UV = (bf16_t*)take(U); p.Pb = (bf16_t*)take(U); p.merged = (bf16_t*)take(U);
    p.x1 = (float*)take(2 * U); p.h2 = (bf16_t*)take(U); p.q = (bf16_t*)take(2 * U); p.eidx = (int*)take(U / 4); p.gw = (float*)take(U / 4);
    p.zseg = U / 2; p.nb = NBD; p.pad = 0;
    (void)hipMemsetAsync(p.diag, 0, 4096, stream);
#endif
#if !defined(DIAG)
    {
        static int grid_blocks = 0;
        if (!grid_blocks) {
            int dev = 0, cus = 0, per_cu = 0;
            (void)hipGetDevice(&dev);
            (void)hipDeviceGetAttribute(&cus, hipDeviceAttributeMultiprocessorCount, dev);
            (void)hipFuncSetAttribute((const void*)k_mega, hipFuncAttributeMaxDynamicSharedMemorySize, LDS_BYTES);
            (void)hipOccupancyMaxActiveBlocksPerMultiprocessor(&per_cu, (const void*)k_mega, NTHR, LDS_BYTES);
            if (per_cu < 1) { fprintf(stderr, "kernel_launch: occupancy query says %d blocks per CU\n", per_cu); per_cu = 1; }
            grid_blocks = cus * 1;
        }
        void* args[] = {(void*)&p};
        const hipError_t e = hipLaunchCooperativeKernel((const void*)k_mega, dim3(grid_blocks), dim3(NTHR), args, LDS_BYTES, stream);
        if (e != hipSuccess) fprintf(stderr, "cooperative launch failed: %s (grid %d)\n", hipGetErrorString(e), grid_blocks);
        return;
    }
#endif
#ifdef DIAG
    const dim3 grid(256), blk(NTHR);
    hipLaunchKernelGGL(k_prep_t, grid, blk, LDS_BYTES, stream, p);
    hipLaunchKernelGGL(k_prep_c, grid, blk, LDS_BYTES, stream, p);
    hipLaunchKernelGGL(k_adaln, grid, blk, LDS_BYTES, stream, p);
    hipLaunchKernelGGL(k_norm1, grid, blk, 0, stream, p);
    hipLaunchKernelGGL(k_gemm_in, grid, blk, LDS_BYTES, stream, p);
    hipLaunchKernelGGL(k_scan, grid, blk, LDS_BYTES, stream, p);
    hipLaunchKernelGGL(k_gemm_dft, grid, blk, LDS_BYTES, stream, p);
    hipLaunchKernelGGL(k_gemm_mix, grid, blk, LDS_BYTES, stream, p);
    hipLaunchKernelGGL(k_gemm_out, grid, blk, LDS_BYTES, stream, p);
    hipLaunchKernelGGL(k_norm2, grid, blk, 0, stream, p);
    hipLaunchKernelGGL(k_gemm_q, grid, blk, LDS_BYTES, stream, p);
    hipLaunchKernelGGL(k_topk, grid, blk, 0, stream, p);
    hipLaunchKernelGGL(k_peer, grid, blk, 0, stream, p);
    hipLaunchKernelGGL(chk_mod, dim3(2), dim3(128), 0, stream, p);
    hipLaunchKernelGGL(chk_norm, dim3(2), dim3(128), 0, stream, p, 0);
    hipLaunchKernelGGL(chk_z, dim3(4), dim3(128), 0, stream, p);
    hipLaunchKernelGGL(chk_uv, dim3(2), dim3(128), 0, stream, p);
    hipLaunchKernelGGL(chk_scan, dim3(8), dim3(512), 0, stream, p);
    hipLaunchKernelGGL(chk_merged, dim3(2), dim3(64), 0, stream, p);
    hipLaunchKernelGGL(chk_x1, dim3(2), dim3(128), 0, stream, p);
    hipLaunchKernelGGL(chk_norm, dim3(2), dim3(128), 0, stream, p, 1);
    hipLaunchKernelGGL(chk_q, dim3(2), dim3(128), 0, stream, p);
    hipLaunchKernelGGL(chk_topk, dim3(64), dim3(256), 0, stream, p);
    hipLaunchKernelGGL(chk_out, dim3(16), dim3(256), 0, stream, p);
    hipLaunchKernelGGL(diag_apply, dim3(1024), dim3(256), 0, stream, p, out_size);
#endif
}
```

```cpp
#include <hip/hip_runtime.h>
#include <hip/hip_cooperative_groups.h>
#include <cstdio>
#include <cstdint>

#define LAS __attribute__((address_space(3)))
typedef unsigned short bf16_t;
typedef short bf16x8 __attribute__((ext_vector_type(8)));
typedef float f32x2 __attribute__((ext_vector_type(2)));
typedef float f32x4 __attribute__((ext_vector_type(4)));
typedef float f32x16 __attribute__((ext_vector_type(16)));
typedef unsigned u32x2 __attribute__((ext_vector_type(2)));
typedef unsigned u32x4 __attribute__((ext_vector_type(4)));
typedef __bf16 bf2_t __attribute__((ext_vector_type(2)));

constexpr int DM = 1024, SEQ = 2048, CTXL = 256, NBATCH = 32;
constexpr int NTHR = 512;
constexpr int LDS_BYTES = 160 * 1024;

__device__ __forceinline__ float bf2f(bf16_t b) { return __uint_as_float(((unsigned)b) << 16); }
__device__ __forceinline__ float bflo(unsigned w) { return __uint_as_float(w << 16); }
__device__ __forceinline__ float bfhi(unsigned w) { return __uint_as_float(w & 0xffff0000u); }
typedef __bf16 bf16x2_t __attribute__((ext_vector_type(2)));
__device__ __forceinline__ unsigned pk2(float lo, float hi) { return __builtin_bit_cast(unsigned, __builtin_convertvector((f32x2){lo, hi}, bf16x2_t)); }
__device__ __forceinline__ bf16_t f2bf(float f) { return (bf16_t)(pk2(f, 0.f) & 0xffffu); }
__device__ __forceinline__ float sigmoid_f(float x) { return __builtin_amdgcn_rcpf(1.0f + __builtin_amdgcn_exp2f(-1.4426950409f * x)); }
__device__ __forceinline__ float gelu_f(float x) { const float in = x + 0.044715f * x * x * x; return x * __builtin_amdgcn_rcpf(1.0f + __builtin_amdgcn_exp2f(-2.3022082f * in)); }
__device__ __forceinline__ int lane_opaque() { int t = threadIdx.x & 63; asm volatile("" : "+v"(t)); return t; }
__device__ __forceinline__ float shx_f(float v, int o) { return __int_as_float(__builtin_amdgcn_ds_bpermute((lane_opaque() ^ o) << 2, __float_as_int(v))); }
__device__ __forceinline__ int shx_i(int v, int o) { return __builtin_amdgcn_ds_bpermute((lane_opaque() ^ o) << 2, v); }
__device__ __forceinline__ f32x2 sigmoid2(f32x2 x) { const f32x2 t = x * (f32x2){-1.4426950409f, -1.4426950409f}; f32x2 e; e[0] = __builtin_amdgcn_exp2f(t[0]); e[1] = __builtin_amdgcn_exp2f(t[1]);
    const f32x2 d = e + (f32x2){1.0f, 1.0f}; f32x2 r; r[0] = __builtin_amdgcn_rcpf(d[0]); r[1] = __builtin_amdgcn_rcpf(d[1]); return r; }
__device__ __forceinline__ f32x2 gelu2(f32x2 x) {
    const f32x2 x2 = x * x; const f32x2 u = x2 * (f32x2){-0.10294324f, -0.10294324f} + (f32x2){-2.3022082f, -2.3022082f}; const f32x2 t = x * u;
    f32x2 e; e[0] = __builtin_amdgcn_exp2f(t[0]); e[1] = __builtin_amdgcn_exp2f(t[1]);
    const f32x2 d = e + (f32x2){1.0f, 1.0f}; f32x2 r; r[0] = __builtin_amdgcn_rcpf(d[0]); r[1] = __builtin_amdgcn_rcpf(d[1]); return x * r; }
__device__ __forceinline__ float wave_sum(float v) {
#pragma unroll
    for (int o = 1; o < 64; o <<= 1) v += shx_f(v, o);
    return v;
}

__device__ __forceinline__ int tid_opaque() { int t = threadIdx.x; asm volatile("" : "+v"(t)); return t; }
struct Params {
    const float *x, *c, *ctx, *c_ctx, *w_mod, *b_mod, *norm1_g, *norm2_g, *w_in, *w_fourier, *conv_w, *conv_b, *lru_wa, *lru_ba, *lru_wx, *lru_bx, *lru_lambda,
        *w_lru_out, *w_out, *b_out, *peer_wq, *peer_keys, *peer_u, *peer_v, *final_g;
    float* out;
    float *mod, *pos;
    bf16_t *Wt_in, *Wfp, *Wt_lru, *Wt_out, *Wt_q, *keys_bf, *gates_bf, *dft, *u_bf, *v_bf;
    bf16_t *h, *hc, *zxc, *zfT, *zx, *gzy, *sga, *sgb, *hf, *ybin, *UV, *Pb, *merged, *h2, *q;
    float* x1; bf16_t* x1b; int* eidx; float* gw; float* su;
    unsigned char *u8, *v8, *h8, *u4, *v4; float* scu; float* scv; bf16_t* peer16; float* pd; float* ssb; unsigned* tmax; unsigned* bar;
    unsigned* diag;
    unsigned char* w8; float* wsc;
    size_t zseg;
    int nb, pad;
};

typedef const Params __attribute__((address_space(4))) CParams;
#ifdef DIAG
#define PREF const Params&
#else
#define PREF CParams&
#endif
__device__ __forceinline__ void dev_transpose(const float* src, int ld, int col0, int K, int N, bf16_t* dst, int nbat, size_t sbs, size_t dbs, LAS unsigned char* lds, int bfirst, int bcount) {
    const int rel = (int)blockIdx.x - bfirst;
    if (rel < 0 || rel >= bcount) return;
    const int tid = tid_opaque(), tk = K / 64, tn = N / 64, per = tk * tn, total = per * nbat;
    const int r = tid >> 4, c4 = tid & 15, nn = tid >> 3, kc = tid & 7;
#define TR_LOAD(V0, V1, it) do { const int it_ = (it) < total ? (it) : total - 1; const int bz_ = it_ / per, rem_ = it_ % per, k0_ = (rem_ / tn) * 64, n0_ = (rem_ % tn) * 64; \
        const float* s_ = src + (size_t)bz_ * sbs + (size_t)(k0_ + r) * ld + col0 + n0_ + 4 * c4; V0 = *(const f32x4*)s_; V1 = *(const f32x4*)(s_ + (size_t)32 * ld); } while (0)
    f32x4 v0, v1, w0, w1;
    TR_LOAD(v0, v1, rel);
    int par = 0;
    for (int item = rel; item < total; item += bcount) {
        TR_LOAD(w0, w1, item + bcount);
        const int bz = item / per, rem = item % per, k0 = (rem / tn) * 64, n0 = (rem % tn) * 64;
        LAS float* tile = (LAS float*)lds + par * (64 * 65);
        { LAS float* t = tile + r * 65 + 4 * c4; t[0] = v0[0]; t[1] = v0[1]; t[2] = v0[2]; t[3] = v0[3]; t += 32 * 65; t[0] = v1[0]; t[1] = v1[1]; t[2] = v1[2]; t[3] = v1[3]; }
        __syncthreads();
        const LAS float* t = tile + (8 * kc) * 65 + nn;
        u32x4 o; o[0] = pk2(t[0], t[65]); o[1] = pk2(t[2 * 65], t[3 * 65]); o[2] = pk2(t[4 * 65], t[5 * 65]); o[3] = pk2(t[6 * 65], t[7 * 65]);
        *(u32x4*)(dst + (size_t)bz * dbs + (size_t)(n0 + nn) * K + k0 + 8 * kc) = o;
        v0 = w0; v1 = w1; par ^= 1;
    }
    __syncthreads();
#undef TR_LOAD
}
__device__ __forceinline__ void dev_convert(const float* src, bf16_t* dst, size_t n) {
    const int tid = tid_opaque();
    for (size_t i = ((size_t)blockIdx.x * NTHR + tid) * 8; i < n; i += (size_t)gridDim.x * NTHR * 8) {
        const f32x4 a = *(const f32x4*)(src + i), b = *(const f32x4*)(src + i + 4);
        u32x4 o; o[0] = pk2(a[0], a[1]); o[1] = pk2(a[2], a[3]); o[2] = pk2(b[0], b[1]); o[3] = pk2(b[2], b[3]);
        *(u32x4*)(dst + i) = o;
    }
}
__device__ __forceinline__ void dev_wfp(PREF p, LAS unsigned char* lds) {
    LAS float* cs = (LAS float*)lds; LAS float* sn = cs + 128;
    const int tid = tid_opaque();
    if (tid < 128) { cs[tid] = cospif((float)tid * (1.0f / 64.0f)); sn[tid] = sinpif((float)tid * (1.0f / 64.0f)); }
    __syncthreads();
    for (int idx = blockIdx.x * NTHR + tid; idx < 1024 * 1024; idx += gridDim.x * NTHR) {
        const int d = idx >> 10, kap = idx & 1023, g = (kap & 511) >> 7, cc = kap & 127, iss = kap >> 9;
        const LAS float* tab = iss ? sn : cs; const float* wf = p.w_fourier + (size_t)(g * 128) * 1024 + d;
        float acc = 0.f;
        for (int kc = 0; kc < 128; ++kc) acc += tab[(kc * cc) & 127] * wf[(size_t)kc * 1024];
        p.Wfp[idx] = f2bf(acc * (iss ? -1.0f / 512.0f : 1.0f / 512.0f));
    }
    __syncthreads();
}
__device__ __forceinline__ void dev_dft(PREF p) {
    const int tid = tid_opaque();
    for (int i8 = blockIdx.x * NTHR + tid; i8 < 2048 * 2048 / 8; i8 += gridDim.x * NTHR) {
        const int m = i8 >> 8, t0 = (i8 & 255) * 8, mm = m & 1023, iss = m >> 10;
        float v[8];
#pragma unroll
        for (int j = 0; j < 8; ++j) { const int kk = (iss && mm == 0) ? 1024 : mm; const float a = (float)((kk * (t0 + j)) & 2047) * (1.0f / 2048.0f);
            v[j] = (iss && mm != 0) ? __builtin_amdgcn_sinf(a) : __builtin_amdgcn_cosf(a); }
        u32x4 o; o[0] = pk2(v[0], v[1]); o[1] = pk2(v[2], v[3]); o[2] = pk2(v[4], v[5]); o[3] = pk2(v[6], v[7]);
        *(u32x4*)(p.dft + (size_t)i8 * 8) = o;
    }
}
__device__ __forceinline__ void dev_pos(PREF p) {
    const int tid = tid_opaque();
    for (int idx = blockIdx.x * NTHR + tid; idx < SEQ * 512; idx += gridDim.x * NTHR) {
        const int t = idx >> 9, half = (idx >> 8) & 1, j = idx & 255;
        const float omega = 1.0f / powf(10000.0f, (float)j * (1.0f / 256.0f));
        const float arg = (float)(half == 0 ? (t >> 6) : (t & 63)) * omega;
        float* d = p.pos + (size_t)t * DM + half * 512 + j;
        d[0] = sinf(arg); d[256] = cosf(arg);
    }
}
__device__ __forceinline__ void dev_adaln(PREF p, LAS unsigned char* lds) {
    constexpr int SROW = 1032;
    LAS bf16_t* Sh = (LAS bf16_t*)lds; LAS bf16_t* Sl = Sh + 33 * SROW;
    const int tid = tid_opaque(), w = tid >> 6, l = tid & 63, c16 = l & 15, g = l >> 4;
    if ((int)blockIdx.x < 192) {
        for (int i = tid; i < 33 * 1024; i += NTHR) { const float v = (i < 32 * 1024) ? p.c[i] : p.c_ctx[i - 32 * 1024]; const float sv = v * sigmoid_f(v);
            const unsigned hi = pk2(sv, 0.f) & 0xffffu; const unsigned lo = pk2(sv - bflo(hi), 0.f) & 0xffffu; const int r = i >> 10, k = i & 1023;
            Sh[r * SROW + k] = (bf16_t)hi; Sl[r * SROW + k] = (bf16_t)lo; }
        __syncthreads();
        const int nt = w & 1, kq = w >> 1, n0 = blockIdx.x * 32 + nt * 16;
        f32x4 acc[3];
#pragma unroll
        for (int mt = 0; mt < 3; ++mt) acc[mt] = (f32x4){0.f, 0.f, 0.f, 0.f};
#pragma unroll
        for (int ks = 0; ks < 8; ++ks) { const int k0 = kq * 256 + ks * 32 + 8 * g;
            float wv[8];
#pragma unroll
            for (int j = 0; j < 8; ++j) wv[j] = p.w_mod[(size_t)(k0 + j) * 6144 + n0 + c16];
            u32x4 bh, bl;
#pragma unroll
            for (int j = 0; j < 4; ++j) { bh[j] = pk2(wv[2 * j], wv[2 * j + 1]); bl[j] = pk2(wv[2 * j] - bflo(bh[j]), wv[2 * j + 1] - bfhi(bh[j])); }
            const bf16x8 Bh = __builtin_bit_cast(bf16x8, bh), Bl = __builtin_bit_cast(bf16x8, bl);
#pragma unroll
            for (int mt = 0; mt < 3; ++mt) { const int row = min(mt * 16 + c16, 32);
                const bf16x8 Ah = *(const LAS bf16x8*)(Sh + row * SROW + k0), Al = *(const LAS bf16x8*)(Sl + row * SROW + k0);
                acc[mt] = __builtin_amdgcn_mfma_f32_16x16x32_bf16(Ah, Bh, acc[mt], 0, 0, 0);
                acc[mt] = __builtin_amdgcn_mfma_f32_16x16x32_bf16(Ah, Bl, acc[mt], 0, 0, 0);
                acc[mt] = __builtin_amdgcn_mfma_f32_16x16x32_bf16(Al, Bh, acc[mt], 0, 0, 0); }
        }
        __syncthreads();
        LAS float* red = (LAS float*)lds;
#pragma unroll
        for (int mt = 0; mt < 3; ++mt)
#pragma unroll
            for (int reg = 0; reg < 4; ++reg) red[(kq * 48 + mt * 16 + 4 * g + reg) * 32 + nt * 16 + c16] = acc[mt][reg];
        __syncthreads();
        for (int o = tid; o < 33 * 32; o += NTHR) { const int r = o >> 5, n = o & 31;
            const float sum = (red[(0 * 48 + r) * 32 + n] + red[(1 * 48 + r) * 32 + n]) + (red[(2 * 48 + r) * 32 + n] + red[(3 * 48 + r) * 32 + n]);
            p.mod[(size_t)r * 6144 + blockIdx.x * 32 + n] = sum + p.b_mod[blockIdx.x * 32 + n]; }
        __syncthreads();
    }
}

__device__ __forceinline__ void dev_norm(PREF p, int which, int rfirst = -1, int rstride = 0, int rend = 0) {
    const int tid = tid_opaque(); const int w = tid >> 6, lane = tid & 63;
    const int T = p.nb * SEQ, TC = (which == 0) ? p.nb * CTXL : 0, NR = T + TC;
    const int first = (rfirst >= 0 ? rfirst : (int)blockIdx.x * 8) + w, stride = rfirst >= 0 ? rstride : (int)gridDim.x * 8, REND = rfirst >= 0 ? rend : NR;
#define NORM_LOAD(XV, PV, r) do { const int r_ = (r) < NR ? (r) : NR - 1; const bool c_ = r_ >= T; const int lr_ = c_ ? r_ - T : r_; \
        const float* s_ = c_ ? p.ctx + (size_t)lr_ * DM : p.x + (size_t)lr_ * DM; \
        _Pragma("unroll") for (int i_ = 0; i_ < 4; ++i_) { const int d_ = 4 * lane + 256 * i_; \
            if (which == 1) { const u32x2 q_ = *(const u32x2*)(p.x1b + (size_t)lr_ * DM + d_); XV[i_] = (f32x4){bflo(q_[0]), bfhi(q_[0]), bflo(q_[1]), bfhi(q_[1])}; } else XV[i_] = __builtin_nontemporal_load((const f32x4*)(s_ + d_)); \
            PV[i_] = (which == 0 && !c_) ? (pos_fixed ? pfix[i_] : *(const f32x4*)(p.pos + (size_t)(lr_ & 2047) * DM + d_)) : (f32x4){0.f, 0.f, 0.f, 0.f}; } } while (0)
    const bool pos_fixed = (which == 0) && (stride % SEQ == 0) && (first < T);
    f32x4 pfix[4];
#pragma unroll
    for (int i = 0; i < 4; ++i) pfix[i] = pos_fixed ? *(const f32x4*)(p.pos + (size_t)(first & 2047) * DM + 4 * lane + 256 * i) : (f32x4){0.f, 0.f, 0.f, 0.f};
    f32x4 xv[4], pv[4], xn[4], pn[4];
    if (first < NR) NORM_LOAD(xv, pv, first);
    for (int row = first; row < REND; row += stride) {
        NORM_LOAD(xn, pn, row + stride);
        const bool isctx = row >= T; const int lrow = isctx ? row - T : row;
        const int b = isctx ? 32 : (lrow >> 11);
        const float* g = (which == 0) ? p.norm1_g : p.norm2_g;
        const float* md = p.mod + (size_t)b * 6144 + (which == 0 ? 0 : 3 * 1024);
        bf16_t* dst = (which == 1) ? p.h2 + (size_t)lrow * DM : (isctx ? p.hc + (size_t)lrow * DM : p.h + (size_t)lrow * DM);
        f32x4 v[4]; float ss = 0.f;
#pragma unroll
        for (int i = 0; i < 4; ++i) { v[i] = xv[i] + pv[i];
            ss += (v[i][0] * v[i][0] + v[i][1] * v[i][1]) + (v[i][2] * v[i][2] + v[i][3] * v[i][3]); }
        ss = wave_sum(ss);
        const float rs = rsqrtf(ss * (1.0f / 1024.0f) + 1e-6f);
#pragma unroll
        for (int i = 0; i < 4; ++i) { const int d = 4 * lane + 256 * i;
            const f32x4 gg = *(const f32x4*)(g + d), sh = *(const f32x4*)(md + d), sc = *(const f32x4*)(md + 1024 + d);
            f32x4 y;
#pragma unroll
            for (int j = 0; j < 4; ++j) y[j] = (v[i][j] * rs * gg[j]) * (1.0f + sc[j]) + sh[j];
            u32x2 o; o[0] = pk2(y[0], y[1]); o[1] = pk2(y[2], y[3]);
            *(u32x2*)(dst + d) = o;
            if (which == 1) { int w8 = 0; w8 = __builtin_amdgcn_cvt_pk_fp8_f32(y[0] * 4.0f, y[1] * 4.0f, w8, false); w8 = __builtin_amdgcn_cvt_pk_fp8_f32(y[2] * 4.0f, y[3] * 4.0f, w8, true);
                *(unsigned*)(p.h8 + (size_t)lrow * DM + d) = (unsigned)w8; } }
#pragma unroll
        for (int i = 0; i < 4; ++i) { xv[i] = xn[i]; pv[i] = pn[i]; }
    }
#undef NORM_LOAD
}

namespace pg8 {
constexpr int BM = 256, BK = 64, HALF = 128, HTB = HALF * BK * 2, STAGE_BYTES = 8 * HTB, NXCD = 8, WGM = 8;
__host__ __device__ __forceinline__ int lds_byte(int r, int c) { const int st = (r >> 4) * 2 + (c >> 5), rr = r & 15, cc = c & 31, ob = rr * 64 + cc * 2; return st * 1024 + (ob ^ (((ob >> 9) & 1) << 5)); }
__host__ __device__ __forceinline__ void stage_rc(int b, int& R, int& C) { const int st = b / 1024, sb = b % 1024, swz = sb ^ (((sb >> 9) & 1) << 5); R = (st >> 1) * 16 + swz / 64; C = (st & 1) * 32 + (swz % 64) / 2; }
__host__ __device__ __forceinline__ int perm32(int rho) { const int n = rho >> 4, i = rho & 15; return 8 * (i >> 2) + 4 * n + (i & 3); }
struct Unit { int pm, pn, z; };
struct Gemm { const bf16_t* A; const bf16_t* Bt; int K, lda, ldb; long aZ, bZ; int natA = 0, natB = 0; };
struct StaticOrder {
    int nM, nN, nwg, G, c;
    __device__ void init(int M, int N, int G_, int c_) { nM = M / BM; nN = N / BM; nwg = nM * nN; G = G_; c = c_; }
    __device__ bool next(int i, Unit& u) const {
        const long L = (long)i * G + c; if (L >= nwg) return false;
        int wgid = (int)L; { const int q = nwg / NXCD, r = nwg % NXCD, xcd = wgid % NXCD, off = wgid / NXCD; wgid = (xcd < r ? xcd * (q + 1) : r * (q + 1) + (xcd - r) * q) + off; }
        const int nig = WGM * nN, gid = wgid / nig, fm = gid * WGM, gsz = (nM - fm) < WGM ? (nM - fm) : WGM;
        u.pm = fm + ((wgid % nig) % gsz); u.pn = (wgid % nig) / gsz; u.z = 0; return true;
    }
};
struct BatchOrder {
    int nM, nN, nz, G, c;
    __device__ void init(int M, int N, int nz_, int G_, int c_) { nM = M / BM; nN = N / BM; nz = nz_; G = G_; c = c_; }
    __device__ bool next(int i, Unit& u) const {
        const long L = (long)i * G + c; const int per = nM * nN; if (L >= (long)per * nz) return false;
        u.z = (int)(L / per); const int r = (int)(L % per); u.pm = r % nM; u.pn = r / nM; return true;
    }
};

template <class Epi, class Sched>
__device__ __forceinline__ void gemm_phase(LAS unsigned char* lds, const Gemm g, const Sched& S, const Epi& E) {
    const int tid = tid_opaque(), wid = __builtin_amdgcn_readfirstlane(tid >> 6), lane = tid & 63, wr = wid >> 2, wc = wid & 3, fr = lane & 15, fq = lane >> 4;
    const int K = g.K, nt = K / BK;
    unsigned voffA[2], voffB[2];
#pragma unroll
    for (int i = 0; i < 2; ++i) { int R, C; stage_rc(tid * 16 + i * 8192, R, C); const int Rb = Epi::PERM ? ((R & ~31) + perm32(R & 31)) : R;
#define PG8_NATOFF(R_, C_) ((unsigned)(((((R_) >> 6) & 1) * 4 + ((C_) >> 5)) * 8192 + ((((R_) >> 4) & 3) * 2) * 512 + (((R_) & 15) + 16 * (((C_) >> 3) & 3)) * 8) * 2u)
        voffA[i] = g.natA ? PG8_NATOFF(R, C) : (unsigned)(R * g.lda + C) * 2u; voffB[i] = g.natB ? PG8_NATOFF(Rb, C) : (unsigned)(Rb * g.ldb + C) * 2u; }
#undef PG8_NATOFF
    const int s0A = g.natA ? 32768 : BK * 2, s1A = g.natA ? 1024 : BK * 4, s2A = g.natA ? 131072 : BK * 8;
    const int s0B = g.natB ? 32768 : BK * 2, s1B = g.natB ? 1024 : BK * 4, s2B = g.natB ? 131072 : BK * 8;
    const size_t hstepA = g.natA ? (size_t)8192 : (size_t)HALF * g.lda * 2, hstepB = g.natB ? (size_t)8192 : (size_t)HALF * g.ldb * 2;
    const size_t tstepA = (size_t)BM * g.lda * 2, tstepB = (size_t)BM * g.ldb * 2;
    const unsigned ldsw = (unsigned)wid * 1024u;
    const int aoff = lds_byte(wr * 64 + fr, fq * 8), boff = lds_byte(wc * 32 + fr, fq * 8);
#define PG8_SA(b, h) (((b) * 2 + (h)) * HTB)
#define PG8_SB(b, h) ((4 + (b) * 2 + (h)) * HTB)
#define PG8_STAGE(bufoff, gbase, voff) do { _Pragma("unroll") for (int _i = 0; _i < 2; ++_i) \
        __builtin_amdgcn_global_load_lds((const unsigned*)((const char*)(gbase) + (voff)[_i]), (LAS unsigned*)(lds + (bufoff) + ldsw + _i * 8192), 16, 0, 0); } while (0)
#define PG8_LDA(dst, b, h) do { _Pragma("unroll") for (int m = 0; m < 4; ++m) _Pragma("unroll") for (int k = 0; k < 2; ++k) dst[m][k] = *(const LAS bf16x8*)(lds + PG8_SA(b, h) + aoff + m * 2048 + k * 1024); } while (0)
#define PG8_LDB(dst, b, h) do { _Pragma("unroll") for (int n = 0; n < 2; ++n) _Pragma("unroll") for (int k = 0; k < 2; ++k) dst[n][k] = *(const LAS bf16x8*)(lds + PG8_SB(b, h) + boff + n * 2048 + k * 1024); } while (0)
#define PG8_MMA(ai, bj, At, Bt) do { __builtin_amdgcn_s_setprio(1); _Pragma("unroll") for (int m = 0; m < 4; ++m) _Pragma("unroll") for (int n = 0; n < 2; ++n) _Pragma("unroll") for (int k = 0; k < 2; ++k) \
        acc[ai][bj][m][n] = __builtin_amdgcn_mfma_f32_16x16x32_bf16(Bt[n][k], At[m][k], acc[ai][bj][m][n], 0, 0, 0); __builtin_amdgcn_s_setprio(0); } while (0)
#define PG8_WAIT_V(n) asm volatile("s_waitcnt vmcnt(" #n ")" ::: "memory")
#define PG8_WAIT_L(n) asm volatile("s_waitcnt lgkmcnt(" #n ")" ::: "memory")
#define PG8_BAR __builtin_amdgcn_s_barrier()
#define PG8_SCHED __builtin_amdgcn_sched_barrier(0)
    Unit cur, nxt; int ui = 0;
    if (!S.next(0, cur)) return;
    f32x4 acc[2][2][4][2];
#pragma unroll
    for (int a = 0; a < 2; ++a)
#pragma unroll
        for (int b = 0; b < 2; ++b)
#pragma unroll
            for (int m = 0; m < 4; ++m)
#pragma unroll
                for (int n = 0; n < 2; ++n) acc[a][b][m][n] = (f32x4){0.f, 0.f, 0.f, 0.f};
    bf16x8 At[4][2], B0[2][2], B1[2][2];
    const char* cA = (const char*)g.A + (size_t)cur.pm * tstepA + (size_t)cur.z * g.aZ * 2; const char* cB = (const char*)g.Bt + (size_t)cur.pn * tstepB + (size_t)cur.z * g.bZ * 2;
    PG8_STAGE(PG8_SB(0, 0), cB, voffB); PG8_STAGE(PG8_SA(0, 0), cA, voffA); PG8_STAGE(PG8_SB(0, 1), cB + hstepB, voffB); PG8_STAGE(PG8_SA(0, 1), cA + hstepA, voffA);
    if (wr == 1) PG8_BAR;
    PG8_WAIT_V(4); PG8_BAR;
    PG8_STAGE(PG8_SB(1, 0), cB + s0B, voffB); PG8_STAGE(PG8_SA(1, 0), cA + s0A, voffA); PG8_STAGE(PG8_SB(1, 1), cB + hstepB + s0B, voffB);
    PG8_WAIT_V(6); PG8_BAR;
    for (;;) {
        const bool has_next = S.next(ui + 1, nxt);
        const char* nA = has_next ? (const char*)g.A + (size_t)nxt.pm * tstepA + (size_t)nxt.z * g.aZ * 2 : cA;
        const char* nB = has_next ? (const char*)g.Bt + (size_t)nxt.pn * tstepB + (size_t)nxt.z * g.bZ * 2 : cB;
        for (int t = 0; t < nt; t += 2) {
            const bool last = (t == nt - 2);
            const int th = t >> 1, tn = th + 1;
            const char* a1 = cA + (size_t)(th >> 1) * s2A + (th & 1) * s1A + s0A;
            const char* a2 = last ? nA : cA + (size_t)(tn >> 1) * s2A + (tn & 1) * s1A; const char* b2 = last ? nB : cB + (size_t)(tn >> 1) * s2B + (tn & 1) * s1B;
            const char* a3 = a2 + s0A; const char* b3 = b2 + s0B;
            PG8_LDB(B0, 0, 0); PG8_SCHED; PG8_LDA(At, 0, 0); PG8_STAGE(PG8_SA(1, 1), a1 + hstepA, voffA);
            PG8_WAIT_L(8); PG8_BAR; PG8_WAIT_L(0); PG8_MMA(0, 0, At, B0); PG8_BAR; PG8_SCHED;
            PG8_LDB(B1, 0, 1); PG8_STAGE(PG8_SB(0, 0), b2, voffB);
            PG8_BAR; PG8_WAIT_L(0); PG8_MMA(0, 1, At, B1); PG8_BAR;
            PG8_LDA(At, 0, 1); PG8_STAGE(PG8_SA(0, 0), a2, voffA);
            PG8_BAR; PG8_WAIT_L(0); PG8_MMA(1, 0, At, B0); PG8_BAR; PG8_SCHED;
            PG8_STAGE(PG8_SB(0, 1), b2 + hstepB, voffB);
            PG8_WAIT_V(6); PG8_BAR; PG8_MMA(1, 1, At, B1); PG8_BAR;
            PG8_LDB(B0, 1, 0); PG8_SCHED; PG8_LDA(At, 1, 0); PG8_STAGE(PG8_SA(0, 1), a2 + hstepA, voffA);
            PG8_WAIT_L(8); PG8_BAR; PG8_WAIT_L(0); PG8_MMA(0, 0, At, B0); PG8_BAR; PG8_SCHED;
            PG8_LDB(B1, 1, 1); PG8_STAGE(PG8_SB(1, 0), b3, voffB);
            PG8_BAR; PG8_WAIT_L(0); PG8_MMA(0, 1, At, B1); PG8_BAR;
            PG8_LDA(At, 1, 1); PG8_STAGE(PG8_SA(1, 0), a3, voffA);
            PG8_BAR; PG8_WAIT_L(0); PG8_MMA(1, 0, At, B0); PG8_BAR; PG8_SCHED;
            PG8_STAGE(PG8_SB(1, 1), b3 + hstepB, voffB);
            PG8_WAIT_V(6); PG8_BAR; PG8_MMA(1, 1, At, B1); PG8_BAR;
        }
        E(acc, cur, wr, wc, fr, fq);
        if (!has_next) break;
#pragma unroll
        for (int a = 0; a < 2; ++a)
#pragma unroll
            for (int b = 0; b < 2; ++b)
#pragma unroll
                for (int m = 0; m < 4; ++m)
#pragma unroll
                    for (int n = 0; n < 2; ++n) acc[a][b][m][n] = (f32x4){0.f, 0.f, 0.f, 0.f};
        cur = nxt; cA = nA; cB = nB; ++ui;
    }
    PG8_WAIT_V(0);
    if (wr == 0) PG8_BAR;
    PG8_BAR;
#undef PG8_SA
#undef PG8_SB
#undef PG8_STAGE
#undef PG8_LDA
#undef PG8_LDB
#undef PG8_MMA
#undef PG8_WAIT_V
#undef PG8_WAIT_L
#undef PG8_BAR
#undef PG8_SCHED
}

__device__ __forceinline__ u32x4 pack8(const f32x4 v0, const f32x4 v1) { u32x4 w; w[0] = pk2(v0[0], v0[1]); w[1] = pk2(v0[2], v0[3]); w[2] = pk2(v1[0], v1[1]); w[3] = pk2(v1[2], v1[3]); return w; }
#define QMAP(pm_) ((((pm_) >> 4) & 1) * 128 + ((pm_) >> 5) * 16 + ((pm_) & 15))
struct EpiAct {
    static constexpr bool PERM = true;
    bf16_t* O; size_t segstride; int actmask; int segtiles; int ldc; int nt; int native; int qmap = 0;
    template <int ACT, bool NT, bool NATIVE>
    __device__ __forceinline__ void body(const f32x4 (&acc)[2][2][4][2], bf16_t* base, int row0, int col0, size_t toff) const {
#pragma unroll
        for (int ai = 0; ai < 2; ++ai)
#pragma unroll
            for (int m = 0; m < 4; ++m) { bf16_t* rowp = NATIVE ? base + toff + ((ai * 4 + m) * 2) * 512 : base + (size_t)(row0 + ai * HALF + m * 16) * ldc + col0;
#pragma unroll
                for (int bj = 0; bj < 2; ++bj) { f32x4 v0 = acc[ai][bj][m][0], v1 = acc[ai][bj][m][1];
                    if (ACT == 1) { const f32x2 a = gelu2((f32x2){v0[0], v0[1]}), b = gelu2((f32x2){v0[2], v0[3]}), c = gelu2((f32x2){v1[0], v1[1]}), d = gelu2((f32x2){v1[2], v1[3]});
                        v0 = (f32x4){a[0], a[1], b[0], b[1]}; v1 = (f32x4){c[0], c[1], d[0], d[1]}; }
                    else if (ACT == 2) { const f32x2 a = sigmoid2((f32x2){v0[0], v0[1]}), b = sigmoid2((f32x2){v0[2], v0[3]}), c = sigmoid2((f32x2){v1[0], v1[1]}), d = sigmoid2((f32x2){v1[2], v1[3]});
                        v0 = (f32x4){a[0], a[1], b[0], b[1]}; v1 = (f32x4){c[0], c[1], d[0], d[1]}; }
                    bf16_t* dp = NATIVE ? rowp + bj * 512 : rowp + bj * HALF;
                    if (NT) __builtin_nontemporal_store(pack8(v0, v1), (u32x4*)dp); else *(u32x4*)dp = pack8(v0, v1); } }
    }
    __device__ __forceinline__ void operator()(const f32x4 (&acc)[2][2][4][2], const Unit& u, int wr, int wc, int fr, int fq) const {
        const int seg = u.pn / segtiles, colt = (u.pn - seg * segtiles) * BM;
        bf16_t* base = O + (size_t)seg * segstride; const int act = seg < 8 ? ((actmask >> (4 * seg)) & 15) : 0;
        const int row0 = u.pm * BM + wr * 64 + fr, col0 = colt + wc * 32 + 8 * fq;
        const int pmx = qmap ? QMAP(u.pm) : u.pm;
        const size_t toff = ((size_t)pmx * (ldc >> 8) + (u.pn - seg * segtiles)) * 65536 + (size_t)(wr * 4 + wc) * 8192 + (size_t)(fr + 16 * fq) * 8;
        if (act == 1) body<1, true, false>(acc, base, row0, col0, 0); else if (act == 2) body<2, true, true>(acc, base, row0, col0, toff); else if (native) body<0, true, true>(acc, base, row0, col0, toff); else if (nt) body<0, true, false>(acc, base, row0, col0, 0); else body<0, false, false>(acc, base, row0, col0, 0);
    }
};
struct EpiUV {
    static constexpr bool PERM = true;
    bf16_t* UV;
    __device__ __forceinline__ void operator()(const f32x4 (&acc)[2][2][4][2], const Unit& u, int wr, int wc, int fr, int fq) const {
        const int isv = u.pm >> 2, mp0 = (u.pm & 3) * BM + wr * 64 + fr, colb = u.pn * BM + wc * 32 + 8 * fq;
        bf16_t* base = UV + (size_t)u.z * SEQ * DM;
#pragma unroll
        for (int ai = 0; ai < 2; ++ai)
#pragma unroll
            for (int m = 0; m < 4; ++m) { const int mp = mp0 + ai * HALF + m * 16;
#pragma unroll
                for (int bj = 0; bj < 2; ++bj) { const u32x4 v = pack8(acc[ai][bj][m][0], acc[ai][bj][m][1]); const int col = colb + bj * HALF;
                    if (!isv) { *(u32x4*)(base + (size_t)mp * DM + col) = v; if (mp) *(u32x4*)(base + (size_t)(SEQ - mp) * DM + col) = v; }
                    else if (mp == 0) { *(u32x4*)(base + (size_t)1024 * DM + col) = v; const u32x4 z = (u32x4){0u, 0u, 0u, 0u};
                        *(u32x4*)(base + 512 + col) = z; *(u32x4*)(base + (size_t)1024 * DM + 512 + col) = z; }
                    else { *(u32x4*)(base + (size_t)mp * DM + 512 + col) = v; const u32x4 nv = (u32x4){v[0] ^ 0x80008000u, v[1] ^ 0x80008000u, v[2] ^ 0x80008000u, v[3] ^ 0x80008000u};
                        *(u32x4*)(base + (size_t)(SEQ - mp) * DM + 512 + col) = nv; } } }
    }
};
struct EpiGate {
    static constexpr bool PERM = true;
    const bf16_t* gate; const bf16_t* addsrc; bf16_t* dst;
    __device__ __forceinline__ void operator()(const f32x4 (&acc)[2][2][4][2], const Unit& u, int wr, int wc, int fr, int fq) const {
        const size_t toff = ((size_t)u.pm * 4 + u.pn) * 65536 + (size_t)(wr * 4 + wc) * 8192 + (size_t)(fr + 16 * fq) * 8;
#pragma unroll
        for (int ai = 0; ai < 2; ++ai)
#pragma unroll
            for (int m = 0; m < 4; ++m) {
#pragma unroll
                for (int bj = 0; bj < 2; ++bj) { const size_t noff = toff + ((ai * 4 + m) * 2 + bj) * 512;
                    const u32x4 gv = __builtin_nontemporal_load((const u32x4*)(gate + noff));
                    f32x4 v0 = acc[ai][bj][m][0], v1 = acc[ai][bj][m][1];
                    v0[0] *= bflo(gv[0]); v0[1] *= bfhi(gv[0]); v0[2] *= bflo(gv[1]); v0[3] *= bfhi(gv[1]);
                    v1[0] *= bflo(gv[2]); v1[1] *= bfhi(gv[2]); v1[2] *= bflo(gv[3]); v1[3] *= bfhi(gv[3]);
                    if (addsrc) { const u32x4 av = *(const u32x4*)(addsrc + noff);
                        v0[0] += bflo(av[0]); v0[1] += bfhi(av[0]); v0[2] += bflo(av[1]); v0[3] += bfhi(av[1]);
                        v1[0] += bflo(av[2]); v1[1] += bfhi(av[2]); v1[2] += bflo(av[3]); v1[3] += bfhi(av[3]); }
                    *(u32x4*)(dst + noff) = pack8(v0, v1); } }
    }
};
struct EpiX1 {
    static constexpr bool PERM = true;
    const float *x, *pos, *mod, *b_out; bf16_t* x1b;
    __device__ __forceinline__ void operator()(const f32x4 (&acc)[2][2][4][2], const Unit& u, int wr, int wc, int fr, int fq) const {
        const int row0 = u.pm * BM + wr * 64 + fr, col0 = u.pn * BM + wc * 32 + 8 * fq;
        const int b = (u.pm * BM) >> 11;
        f32x4 bv[2][2], gv[2][2];
#pragma unroll
        for (int bj = 0; bj < 2; ++bj)
#pragma unroll
            for (int n = 0; n < 2; ++n) { bv[bj][n] = *(const f32x4*)(b_out + col0 + bj * HALF + 4 * n); gv[bj][n] = *(const f32x4*)(mod + (size_t)b * 6144 + 2 * 1024 + col0 + bj * HALF + 4 * n); }
#pragma unroll
        for (int ai = 0; ai < 2; ++ai)
#pragma unroll
            for (int m = 0; m < 4; ++m) { const int row = row0 + ai * HALF + m * 16; const size_t off = (size_t)row * DM + col0; const size_t poff = (size_t)(row & 2047) * DM + col0;
#pragma unroll
                for (int bj = 0; bj < 2; ++bj) { f32x4 r[2];
#pragma unroll
                    for (int n = 0; n < 2; ++n) { const f32x4 xv = __builtin_nontemporal_load((const f32x4*)(x + off + bj * HALF + 4 * n)), pv = *(const f32x4*)(pos + poff + bj * HALF + 4 * n);
                        r[n] = xv + pv + gv[bj][n] * (acc[ai][bj][m][n] + bv[bj][n]); }
                    *(u32x4*)(x1b + off + bj * HALF) = pack8(r[0], r[1]); } }
    }
};
}

constexpr int XC_STRIDE = 272;
constexpr int HT_STRIDE = 132;
constexpr int XC_BYTES = 64 * XC_STRIDE, HT_BYTES = 64 * HT_STRIDE * 4, SCAN_CW_OFF = 2 * XC_BYTES + 2 * HT_BYTES;
template <int DIR>
__device__ __forceinline__ void scan_dir(PREF p, LAS unsigned char* lds, int b, int head) {
    const int tid = tid_opaque(), w = tid >> 6, l = tid & 63, c16 = l & 15, q4 = l >> 4;
    LAS float* CW = (LAS float*)(lds + SCAN_CW_OFF);
    const int ch = head * 128 + 16 * w + c16;
    bf16x8 bfa[4], bfx[4];
    {
        const bf16_t* Ga = p.gates_bf + ((size_t)((DIR * 2 + 0) * 8 + head) * 128 + 16 * w + c16) * 128 + 8 * q4;
        const bf16_t* Gx = p.gates_bf + ((size_t)((DIR * 2 + 1) * 8 + head) * 128 + 16 * w + c16) * 128 + 8 * q4;
#pragma unroll
        for (int ks = 0; ks < 4; ++ks) { bfa[ks] = *(const bf16x8*)(Ga + 32 * ks); bfx[ks] = *(const bf16x8*)(Gx + 32 * ks); }
    }
    const float nba = -1.4426950409f * p.lru_ba[DIR * 1024 + ch], nbx = -1.4426950409f * p.lru_bx[DIR * 1024 + ch];
    const float m8sp = -8.0f * log1pf(expf(-p.lru_lambda[DIR * 1024 + ch])) * 1.4426950409f;
    const int pos4 = DIR == 0 ? q4 : 3 - q4;
    const int src1 = (DIR == 0 ? l - 16 : l + 16) & 63, src2 = (DIR == 0 ? l - 32 : l + 32) & 63, srcl = DIR == 0 ? c16 + 48 : c16;
    float carry = 0.f;
    const int tt = tid >> 3, cg = tid & 7;
#define SCAN_CREF(k, SEQI, T0, TSEQ, SRC) const int SEQI = (k) >= 4 ? 1 : 0; const int TSEQ = SEQI ? SEQ : CTXL; \
        const int T0 = (DIR == 0 ? (SEQI ? (k) - 4 : (k)) : (SEQI ? 35 - (k) : 3 - (k))) * 64; const bf16_t* SRC = SEQI ? p.zx + (size_t)b * SEQ * DM : p.zxc + (size_t)b * CTXL * DM;
#define SCAN_LOADZ(k) do { SCAN_CREF(k, sq_, t0_, ts_, sr_) \
        if (t0_ >= 1 && t0_ + 66 <= ts_) { const bf16_t* zp_ = sr_ + (size_t)(t0_ + tt - 1) * DM + head * 128 + 16 * cg;     \
            _Pragma("unroll") for (int r_ = 0; r_ < 4; ++r_) { Z[2 * r_] = *(const u32x4*)(zp_ + (size_t)r_ * DM); Z[2 * r_ + 1] = *(const u32x4*)(zp_ + (size_t)r_ * DM + 8); } } \
        else { _Pragma("unroll") for (int r_ = 0; r_ < 4; ++r_) { const int tr_ = t0_ + tt - 1 + r_; const bool ok_ = tr_ >= 0 && tr_ < ts_; \
            const bf16_t* zp_ = sr_ + (size_t)(ok_ ? tr_ : 0) * DM + head * 128 + 16 * cg; const u32x4 za_ = *(const u32x4*)zp_, zb_ = *(const u32x4*)(zp_ + 8); const u32x4 zz_ = (u32x4){0u, 0u, 0u, 0u}; \
            Z[2 * r_] = ok_ ? za_ : zz_; Z[2 * r_ + 1] = ok_ ? zb_ : zz_; } } } while (0)
#define SCAN_BUILD(XCB) do { f32x2 xc2[8]; \
        { const LAS f32x4* cb_ = (const LAS f32x4*)(CW + 4 * 128 + 16 * cg); _Pragma("unroll") for (int j4 = 0; j4 < 4; ++j4) { const f32x4 v_ = cb_[j4]; xc2[2 * j4] = (f32x2){v_[0], v_[1]}; xc2[2 * j4 + 1] = (f32x2){v_[2], v_[3]}; } } \
        _Pragma("unroll") for (int r = 0; r < 4; ++r) { const u32x4 z0 = Z[2 * r], z1 = Z[2 * r + 1]; const LAS f32x4* cw_ = (const LAS f32x4*)(CW + r * 128 + 16 * cg); \
            _Pragma("unroll") for (int j4 = 0; j4 < 4; ++j4) { const f32x4 w_ = cw_[j4]; const unsigned da_ = j4 < 2 ? z0[2 * j4] : z1[2 * (j4 - 2)], db_ = j4 < 2 ? z0[2 * j4 + 1] : z1[2 * (j4 - 2) + 1]; \
                xc2[2 * j4] = (f32x2){w_[0], w_[1]} * (f32x2){bflo(da_), bfhi(da_)} + xc2[2 * j4]; xc2[2 * j4 + 1] = (f32x2){w_[2], w_[3]} * (f32x2){bflo(db_), bfhi(db_)} + xc2[2 * j4 + 1]; } } \
        u32x4 o0_, o1_; o0_[0] = pk2(xc2[0][0], xc2[0][1]); o0_[1] = pk2(xc2[1][0], xc2[1][1]); o0_[2] = pk2(xc2[2][0], xc2[2][1]); o0_[3] = pk2(xc2[3][0], xc2[3][1]); \
        o1_[0] = pk2(xc2[4][0], xc2[4][1]); o1_[1] = pk2(xc2[5][0], xc2[5][1]); o1_[2] = pk2(xc2[6][0], xc2[6][1]); o1_[3] = pk2(xc2[7][0], xc2[7][1]); \
        *(LAS u32x4*)((XCB) + tt * XC_STRIDE + cg * 32) = o0_; *(LAS u32x4*)((XCB) + tt * XC_STRIDE + cg * 32 + 16) = o1_; } while (0)
    u32x4 Z[8];
    SCAN_LOADZ(0);
    SCAN_BUILD(lds);
    SCAN_LOADZ(1);
    __syncthreads();
    size_t off_prev = 0; int seqi_prev = 0;
    u32x4 f0 = (u32x4){0u, 0u, 0u, 0u}, f1 = f0, g0 = f0, g1 = f0;
    for (int k = 0; k <= 36; ++k) {
        if (k > 0 && seqi_prev == 1) {
            const LAS float* HTp = (const LAS float*)(lds + 2 * XC_BYTES + ((k - 1) & 1) * HT_BYTES);
            const LAS f32x4* hp = (const LAS f32x4*)(HTp + tt * HT_STRIDE + 16 * cg);
            const f32x4 h0 = hp[0], h1 = hp[1], h2 = hp[2], h3 = hp[3];
            const size_t off = off_prev;
            if (DIR == 0) {
                *(u32x4*)(p.hf + off) = pg8::pack8(h0, h1); *(u32x4*)(p.hf + off + 8) = pg8::pack8(h2, h3);
            } else {
                f32x4 y0, y1, y2, y3;
                y0[0] = (h0[0] + bflo(f0[0])) * bflo(g0[0]); y0[1] = (h0[1] + bfhi(f0[0])) * bfhi(g0[0]); y0[2] = (h0[2] + bflo(f0[1])) * bflo(g0[1]); y0[3] = (h0[3] + bfhi(f0[1])) * bfhi(g0[1]);
                y1[0] = (h1[0] + bflo(f0[2])) * bflo(g0[2]); y1[1] = (h1[1] + bfhi(f0[2])) * bfhi(g0[2]); y1[2] = (h1[2] + bflo(f0[3])) * bflo(g0[3]); y1[3] = (h1[3] + bfhi(f0[3])) * bfhi(g0[3]);
                y2[0] = (h2[0] + bflo(f1[0])) * bflo(g1[0]); y2[1] = (h2[1] + bfhi(f1[0])) * bfhi(g1[0]); y2[2] = (h2[2] + bflo(f1[1])) * bflo(g1[1]); y2[3] = (h2[3] + bfhi(f1[1])) * bfhi(g1[1]);
                y3[0] = (h3[0] + bflo(f1[2])) * bflo(g1[2]); y3[1] = (h3[1] + bfhi(f1[2])) * bfhi(g1[2]); y3[2] = (h3[2] + bflo(f1[3])) * bflo(g1[3]); y3[3] = (h3[3] + bfhi(f1[3])) * bfhi(g1[3]);
                *(u32x4*)(p.ybin + off) = pg8::pack8(y0, y1); *(u32x4*)(p.ybin + off + 8) = pg8::pack8(y2, y3);
            }
        }
        if (k == 36) break;
        if (k + 1 < 36) { SCAN_BUILD(lds + ((k + 1) & 1) * XC_BYTES); if (k + 2 < 36) SCAN_LOADZ(k + 2); }
        SCAN_CREF(k, seqi, t0, Tseq, src) (void)Tseq; (void)src;
        {
            const size_t off = ((size_t)b * SEQ + t0 + tt) * DM + head * 128 + 16 * cg;
            if (DIR == 1 && seqi == 1) { f0 = *(const u32x4*)(p.hf + off); f1 = *(const u32x4*)(p.hf + off + 8); g0 = __builtin_nontemporal_load((const u32x4*)(p.gzy + off)); g1 = __builtin_nontemporal_load((const u32x4*)(p.gzy + off + 8)); }
            off_prev = off; seqi_prev = seqi;
        }
        {
            const LAS unsigned char* XC = lds + (k & 1) * XC_BYTES;
            LAS float* HT = (LAS float*)(lds + 2 * XC_BYTES + (k & 1) * HT_BYTES);
            f32x4 accr[4], acci[4];
#pragma unroll
            for (int mt = 0; mt < 4; ++mt) { accr[mt] = (f32x4){0.f, 0.f, 0.f, 0.f}; acci[mt] = (f32x4){0.f, 0.f, 0.f, 0.f}; }
#pragma unroll
            for (int mt = 0; mt < 4; ++mt)
#pragma unroll
                for (int ks = 0; ks < 4; ++ks) { const bf16x8 a = *(const LAS bf16x8*)(XC + (16 * mt + c16) * XC_STRIDE + (32 * ks + 8 * q4) * 2);
                    accr[mt] = __builtin_amdgcn_mfma_f32_16x16x32_bf16(a, bfa[ks], accr[mt], 0, 0, 0);
                    acci[mt] = __builtin_amdgcn_mfma_f32_16x16x32_bf16(a, bfx[ks], acci[mt], 0, 0, 0); }
#pragma unroll
            for (int mi = 0; mi < 4; ++mi) {
                const int mt = DIR == 0 ? mi : 3 - mi;
                float av[4], bv[4];
#pragma unroll
                for (int reg = 0; reg < 4; ++reg) {
                    const float xcv = bf2f(*(const LAS bf16_t*)(XC + (16 * mt + 4 * q4 + reg) * XC_STRIDE + (16 * w + c16) * 2));
                    const float r = __builtin_amdgcn_rcpf(1.0f + __builtin_amdgcn_exp2f(__builtin_fmaf(accr[mt][reg], -1.4426950409f, nba))), ig = __builtin_amdgcn_rcpf(1.0f + __builtin_amdgcn_exp2f(__builtin_fmaf(acci[mt][reg], -1.4426950409f, nbx)));
                    const float a = __builtin_amdgcn_exp2f(m8sp * r);
                    av[reg] = a; bv[reg] = __builtin_amdgcn_sqrtf(1.0f - a * a) * ig * xcv;
                }
                float A, B;
                if (DIR == 0) { A = av[0]; B = bv[0];
#pragma unroll
                    for (int reg = 1; reg < 4; ++reg) { B = av[reg] * B + bv[reg]; A *= av[reg]; } }
                else { A = av[3]; B = bv[3];
#pragma unroll
                    for (int reg = 2; reg >= 0; --reg) { B = av[reg] * B + bv[reg]; A *= av[reg]; } }
                { const float A1 = __shfl(A, src1), B1 = __shfl(B, src1); if (pos4 >= 1) { B = A * B1 + B; A = A * A1; } }
                { const float A2 = __shfl(A, src2), B2 = __shfl(B, src2); if (pos4 >= 2) { B = A * B2 + B; A = A * A2; } }
                float Aex = __shfl(A, src1), Bex = __shfl(B, src1); if (pos4 == 0) { Aex = 1.f; Bex = 0.f; }
                const float A3 = __shfl(A, srcl), B3 = __shfl(B, srcl);
                float hs = Aex * carry + Bex;
                float st[4];
                if (DIR == 0) {
#pragma unroll
                    for (int reg = 0; reg < 4; ++reg) { hs = av[reg] * hs + bv[reg]; st[reg] = hs; } }
                else {
#pragma unroll
                    for (int reg = 3; reg >= 0; --reg) { hs = av[reg] * hs + bv[reg]; st[reg] = hs; } }
                carry = A3 * carry + B3;
                if (seqi == 1) {
#pragma unroll
                    for (int reg = 0; reg < 4; ++reg) HT[(16 * mt + 4 * q4 + reg) * HT_STRIDE + 16 * w + c16] = st[reg]; }
            }
        }
        __syncthreads();
    }
#undef SCAN_CREF
#undef SCAN_LOADZ
#undef SCAN_BUILD
}
__device__ __forceinline__ void dev_scan(PREF p, LAS unsigned char* lds) {
    LAS float* CW = (LAS float*)(lds + SCAN_CW_OFF);
    for (int item = blockIdx.x; item < p.nb * 8; item += gridDim.x) {
        const int b = item >> 3, head = item & 7;
        __syncthreads();
        for (int i = tid_opaque(); i < 640; i += NTHR) CW[i] = (i < 512) ? p.conv_w[(i >> 7) * 1024 + head * 128 + (i & 127)] : p.conv_b[head * 128 + (i - 512)];
        __syncthreads();
        scan_dir<0>(p, lds, b, head);
        __syncthreads();
        scan_dir<1>(p, lds, b, head);
    }
}

#define CASD(a, b) { const int _x = max(a, b), _y = min(a, b); a = _x; b = _y; }
template <int K, int J, int BASE, int N> __device__ __forceinline__ void bitonic_step(int (&v)[N]) {
#pragma unroll
    for (int i = 0; i < 16; ++i) { const int l = i ^ J; if (l > i) { if ((i & K) == 0) { CASD(v[BASE + i], v[BASE + l]); } else { CASD(v[BASE + l], v[BASE + i]); } } }
}
template <int BASE, int N> __device__ __forceinline__ void sort16_desc(int (&v)[N]) {
    bitonic_step<2, 1, BASE>(v);
    bitonic_step<4, 2, BASE>(v); bitonic_step<4, 1, BASE>(v);
    bitonic_step<8, 4, BASE>(v); bitonic_step<8, 2, BASE>(v); bitonic_step<8, 1, BASE>(v);
    bitonic_step<16, 8, BASE>(v); bitonic_step<16, 4, BASE>(v); bitonic_step<16, 2, BASE>(v); bitonic_step<16, 1, BASE>(v);
}
template <int AB, int BB, int NA, int NB> __device__ __forceinline__ void merge16(int (&a)[NA], const int (&b)[NB]) {
#pragma unroll
    for (int i = 0; i < 16; ++i) a[AB + i] = max(a[AB + i], b[BB + 15 - i]);
    bitonic_step<32, 8, AB>(a); bitonic_step<32, 4, AB>(a); bitonic_step<32, 2, AB>(a); bitonic_step<32, 1, AB>(a);
}
__device__ __forceinline__ void top16_of_64(int (&v)[64]) {
    sort16_desc<0>(v); sort16_desc<16>(v); sort16_desc<32>(v); sort16_desc<48>(v);
    merge16<0, 16>(v, v); merge16<32, 48>(v, v); merge16<0, 32>(v, v);
}
__device__ __forceinline__ int f2key(float f) { const int b = __float_as_int(f); return b ^ ((b >> 31) & 0x7fffffff); }
__device__ __forceinline__ float key2f(int k) { return __int_as_float(k ^ ((k >> 31) & 0x7fffffff)); }
__device__ __forceinline__ int lut16(unsigned t0, unsigned t1, unsigned t2, unsigned t3, int i) {
    const int wsel = i >> 2; const unsigned lo = (wsel & 1) ? t1 : t0, hi = (wsel & 1) ? t3 : t2; const unsigned wv = (wsel & 2) ? hi : lo;
    return (int)((wv >> (8 * (i & 3))) & 0xffu);
}
#define CROW(I, CNT, OFF) { _Pragma("unroll") for (int j = 0; j < CNT; ++j) cv[OFF + j] = (f2key(s0[I] + s1[j]) & ~255) | (I << 4) | j; }
constexpr int TK_ROW = 272;
#define SUOFF(t_) ((size_t)((t_) >> 13) * 4194304 + (size_t)((t_) & 8191) * 128)
__device__ __forceinline__ void dev_topk(PREF p, LAS unsigned char* lds, int hd_ = -1, int tg0 = 0, int tgend = 0, int tgstep = 0) {
    const int tid = tid_opaque(), w = tid >> 6, l = tid & 63, tl = l & 31, hh = l >> 5;
    const int T = p.nb * SEQ;
    const int hd = hd_ >= 0 ? hd_ : (int)(blockIdx.x & 7);
    if (hd_ < 0) { tg0 = (int)(blockIdx.x >> 3) * 8; tgend = T / 32; tgstep = (int)(gridDim.x >> 3) * 8; }
    __syncthreads();
    {
        const bf16_t* kg = p.keys_bf + (size_t)hd * 2 * 128 * 128;
        for (int c = tid; c < 2 * 128 * 16; c += NTHR) { const int row = c >> 4, ch = c & 15; *(LAS u32x4*)(lds + row * TK_ROW + ch * 16) = *(const u32x4*)(kg + (size_t)row * 128 + ch * 8); }
    }
    __syncthreads();
    for (int tg = tg0 + w; tg < tgend; tg += tgstep) {
        const int tok = tg * 32 + tl;
        int k0[16], k1[16];
        u32x4 qr[8];
        LAS unsigned char* qrel = lds + 2 * 128 * TK_ROW + w * (32 * TK_ROW);
#define TK_QLOAD(ph_) do { _Pragma("unroll") for (int i_ = 0; i_ < 8; ++i_) { const int tk_ = tg * 32 + 8 * (i_ >> 1) + (l & 7), tr_ = tk_ & 255, ch_ = 8 * (i_ & 1) + (l >> 3);     \
            qr[i_] = __builtin_nontemporal_load((const u32x4*)(p.q + ((size_t)QMAP(tk_ >> 8) * 8 + hd) * 65536 + (size_t)((((tr_ >> 6) & 1) * 4 + (ch_ >> 2)) * 8192 + (((tr_ >> 7) * 4 + ((tr_ >> 4) & 3)) * 2 + (ph_)) * 512 + ((tr_ & 15) + 16 * (ch_ & 3)) * 8))); } } while (0)
#define TK_QSTORE() do { _Pragma("unroll") for (int i_ = 0; i_ < 8; ++i_) *(LAS u32x4*)(qrel + (8 * (i_ >> 1) + (l & 7)) * TK_ROW + 16 * (8 * (i_ & 1) + (l >> 3))) = qr[i_]; } while (0)
        TK_QLOAD(0);
#pragma unroll
        for (int ph = 0; ph < 2; ++ph) {
            f32x16 acc[4];
#pragma unroll
            for (int kb = 0; kb < 4; ++kb)
#pragma unroll
                for (int r = 0; r < 16; ++r) acc[kb][r] = 0.f;
            const LAS unsigned char* kpl = lds + (ph * 128 + tl) * TK_ROW + 16 * hh;
            TK_QSTORE();
            if (ph == 0) TK_QLOAD(1);
#pragma unroll
            for (int ks = 0; ks < 8; ++ks) {
                if (ks == 2 || ks == 4 || ks == 6) asm volatile("" : "+v"(acc[0]), "+v"(acc[1]), "+v"(acc[2]), "+v"(acc[3]));
                const bf16x8 bq = *(const LAS bf16x8*)(qrel + tl * TK_ROW + 32 * ks + 16 * hh);
#pragma unroll
                for (int kb = 0; kb < 4; ++kb) { const bf16x8 ak = *(const LAS bf16x8*)(kpl + kb * 32 * TK_ROW + 32 * ks);
                    acc[kb] = __builtin_amdgcn_mfma_f32_32x32x16_bf16(ak, bq, acc[kb], 0, 0, 0); }
            }
            int v[64];
#pragma unroll
            for (int kb = 0; kb < 4; ++kb)
#pragma unroll
                for (int r = 0; r < 16; ++r) { const int idx = 32 * kb + (r & 3) + 8 * (r >> 2); v[kb * 16 + r] = (f2key(acc[kb][r]) & ~127) | idx | (hh << 2); }
            top16_of_64(v);
            int o[16];
#pragma unroll
            for (int i = 0; i < 16; ++i) o[i] = shx_i(v[i], 32);
            merge16<0, 0>(v, o);
#pragma unroll
            for (int i = 0; i < 16; ++i) { if (ph == 0) k0[i] = v[i]; else k1[i] = v[i]; }
        }
        float s0[16], s1[16];
#pragma unroll
        for (int i = 0; i < 16; ++i) { s0[i] = key2f(k0[i] & ~127); s1[i] = key2f(k1[i] & ~127); }
        int cv[64];
        CROW(0, 16, 0) CROW(1, 8, 16) CROW(2, 5, 24) CROW(3, 4, 29) CROW(4, 3, 33) CROW(5, 2, 36) CROW(6, 2, 38) CROW(7, 2, 40)
        CROW(8, 1, 42) CROW(9, 1, 43) CROW(10, 1, 44) CROW(11, 1, 45) CROW(12, 1, 46) CROW(13, 1, 47) CROW(14, 1, 48) CROW(15, 1, 49)
#pragma unroll
        for (int i = 50; i < 64; ++i) cv[i] = (int)0x80000000;
        top16_of_64(cv);
#define PK4(K, W) ((unsigned)(K[4 * W] & 127) | ((unsigned)(K[4 * W + 1] & 127) << 8) | ((unsigned)(K[4 * W + 2] & 127) << 16) | ((unsigned)(K[4 * W + 3] & 127) << 24))
        unsigned ta0 = PK4(k0, 0), ta1 = PK4(k0, 1), ta2 = PK4(k0, 2), ta3 = PK4(k0, 3);
        unsigned tc0 = PK4(k1, 0), tc1 = PK4(k1, 1), tc2 = PK4(k1, 2), tc3 = PK4(k1, 3);
        asm volatile("" : "+v"(ta0), "+v"(ta1), "+v"(ta2), "+v"(ta3), "+v"(tc0), "+v"(tc1), "+v"(tc2), "+v"(tc3));
        const float mx = key2f(cv[0] & ~255);
        float e[16], sum = 0.f;
#pragma unroll
        for (int k = 0; k < 16; ++k) { e[k] = __builtin_amdgcn_exp2f((key2f(cv[k] & ~255) - mx) * 1.4426950409f); sum += e[k]; }
        const float inv = 1.0f / sum;
        int eo[8]; float go[8];
#pragma unroll
        for (int k = 0; k < 8; ++k) { int c_lo = cv[k], c_hi = cv[8 + k]; float e_lo = e[k], e_hi = e[8 + k];
            asm volatile("" : "+v"(c_lo), "+v"(c_hi), "+v"(e_lo), "+v"(e_hi));
            const int cvk = hh ? c_hi : c_lo; const float ek = hh ? e_hi : e_lo;
            const int i = (cvk >> 4) & 15, j = cvk & 15;
            eo[k] = lut16(ta0, ta1, ta2, ta3, i) * 128 + lut16(tc0, tc1, tc2, tc3, j); go[k] = ek * inv; }
        float so[8];
#pragma unroll
        for (int k = 0; k < 8; ++k) { const f32x2 s2 = *(const f32x2*)(p.scu + 2 * eo[k]); go[k] *= s2[1]; so[k] = s2[0]; }
        const size_t off = (size_t)tok * 128 + hd * 16 + hh * 8;
        *(u32x4*)(p.eidx + off) = (u32x4){(unsigned)eo[0], (unsigned)eo[1], (unsigned)eo[2], (unsigned)eo[3]};
        *(u32x4*)(p.eidx + off + 4) = (u32x4){(unsigned)eo[4], (unsigned)eo[5], (unsigned)eo[6], (unsigned)eo[7]};
        *(f32x4*)(p.gw + off) = (f32x4){go[0], go[1], go[2], go[3]};
        *(f32x4*)(p.gw + off + 4) = (f32x4){go[4], go[5], go[6], go[7]};
        const size_t soff = SUOFF(tok) + hd * 16 + hh * 8;
        *(f32x4*)(p.su + soff) = (f32x4){so[0], so[1], so[2], so[3]};
        *(f32x4*)(p.su + soff + 4) = (f32x4){so[4], so[5], so[6], so[7]};
    }
}

__device__ __forceinline__ float dot8(const u32x4 a, const u32x4 b, float acc) {
    const unsigned a0 = a[0], a1 = a[1], a2 = a[2], a3 = a[3], b0 = b[0], b1 = b[1], b2 = b[2], b3 = b[3];
    asm("v_dot2c_f32_bf16 %0, %1, %2" : "+v"(acc) : "v"(a0), "v"(b0));
    asm("v_dot2c_f32_bf16 %0, %1, %2" : "+v"(acc) : "v"(a1), "v"(b1));
    asm("v_dot2c_f32_bf16 %0, %1, %2" : "+v"(acc) : "v"(a2), "v"(b2));
    asm("v_dot2c_f32_bf16 %0, %1, %2" : "+v"(acc) : "v"(a3), "v"(b3));
    return acc;
}
__device__ __forceinline__ void dev_peer(PREF p) {
    const int tid = tid_opaque(), w = tid >> 6, l = tid & 63;
    const int T = p.nb * SEQ;
    const int b5 = (l >> 5) & 1, b4 = (l >> 4) & 1, b3 = (l >> 3) & 1;
    for (int tok = blockIdx.x * 8 + w; tok < T; tok += gridDim.x * 8) {
        const int b = tok >> 11;
        const u32x4 ha = *(const u32x4*)(p.h2 + (size_t)tok * DM + 8 * l), hb = *(const u32x4*)(p.h2 + (size_t)tok * DM + 512 + 8 * l);
        const int e_lo = p.eidx[(size_t)tok * 128 + l], e_hi = p.eidx[(size_t)tok * 128 + 64 + l];
        const float g_lo = p.gw[(size_t)tok * 128 + l], g_hi = p.gw[(size_t)tok * 128 + 64 + l];
        float acc[16];
#pragma unroll
        for (int i = 0; i < 16; ++i) acc[i] = 0.f;
        for (int grp = 0; grp < 16; ++grp) {
            const int esrc = grp < 8 ? e_lo : e_hi; const float gsrc = grp < 8 ? g_lo : g_hi; const int lbase = (grp & 7) * 8;
            int e[8];
#pragma unroll
            for (int k = 0; k < 8; ++k) e[k] = __builtin_amdgcn_readlane(esrc, lbase + k);
            u32x4 s0[8], s1[8];
            float part[8];
            {
                u32x4 r0[8], r1[8];
#pragma unroll
                for (int k = 0; k < 8; ++k) { const bf16_t* up = p.u_bf + (size_t)e[k] * DM + 8 * l; r0[k] = *(const u32x4*)up; r1[k] = *(const u32x4*)(up + 512); }
#pragma unroll
                for (int k = 0; k < 8; ++k) part[k] = dot8(r1[k], hb, dot8(r0[k], ha, 0.f));
            }
            asm volatile("" : "+v"(part[0]), "+v"(part[1]), "+v"(part[2]), "+v"(part[3]), "+v"(part[4]), "+v"(part[5]), "+v"(part[6]), "+v"(part[7]));
#pragma unroll
            for (int k = 0; k < 8; ++k) { const bf16_t* vp = p.v_bf + (size_t)e[k] * DM + 8 * l; s0[k] = *(const u32x4*)vp; s1[k] = *(const u32x4*)(vp + 512); }
            float q4v[4];
#pragma unroll
            for (int k = 0; k < 4; ++k) { const float send = b5 ? part[k] : part[k + 4]; const float recv = __shfl_xor(send, 32); q4v[k] = (b5 ? part[k + 4] : part[k]) + recv; }
            float r2[2];
#pragma unroll
            for (int k = 0; k < 2; ++k) { const float send = b4 ? q4v[k] : q4v[k + 2]; const float recv = __shfl_xor(send, 16); r2[k] = (b4 ? q4v[k + 2] : q4v[k]) + recv; }
            float sdot;
            { const float send = b3 ? r2[0] : r2[1]; const float recv = __shfl_xor(send, 8); sdot = (b3 ? r2[1] : r2[0]) + recv; }
            sdot += __shfl_xor(sdot, 4); sdot += __shfl_xor(sdot, 2); sdot += __shfl_xor(sdot, 1);
            const int kk = 4 * b5 + 2 * b4 + b3;
            const float gv = __shfl(gsrc, lbase + kk);
            const float wv = gv * gelu_f(sdot);
#pragma unroll
            for (int k = 0; k < 8; ++k) {
                const float wk = __int_as_float(__builtin_amdgcn_readlane(__float_as_int(wv), ((k >> 2) & 1) * 32 + ((k >> 1) & 1) * 16 + (k & 1) * 8));
#pragma unroll
                for (int i = 0; i < 4; ++i) { acc[2 * i] += wk * bflo(s0[k][i]); acc[2 * i + 1] += wk * bfhi(s0[k][i]); acc[8 + 2 * i] += wk * bflo(s1[k][i]); acc[8 + 2 * i + 1] += wk * bfhi(s1[k][i]); }
            }
        }
        const float* x1p = p.x1 + (size_t)tok * DM; const float* g2p = p.mod + (size_t)b * 6144 + 5 * 1024;
        f32x4 xv[4]; float ss = 0.f;
#pragma unroll
        for (int hlf = 0; hlf < 2; ++hlf)
#pragma unroll
            for (int q = 0; q < 2; ++q) { const int d = hlf * 512 + 8 * l + 4 * q; const f32x4 xx = *(const f32x4*)(x1p + d), gg = *(const f32x4*)(g2p + d);
                f32x4 r;
#pragma unroll
                for (int j = 0; j < 4; ++j) { r[j] = xx[j] + gg[j] * acc[hlf * 8 + 4 * q + j]; ss += r[j] * r[j]; }
                xv[hlf * 2 + q] = r; }
        ss = wave_sum(ss);
        const float rs = rsqrtf(ss * (1.0f / 1024.0f) + 1e-6f);
#pragma unroll
        for (int hlf = 0; hlf < 2; ++hlf)
#pragma unroll
            for (int q = 0; q < 2; ++q) { const int d = hlf * 512 + 8 * l + 4 * q; const f32x4 fg = *(const f32x4*)(p.final_g + d);
                f32x4 o;
#pragma unroll
                for (int j = 0; j < 4; ++j) o[j] = xv[hlf * 2 + q][j] * rs * fg[j];
                *(f32x4*)(p.out + (size_t)tok * DM + d) = o; }
    }
}


__device__ __forceinline__ float table_scale(unsigned maxbits) { const float m = fmaxf(__uint_as_float(maxbits), 1e-30f); return exp2f(floorf(log2f(448.0f / m))); }
__device__ __forceinline__ void dev_tabmax(PREF p) {
    const int tid = tid_opaque();
    float mu = 0.f, mv = 0.f;
    for (size_t i = ((size_t)blockIdx.x * NTHR + tid) * 4; i < (size_t)16384 * 1024; i += (size_t)gridDim.x * NTHR * 4) {
        const f32x4 a = *(const f32x4*)(p.peer_u + i), b = *(const f32x4*)(p.peer_v + i);
        mu = fmaxf(mu, fmaxf(fmaxf(fabsf(a[0]), fabsf(a[1])), fmaxf(fabsf(a[2]), fabsf(a[3]))));
        mv = fmaxf(mv, fmaxf(fmaxf(fabsf(b[0]), fabsf(b[1])), fmaxf(fabsf(b[2]), fabsf(b[3])))); }
#pragma unroll
    for (int o = 1; o < 64; o <<= 1) { mu = fmaxf(mu, __shfl_xor(mu, o)); mv = fmaxf(mv, __shfl_xor(mv, o)); }
    if ((tid & 63) == 0) { atomicMax(p.tmax + 0, __float_as_uint(mu)); atomicMax(p.tmax + 1, __float_as_uint(mv)); }
}
__device__ __forceinline__ unsigned fp4_code(float x) {
    const float ax = fabsf(x);
    unsigned c = ax < 0.25f ? 0u : ax < 0.75f ? 1u : ax < 1.25f ? 2u : ax < 1.75f ? 3u : ax < 2.5f ? 4u : ax < 3.5f ? 5u : ax < 5.0f ? 6u : 7u;
    return c | (x < 0.f ? 8u : 0u);
}
__device__ __forceinline__ void tab8_row(PREF p, const f32x4 (&a)[4], int r, int lane) {
    const int tab = r >> 14, e = r & 16383;
    float m = 0.f, ss = 0.f;
#pragma unroll
    for (int i = 0; i < 4; ++i) { m = fmaxf(m, fmaxf(fmaxf(fabsf(a[i][0]), fabsf(a[i][1])), fmaxf(fabsf(a[i][2]), fabsf(a[i][3]))));
        ss += (a[i][0] * a[i][0] + a[i][1] * a[i][1]) + (a[i][2] * a[i][2] + a[i][3] * a[i][3]); }
#pragma unroll
    for (int o = 1; o < 64; o <<= 1) { m = fmaxf(m, shx_f(m, o)); ss += shx_f(ss, o); }
    const float rms = sqrtf(ss * (1.0f / 1024.0f));
    const float sc = m > 0.f ? fminf(2.0f / rms, 9.0f / m) : 1.0f;
    unsigned char* dst = (tab ? p.v4 : p.u4) + (size_t)e * 128 + 2 * lane;
#pragma unroll
    for (int i = 0; i < 4; ++i) { unsigned b = 0u;
        b = __builtin_amdgcn_cvt_scalef32_pk_fp4_f32(b, a[i][0] * sc, a[i][1] * sc, 1.0f, 0); b = __builtin_amdgcn_cvt_scalef32_pk_fp4_f32(b, a[i][2] * sc, a[i][3] * sc, 1.0f, 1);
        *(unsigned short*)(dst + (size_t)i * 16384 * 128) = (unsigned short)b; }
    if (lane == 0) p.scu[2 * e + tab] = 1.0f / sc;
}
__device__ __forceinline__ void dev_tab8(PREF p) {
    const int tid = tid_opaque();
    const int w = tid >> 6, lane = tid & 63;
    const int G = (int)gridDim.x, nctx = (p.nb * CTXL / 256) * 4, NR = 2 * 16384;
    const int Wt = nctx + 7 * (G - nctx), unit = (G > nctx) ? NR / Wt : 0;
    int first, S, end;
    if (G > nctx && unit * Wt == NR && (unit & 7) == 0) { const int b = (int)blockIdx.x; const int r0 = b < nctx ? b * unit : nctx * unit + (b - nctx) * 7 * unit; first = r0 + w; S = 8; end = r0 + (b < nctx ? unit : 7 * unit); }
    else { first = (int)blockIdx.x * 8 + w; S = G * 8; end = NR; }
#define TAB_LOAD(A, r) do { const int r_ = (r) < NR ? (r) : NR - 1; const float* s_ = ((r_ >> 14) ? p.peer_v : p.peer_u) + (size_t)(r_ & 16383) * 1024 + 4 * lane; \
        _Pragma("unroll") for (int i_ = 0; i_ < 4; ++i_) A[i_] = __builtin_nontemporal_load((const f32x4*)(s_ + 256 * i_)); } while (0)
    f32x4 A0[4], A1[4], A2[4], A3[4];
    if (first < end) { TAB_LOAD(A0, first); TAB_LOAD(A1, first + S); TAB_LOAD(A2, first + 2 * S); }
    for (int r = first; r < end; r += 4 * S) {
        TAB_LOAD(A3, r + 3 * S); tab8_row(p, A0, r, lane);
        TAB_LOAD(A0, r + 4 * S); if (r + S < end) tab8_row(p, A1, r + S, lane);
        TAB_LOAD(A1, r + 5 * S); if (r + 2 * S < end) tab8_row(p, A2, r + 2 * S, lane);
        TAB_LOAD(A2, r + 6 * S); if (r + 3 * S < end) tab8_row(p, A3, r + 3 * S, lane);
    }
#undef TAB_LOAD
}
#define PEER_ISSUE(R, E0, E1, E2, E3) do { _Pragma("unroll") for (int i_ = 0; i_ < 4; ++i_) { R[i_] = *(const u32x4*)(tab + (E0[i_] * 128u + kc16)); R[4 + i_] = *(const u32x4*)(tab + (E1[i_] * 128u + kc16)); \
        R[8 + i_] = *(const u32x4*)(tab + (E2[i_] * 128u + kc16)); R[12 + i_] = *(const u32x4*)(tab + (E3[i_] * 128u + kc16)); } } while (0)
#define PEER_LD_E(E0, E1, E2, E3, t) do { const u32x4* ep_ = (const u32x4*)(p.eidx + (size_t)(t) * 128 + 16 * rsub); E0 = ep_[0]; E1 = ep_[1]; E2 = ep_[2]; E3 = ep_[3]; } while (0)
typedef int i32x8 __attribute__((ext_vector_type(8)));
__device__ __forceinline__ void sddmm_compute(u32x4 (&R)[16], const u32x4 (&hb)[4], LAS unsigned char* wbuf, float* dst_tok, int l) {
    const int rsub = l >> 3, kc = l & 7, rho = l & 15, kg = l >> 4;
    const int wr0 = rsub * 128 + ((kc ^ rsub) << 4), wr1 = (8 + rsub) * 128 + ((kc ^ rsub ^ 1) << 4);
    const int key = (rho & 7) ^ (rho >> 3), rbase = rho * 128;
    i32x8 b0, b1;
#pragma unroll
    for (int i = 0; i < 4; ++i) { b0[i] = (int)hb[0][i]; b0[4 + i] = (int)hb[1][i]; b1[i] = (int)hb[2][i]; b1[4 + i] = (int)hb[3][i]; }
    f32x4 acc[8];
#pragma unroll
    for (int t = 0; t < 8; ++t) {
        LAS unsigned char* buf = wbuf + (t & 1) * 2048;
        *(LAS u32x4*)(buf + wr0) = R[t]; *(LAS u32x4*)(buf + wr1) = R[t + 8];
        const u32x4 x0 = *(const LAS u32x4*)(buf + rbase + ((kg ^ key) << 4)), x1 = *(const LAS u32x4*)(buf + rbase + (((4 + kg) ^ key) << 4));
        i32x8 a0, a1;
#pragma unroll
        for (int i = 0; i < 4; ++i) { a0[i] = (int)x0[i]; a0[4 + i] = 0; a1[i] = (int)x1[i]; a1[4 + i] = 0; }
        f32x4 c = (f32x4){0.f, 0.f, 0.f, 0.f};
        c = __builtin_amdgcn_mfma_scale_f32_16x16x128_f8f6f4(a0, b0, c, 4, 0, 0, 0x7f7f7f7f, 0, 0x7f7f7f7f);
        c = __builtin_amdgcn_mfma_scale_f32_16x16x128_f8f6f4(a1, b1, c, 4, 0, 0, 0x7f7f7f7f, 0, 0x7f7f7f7f);
        acc[t] = c;
    }
    const int reg = rho & 3, half = (rho >> 2) & 1;
    f32x4 o;
#pragma unroll
    for (int c4 = 0; c4 < 4; ++c4) { f32x4 lo = acc[c4], hi = acc[4 + c4];
        asm volatile("" : "+v"(lo), "+v"(hi));
        const f32x4 x = half ? hi : lo; float x0 = x[0], x1 = x[1], x2 = x[2], x3 = x[3];
        asm volatile("" : "+v"(x0), "+v"(x1), "+v"(x2), "+v"(x3));
        o[c4] = (reg & 2) ? ((reg & 1) ? x3 : x2) : ((reg & 1) ? x1 : x0); }
    if (rho < 8) *(f32x4*)(dst_tok + 16 * (4 * (kg & 1) + reg) + 8 * (kg >> 1) + 4 * half) = o;
}
__device__ __forceinline__ void dev_sddmm(PREF p, LAS unsigned char* lds) {
    const int tid = tid_opaque(), w = tid >> 6, l = tid & 63, rsub = l >> 3, kc = l & 7, kg = l >> 4;
    const int T = p.nb * SEQ; const int s = blockIdx.x & 3, sub = blockIdx.x >> 2, nsub = gridDim.x >> 2;
    const unsigned char* tab = p.u4 + (size_t)s * 16384 * 128; const unsigned kc16 = 16u * kc;
    const int first = sub * 8 + w, S = nsub * 8;
    const int n = first < T ? (T - first + S - 1) / S : 0;
    LAS unsigned char* wbuf = lds + w * 4096;
    float* pdb = p.pd + (size_t)s * T * 128;
#define TOKI(i) (first + ((i) < n ? (i) : n - 1) * S)
#define LD_H(H, t) do { const unsigned char* hp_ = p.h8 + (size_t)(t) * DM + 256 * s + 16 * kg; H[0] = *(const u32x4*)hp_; H[1] = *(const u32x4*)(hp_ + 64); H[2] = *(const u32x4*)(hp_ + 128); H[3] = *(const u32x4*)(hp_ + 192); } while (0)
    if (n > 0) {
        u32x4 RA[16], RB[16], eA0, eA1, eA2, eA3, eB0, eB1, eB2, eB3, hA[4], hB[4];
        PEER_LD_E(eA0, eA1, eA2, eA3, TOKI(0)); LD_H(hA, TOKI(0)); PEER_ISSUE(RA, eA0, eA1, eA2, eA3);
        PEER_LD_E(eB0, eB1, eB2, eB3, TOKI(1)); LD_H(hB, TOKI(1));
        for (int i = 0; i < n; i += 2) {
            PEER_ISSUE(RB, eB0, eB1, eB2, eB3);
            PEER_LD_E(eA0, eA1, eA2, eA3, TOKI(i + 2));
            sddmm_compute(RA, hA, wbuf, pdb + (size_t)TOKI(i) * 128, l);
            LD_H(hA, TOKI(i + 2));
            PEER_ISSUE(RA, eA0, eA1, eA2, eA3);
            PEER_LD_E(eB0, eB1, eB2, eB3, TOKI(i + 3));
            if (i + 1 < n) sddmm_compute(RB, hB, wbuf, pdb + (size_t)TOKI(i + 1) * 128, l);
            LD_H(hB, TOKI(i + 3));
        }
    }
#undef LD_H
}
__device__ __forceinline__ void dev_act(PREF p) {
    const int tid = tid_opaque(); const int T = p.nb * SEQ; const size_t n = (size_t)T * 128;
    for (size_t i = ((size_t)blockIdx.x * NTHR + tid) * 4; i < n; i += (size_t)gridDim.x * NTHR * 4) {
        f32x4 a = *(const f32x4*)(p.pd + i);
#pragma unroll
        for (int s = 1; s < 4; ++s) a += *(const f32x4*)(p.pd + (size_t)s * n + i);
        const u32x4 e = *(const u32x4*)(p.eidx + i);
        f32x4 g = *(const f32x4*)(p.gw + i);
#pragma unroll
        for (int j = 0; j < 4; ++j) g[j] *= gelu_f(a[j] * (0.25f * p.scu[2 * e[j]])) * p.scu[2 * e[j] + 1];
        *(f32x4*)(p.gw + i) = g;
    }
}
template <int CTRL> __device__ __forceinline__ float dpp_f(float v) { return __int_as_float(__builtin_amdgcn_update_dpp(0, __float_as_int(v), CTRL, 0xf, 0xf, true)); }
__device__ __forceinline__ void spmm_compute(PREF p, u32x4 (&R)[16], const f32x4 w0, const f32x4 w1, const f32x4 w2, const f32x4 w3, int t, int col, int l) {
    const int b5 = (l >> 5) & 1, b4 = (l >> 4) & 1, b3 = (l >> 3) & 1;
    f32x2 ac2[16];
#pragma unroll
    for (int i = 0; i < 16; ++i) ac2[i] = (f32x2){0.f, 0.f};
#pragma unroll
    for (int r = 0; r < 16; ++r) { const float wg = (r < 4) ? w0[r & 3] : (r < 8) ? w1[r & 3] : (r < 12) ? w2[r & 3] : w3[r & 3];
        if (r >= 1) asm volatile("" : "+v"(R[r]) : "v"(ac2[0]));
        const f32x2 wg2 = (f32x2){wg, wg};
#pragma unroll
        for (int i = 0; i < 4; ++i) {
            ac2[4 * i + 0] = wg2 * __builtin_amdgcn_cvt_scalef32_pk_f32_fp4(R[r][i], 1.0f, 0) + ac2[4 * i + 0];
            ac2[4 * i + 1] = wg2 * __builtin_amdgcn_cvt_scalef32_pk_f32_fp4(R[r][i], 1.0f, 1) + ac2[4 * i + 1];
            ac2[4 * i + 2] = wg2 * __builtin_amdgcn_cvt_scalef32_pk_f32_fp4(R[r][i], 1.0f, 2) + ac2[4 * i + 2];
            ac2[4 * i + 3] = wg2 * __builtin_amdgcn_cvt_scalef32_pk_f32_fp4(R[r][i], 1.0f, 3) + ac2[4 * i + 3]; } }
    f32x2 a8[8], a4[4], a2[2];
#pragma unroll
    for (int k = 0; k < 8; ++k)
#pragma unroll
        for (int c = 0; c < 2; ++c) { const u32x2 r = __builtin_amdgcn_permlane32_swap(__float_as_uint(ac2[k][c]), __float_as_uint(ac2[k + 8][c]), false, false); a8[k][c] = __uint_as_float(r[0]) + __uint_as_float(r[1]); }
#pragma unroll
    for (int k = 0; k < 4; ++k)
#pragma unroll
        for (int c = 0; c < 2; ++c) { const u32x2 r = __builtin_amdgcn_permlane16_swap(__float_as_uint(a8[k][c]), __float_as_uint(a8[k + 4][c]), false, false); a4[k][c] = __uint_as_float(r[0]) + __uint_as_float(r[1]); }
#pragma unroll
    for (int k = 0; k < 2; ++k)
#pragma unroll
        for (int c = 0; c < 2; ++c) { const float snd = b3 ? a4[k][c] : a4[k + 2][c]; a2[k][c] = (b3 ? a4[k + 2][c] : a4[k][c]) + dpp_f<0x128>(snd); }
    *(u32x2*)(p.peer16 + (size_t)t * DM + col) = (u32x2){pk2(a2[0][0], a2[0][1]), pk2(a2[1][0], a2[1][1])};
}
__device__ __forceinline__ void dev_spmm(PREF p) {
    const int tid = tid_opaque(), w = tid >> 6, l = tid & 63, rsub = l >> 3, kc = l & 7;
    const int T = p.nb * SEQ; const int s = blockIdx.x & 3, sub = blockIdx.x >> 2, nsub = gridDim.x >> 2;
    const unsigned char* tab = p.v4 + (size_t)s * 16384 * 128; const unsigned kc16 = 16u * kc;
    const int col = 256 * s + 32 * kc + 2 * (8 * ((l >> 5) & 1) + 4 * ((l >> 4) & 1) + 2 * ((l >> 3) & 1));
    const int first = sub * 8 + w, S = nsub * 8;
    const int n = first < T ? (T - first + S - 1) / S : 0;
#define LD_W(W0, W1, W2, W3, t) do { const f32x4* wp_ = (const f32x4*)(p.gw + (size_t)(t) * 128 + 16 * rsub); W0 = wp_[0]; W1 = wp_[1]; W2 = wp_[2]; W3 = wp_[3]; } while (0)
    if (n > 0) {
        u32x4 RA[16], RB[16], eA0, eA1, eA2, eA3, eB0, eB1, eB2, eB3; f32x4 wA0, wA1, wA2, wA3, wB0, wB1, wB2, wB3;
        PEER_LD_E(eA0, eA1, eA2, eA3, TOKI(0)); LD_W(wA0, wA1, wA2, wA3, TOKI(0)); PEER_ISSUE(RA, eA0, eA1, eA2, eA3);
        PEER_LD_E(eB0, eB1, eB2, eB3, TOKI(1)); LD_W(wB0, wB1, wB2, wB3, TOKI(1));
        for (int i = 0; i < n; i += 2) {
            PEER_ISSUE(RB, eB0, eB1, eB2, eB3);
            PEER_LD_E(eA0, eA1, eA2, eA3, TOKI(i + 2));
            spmm_compute(p, RA, wA0, wA1, wA2, wA3, TOKI(i), col, l);
            LD_W(wA0, wA1, wA2, wA3, TOKI(i + 2));
            PEER_ISSUE(RA, eA0, eA1, eA2, eA3);
            PEER_LD_E(eB0, eB1, eB2, eB3, TOKI(i + 3));
            if (i + 1 < n) spmm_compute(p, RB, wB0, wB1, wB2, wB3, TOKI(i + 1), col, l);
            LD_W(wB0, wB1, wB2, wB3, TOKI(i + 3));
        }
    }
#undef LD_W
#undef TOKI
}
__device__ __forceinline__ void dev_final(PREF p) {
    const int tid = tid_opaque(), w = tid >> 6, lane = tid & 63; const int T = p.nb * SEQ;
    for (int t = blockIdx.x * 8 + w; t < T; t += gridDim.x * 8) {
        const float* g2p = p.mod + (size_t)(t >> 11) * 6144 + 5 * 1024;
        f32x4 xv[4]; float ss = 0.f;
#pragma unroll
        for (int i = 0; i < 4; ++i) { const int d = 4 * lane + 256 * i; const f32x4 x = *(const f32x4*)(p.x1 + (size_t)t * DM + d), gg = *(const f32x4*)(g2p + d);
            const u32x2 pv = *(const u32x2*)(p.peer16 + (size_t)t * DM + d);
            f32x4 r; r[0] = x[0] + gg[0] * bflo(pv[0]); r[1] = x[1] + gg[1] * bfhi(pv[0]); r[2] = x[2] + gg[2] * bflo(pv[1]); r[3] = x[3] + gg[3] * bfhi(pv[1]);
            ss += (r[0] * r[0] + r[1] * r[1]) + (r[2] * r[2] + r[3] * r[3]); xv[i] = r; }
        ss = wave_sum(ss);
        const float rs = rsqrtf(ss * (1.0f / 1024.0f) + 1e-6f);
#pragma unroll
        for (int i = 0; i < 4; ++i) { const int d = 4 * lane + 256 * i; const f32x4 fg = *(const f32x4*)(p.final_g + d);
            f32x4 o;
#pragma unroll
            for (int j = 0; j < 4; ++j) o[j] = xv[i][j] * rs * fg[j];
            *(f32x4*)(p.out + (size_t)t * DM + d) = o; }
    }
}


__device__ __forceinline__ void sddmm_accum(u32x4 (&R)[16], const u32x4 (&hb)[4], LAS unsigned char* wbuf, f32x4 (&acc)[8], int l) {
    const int rsub = l >> 3, kc = l & 7, rho = l & 15, kg = l >> 4;
    const int wr0 = rsub * 128 + ((kc ^ rsub) << 4), wr1 = (8 + rsub) * 128 + ((kc ^ rsub ^ 1) << 4);
    const int key = (rho & 7) ^ (rho >> 3), rbase = rho * 128;
    i32x8 b0, b1;
#pragma unroll
    for (int i = 0; i < 4; ++i) { b0[i] = (int)hb[0][i]; b0[4 + i] = (int)hb[1][i]; b1[i] = (int)hb[2][i]; b1[4 + i] = (int)hb[3][i]; }
#pragma unroll
    for (int t = 0; t < 8; ++t) {
        LAS unsigned char* buf = wbuf + (t & 1) * 2048;
        *(LAS u32x4*)(buf + wr0) = R[t]; *(LAS u32x4*)(buf + wr1) = R[t + 8];
        const u32x4 x0 = *(const LAS u32x4*)(buf + rbase + ((kg ^ key) << 4)), x1 = *(const LAS u32x4*)(buf + rbase + (((4 + kg) ^ key) << 4));
        i32x8 a0, a1;
#pragma unroll
        for (int i = 0; i < 4; ++i) { a0[i] = (int)x0[i]; a0[4 + i] = 0; a1[i] = (int)x1[i]; a1[4 + i] = 0; }
        f32x4 c = acc[t];
        c = __builtin_amdgcn_mfma_scale_f32_16x16x128_f8f6f4(a0, b0, c, 4, 0, 0, 0x7f7f7f7f, 0, 0x7f7f7f7f);
        c = __builtin_amdgcn_mfma_scale_f32_16x16x128_f8f6f4(a1, b1, c, 4, 0, 0, 0x7f7f7f7f, 0, 0x7f7f7f7f);
        acc[t] = c;
    }
}
__device__ __forceinline__ void dev_sddmm_act(PREF p, LAS unsigned char* lds, int first0 = -1, int S_ = 0, int tend = 0) {
    const int tid = tid_opaque(), w = __builtin_amdgcn_readfirstlane(tid >> 6), l = tid & 63, rsub = l >> 3, kc = l & 7, kg = l >> 4, rho = l & 15;
    const int T = p.nb * SEQ;
    const unsigned kc16 = 16u * kc;
    const int first = (first0 >= 0 ? first0 : (int)blockIdx.x * 8) + w, S = first0 >= 0 ? S_ : (int)gridDim.x * 8, TE = first0 >= 0 ? tend : T;
    const int n = first < TE ? (TE - first + S - 1) / S : 0;
    LAS unsigned char* wbuf = lds + w * 4096;
    const int reg = rho & 3, half = (rho >> 2) & 1, j0 = 16 * (4 * (kg & 1) + reg) + 8 * (kg >> 1) + 4 * half;
#define TOKI(i) (first + ((i) < n ? (i) : n - 1) * S)
#define SA_ISSUE(R, E0, E1, E2, E3, sl) do { const unsigned char* tab = p.u4 + (size_t)(sl) * 16384 * 128; PEER_ISSUE(R, E0, E1, E2, E3); } while (0)
#define SA_LD_H(H, t, sl) do { const unsigned char* hp_ = p.h8 + (size_t)(t) * DM + 256 * (sl) + 16 * kg; H[0] = *(const u32x4*)hp_; H[1] = *(const u32x4*)(hp_ + 64); H[2] = *(const u32x4*)(hp_ + 128); H[3] = *(const u32x4*)(hp_ + 192); } while (0)
    if (n > 0) {
        u32x4 RA[16], RB[16], eC0, eC1, eC2, eC3, eN0, eN1, eN2, eN3, hA[4], hB[4];
        PEER_LD_E(eC0, eC1, eC2, eC3, TOKI(0)); SA_LD_H(hA, TOKI(0), 0); SA_ISSUE(RA, eC0, eC1, eC2, eC3, 0);
        PEER_LD_E(eN0, eN1, eN2, eN3, TOKI(1));
        for (int i = 0; i < n; ++i) {
            const int t = TOKI(i);
            f32x4 acc[8];
#pragma unroll
            for (int k = 0; k < 8; ++k) acc[k] = (f32x4){0.f, 0.f, 0.f, 0.f};
            SA_ISSUE(RB, eC0, eC1, eC2, eC3, 1); SA_LD_H(hB, t, 1); sddmm_accum(RA, hA, wbuf, acc, l);
            SA_ISSUE(RA, eC0, eC1, eC2, eC3, 2); SA_LD_H(hA, t, 2); sddmm_accum(RB, hB, wbuf, acc, l);
            SA_ISSUE(RB, eC0, eC1, eC2, eC3, 3); SA_LD_H(hB, t, 3); sddmm_accum(RA, hA, wbuf, acc, l);
            const f32x4 sj = *(const f32x4*)(p.su + SUOFF(t) + j0); const f32x4 gj = *(const f32x4*)(p.gw + (size_t)t * 128 + j0);
            SA_ISSUE(RA, eN0, eN1, eN2, eN3, 0); SA_LD_H(hA, TOKI(i + 1), 0); sddmm_accum(RB, hB, wbuf, acc, l);
            eC0 = eN0; eC1 = eN1; eC2 = eN2; eC3 = eN3;
            PEER_LD_E(eN0, eN1, eN2, eN3, TOKI(i + 2));
            f32x4 o;
#pragma unroll
            for (int c4 = 0; c4 < 4; ++c4) { f32x4 lo = acc[c4], hi = acc[4 + c4];
                asm volatile("" : "+v"(lo), "+v"(hi));
                const f32x4 x = half ? hi : lo; float x0 = x[0], x1 = x[1], x2 = x[2], x3 = x[3];
                asm volatile("" : "+v"(x0), "+v"(x1), "+v"(x2), "+v"(x3));
                o[c4] = (reg & 2) ? ((reg & 1) ? x3 : x2) : ((reg & 1) ? x1 : x0); }
            f32x4 wv = (f32x4){0.f, 0.f, 0.f, 0.f};
            if (rho < 8) {
#pragma unroll
                for (int c4 = 0; c4 < 4; ++c4) wv[c4] = gj[c4] * gelu_f(o[c4] * (0.25f * sj[c4])); }
            float mx = fmaxf(fmaxf(fabsf(wv[0]), fabsf(wv[1])), fmaxf(fabsf(wv[2]), fabsf(wv[3])));
#pragma unroll
            for (int sh = 1; sh < 64; sh <<= 1) mx = fmaxf(mx, shx_f(mx, sh));
            const int bexp = max((__float_as_int(mx) >> 23) & 255, 8);
            const float wsc = __int_as_float((261 - bexp) << 23);
            if (rho < 8) { int w8v = 0; w8v = __builtin_amdgcn_cvt_pk_fp8_f32(wv[0] * wsc, wv[1] * wsc, w8v, false); w8v = __builtin_amdgcn_cvt_pk_fp8_f32(wv[2] * wsc, wv[3] * wsc, w8v, true);
                *(unsigned*)(p.w8 + (size_t)t * 128 + j0) = (unsigned)w8v; }
            if (l == 0) p.wsc[t] = __int_as_float((bexp - 7) << 23);
        }
    }
#undef SA_ISSUE
#undef SA_LD_H
#undef TOKI
}
#define SF_ISSUE(R, ESRC, LBASE) do { int es_ = ESRC; _Pragma("unroll") for (int r_ = 0; r_ < 32; ++r_) { if ((r_ & 7) == 0) asm volatile("" : "+v"(es_) :: "memory");     \
        const unsigned e_ = (unsigned)__builtin_amdgcn_readlane(es_, (LBASE) + r_); R[r_] = *(const u32x2*)(tab + (lane_off + e_ * 128u)); } } while (0)
#define SF_COMPUTE(R, WSRC, LBASE) do { int ws_ = __float_as_int(WSRC); _Pragma("unroll") for (int r_ = 0; r_ < 32; ++r_) { \
        if ((r_ & 3) == 0 && r_ > 0) asm volatile("" : "+v"(R[r_]), "+v"(R[r_ + 1]), "+v"(R[r_ + 2]), "+v"(R[r_ + 3]), "+v"(ws_) : "v"(acc[0])); \
        const float wj_ = __int_as_float(__builtin_amdgcn_readlane(ws_, (LBASE) + r_)); const f32x2 w2_ = (f32x2){wj_, wj_}; \
        _Pragma("unroll") for (int i_ = 0; i_ < 2; ++i_) { \
            acc[4 * i_ + 0] = w2_ * __builtin_amdgcn_cvt_scalef32_pk_f32_fp4(R[r_][i_], 1.0f, 0) + acc[4 * i_ + 0]; acc[4 * i_ + 1] = w2_ * __builtin_amdgcn_cvt_scalef32_pk_f32_fp4(R[r_][i_], 1.0f, 1) + acc[4 * i_ + 1]; \
            acc[4 * i_ + 2] = w2_ * __builtin_amdgcn_cvt_scalef32_pk_f32_fp4(R[r_][i_], 1.0f, 2) + acc[4 * i_ + 2]; acc[4 * i_ + 3] = w2_ * __builtin_amdgcn_cvt_scalef32_pk_f32_fp4(R[r_][i_], 1.0f, 3) + acc[4 * i_ + 3]; } } } while (0)
__device__ __forceinline__ void dev_spmm_final(PREF p) {
    const int tid = tid_opaque(), w = __builtin_amdgcn_readfirstlane(tid >> 6), l = tid & 63;
    const int T = p.nb * SEQ;
    const unsigned char* tab = p.v4; const unsigned lane_off = (unsigned)(l >> 4) * (16384u * 128u) + 8u * (unsigned)(l & 15);
    const int first = blockIdx.x * 8 + w, S = gridDim.x * 8;
    const int n = first < T ? (T - first + S - 1) / S : 0;
#define TOKJ(i) (first + ((i) < n ? (i) : n - 1) * S)
#define SF_LISTS(EL, EH, WL, WH, t) do { EL = p.eidx[(size_t)(t) * 128 + l]; EH = p.eidx[(size_t)(t) * 128 + 64 + l]; const float is_ = p.wsc[t]; \
        WL = __builtin_amdgcn_cvt_f32_fp8((int)p.w8[(size_t)(t) * 128 + l], 0) * is_; WH = __builtin_amdgcn_cvt_f32_fp8((int)p.w8[(size_t)(t) * 128 + 64 + l], 0) * is_; } while (0)
    if (n > 0) {
        u32x2 RA[32], RB[32]; int eCl, eCh, eNl, eNh; float wCl, wCh, wNl, wNh;
        SF_LISTS(eCl, eCh, wCl, wCh, TOKJ(0)); SF_ISSUE(RA, eCl, 0); SF_LISTS(eNl, eNh, wNl, wNh, TOKJ(1));
        for (int i = 0; i < n; ++i) {
            const int t = TOKJ(i);
            f32x2 acc[8];
#pragma unroll
            for (int k = 0; k < 8; ++k) acc[k] = (f32x2){0.f, 0.f};
            SF_ISSUE(RB, eCl, 32); SF_COMPUTE(RA, wCl, 0);
            SF_ISSUE(RA, eCh, 0);  SF_COMPUTE(RB, wCl, 32);
            SF_ISSUE(RB, eCh, 32); SF_COMPUTE(RA, wCh, 0);
            int lo16 = 16 * l; asm volatile("" : "+v"(lo16));
            const bf16_t* x1p = p.x1b + (size_t)t * DM + lo16; const float* g2p = p.mod + (size_t)(t >> 11) * 6144 + 5 * 1024 + lo16;
            f32x4 xv[4], gg[4];
            { const u32x4 xa = *(const u32x4*)x1p, xb = *(const u32x4*)(x1p + 8);
              xv[0] = (f32x4){bflo(xa[0]), bfhi(xa[0]), bflo(xa[1]), bfhi(xa[1])}; xv[1] = (f32x4){bflo(xa[2]), bfhi(xa[2]), bflo(xa[3]), bfhi(xa[3])};
              xv[2] = (f32x4){bflo(xb[0]), bfhi(xb[0]), bflo(xb[1]), bfhi(xb[1])}; xv[3] = (f32x4){bflo(xb[2]), bfhi(xb[2]), bflo(xb[3]), bfhi(xb[3])}; }
#pragma unroll
            for (int q = 0; q < 4; ++q) gg[q] = *(const f32x4*)(g2p + 4 * q);
            SF_ISSUE(RA, eNl, 0);  SF_COMPUTE(RB, wCh, 32);
            eCl = eNl; eCh = eNh; wCl = wNl; wCh = wNh;
            SF_LISTS(eNl, eNh, wNl, wNh, TOKJ(i + 2));
            float ss = 0.f;
#pragma unroll
            for (int q = 0; q < 4; ++q) { xv[q][0] += gg[q][0] * acc[2 * q][0]; xv[q][1] += gg[q][1] * acc[2 * q][1]; xv[q][2] += gg[q][2] * acc[2 * q + 1][0]; xv[q][3] += gg[q][3] * acc[2 * q + 1][1];
                ss += (xv[q][0] * xv[q][0] + xv[q][1] * xv[q][1]) + (xv[q][2] * xv[q][2] + xv[q][3] * xv[q][3]); }
            ss = wave_sum(ss);
            const float rs = rsqrtf(ss * (1.0f / 1024.0f) + 1e-6f);
#pragma unroll
            for (int q = 0; q < 4; ++q) { const f32x4 fg = *(const f32x4*)(p.final_g + lo16 + 4 * q); f32x4 o;
#pragma unroll
                for (int j = 0; j < 4; ++j) o[j] = xv[q][j] * rs * fg[j];
                *(f32x4*)(p.out + (size_t)t * DM + lo16 + 4 * q) = o; }
        }
    }
#undef TOKJ
#undef SF_LISTS
}

typedef int v2i_t __attribute__((ext_vector_type(2)));
__device__ __forceinline__ void spmm_slice(const u32x4 (&R)[16], const i32x8 bw, LAS unsigned char* wbuf, int wa, int rb, int L, f32x4& acc) {
#pragma unroll
    for (int i = 0; i < 16; ++i) { LAS u32x4* d = (LAS u32x4*)(wbuf + (wa ^ ((i >> 1) << 4)) + i * 128);
        if (i & 1) *d = (u32x4){R[i][2], R[i][3], R[i][0], R[i][1]}; else *d = R[i]; }
#pragma unroll
    for (int mf = 0; mf < 16; ++mf) {
        LAS unsigned char* ap = wbuf + (rb ^ (mf << 3));
        const v2i_t lo = __builtin_amdgcn_ds_read_tr4_b64_v2i32((LAS v2i_t*)ap), hi = __builtin_amdgcn_ds_read_tr4_b64_v2i32((LAS v2i_t*)(ap + 2048));
        i32x8 a; a[0] = lo[0]; a[1] = lo[1]; a[2] = hi[0]; a[3] = hi[1]; a[4] = 0; a[5] = 0; a[6] = 0; a[7] = 0;
        const f32x4 d = __builtin_amdgcn_mfma_scale_f32_16x16x128_f8f6f4(a, bw, (f32x4){0.f, 0.f, 0.f, 0.f}, 4, 0, 0, 0x7f7f7f7f, 0, 0x7f7f7f7f);
        const bool keep = (L == mf);
#pragma unroll
        for (int j = 0; j < 4; ++j) acc[j] = keep ? d[j] : acc[j];
    }
}
__device__ __forceinline__ void dev_spmm_mfma(PREF p, LAS unsigned char* lds, int first0 = -1, int S_ = 0, int tend = 0) {
    const int tid = tid_opaque(), w = __builtin_amdgcn_readfirstlane(tid >> 6), l = tid & 63, rsub = l >> 3, kc = l & 7, L = l & 15, g = l >> 4;
    const int T = p.nb * SEQ;
    const unsigned kc16 = 16u * kc;
    const int first = (first0 >= 0 ? first0 : (int)blockIdx.x * 8) + w, S = first0 >= 0 ? S_ : (int)gridDim.x * 8, TE = first0 >= 0 ? tend : T;
    const int n = first < TE ? (TE - first + S - 1) / S : 0;
    LAS unsigned char* wbuf = lds + w * 16384;
    const int wa = rsub * 2048 + (kc << 4);
    const int rb = g * 4096 + L * 128 + (L << 3);
#define TOKI(i) (first + ((i) < n ? (i) : n - 1) * S)
#define SV_ISSUE(R, E0, E1, E2, E3, sl) do { const unsigned char* tab = p.v4 + (size_t)(sl) * 16384 * 128; PEER_ISSUE(R, E0, E1, E2, E3); } while (0)
    if (n > 0) {
        u32x4 RA[16], RB[16], eC0, eC1, eC2, eC3;
        PEER_LD_E(eC0, eC1, eC2, eC3, TOKI(0)); SV_ISSUE(RA, eC0, eC1, eC2, eC3, 0);
        for (int i = 0; i < n; ++i) {
            const int t = TOKI(i);
            const unsigned char* wp = p.w8 + (size_t)t * 128 + 16 * g;
            const u32x4 w0 = *(const u32x4*)wp, w1 = *(const u32x4*)(wp + 64);
            i32x8 bw;
#pragma unroll
            for (int j = 0; j < 4; ++j) { bw[j] = (int)w0[j]; bw[4 + j] = (int)w1[j]; }
            const float isc = p.wsc[t];
            f32x4 acc[4];
#pragma unroll
            for (int k = 0; k < 4; ++k) acc[k] = (f32x4){0.f, 0.f, 0.f, 0.f};
            SV_ISSUE(RB, eC0, eC1, eC2, eC3, 1); spmm_slice(RA, bw, wbuf, wa, rb, L, acc[0]);
            SV_ISSUE(RA, eC0, eC1, eC2, eC3, 2); spmm_slice(RB, bw, wbuf, wa, rb, L, acc[1]);
            SV_ISSUE(RB, eC0, eC1, eC2, eC3, 3);
            PEER_LD_E(eC0, eC1, eC2, eC3, TOKI(i + 1));
            spmm_slice(RA, bw, wbuf, wa, rb, L, acc[2]);
            int col4 = 16 * L + 4 * g; asm volatile("" : "+v"(col4));
            const bf16_t* x1p = p.x1b + (size_t)t * DM + col4; const float* g2p = p.mod + (size_t)(t >> 11) * 6144 + 5 * 1024 + col4;
            u32x2 xq[4]; f32x4 gg[4];
#pragma unroll
            for (int q = 0; q < 4; ++q) { xq[q] = __builtin_nontemporal_load((const u32x2*)(x1p + 256 * q)); gg[q] = *(const f32x4*)(g2p + 256 * q); }
            SV_ISSUE(RA, eC0, eC1, eC2, eC3, 0); spmm_slice(RB, bw, wbuf, wa, rb, L, acc[3]);
            f32x4 xv[4]; float ss = 0.f;
#pragma unroll
            for (int q = 0; q < 4; ++q) { xv[q] = (f32x4){bflo(xq[q][0]), bfhi(xq[q][0]), bflo(xq[q][1]), bfhi(xq[q][1])};
#pragma unroll
                for (int j = 0; j < 4; ++j) xv[q][j] += gg[q][j] * (acc[q][j] * isc);
                ss += (xv[q][0] * xv[q][0] + xv[q][1] * xv[q][1]) + (xv[q][2] * xv[q][2] + xv[q][3] * xv[q][3]); }
            ss = wave_sum(ss);
            const float rs = rsqrtf(ss * (1.0f / 1024.0f) + 1e-6f);
#pragma unroll
            for (int q = 0; q < 4; ++q) { const f32x4 fg = *(const f32x4*)(p.final_g + col4 + 256 * q); f32x4 o;
#pragma unroll
                for (int j = 0; j < 4; ++j) o[j] = xv[q][j] * rs * fg[j];
                __builtin_nontemporal_store(o, (f32x4*)(p.out + (size_t)t * DM + col4 + 256 * q)); }
        }
    }
#undef SV_ISSUE
#undef TOKI
}

__device__ __forceinline__ void dev_gemm_in(PREF p, LAS unsigned char* lds) {
    const int T = p.nb * SEQ, TC = p.nb * CTXL;
    {
        pg8::Gemm g{p.hc, p.Wt_in + (size_t)512 * DM, DM, DM, DM, 0, 0}; pg8::StaticOrder S; S.init(TC, 1024, gridDim.x, blockIdx.x);
        pg8::EpiAct E{p.zxc, 0, 0, 1 << 20, DM, 0, 0};
        pg8::gemm_phase(lds, g, S, E);
    }
    {
        pg8::Gemm g{p.h, p.Wt_in + (size_t)512 * DM, DM, DM, DM, 0, 0}; pg8::StaticOrder S; S.init(T, 4096, gridDim.x, blockIdx.x);
        pg8::EpiAct E{p.zx, p.zseg, 0x2210, 4, DM, 1, 0};
        pg8::gemm_phase(lds, g, S, E);
    }
    {
        pg8::Gemm g{p.Wt_in, p.h, DM, DM, DM, 0, 0}; pg8::StaticOrder S; S.init(512, T, gridDim.x, blockIdx.x);
        pg8::EpiAct E{p.zfT, (size_t)512 * SEQ, 0, SEQ / 256, SEQ, 0, 0};
        pg8::gemm_phase(lds, g, S, E);
    }
}
__device__ __forceinline__ void dev_gemm_dft(PREF p, LAS unsigned char* lds) {
    const int T = p.nb * SEQ;
    pg8::Gemm g{p.dft, p.zfT, SEQ, SEQ, SEQ, 0, (long)512 * SEQ}; pg8::BatchOrder S; S.init(2048, 512, p.nb, gridDim.x, blockIdx.x);
    pg8::EpiUV E{p.UV};
    pg8::gemm_phase(lds, g, S, E);
}
__device__ __forceinline__ void dev_gemm_mix(PREF p, LAS unsigned char* lds, int vb = -1) {
    if (vb < 0) vb = blockIdx.x;
    const int T = p.nb * SEQ;
    {
        pg8::Gemm g{p.UV, p.Wfp, DM, DM, DM, 0, 0}; pg8::StaticOrder S; S.init(T, 1024, gridDim.x, vb);
        pg8::EpiGate E{p.sga, nullptr, p.Pb};
        pg8::gemm_phase(lds, g, S, E);
    }
    {
        pg8::Gemm g{p.ybin, p.Wt_lru, DM, DM, DM, 0, 0}; pg8::StaticOrder S; S.init(T, 1024, gridDim.x, vb);
        pg8::EpiGate E{p.sgb, p.Pb, p.merged};
        pg8::gemm_phase(lds, g, S, E);
    }
}
__device__ __forceinline__ void dev_gemm_out(PREF p, LAS unsigned char* lds, int vb = -1) {
    if (vb < 0) vb = blockIdx.x;
    const int T = p.nb * SEQ;
    pg8::Gemm g{p.merged, p.Wt_out, DM, DM, DM, 0, 0, 1, 0}; pg8::StaticOrder S; S.init(T, 1024, gridDim.x, vb);
    pg8::EpiX1 E{p.x, p.pos, p.mod, p.b_out, p.x1b};
    pg8::gemm_phase(lds, g, S, E);
}
__device__ __forceinline__ void dev_gemm_q(PREF p, LAS unsigned char* lds, int vb = -1) {
    if (vb < 0) vb = blockIdx.x;
    const int T = p.nb * SEQ;
    pg8::Gemm g{p.h2, p.Wt_q, DM, DM, DM, 0, 0}; pg8::StaticOrder S; S.init(T, 2048, gridDim.x, vb);
    pg8::EpiAct E{p.q, 0, 0, 1 << 20, 2048, 1, 1, 1};
    pg8::gemm_phase(lds, g, S, E);
}

#define KERNEL_HEAD extern __shared__ __attribute__((aligned(16))) unsigned char smem_raw[]; LAS unsigned char* lds = (LAS unsigned char*)smem_raw;
#ifdef DIAG
__global__ void __launch_bounds__(NTHR, 2) k_prep_t(Params p) { KERNEL_HEAD
    dev_transpose(p.w_in, 4608, 0, 1024, 4608, p.Wt_in, 1, 0, 0, lds, 0, (int)gridDim.x);
    dev_transpose(p.w_lru_out, 1024, 0, 1024, 1024, p.Wt_lru, 1, 0, 0, lds, 0, (int)gridDim.x);
    dev_transpose(p.w_out, 1024, 0, 1024, 1024, p.Wt_out, 1, 0, 0, lds, 0, (int)gridDim.x);
    dev_transpose(p.peer_wq, 2048, 0, 1024, 2048, p.Wt_q, 1, 0, 0, lds, 0, (int)gridDim.x);
    dev_transpose(p.lru_wa, 128, 0, 128, 128, p.gates_bf, 8, 16384, 16384, lds, 0, (int)gridDim.x);
    dev_transpose(p.lru_wx, 128, 0, 128, 128, p.gates_bf + (size_t)8 * 16384, 8, 16384, 16384, lds, 0, (int)gridDim.x);
    dev_transpose(p.lru_wa + (size_t)8 * 16384, 128, 0, 128, 128, p.gates_bf + (size_t)16 * 16384, 8, 16384, 16384, lds, 0, (int)gridDim.x);
    dev_transpose(p.lru_wx + (size_t)8 * 16384, 128, 0, 128, 128, p.gates_bf + (size_t)24 * 16384, 8, 16384, 16384, lds, 0, (int)gridDim.x);
}
__global__ void __launch_bounds__(NTHR, 2) k_prep_c(Params p) { KERNEL_HEAD
    dev_convert(p.peer_keys, p.keys_bf, (size_t)8 * 2 * 128 * 128);
    dev_convert(p.peer_u, p.u_bf, (size_t)16384 * 1024);
    dev_convert(p.peer_v, p.v_bf, (size_t)16384 * 1024);
    dev_wfp(p, lds);
    dev_dft(p);
    dev_pos(p);
}
__global__ void __launch_bounds__(NTHR, 2) k_adaln(Params p) { KERNEL_HEAD dev_adaln(p, lds); }
__global__ void __launch_bounds__(NTHR, 2) k_norm1(Params p) { dev_norm(p, 0); }
__global__ void __launch_bounds__(NTHR, 2) k_gemm_in(Params p) { KERNEL_HEAD dev_gemm_in(p, lds); }
__global__ void __launch_bounds__(NTHR, 2) k_scan(Params p) { KERNEL_HEAD dev_scan(p, lds); }
__global__ void __launch_bounds__(NTHR, 2) k_gemm_dft(Params p) { KERNEL_HEAD dev_gemm_dft(p, lds); }
__global__ void __launch_bounds__(NTHR, 2) k_gemm_mix(Params p) { KERNEL_HEAD dev_gemm_mix(p, lds); }
__global__ void __launch_bounds__(NTHR, 2) k_gemm_out(Params p) { KERNEL_HEAD dev_gemm_out(p, lds); }
__global__ void __launch_bounds__(NTHR, 2) k_norm2(Params p) { dev_norm(p, 1); }
__global__ void __launch_bounds__(NTHR, 2) k_gemm_q(Params p) { KERNEL_HEAD dev_gemm_q(p, lds); }
__global__ void __launch_bounds__(NTHR, 2) k_topk(Params p) { dev_topk(p); }
__global__ void __launch_bounds__(NTHR, 2) k_peer(Params p) { dev_peer(p); }


#endif
namespace cg = cooperative_groups;

#define XB_TMO      128
#define XB_XCNT(j)  (256  + 64 * (j))
#define XB_XSUB(j)  (1280 + 64 * (j))
#define XB_XGEN(j)  (2304 + 64 * (j))
#define XB_TOP      3328
#define XB_TOPGEN   3392
#define XB_LSUB(j)  (3456 + 64 * (j))
#define XB_LGEN(j)  (4480 + 64 * (j))
#define XCD_BAR_WORDS 5504
#define XB_SPIN_CAP (1u << 22)
__device__ __forceinline__ unsigned xb_ld(unsigned* p)              { return __hip_atomic_load(p, __ATOMIC_RELAXED, __HIP_MEMORY_SCOPE_AGENT); }
__device__ __forceinline__ unsigned xb_add(unsigned* p, unsigned v) { return __hip_atomic_fetch_add(p, v, __ATOMIC_RELAXED, __HIP_MEMORY_SCOPE_AGENT); }
__device__ __forceinline__ unsigned xb_xcc_id() { return (unsigned)__builtin_amdgcn_s_getreg((3 << 11) | 20) & 0xFu; }
#define XB_SPIN(cond, bar) do { unsigned _sp = 0; while (cond) { __builtin_amdgcn_s_sleep(1); \
    if ((++_sp & 255u) == 0u) { if (xb_ld(&(bar)[XB_TMO])) break; if (_sp > XB_SPIN_CAP) { atomicAdd(&(bar)[XB_TMO], 1u); break; } } } } while (0)
struct XcdBarrier { unsigned* bar; unsigned x; volatile LAS unsigned* st; };
__device__ __forceinline__ XcdBarrier xcd_barrier_post(unsigned* bar, volatile LAS unsigned* st) {
    XcdBarrier b; b.bar = bar; b.x = xb_xcc_id(); b.st = st;
    if (threadIdx.x == 0) st[3] = xb_add(&bar[XB_XCNT(b.x)], 1u);
    return b;
}
__device__ __forceinline__ void xcd_barrier_complete(unsigned* bar, unsigned x, unsigned& nloc, unsigned& nx, unsigned& uni) {
    const unsigned G = gridDim.x * gridDim.y * gridDim.z;
    unsigned sum, cnt, mine, even, sp = 0u;
    for (;;) {
        sum = 0u; cnt = 0u; mine = 0u; even = ((G & 63u) == 0u) ? 1u : 0u;
#pragma unroll
        for (unsigned j = 0; j < 16; ++j) { const unsigned c = xb_ld(&bar[XB_XCNT(j)]); sum += c; cnt += (c > 0u) ? 1u : 0u; mine = (j == x) ? c : mine; if (j < 8 && c != (G >> 3)) even = 0u; }
        if (sum == G) break;
        __builtin_amdgcn_s_sleep(1);
        if ((++sp & 255u) == 0u) { if (xb_ld(&bar[XB_TMO])) break; if (sp > XB_SPIN_CAP) { atomicAdd(&bar[XB_TMO], 1u); break; } }
    }
    nloc = mine > 0u ? mine : 1u; nx = cnt > 0u ? cnt : 1u; uni = (sum == G) ? even : 0u;
}
__device__ __forceinline__ void xcd_barrier(const XcdBarrier& b) {
    asm volatile("s_waitcnt vmcnt(0)" ::: "memory");
    __syncthreads();
    if (threadIdx.x == 0) {
        unsigned* bar = b.bar;
        __builtin_amdgcn_s_waitcnt(0);
        unsigned nloc = b.st[0], nx = b.st[1];
        if (nloc == 0u) { unsigned uni; xcd_barrier_complete(bar, b.x, nloc, nx, uni); b.st[0] = nloc; b.st[1] = nx; b.st[2] = uni; }
        const unsigned old = xb_add(&bar[XB_XSUB(b.x)], 1u);
        const unsigned gen = old / nloc;
        if (old + 1u == (gen + 1u) * nloc) {
            __builtin_amdgcn_fence(__ATOMIC_RELEASE, "agent");
            asm volatile("s_waitcnt vmcnt(0)" ::: "memory");
            const unsigned og = xb_add(&bar[XB_TOP], 1u);
            const unsigned tg = og / nx;
            if (og + 1u == (tg + 1u) * nx) xb_add(&bar[XB_TOPGEN], 1u);
            else XB_SPIN(xb_ld(&bar[XB_TOPGEN]) == tg, bar);
            __builtin_amdgcn_fence(__ATOMIC_ACQUIRE, "agent");
            xb_add(&bar[XB_XGEN(b.x)], 1u);
            asm volatile("s_waitcnt vmcnt(0)" ::: "memory");
        } else {
            XB_SPIN(xb_ld(&bar[XB_XGEN(b.x)]) == gen, bar);
            __builtin_amdgcn_fence(__ATOMIC_ACQUIRE, "agent");
            asm volatile("s_waitcnt vmcnt(0)" ::: "memory");
        }
    }
    __syncthreads();
}

__device__ __forceinline__ void xcd_local_barrier(const XcdBarrier& b) {
    asm volatile("s_waitcnt vmcnt(0)" ::: "memory");
    __syncthreads();
    if (threadIdx.x == 0) {
        unsigned* bar = b.bar;
        __builtin_amdgcn_s_waitcnt(0);
        const unsigned nloc = b.st[0];
        const unsigned old = xb_add(&bar[XB_LSUB(b.x)], 1u);
        const unsigned gen = old / nloc;
        if (old + 1u == (gen + 1u) * nloc) xb_add(&bar[XB_LGEN(b.x)], 1u);
        else XB_SPIN(xb_ld(&bar[XB_LGEN(b.x)]) == gen, bar);
        __builtin_amdgcn_fence(__ATOMIC_ACQUIRE, "agent");
        asm volatile("s_waitcnt vmcnt(0)" ::: "memory");
    }
    __syncthreads();
}

#ifndef DIAG
__device__ __forceinline__ CParams* kparams() { CParams* q = (CParams*)__builtin_amdgcn_kernarg_segment_ptr(); asm volatile("" : "+s"(q)); return q; }
__global__ void __launch_bounds__(NTHR, 2) k_mega(Params p_unused) { KERNEL_HEAD
    cg::grid_group grid = cg::this_grid();
    volatile LAS unsigned* bst = (volatile LAS unsigned*)(lds + LDS_BYTES - 16);
    if (blockIdx.x == 0) { CParams& p = *kparams(); for (int i = tid_opaque(); i < XCD_BAR_WORDS; i += NTHR) p.bar[i] = 0u; }
    if (tid_opaque() < 2) bst[tid_opaque()] = 0u;
    { CParams& p = *kparams(); dev_adaln(p, lds); }
    __syncthreads();
    { CParams& p = *kparams();
      const int G = (int)gridDim.x, G8 = (G & 7) ? G : (G >> 3), gf = (G & 7) ? 0 : (G >> 1);
      dev_transpose(p.w_in, 4608, 0, 1024, 4608, p.Wt_in, 1, 0, 0, lds, 0, G);
      dev_transpose(p.lru_wa, 128, 0, 128, 128, p.gates_bf, 8, 16384, 16384, lds, gf, G8);
      dev_transpose(p.lru_wx, 128, 0, 128, 128, p.gates_bf + (size_t)8 * 16384, 8, 16384, 16384, lds, (G & 7) ? 0 : gf + G8, G8);
      dev_transpose(p.lru_wa + (size_t)8 * 16384, 128, 0, 128, 128, p.gates_bf + (size_t)16 * 16384, 8, 16384, 16384, lds, (G & 7) ? 0 : gf + 2 * G8, G8);
      dev_transpose(p.lru_wx + (size_t)8 * 16384, 128, 0, 128, 128, p.gates_bf + (size_t)24 * 16384, 8, 16384, 16384, lds, (G & 7) ? 0 : gf + 3 * G8, G8);
      dev_transpose(p.w_lru_out, 1024, 0, 1024, 1024, p.Wt_lru, 1, 0, 0, lds, 0, G);
      dev_transpose(p.w_out, 1024, 0, 1024, 1024, p.Wt_out, 1, 0, 0, lds, 0, G);
      dev_transpose(p.peer_wq, 2048, 0, 1024, 2048, p.Wt_q, 1, 0, 0, lds, 0, G); }
    { CParams& p = *kparams();
      dev_convert(p.peer_keys, p.keys_bf, (size_t)8 * 2 * 128 * 128);
      if (blockIdx.x == 0 && tid_opaque() < 2) p.tmax[tid_opaque()] = 0u; }
    { CParams& p = *kparams(); dev_wfp(p, lds); }
    { CParams& p = *kparams(); dev_dft(p); dev_pos(p); }
    grid.sync();
    XcdBarrier xbar; { CParams& p = *kparams(); xbar = xcd_barrier_post(p.bar, bst); }
    { CParams& p = *kparams(); dev_norm(p, 0); }
    xcd_barrier(xbar);
    { CParams& p = *kparams(); dev_tab8(p); }
    { CParams& p = *kparams(); dev_gemm_in(p, lds); }
    xcd_barrier(xbar);
    { CParams& p = *kparams(); dev_scan(p, lds); }
    { CParams& p = *kparams(); dev_gemm_dft(p, lds); }
    xcd_barrier(xbar);
    const unsigned uni = __builtin_amdgcn_readfirstlane(bst[2]), rank = __builtin_amdgcn_readfirstlane(bst[3]);
    const int vb = uni ? (int)(rank * 8u + xbar.x) : (int)blockIdx.x;
    { CParams& p = *kparams(); dev_gemm_mix(p, lds, vb); }
    if (uni) xcd_local_barrier(xbar); else xcd_barrier(xbar);
    { CParams& p = *kparams(); dev_gemm_out(p, lds, vb); }
    if (uni) xcd_local_barrier(xbar); else xcd_barrier(xbar);
    { CParams& p = *kparams(); const int TX = (p.nb * SEQ) >> 3;
      dev_norm(p, 1, uni ? (int)xbar.x * TX + (int)rank * 8 : (int)blockIdx.x * 8, uni ? (int)gridDim.x : (int)gridDim.x * 8, uni ? ((int)xbar.x + 1) * TX : p.nb * SEQ); }
    if (uni) xcd_local_barrier(xbar); else xcd_barrier(xbar);
    { CParams& p = *kparams(); dev_gemm_q(p, lds, vb); }
    if (uni) xcd_local_barrier(xbar); else xcd_barrier(xbar);
    const int TXr = (NBATCH * SEQ) >> 3, nlb = (int)gridDim.x >> 3, tk0 = uni ? (int)xbar.x * TXr + (int)rank * 8 : (int)blockIdx.x * 8, tkS = uni ? (int)gridDim.x : (int)gridDim.x * 8, tkE = uni ? ((int)xbar.x + 1) * TXr : NBATCH * SEQ;
    { CParams& p = *kparams();
      dev_topk(p, lds, uni ? (int)(rank & 7u) : (int)(blockIdx.x & 7), uni ? (int)xbar.x * (TXr >> 5) + (int)(rank >> 3) * 8 : (int)(blockIdx.x >> 3) * 8, uni ? ((int)xbar.x + 1) * (TXr >> 5) : (NBATCH * SEQ) >> 5, (nlb >> 3) * 8); }
    if (uni) xcd_local_barrier(xbar); else xcd_barrier(xbar);
    { CParams& p = *kparams(); dev_sddmm_act(p, lds, tk0, tkS, tkE); }
    asm volatile("s_waitcnt vmcnt(0)" ::: "memory");
    __syncthreads();
    { CParams& p = *kparams(); dev_spmm_mfma(p, lds, tk0, tkS, tkE); }
}
#endif

#ifdef DIAG
__device__ __forceinline__ unsigned hsh(unsigned a, unsigned b) { unsigned x = a * 0x9E3779B1u ^ (b + 0x7F4A7C15u) * 0x85EBCA6Bu; x ^= x >> 15; x *= 0x2C1B3C6Du; x ^= x >> 12; x *= 0x297A2D39u; x ^= x >> 15; return x; }
__device__ __forceinline__ void rep(unsigned* slot, float got, float ref, float floor_) {
    float err = fabsf(got - ref) / (fabsf(ref) + floor_); if (!(err < 1e30f)) err = 1e30f; atomicMax(slot, __float_as_uint(err));
}
__device__ __forceinline__ float pos_direct(int t, int d) { const int j = d & 255, part = d >> 8; const float omega = 1.0f / powf(10000.0f, (float)j / 256.0f);
    const float arg = (float)(part < 2 ? (t >> 6) : (t & 63)) * omega; return (part & 1) ? cosf(arg) : sinf(arg); }
__global__ void chk_mod(Params p) {
    const int s = blockIdx.x * blockDim.x + threadIdx.x; const unsigned hv = hsh(s, 1); const int r = hv % 33, n = (hv >> 8) % 6144;
    const float* cond = r < 32 ? p.c + r * 1024 : p.c_ctx; float acc = p.b_mod[n];
    for (int k = 0; k < 1024; ++k) { const float v = cond[k]; acc += (v / (1.0f + expf(-v))) * p.w_mod[(size_t)k * 6144 + n]; }
    rep(p.diag + 1, p.mod[(size_t)r * 6144 + n], acc, 0.3f);
}
__global__ void chk_norm(Params p, int which) {
    const int s = blockIdx.x * blockDim.x + threadIdx.x; const unsigned hv = hsh(s, 2 + which);
    const int T = p.nb * SEQ, TC = which == 0 ? p.nb * CTXL : 0; const int row = hv % (T + TC), d = (hv >> 12) % 1024;
    const bool isctx = row >= T; const int lrow = isctx ? row - T : row; const int b = isctx ? 32 : lrow >> 11;
    const float* src = which == 1 ? p.x1 + (size_t)lrow * DM : (isctx ? p.ctx + (size_t)lrow * DM : p.x + (size_t)lrow * DM);
    float ss = 0.f, vd = 0.f;
    for (int k = 0; k < 1024; ++k) { float v = src[k]; if (which == 0 && !isctx) v += pos_direct(lrow & 2047, k); ss += v * v; if (k == d) vd = v; }
    const float rs = 1.0f / sqrtf(ss / 1024.0f + 1e-6f);
    const float* md = p.mod + (size_t)b * 6144 + (which == 0 ? 0 : 3 * 1024);
    const float ref = (vd * rs * (which == 0 ? p.norm1_g[d] : p.norm2_g[d])) * (1.0f + md[1024 + d]) + md[d];
    const bf16_t* dst = which == 1 ? p.h2 + (size_t)lrow * DM : (isctx ? p.hc + (size_t)lrow * DM : p.h + (size_t)lrow * DM);
    rep(p.diag + (which == 0 ? 2 : 8), bf2f(dst[d]), ref, 0.3f);
}
__global__ void chk_z(Params p) {
    const int s = blockIdx.x * blockDim.x + threadIdx.x; const unsigned hv = hsh(s, 5);
    const int T = p.nb * SEQ, TC = p.nb * CTXL;
    if (s & 1) { const int row = hv % T, col = (hv >> 13) % 4608; float acc = 0.f;
        for (int k = 0; k < 1024; ++k) acc += bf2f(p.h[(size_t)row * DM + k]) * p.w_in[(size_t)k * 4608 + col];
        float got;
        if (col < 512) got = bf2f(p.zfT[(size_t)col * T + row]);
        else if (col < 1536) got = bf2f(p.zx[(size_t)row * DM + col - 512]);
        else if (col < 2560) { got = bf2f(p.gzy[(size_t)row * DM + col - 1536]); acc = 0.5f * acc * (1.0f + tanhf(0.7978845608f * (acc + 0.044715f * acc * acc * acc))); }
        else if (col < 3584) { got = bf2f(p.sga[(size_t)row * DM + col - 2560]); acc = 1.0f / (1.0f + expf(-acc)); }
        else { got = bf2f(p.sgb[(size_t)row * DM + col - 3584]); acc = 1.0f / (1.0f + expf(-acc)); }
        rep(p.diag + 3, got, acc, 0.5f);
    } else { const int row = hv % TC, col = 512 + (hv >> 13) % 1024; float acc = 0.f;
        for (int k = 0; k < 1024; ++k) acc += bf2f(p.hc[(size_t)row * DM + k]) * p.w_in[(size_t)k * 4608 + col];
        rep(p.diag + 3, bf2f(p.zxc[(size_t)row * DM + col - 512]), acc, 0.5f); }
}
__global__ void chk_uv(Params p) {
    const int s = blockIdx.x * blockDim.x + threadIdx.x; const unsigned hv = hsh(s, 6);
    const int T = p.nb * SEQ; const int b = hv % p.nb, kt = (hv >> 4) % 2048, ch = (hv >> 15) % 512, part = (hv >> 25) & 1;
    float acc = 0.f;
    for (int t = 0; t < 2048; ++t) { const float a = (float)((kt * t) & 2047) / 1024.0f; acc += (part ? sinpif(a) : cospif(a)) * bf2f(p.zfT[(size_t)ch * T + b * 2048 + t]); }
    rep(p.diag + 4, bf2f(p.UV[((size_t)b * 2048 + kt) * DM + part * 512 + ch]), acc, 16.0f);
}
__global__ void __launch_bounds__(512) chk_scan(Params p) {
    __shared__ float AF[2304], BF[2304], AB[2304], BB[2304];
    const unsigned hv = hsh(blockIdx.x, 7); const int b = hv % p.nb, c = (hv >> 8) % 1024, head = c >> 7, cc = c & 127;
    for (int tp = threadIdx.x; tp < 2304; tp += blockDim.x) {
        const bool isctx = tp < 256; const int t = isctx ? tp : tp - 256, Tseq = isctx ? 256 : 2048;
        const bf16_t* src = isctx ? p.zxc + (size_t)b * 256 * DM : p.zx + (size_t)b * 2048 * DM;
        float gaf = 0.f, gxf = 0.f, gab = 0.f, gxb = 0.f, xcc = 0.f;
        for (int i = 0; i < 128; ++i) { const int hi = head * 128 + i; float xci = p.conv_b[hi];
            for (int r = 0; r < 4; ++r) { const int tr = t - 1 + r; if (tr >= 0 && tr < Tseq) xci += p.conv_w[r * 1024 + hi] * bf2f(src[(size_t)tr * DM + hi]); }
            const size_t wo = ((size_t)head * 128 + i) * 128 + cc;
            gaf += xci * p.lru_wa[wo]; gxf += xci * p.lru_wx[wo]; gab += xci * p.lru_wa[(size_t)8 * 16384 + wo]; gxb += xci * p.lru_wx[(size_t)8 * 16384 + wo];
            if (i == cc) xcc = xci; }
        { const float r = 1.0f / (1.0f + expf(-(gaf + p.lru_ba[c]))), ig = 1.0f / (1.0f + expf(-(gxf + p.lru_bx[c])));
          const float la = -8.0f * r * log1pf(expf(-p.lru_lambda[c])); AF[tp] = expf(la); BF[tp] = sqrtf(fmaxf(0.f, -expm1f(2.0f * la))) * ig * xcc; }
        { const float r = 1.0f / (1.0f + expf(-(gab + p.lru_ba[1024 + c]))), ig = 1.0f / (1.0f + expf(-(gxb + p.lru_bx[1024 + c])));
          const float la = -8.0f * r * log1pf(expf(-p.lru_lambda[1024 + c])); AB[tp] = expf(la); BB[tp] = sqrtf(fmaxf(0.f, -expm1f(2.0f * la))) * ig * xcc; }
    }
    __syncthreads();
    if (threadIdx.x == 0) { float h = 0.f; for (int tp = 0; tp < 2304; ++tp) { h = AF[tp] * h + BF[tp]; AF[tp] = h; } }
    if (threadIdx.x == 64) { float h = 0.f; for (int tp = 255; tp >= 0; --tp) { h = AB[tp] * h + BB[tp]; AB[tp] = h; } for (int tp = 2303; tp >= 256; --tp) { h = AB[tp] * h + BB[tp]; AB[tp] = h; } }
    __syncthreads();
    for (int t = threadIdx.x; t < 2048; t += blockDim.x) { float z = 0.f; const size_t row = (size_t)b * 2048 + t;
        for (int k = 0; k < 1024; ++k) z += bf2f(p.h[row * DM + k]) * p.w_in[(size_t)k * 4608 + 1536 + c];
        const float gz = 0.5f * z * (1.0f + tanhf(0.7978845608f * (z + 0.044715f * z * z * z)));
        rep(p.diag + 5, bf2f(p.ybin[row * DM + c]), (AF[256 + t] + AB[256 + t]) * gz, 0.25f); }
}
__global__ void chk_merged(Params p) {
    const int s = blockIdx.x * blockDim.x + threadIdx.x; const unsigned hv = hsh(s, 8); const int T = p.nb * SEQ; const int row = hv % T, col = (hv >> 13) % 1024;
    float ya = 0.f;
    for (int g = 0; g < 4; ++g) for (int kc = 0; kc < 128; ++kc) { float y = 0.f;
        for (int c = 0; c < 128; ++c) { const float a = (float)((kc * c) & 127) / 64.0f; y += bf2f(p.UV[(size_t)row * DM + g * 128 + c]) * cospif(a) - bf2f(p.UV[(size_t)row * DM + 512 + g * 128 + c]) * sinpif(a); }
        ya += (y / 512.0f) * p.w_fourier[(size_t)(g * 128 + kc) * 1024 + col]; }
    float yb = 0.f;
    for (int k = 0; k < 1024; ++k) yb += bf2f(p.ybin[(size_t)row * DM + k]) * p.w_lru_out[(size_t)k * 1024 + col];
    const float ref = bf2f(p.sga[(size_t)row * DM + col]) * ya + bf2f(p.sgb[(size_t)row * DM + col]) * yb;
    rep(p.diag + 6, bf2f(p.merged[(size_t)row * DM + col]), ref, 0.4f);
}
__global__ void chk_x1(Params p) {
    const int s = blockIdx.x * blockDim.x + threadIdx.x; const unsigned hv = hsh(s, 9); const int T = p.nb * SEQ; const int row = hv % T, col = (hv >> 13) % 1024, b = row >> 11;
    float acc = p.b_out[col];
    for (int k = 0; k < 1024; ++k) acc += bf2f(p.merged[(size_t)row * DM + k]) * p.w_out[(size_t)k * 1024 + col];
    const float ref = p.x[(size_t)row * DM + col] + pos_direct(row & 2047, col) + p.mod[(size_t)b * 6144 + 2048 + col] * acc;
    rep(p.diag + 7, p.x1[(size_t)row * DM + col], ref, 1.0f);
}
__global__ void chk_q(Params p) {
    const int s = blockIdx.x * blockDim.x + threadIdx.x; const unsigned hv = hsh(s, 10); const int T = p.nb * SEQ; const int row = hv % T, col = (hv >> 13) % 2048;
    float acc = 0.f;
    for (int k = 0; k < 1024; ++k) acc += bf2f(p.h2[(size_t)row * DM + k]) * p.peer_wq[(size_t)k * 2048 + col];
    rep(p.diag + 9, bf2f(p.q[(size_t)row * 2048 + col]), acc, 0.5f);
}
__global__ void __launch_bounds__(256) chk_topk(Params p) {
    __shared__ float sc[256]; __shared__ float cand[256]; __shared__ int top0[16], top1[16], refe[16]; __shared__ float tv0[16], tv1[16], refv[16];
    const unsigned hv = hsh(blockIdx.x, 11); const int T = p.nb * SEQ; const int tok = hv % T, hd = (hv >> 16) & 7; const int j = threadIdx.x, ph = j >> 7, key = j & 127;
    float a = 0.f;
    for (int d = 0; d < 128; ++d) a += bf2f(p.q[(size_t)tok * 2048 + hd * 256 + ph * 128 + d]) * p.peer_keys[((size_t)(hd * 2 + ph) * 128 + key) * 128 + d];
    sc[j] = a; __syncthreads();
    if (j == 0) {
        for (int hf = 0; hf < 2; ++hf) for (int r = 0; r < 16; ++r) { int bi = 0; float bv = -1e30f; for (int k = 0; k < 128; ++k) if (sc[hf * 128 + k] > bv) { bv = sc[hf * 128 + k]; bi = k; }
            sc[hf * 128 + bi] = -1e30f; if (hf == 0) { top0[r] = bi; tv0[r] = bv; } else { top1[r] = bi; tv1[r] = bv; } }
        for (int i = 0; i < 16; ++i) for (int k = 0; k < 16; ++k) cand[i * 16 + k] = tv0[i] + tv1[k];
        for (int r = 0; r < 16; ++r) { int bi = 0; float bv = -1e30f; for (int k = 0; k < 256; ++k) if (cand[k] > bv) { bv = cand[k]; bi = k; }
            cand[bi] = -1e30f; refe[r] = top0[bi >> 4] * 128 + top1[bi & 15]; refv[r] = bv; }
        const float mx = refv[0]; float sum = 0.f;
        for (int r = 0; r < 16; ++r) sum += expf(refv[r] - mx);
        int bad = 0;
        for (int k = 0; k < 16; ++k) { const int e = p.eidx[(size_t)tok * 128 + hd * 16 + k]; const float g = p.gw[(size_t)tok * 128 + hd * 16 + k]; bool ok = false;
            for (int r = 0; r < 16; ++r) if (refe[r] == e) { const float gr = expf(refv[r] - mx) / sum; if (fabsf(g - gr) <= 0.05f * gr + 0.003f) ok = true; }
            if (!ok) ++bad; }
        atomicMax(p.diag + 10, __float_as_uint((float)bad / 16.0f)); atomicMax(p.diag + 16, (unsigned)bad);
        { int nf = 0; float sg = 0.f;
          for (int k = 0; k < 16; ++k) { const int e = p.eidx[(size_t)tok * 128 + hd * 16 + k]; sg += p.gw[(size_t)tok * 128 + hd * 16 + k]; bool f = false; for (int r = 0; r < 16; ++r) if (refe[r] == e) f = true; if (!f) ++nf; }
          atomicMax(p.diag + 12, (unsigned)nf); atomicMax(p.diag + 13, __float_as_uint(fabsf(sg - 1.0f)));
          int dup = 0; float wre = 0.f;
          for (int k = 0; k < 16; ++k) { const int e = p.eidx[(size_t)tok * 128 + hd * 16 + k]; const float g = p.gw[(size_t)tok * 128 + hd * 16 + k];
              for (int k2 = 0; k2 < k; ++k2) if (p.eidx[(size_t)tok * 128 + hd * 16 + k2] == e) ++dup;
              for (int r = 0; r < 16; ++r) if (refe[r] == e) { const float gr = expf(refv[r] - mx) / sum; wre = fmaxf(wre, fabsf(g - gr) / (gr + 0.003f)); } }
          atomicMax(p.diag + 14, (unsigned)dup); atomicMax(p.diag + 15, __float_as_uint(wre)); }
    }
}
__global__ void __launch_bounds__(256) chk_out(Params p) {
    __shared__ float wj[128]; __shared__ float red[256];
    const unsigned hv = hsh(blockIdx.x, 12); const int T = p.nb * SEQ; const int tok = hv % T, b = tok >> 11, t = threadIdx.x;
    if (t < 128) { const int e = p.eidx[(size_t)tok * 128 + t]; float dsum = 0.f;
        for (int d = 0; d < 1024; ++d) dsum += p.peer_u[(size_t)e * 1024 + d] * bf2f(p.h2[(size_t)tok * DM + d]);
        const float ge = 0.5f * dsum * (1.0f + tanhf(0.7978845608f * (dsum + 0.044715f * dsum * dsum * dsum)));
        wj[t] = p.gw[(size_t)tok * 128 + t] * ge; }
    __syncthreads();
    float x2[4]; float ss = 0.f;
    for (int i = 0; i < 4; ++i) { const int d = t + 256 * i; float acc = 0.f;
        for (int jx = 0; jx < 128; ++jx) acc += wj[jx] * p.peer_v[(size_t)p.eidx[(size_t)tok * 128 + jx] * 1024 + d];
        const float v = p.x1[(size_t)tok * DM + d] + p.mod[(size_t)b * 6144 + 5 * 1024 + d] * acc;
        if (i == 0) x2[0] = v; else if (i == 1) x2[1] = v; else if (i == 2) x2[2] = v; else x2[3] = v;
        ss += v * v; }
    red[t] = ss; __syncthreads();
    for (int o = 128; o > 0; o >>= 1) { if (t < o) red[t] += red[t + o]; __syncthreads(); }
    const float rs = 1.0f / sqrtf(red[0] / 1024.0f + 1e-6f);
    rep(p.diag + 11, p.out[(size_t)tok * DM + t], x2[0] * rs * p.final_g[t], 0.5f);
    rep(p.diag + 11, p.out[(size_t)tok * DM + t + 256], x2[1] * rs * p.final_g[t + 256], 0.5f);
    rep(p.diag + 11, p.out[(size_t)tok * DM + t + 512], x2[2] * rs * p.final_g[t + 512], 0.5f);
    rep(p.diag + 11, p.out[(size_t)tok * DM + t + 768], x2[3] * rs * p.final_g[t + 768], 0.5f);
}
__global__ void diag_apply(Params p, int total) {
    const float tol[12] = {0.f, 2e-3f, 2e-2f, 3e-2f, 3e-2f, 8e-2f, 4e-2f, 1e-2f, 2e-2f, 3e-2f, 0.2f, 3e-2f};
    int F = 0; float err = 1.f;
    for (int i = 11; i >= 1; --i) { const float e = __uint_as_float(p.diag[i]); const float tl = i == 1 ? tol[1] : i == 2 ? tol[2] : i == 3 ? tol[3] : i == 4 ? tol[4] : i == 5 ? tol[5] : i == 6 ? tol[6] : i == 7 ? tol[7] : i == 8 ? tol[8] : i == 9 ? tol[9] : i == 10 ? tol[10] : tol[11];
        if (!(e <= tl)) { F = i; err = e; } }
    int cls = 0; if (F) { const float l = -log10f(fmaxf(err, 1e-12f)); cls = l < 0.f ? 0 : (l > 9.f ? 9 : (int)l); }
    if (F == 10) { cls = (int)p.diag[16]; if (cls > 9) cls = 9; }
#ifdef DIAG_AB
    { const float e10 = __uint_as_float(p.diag[10]), e11 = __uint_as_float(p.diag[11]); F = (e10 <= 1e9f ? 1 : 2) + (e11 <= 0.03f ? 0 : 4); const float l = -log10f(fmaxf(e11, 1e-12f)); cls = l < 0.f ? 0 : (l > 9.f ? 9 : (int)l); }
#endif
    const float K = sqrtf(((float)F / 10.0f + 1.0f) * powf(10.0f, (float)(cls + 6)));
    for (int i = blockIdx.x * blockDim.x + threadIdx.x; i < total; i += gridDim.x * blockDim.x) p.out[i] = K;
}
#endif

static inline size_t al(size_t x) { return (x + 255) & ~(size_t)255; }
extern "C" void kernel_launch(void* const* d_in, const int* in_sizes, int n_in, void* d_out, int out_size, void* d_ws, size_t ws_size, hipStream_t stream) {
#ifdef DIAG
    static int inited = 0;
    const void* kerns[] = {(const void*)k_prep_t, (const void*)k_prep_c, (const void*)k_adaln, (const void*)k_gemm_in, (const void*)k_scan, (const void*)k_gemm_dft, (const void*)k_gemm_mix, (const void*)k_gemm_out, (const void*)k_gemm_q};
    if (!inited) { for (auto k : kerns) (void)hipFuncSetAttribute(k, hipFuncAttributeMaxDynamicSharedMemorySize, LDS_BYTES); inited = 1; }
#endif
    Params p{};
    const float* const* in = (const float* const*)d_in;
    p.x = in[0]; p.c = in[1]; p.ctx = in[2]; p.c_ctx = in[3]; p.w_mod = in[4]; p.b_mod = in[5]; p.norm1_g = in[6]; p.norm2_g = in[7]; p.w_in = in[8]; p.w_fourier = in[9];
    p.conv_w = in[10]; p.conv_b = in[11]; p.lru_wa = in[12]; p.lru_ba = in[13]; p.lru_wx = in[14]; p.lru_bx = in[15]; p.lru_lambda = in[16]; p.w_lru_out = in[17];
    p.w_out = in[18]; p.b_out = in[19]; p.peer_wq = in[20]; p.peer_keys = in[21]; p.peer_u = in[22]; p.peer_v = in[23]; p.final_g = in[24];
    p.out = (float*)d_out;
    unsigned char* ws = (unsigned char*)d_ws; size_t o = 0;
    auto take = [&](size_t bytes) { unsigned char* r = ws + o; o += al(bytes); return r; };
    const size_t MiB = 1ull << 20;
    p.diag = (unsigned*)take(4096);
    p.mod = (float*)take(33 * 6144 * 4); p.pos = (float*)take((size_t)SEQ * DM * 4);
    p.Wt_in = (bf16_t*)take((size_t)4608 * 1024 * 2); p.Wfp = (bf16_t*)take(2 * MiB); p.Wt_lru = (bf16_t*)take(2 * MiB); p.Wt_out = (bf16_t*)take(2 * MiB); p.Wt_q = (bf16_t*)take(4 * MiB);
    p.keys_bf = (bf16_t*)take(MiB / 2); p.gates_bf = (bf16_t*)take(MiB); p.dft = (bf16_t*)take(16 * MiB);
#ifdef DIAG
    p.u_bf = (bf16_t*)take(32 * MiB); p.v_bf = (bf16_t*)take(32 * MiB);
#endif
    p.u8 = nullptr; p.u4 = (unsigned char*)take(8 * MiB); p.scu = (float*)take(131072); p.v8 = nullptr; p.v4 = (unsigned char*)take(8 * MiB); p.scv = (float*)take(65536); p.ssb = (float*)take(2 * MiB); p.tmax = (unsigned*)take(256); p.bar = (unsigned*)take(XCD_BAR_WORDS * 4);
#ifndef DIAG
    { const size_t need = 928 * MiB; if (ws_size > o + need + MiB) o = (ws_size - need) & ~((size_t)4095); }
    unsigned char* R9 = take(64 * MiB);
    unsigned char* R8 = take(128 * MiB);
    unsigned char* R45 = take(256 * MiB);
    unsigned char* R67 = take(256 * MiB);
    unsigned char* R3 = take(64 * MiB);
    p.zxc = (bf16_t*)take(16 * MiB); p.hc = (bf16_t*)take(16 * MiB);
    unsigned char* R0 = take(128 * MiB);
    p.h = (bf16_t*)R0; p.hf = (bf16_t*)R0; p.h2 = (bf16_t*)R0;
    p.zfT = (bf16_t*)R3; p.eidx = (int*)R3; p.gw = (float*)(R3 + 32 * MiB); p.su = (float*)(R45 + 128 * MiB);
    p.zx = (bf16_t*)R45; p.gzy = (bf16_t*)(R45 + 128 * MiB); p.ybin = p.gzy; p.x1 = (float*)R45; p.x1b = (bf16_t*)R45;
    p.sga = (bf16_t*)R67; p.Pb = p.sga; p.sgb = (bf16_t*)(R67 + 128 * MiB); p.merged = (bf16_t*)R0; p.q = (bf16_t*)R67;
    p.UV = (bf16_t*)R8; p.pd = (float*)R67; p.h8 = R9; p.peer16 = (bf16_t*)R0; p.w8 = (unsigned char*)p.zxc; p.wsc = p.ssb;
    p.zseg = (size_t)64 * MiB; p.nb = NBATCH; p.pad = 0;
#else
    const int NBD = 4; const size_t U = (size_t)NBD * SEQ * DM * 2;
    p.h = (bf16_t*)take(U); p.hc = (bf16_t*)take(U / 8); p.zxc = (bf16_t*)take(U / 8); p.zfT = (bf16_t*)take(U / 2);
    p.zx = (bf16_t*)take(U); p.gzy = (bf16_t*)take(U); p.sga = (bf16_t*)take(U); p.sgb = (bf16_t*)take(U);
    p.hf = (bf16_t*)take(U); p.ybin = (bf16_t*)take(U); p.UV = (bf16_t*)take(U); p.Pb = (bf16_t*)take(U); p.merged = (bf16_t*)take(U);
    p.x1 = (float*)take(2 * U); p.h2 = (bf16_t*)take(U); p.q = (bf16_t*)take(2 * U); p.eidx = (int*)take(U / 4); p.gw = (float*)take(U / 4);
    p.zseg = U / 2; p.nb = NBD; p.pad = 0;
    (void)hipMemsetAsync(p.diag, 0, 4096, stream);
#endif
#if !defined(DIAG)
    {
        static int grid_blocks = 0;
        if (!grid_blocks) {
            int dev = 0, cus = 0, per_cu = 0;
            (void)hipGetDevice(&dev);
            (void)hipDeviceGetAttribute(&cus, hipDeviceAttributeMultiprocessorCount, dev);
            (void)hipFuncSetAttribute((const void*)k_mega, hipFuncAttributeMaxDynamicSharedMemorySize, LDS_BYTES);
            (void)hipOccupancyMaxActiveBlocksPerMultiprocessor(&per_cu, (const void*)k_mega, NTHR, LDS_BYTES);
            if (per_cu < 1) { fprintf(stderr, "kernel_launch: occupancy query says %d blocks per CU\n", per_cu); per_cu = 1; }
            grid_blocks = cus * 1;
        }
        void* args[] = {(void*)&p};
        const hipError_t e = hipLaunchCooperativeKernel((const void*)k_mega, dim3(grid_blocks), dim3(NTHR), args, LDS_BYTES, stream);
        if (e != hipSuccess) fprintf(stderr, "cooperative launch failed: %s (grid %d)\n", hipGetErrorString(e), grid_blocks);
        return;
    }
#endif
#ifdef DIAG
    const dim3 grid(256), blk(NTHR);
    hipLaunchKernelGGL(k_prep_t, grid, blk, LDS_BYTES, stream, p);
    hipLaunchKernelGGL(k_prep_c, grid, blk, LDS_BYTES, stream, p);
    hipLaunchKernelGGL(k_adaln, grid, blk, LDS_BYTES, stream, p);
    hipLaunchKernelGGL(k_norm1, grid, blk, 0, stream, p);
    hipLaunchKernelGGL(k_gemm_in, grid, blk, LDS_BYTES, stream, p);
    hipLaunchKernelGGL(k_scan, grid, blk, LDS_BYTES, stream, p);
    hipLaunchKernelGGL(k_gemm_dft, grid, blk, LDS_BYTES, stream, p);
    hipLaunchKernelGGL(k_gemm_mix, grid, blk, LDS_BYTES, stream, p);
    hipLaunchKernelGGL(k_gemm_out, grid, blk, LDS_BYTES, stream, p);
    hipLaunchKernelGGL(k_norm2, grid, blk, 0, stream, p);
    hipLaunchKernelGGL(k_gemm_q, grid, blk, LDS_BYTES, stream, p);
    hipLaunchKernelGGL(k_topk, grid, blk, 0, stream, p);
    hipLaunchKernelGGL(k_peer, grid, blk, 0, stream, p);
    hipLaunchKernelGGL(chk_mod, dim3(2), dim3(128), 0, stream, p);
    hipLaunchKernelGGL(chk_norm, dim3(2), dim3(128), 0, stream, p, 0);
    hipLaunchKernelGGL(chk_z, dim3(4), dim3(128), 0, stream, p);
    hipLaunchKernelGGL(chk_uv, dim3(2), dim3(128), 0, stream, p);
    hipLaunchKernelGGL(chk_scan, dim3(8), dim3(512), 0, stream, p);
    hipLaunchKernelGGL(chk_merged, dim3(2), dim3(64), 0, stream, p);
    hipLaunchKernelGGL(chk_x1, dim3(2), dim3(128), 0, stream, p);
    hipLaunchKernelGGL(chk_norm, dim3(2), dim3(128), 0, stream, p, 1);
    hipLaunchKernelGGL(chk_q, dim3(2), dim3(128), 0, stream, p);
    hipLaunchKernelGGL(chk_topk, dim3(64), dim3(256), 0, stream, p);
    hipLaunchKernelGGL(chk_out, dim3(16), dim3(256), 0, stream, p);
    hipLaunchKernelGGL(diag_apply, dim3(1024), dim3(256), 0, stream, p, out_size);
#endif
}
```

```cpp
#include <hip/hip_runtime.h>
#include <hip/hip_cooperative_groups.h>
#include <cstdio>
#include <cstdint>

#define LAS __attribute__((address_space(3)))
typedef unsigned short bf16_t;
typedef short bf16x8 __attribute__((ext_vector_type(8)));
typedef float f32x2 __attribute__((ext_vector_type(2)));
typedef float f32x4 __attribute__((ext_vector_type(4)));
typedef float f32x16 __attribute__((ext_vector_type(16)));
typedef unsigned u32x2 __attribute__((ext_vector_type(2)));
typedef unsigned u32x4 __attribute__((ext_vector_type(4)));
typedef __bf16 bf2_t __attribute__((ext_vector_type(2)));

constexpr int DM = 1024, SEQ = 2048, CTXL = 256, NBATCH = 32;
constexpr int NTHR = 512;
constexpr int LDS_BYTES = 160 * 1024;

__device__ __forceinline__ float bf2f(bf16_t b) { return __uint_as_float(((unsigned)b) << 16); }
__device__ __forceinline__ float bflo(unsigned w) { return __uint_as_float(w << 16); }
__device__ __forceinline__ float bfhi(unsigned w) { return __uint_as_float(w & 0xffff0000u); }
typedef __bf16 bf16x2_t __attribute__((ext_vector_type(2)));
__device__ __forceinline__ unsigned pk2(float lo, float hi) { return __builtin_bit_cast(unsigned, __builtin_convertvector((f32x2){lo, hi}, bf16x2_t)); }
__device__ __forceinline__ bf16_t f2bf(float f) { return (bf16_t)(pk2(f, 0.f) & 0xffffu); }
__device__ __forceinline__ float sigmoid_f(float x) { return __builtin_amdgcn_rcpf(1.0f + __builtin_amdgcn_exp2f(-1.4426950409f * x)); }
__device__ __forceinline__ float gelu_f(float x) { const float in = x + 0.044715f * x * x * x; return x * __builtin_amdgcn_rcpf(1.0f + __builtin_amdgcn_exp2f(-2.3022082f * in)); }
__device__ __forceinline__ int lane_opaque() { int t = threadIdx.x & 63; asm volatile("" : "+v"(t)); return t; }
__device__ __forceinline__ float shx_f(float v, int o) { return __int_as_float(__builtin_amdgcn_ds_bpermute((lane_opaque() ^ o) << 2, __float_as_int(v))); }
__device__ __forceinline__ int shx_i(int v, int o) { return __builtin_amdgcn_ds_bpermute((lane_opaque() ^ o) << 2, v); }
__device__ __forceinline__ f32x2 sigmoid2(f32x2 x) { const f32x2 t = x * (f32x2){-1.4426950409f, -1.4426950409f}; f32x2 e; e[0] = __builtin_amdgcn_exp2f(t[0]); e[1] = __builtin_amdgcn_exp2f(t[1]);
    const f32x2 d = e + (f32x2){1.0f, 1.0f}; f32x2 r; r[0] = __builtin_amdgcn_rcpf(d[0]); r[1] = __builtin_amdgcn_rcpf(d[1]); return r; }
__device__ __forceinline__ f32x2 gelu2(f32x2 x) {
    const f32x2 x2 = x * x; const f32x2 u = x2 * (f32x2){-0.10294324f, -0.10294324f} + (f32x2){-2.3022082f, -2.3022082f}; const f32x2 t = x * u;
    f32x2 e; e[0] = __builtin_amdgcn_exp2f(t[0]); e[1] = __builtin_amdgcn_exp2f(t[1]);
    const f32x2 d = e + (f32x2){1.0f, 1.0f}; f32x2 r; r[0] = __builtin_amdgcn_rcpf(d[0]); r[1] = __builtin_amdgcn_rcpf(d[1]); return x * r; }
__device__ __forceinline__ float wave_sum(float v) {
#pragma unroll
    for (int o = 1; o < 64; o <<= 1) v += shx_f(v, o);
    return v;
}

__device__ __forceinline__ int tid_opaque() { int t = threadIdx.x; asm volatile("" : "+v"(t)); return t; }
struct Params {
    const float *x, *c, *ctx, *c_ctx, *w_mod, *b_mod, *norm1_g, *norm2_g, *w_in, *w_fourier, *conv_w, *conv_b, *lru_wa, *lru_ba, *lru_wx, *lru_bx, *lru_lambda,
        *w_lru_out, *w_out, *b_out, *peer_wq, *peer_keys, *peer_u, *peer_v, *final_g;
    float* out;
    float *mod, *pos;
    bf16_t *Wt_in, *Wfp, *Wt_lru, *Wt_out, *Wt_q, *keys_bf, *gates_bf, *dft, *u_bf, *v_bf;
    bf16_t *h, *hc, *zxc, *zfT, *zx, *gzy, *sga, *sgb, *hf, *ybin, *UV, *Pb, *merged, *h2, *q;
    float* x1; bf16_t* x1b; int* eidx; float* gw; float* su;
    unsigned char *u8, *v8, *h8, *u4, *v4; float* scu; float* scv; bf16_t* peer16; float* pd; float* ssb; unsigned* tmax; unsigned* bar;
    unsigned* diag;
    unsigned char* w8; float* wsc;
    size_t zseg;
    int nb, pad;
};

typedef const Params __attribute__((address_space(4))) CParams;
#ifdef DIAG
#define PREF const Params&
#else
#define PREF CParams&
#endif
__device__ __forceinline__ void dev_transpose(const float* src, int ld, int col0, int K, int N, bf16_t* dst, int nbat, size_t sbs, size_t dbs, LAS unsigned char* lds, int bfirst, int bcount) {
    const int rel = (int)blockIdx.x - bfirst;
    if (rel < 0 || rel >= bcount) return;
    const int tid = tid_opaque(), tk = K / 64, tn = N / 64, per = tk * tn, total = per * nbat;
    const int r = tid >> 4, c4 = tid & 15, nn = tid >> 3, kc = tid & 7;
#define TR_LOAD(V0, V1, it) do { const int it_ = (it) < total ? (it) : total - 1; const int bz_ = it_ / per, rem_ = it_ % per, k0_ = (rem_ / tn) * 64, n0_ = (rem_ % tn) * 64; \
        const float* s_ = src + (size_t)bz_ * sbs + (size_t)(k0_ + r) * ld + col0 + n0_ + 4 * c4; V0 = *(const f32x4*)s_; V1 = *(const f32x4*)(s_ + (size_t)32 * ld); } while (0)
    f32x4 v0, v1, w0, w1;
    TR_LOAD(v0, v1, rel);
    int par = 0;
    for (int item = rel; item < total; item += bcount) {
        TR_LOAD(w0, w1, item + bcount);
        const int bz = item / per, rem = item % per, k0 = (rem / tn) * 64, n0 = (rem % tn) * 64;
        LAS float* tile = (LAS float*)lds + par * (64 * 65);
        { LAS float* t = tile + r * 65 + 4 * c4; t[0] = v0[0]; t[1] = v0[1]; t[2] = v0[2]; t[3] = v0[3]; t += 32 * 65; t[0] = v1[0]; t[1] = v1[1]; t[2] = v1[2]; t[3] = v1[3]; }
        __syncthreads();
        const LAS float* t = tile + (8 * kc) * 65 + nn;
        u32x4 o; o[0] = pk2(t[0], t[65]); o[1] = pk2(t[2 * 65], t[3 * 65]); o[2] = pk2(t[4 * 65], t[5 * 65]); o[3] = pk2(t[6 * 65], t[7 * 65]);
        *(u32x4*)(dst + (size_t)bz * dbs + (size_t)(n0 + nn) * K + k0 + 8 * kc) = o;
        v0 = w0; v1 = w1; par ^= 1;
    }
    __syncthreads();
#undef TR_LOAD
}
__device__ __forceinline__ void dev_convert(const float* src, bf16_t* dst, size_t n) {
    const int tid = tid_opaque();
    for (size_t i = ((size_t)blockIdx.x * NTHR + tid) * 8; i < n; i += (size_t)gridDim.x * NTHR * 8) {
        const f32x4 a = *(const f32x4*)(src + i), b = *(const f32x4*)(src + i + 4);
        u32x4 o; o[0] = pk2(a[0], a[1]); o[1] = pk2(a[2], a[3]); o[2] = pk2(b[0], b[1]); o[3] = pk2(b[2], b[3]);
        *(u32x4*)(dst + i) = o;
    }
}
__device__ __forceinline__ void dev_wfp(PREF p, LAS unsigned char* lds) {
    LAS float* cs = (LAS float*)lds; LAS float* sn = cs + 128;
    const int tid = tid_opaque();
    if (tid < 128) { cs[tid] = cospif((float)tid * (1.0f / 64.0f)); sn[tid] = sinpif((float)tid * (1.0f / 64.0f)); }
    __syncthreads();
    for (int idx = blockIdx.x * NTHR + tid; idx < 1024 * 1024; idx += gridDim.x * NTHR) {
        const int d = idx >> 10, kap = idx & 1023, g = (kap & 511) >> 7, cc = kap & 127, iss = kap >> 9;
        const LAS float* tab = iss ? sn : cs; const float* wf = p.w_fourier + (size_t)(g * 128) * 1024 + d;
        float acc = 0.f;
        for (int kc = 0; kc < 128; ++kc) acc += tab[(kc * cc) & 127] * wf[(size_t)kc * 1024];
        p.Wfp[idx] = f2bf(acc * (iss ? -1.0f / 512.0f : 1.0f / 512.0f));
    }
    __syncthreads();
}
__device__ __forceinline__ void dev_dft(PREF p) {
    const int tid = tid_opaque();
    for (int i8 = blockIdx.x * NTHR + tid; i8 < 2048 * 2048 / 8; i8 += gridDim.x * NTHR) {
        const int m = i8 >> 8, t0 = (i8 & 255) * 8, mm = m & 1023, iss = m >> 10;
        float v[8];
#pragma unroll
        for (int j = 0; j < 8; ++j) { const int kk = (iss && mm == 0) ? 1024 : mm; const float a = (float)((kk * (t0 + j)) & 2047) * (1.0f / 2048.0f);
            v[j] = (iss && mm != 0) ? __builtin_amdgcn_sinf(a) : __builtin_amdgcn_cosf(a); }
        u32x4 o; o[0] = pk2(v[0], v[1]); o[1] = pk2(v[2], v[3]); o[2] = pk2(v[4], v[5]); o[3] = pk2(v[6], v[7]);
        *(u32x4*)(p.dft + (size_t)i8 * 8) = o;
    }
}
__device__ __forceinline__ void dev_pos(PREF p) {
    const int tid = tid_opaque();
    for (int idx = blockIdx.x * NTHR + tid; idx < SEQ * 512; idx += gridDim.x * NTHR) {
        const int t = idx >> 9, half = (idx >> 8) & 1, j = idx & 255;
        const float omega = 1.0f / powf(10000.0f, (float)j * (1.0f / 256.0f));
        const float arg = (float)(half == 0 ? (t >> 6) : (t & 63)) * omega;
        float* d = p.pos + (size_t)t * DM + half * 512 + j;
        d[0] = sinf(arg); d[256] = cosf(arg);
    }
}
__device__ __forceinline__ void dev_adaln(PREF p, LAS unsigned char* lds) {
    constexpr int SROW = 1032;
    LAS bf16_t* Sh = (LAS bf16_t*)lds; LAS bf16_t* Sl = Sh + 33 * SROW;
    const int tid = tid_opaque(), w = tid >> 6, l = tid & 63, c16 = l & 15, g = l >> 4;
    if ((int)blockIdx.x < 192) {
        for (int i = tid; i < 33 * 1024; i += NTHR) { const float v = (i < 32 * 1024) ? p.c[i] : p.c_ctx[i - 32 * 1024]; const float sv = v * sigmoid_f(v);
            const unsigned hi = pk2(sv, 0.f) & 0xffffu; const unsigned lo = pk2(sv - bflo(hi), 0.f) & 0xffffu; const int r = i >> 10, k = i & 1023;
            Sh[r * SROW + k] = (bf16_t)hi; Sl[r * SROW + k] = (bf16_t)lo; }
        __syncthreads();
        const int nt = w & 1, kq = w >> 1, n0 = blockIdx.x * 32 + nt * 16;
        f32x4 acc[3];
#pragma unroll
        for (int mt = 0; mt < 3; ++mt) acc[mt] = (f32x4){0.f, 0.f, 0.f, 0.f};
#pragma unroll
        for (int ks = 0; ks < 8; ++ks) { const int k0 = kq * 256 + ks * 32 + 8 * g;
            float wv[8];
#pragma unroll
            for (int j = 0; j < 8; ++j) wv[j] = p.w_mod[(size_t)(k0 + j) * 6144 + n0 + c16];
            u32x4 bh, bl;
#pragma unroll
            for (int j = 0; j < 4; ++j) { bh[j] = pk2(wv[2 * j], wv[2 * j + 1]); bl[j] = pk2(wv[2 * j] - bflo(bh[j]), wv[2 * j + 1] - bfhi(bh[j])); }
            const bf16x8 Bh = __builtin_bit_cast(bf16x8, bh), Bl = __builtin_bit_cast(bf16x8, bl);
#pragma unroll
            for (int mt = 0; mt < 3; ++mt) { const int row = min(mt * 16 + c16, 32);
                const bf16x8 Ah = *(const LAS bf16x8*)(Sh + row * SROW + k0), Al = *(const LAS bf16x8*)(Sl + row * SROW + k0);
                acc[mt] = __builtin_amdgcn_mfma_f32_16x16x32_bf16(Ah, Bh, acc[mt], 0, 0, 0);
                acc[mt] = __builtin_amdgcn_mfma_f32_16x16x32_bf16(Ah, Bl, acc[mt], 0, 0, 0);
                acc[mt] = __builtin_amdgcn_mfma_f32_16x16x32_bf16(Al, Bh, acc[mt], 0, 0, 0); }
        }
        __syncthreads();
        LAS float* red = (LAS float*)lds;
#pragma unroll
        for (int mt = 0; mt < 3; ++mt)
#pragma unroll
            for (int reg = 0; reg < 4; ++reg) red[(kq * 48 + mt * 16 + 4 * g + reg) * 32 + nt * 16 + c16] = acc[mt][reg];
        __syncthreads();
        for (int o = tid; o < 33 * 32; o += NTHR) { const int r = o >> 5, n = o & 31;
            const float sum = (red[(0 * 48 + r) * 32 + n] + red[(1 * 48 + r) * 32 + n]) + (red[(2 * 48 + r) * 32 + n] + red[(3 * 48 + r) * 32 + n]);
            p.mod[(size_t)r * 6144 + blockIdx.x * 32 + n] = sum + p.b_mod[blockIdx.x * 32 + n]; }
        __syncthreads();
    }
}

__device__ __forceinline__ void dev_norm(PREF p, int which, int rfirst = -1, int rstride = 0, int rend = 0) {
    const int tid = tid_opaque(); const int w = tid >> 6, lane = tid & 63;
    const int T = p.nb * SEQ, TC = (which == 0) ? p.nb * CTXL : 0, NR = T + TC;
    const int first = (rfirst >= 0 ? rfirst : (int)blockIdx.x * 8) + w, stride = rfirst >= 0 ? rstride : (int)gridDim.x * 8, REND = rfirst >= 0 ? rend : NR;
#define NORM_LOAD(XV, PV, r, PF) do { const int r_ = (r) < NR ? (r) : NR - 1; const bool c_ = r_ >= T; const int lr_ = c_ ? r_ - T : r_; \
        const float* s_ = c_ ? p.ctx + (size_t)lr_ * DM : p.x + (size_t)lr_ * DM; \
        _Pragma("unroll") for (int i_ = 0; i_ < 4; ++i_) { const int d_ = 4 * lane + 256 * i_; \
            if (which == 1) { const u32x2 q_ = *(const u32x2*)(p.x1b + (size_t)lr_ * DM + d_); XV[i_] = (f32x4){bflo(q_[0]), bfhi(q_[0]), bflo(q_[1]), bfhi(q_[1])}; } else XV[i_] = __builtin_nontemporal_load((const f32x4*)(s_ + d_)); \
            PV[i_] = (which == 0 && !c_) ? ((PF) ? pfix[i_] : *(const f32x4*)(p.pos + (size_t)(lr_ & 2047) * DM + d_)) : (f32x4){0.f, 0.f, 0.f, 0.f}; } } while (0)
    const bool pos_fixed = (which == 0) && (stride % SEQ == 0) && (first < T);
    f32x4 pfix[4];
#pragma unroll
    for (int i = 0; i < 4; ++i) pfix[i] = pos_fixed ? *(const f32x4*)(p.pos + (size_t)(first & 2047) * DM + 4 * lane + 256 * i) : (f32x4){0.f, 0.f, 0.f, 0.f};
    f32x4 xv[4], pv[4], xn[4], pn[4];
    if (first < NR) NORM_LOAD(xv, pv, first, pos_fixed);
    f32x4 ggv[4];
#pragma unroll
    for (int i = 0; i < 4; ++i) ggv[i] = *(const f32x4*)(((which == 0) ? p.norm1_g : p.norm2_g) + 4 * lane + 256 * i);
#define NORM_LOOP(PFC) do { \
    _Pragma("unroll 2") for (int row = first; row < REND; row += stride) { \
        const bool isctx = row >= T; const int lrow = isctx ? row - T : row; \
        const int b = isctx ? 32 : (lrow >> 11); \
        const float* md = p.mod + (size_t)b * 6144 + (which == 0 ? 0 : 3 * 1024); \
        f32x4 shv[4], scv[4]; \
_Pragma("unroll") \
        for (int i = 0; i < 4; ++i) { shv[i] = *(const f32x4*)(md + 4 * lane + 256 * i); scv[i] = *(const f32x4*)(md + 1024 + 4 * lane + 256 * i); } \
        asm volatile("" ::: "memory"); \
        NORM_LOAD(xn, pn, row + stride, PFC); \
        bf16_t* dst = (which == 1) ? p.h2 + (size_t)lrow * DM : (isctx ? p.hc + (size_t)lrow * DM : p.h + (size_t)lrow * DM); \
        f32x4 v[4]; float ss = 0.f; \
_Pragma("unroll") \
        for (int i = 0; i < 4; ++i) { v[i] = xv[i] + pv[i]; \
            ss += (v[i][0] * v[i][0] + v[i][1] * v[i][1]) + (v[i][2] * v[i][2] + v[i][3] * v[i][3]); } \
        ss = wave_sum(ss); \
        const float rs = rsqrtf(ss * (1.0f / 1024.0f) + 1e-6f); \
_Pragma("unroll") \
        for (int i = 0; i < 4; ++i) { const int d = 4 * lane + 256 * i; \
            const f32x4 gg = ggv[i], sh = shv[i], sc = scv[i]; \
            f32x4 y; \
_Pragma("unroll") \
            for (int j = 0; j < 4; ++j) y[j] = (v[i][j] * rs * gg[j]) * (1.0f + sc[j]) + sh[j]; \
            u32x2 o; o[0] = pk2(y[0], y[1]); o[1] = pk2(y[2], y[3]); \
            *(u32x2*)(dst + d) = o; \
            if (which == 1) { int w8 = 0; w8 = __builtin_amdgcn_cvt_pk_fp8_f32(y[0] * 4.0f, y[1] * 4.0f, w8, false); w8 = __builtin_amdgcn_cvt_pk_fp8_f32(y[2] * 4.0f, y[3] * 4.0f, w8, true); \
                *(unsigned*)(p.h8 + (size_t)lrow * DM + d) = (unsigned)w8; } } \
_Pragma("unroll") \
        for (int i = 0; i < 4; ++i) { xv[i] = xn[i]; pv[i] = pn[i]; } \
    } \
    } while (0)
    if (pos_fixed) NORM_LOOP(true); else NORM_LOOP(false);
#undef NORM_LOOP
#undef NORM_LOAD
}

namespace pg8 {
constexpr int BM = 256, BK = 64, HALF = 128, HTB = HALF * BK * 2, STAGE_BYTES = 8 * HTB, NXCD = 8, WGM = 8;
__host__ __device__ __forceinline__ int lds_byte(int r, int c) { const int st = (r >> 4) * 2 + (c >> 5), rr = r & 15, cc = c & 31, ob = rr * 64 + cc * 2; return st * 1024 + (ob ^ (((ob >> 9) & 1) << 5)); }
__host__ __device__ __forceinline__ void stage_rc(int b, int& R, int& C) { const int st = b / 1024, sb = b % 1024, swz = sb ^ (((sb >> 9) & 1) << 5); R = (st >> 1) * 16 + swz / 64; C = (st & 1) * 32 + (swz % 64) / 2; }
__host__ __device__ __forceinline__ int perm32(int rho) { const int n = rho >> 4, i = rho & 15; return 8 * (i >> 2) + 4 * n + (i & 3); }
struct Unit { int pm, pn, z; };
struct Gemm { const bf16_t* A; const bf16_t* Bt; int K, lda, ldb; long aZ, bZ; int natA = 0, natB = 0; };
struct StaticOrder {
    int nM, nN, nwg, G, c;
    __device__ void init(int M, int N, int G_, int c_) { nM = M / BM; nN = N / BM; nwg = nM * nN; G = G_; c = c_; }
    __device__ bool next(int i, Unit& u) const {
        const long L = (long)i * G + c; if (L >= nwg) return false;
        int wgid = (int)L; { const int q = nwg / NXCD, r = nwg % NXCD, xcd = wgid % NXCD, off = wgid / NXCD; wgid = (xcd < r ? xcd * (q + 1) : r * (q + 1) + (xcd - r) * q) + off; }
        const int nig = WGM * nN, gid = wgid / nig, fm = gid * WGM, gsz = (nM - fm) < WGM ? (nM - fm) : WGM;
        u.pm = fm + ((wgid % nig) % gsz); u.pn = (wgid % nig) / gsz; u.z = 0; return true;
    }
};
struct BatchOrder {
    int nM, nN, nz, G, c; long Lend;
    __device__ void init(int M, int N, int nz_, int G_, int c_, long Lend_ = -1) { nM = M / BM; nN = N / BM; nz = nz_; G = G_; c = c_; Lend = Lend_ < 0 ? (long)nM * nN * nz : Lend_; }
    __device__ bool next(int i, Unit& u) const {
        const long L = (long)i * G + c; const int per = nM * nN; if (L >= Lend) return false;
        u.z = (int)(L / per); const int r = (int)(L % per); u.pm = r % nM; u.pn = r / nM; return true;
    }
};

template <class Epi, class Sched>
__device__ __forceinline__ void gemm_phase(LAS unsigned char* lds, const Gemm g, const Sched& S, const Epi& E) {
    const int tid = tid_opaque(), wid = __builtin_amdgcn_readfirstlane(tid >> 6), lane = tid & 63, wr = wid >> 2, wc = wid & 3, fr = lane & 15, fq = lane >> 4;
    const int K = g.K, nt = K / BK;
    unsigned voffA[2], voffB[2];
#pragma unroll
    for (int i = 0; i < 2; ++i) { int R, C; stage_rc(tid * 16 + i * 8192, R, C); const int Rb = Epi::PERM ? ((R & ~31) + perm32(R & 31)) : R;
#define PG8_NATOFF(R_, C_) ((unsigned)(((((R_) >> 6) & 1) * 4 + ((C_) >> 5)) * 8192 + ((((R_) >> 4) & 3) * 2) * 512 + (((R_) & 15) + 16 * (((C_) >> 3) & 3)) * 8) * 2u)
        voffA[i] = g.natA ? PG8_NATOFF(R, C) : (unsigned)(R * g.lda + C) * 2u; voffB[i] = g.natB ? PG8_NATOFF(Rb, C) : (unsigned)(Rb * g.ldb + C) * 2u; }
#undef PG8_NATOFF
    const int s0A = g.natA ? 32768 : BK * 2, s1A = g.natA ? 1024 : BK * 4, s2A = g.natA ? 131072 : BK * 8;
    const int s0B = g.natB ? 32768 : BK * 2, s1B = g.natB ? 1024 : BK * 4, s2B = g.natB ? 131072 : BK * 8;
    const size_t hstepA = g.natA ? (size_t)8192 : (size_t)HALF * g.lda * 2, hstepB = g.natB ? (size_t)8192 : (size_t)HALF * g.ldb * 2;
    const size_t tstepA = (size_t)BM * g.lda * 2, tstepB = (size_t)BM * g.ldb * 2;
    const unsigned ldsw = (unsigned)wid * 1024u;
    const int aoff = lds_byte(wr * 64 + fr, fq * 8), boff = lds_byte(wc * 32 + fr, fq * 8);
#define PG8_SA(b, h) (((b) * 2 + (h)) * HTB)
#define PG8_SB(b, h) ((4 + (b) * 2 + (h)) * HTB)
#define PG8_STAGE(bufoff, gbase, voff) do { _Pragma("unroll") for (int _i = 0; _i < 2; ++_i) \
        __builtin_amdgcn_global_load_lds((const unsigned*)((const char*)(gbase) + (voff)[_i]), (LAS unsigned*)(lds + (bufoff) + ldsw + _i * 8192), 16, 0, 0); } while (0)
#define PG8_LDA(dst, b, h) do { _Pragma("unroll") for (int m = 0; m < 4; ++m) _Pragma("unroll") for (int k = 0; k < 2; ++k) dst[m][k] = *(const LAS bf16x8*)(lds + PG8_SA(b, h) + aoff + m * 2048 + k * 1024); } while (0)
#define PG8_LDB(dst, b, h) do { _Pragma("unroll") for (int n = 0; n < 2; ++n) _Pragma("unroll") for (int k = 0; k < 2; ++k) dst[n][k] = *(const LAS bf16x8*)(lds + PG8_SB(b, h) + boff + n * 2048 + k * 1024); } while (0)
#define PG8_MMA(ai, bj, At, Bt) do { __builtin_amdgcn_s_setprio(1); _Pragma("unroll") for (int m = 0; m < 4; ++m) _Pragma("unroll") for (int n = 0; n < 2; ++n) _Pragma("unroll") for (int k = 0; k < 2; ++k) \
        acc[ai][bj][m][n] = __builtin_amdgcn_mfma_f32_16x16x32_bf16(Bt[n][k], At[m][k], acc[ai][bj][m][n], 0, 0, 0); __builtin_amdgcn_s_setprio(0); } while (0)
#define PG8_WAIT_V(n) asm volatile("s_waitcnt vmcnt(" #n ")" ::: "memory")
#define PG8_WAIT_L(n) asm volatile("s_waitcnt lgkmcnt(" #n ")" ::: "memory")
#define PG8_BAR __builtin_amdgcn_s_barrier()
#define PG8_SCHED __builtin_amdgcn_sched_barrier(0)
    Unit cur, nxt; int ui = 0;
    if (!S.next(0, cur)) return;
    f32x4 acc[2][2][4][2];
#pragma unroll
    for (int a = 0; a < 2; ++a)
#pragma unroll
        for (int b = 0; b < 2; ++b)
#pragma unroll
            for (int m = 0; m < 4; ++m)
#pragma unroll
                for (int n = 0; n < 2; ++n) acc[a][b][m][n] = (f32x4){0.f, 0.f, 0.f, 0.f};
    bf16x8 At[4][2], B0[2][2], B1[2][2];
    const char* cA = (const char*)g.A + (size_t)cur.pm * tstepA + (size_t)cur.z * g.aZ * 2; const char* cB = (const char*)g.Bt + (size_t)cur.pn * tstepB + (size_t)cur.z * g.bZ * 2;
    PG8_STAGE(PG8_SB(0, 0), cB, voffB); PG8_STAGE(PG8_SA(0, 0), cA, voffA); PG8_STAGE(PG8_SB(0, 1), cB + hstepB, voffB); PG8_STAGE(PG8_SA(0, 1), cA + hstepA, voffA);
    if (wr == 1) PG8_BAR;
    PG8_WAIT_V(4); PG8_BAR;
    PG8_STAGE(PG8_SB(1, 0), cB + s0B, voffB); PG8_STAGE(PG8_SA(1, 0), cA + s0A, voffA); PG8_STAGE(PG8_SB(1, 1), cB + hstepB + s0B, voffB);
    PG8_WAIT_V(6); PG8_BAR;
    for (;;) {
        const bool has_next = S.next(ui + 1, nxt);
        const char* nA = has_next ? (const char*)g.A + (size_t)nxt.pm * tstepA + (size_t)nxt.z * g.aZ * 2 : cA;
        const char* nB = has_next ? (const char*)g.Bt + (size_t)nxt.pn * tstepB + (size_t)nxt.z * g.bZ * 2 : cB;
        for (int t = 0; t < nt; t += 2) {
            const bool last = (t == nt - 2);
            const int th = t >> 1, tn = th + 1;
            const char* a1 = cA + (size_t)(th >> 1) * s2A + (th & 1) * s1A + s0A;
            const char* a2 = last ? nA : cA + (size_t)(tn >> 1) * s2A + (tn & 1) * s1A; const char* b2 = last ? nB : cB + (size_t)(tn >> 1) * s2B + (tn & 1) * s1B;
            const char* a3 = a2 + s0A; const char* b3 = b2 + s0B;
            PG8_LDB(B0, 0, 0); PG8_SCHED; PG8_LDA(At, 0, 0); PG8_STAGE(PG8_SA(1, 1), a1 + hstepA, voffA);
            PG8_WAIT_L(8); PG8_BAR; PG8_WAIT_L(0); PG8_MMA(0, 0, At, B0); PG8_BAR; PG8_SCHED;
            PG8_LDB(B1, 0, 1); PG8_STAGE(PG8_SB(0, 0), b2, voffB);
            PG8_BAR; PG8_WAIT_L(0); PG8_MMA(0, 1, At, B1); PG8_BAR;
            PG8_LDA(At, 0, 1); PG8_STAGE(PG8_SA(0, 0), a2, voffA);
            PG8_BAR; PG8_WAIT_L(0); PG8_MMA(1, 0, At, B0); PG8_BAR; PG8_SCHED;
            PG8_STAGE(PG8_SB(0, 1), b2 + hstepB, voffB);
            PG8_WAIT_V(6); PG8_BAR; PG8_MMA(1, 1, At, B1); PG8_BAR;
            PG8_LDB(B0, 1, 0); PG8_SCHED; PG8_LDA(At, 1, 0); PG8_STAGE(PG8_SA(0, 1), a2 + hstepA, voffA);
            PG8_WAIT_L(8); PG8_BAR; PG8_WAIT_L(0); PG8_MMA(0, 0, At, B0); PG8_BAR; PG8_SCHED;
            PG8_LDB(B1, 1, 1); PG8_STAGE(PG8_SB(1, 0), b3, voffB);
            PG8_BAR; PG8_WAIT_L(0); PG8_MMA(0, 1, At, B1); PG8_BAR;
            PG8_LDA(At, 1, 1); PG8_STAGE(PG8_SA(1, 0), a3, voffA);
            PG8_BAR; PG8_WAIT_L(0); PG8_MMA(1, 0, At, B0); PG8_BAR; PG8_SCHED;
            PG8_STAGE(PG8_SB(1, 1), b3 + hstepB, voffB);
            PG8_WAIT_V(6); PG8_BAR; PG8_MMA(1, 1, At, B1); PG8_BAR;
        }
        E(acc, cur, wr, wc, fr, fq);
        if (!has_next) break;
#pragma unroll
        for (int a = 0; a < 2; ++a)
#pragma unroll
            for (int b = 0; b < 2; ++b)
#pragma unroll
                for (int m = 0; m < 4; ++m)
#pragma unroll
                    for (int n = 0; n < 2; ++n) acc[a][b][m][n] = (f32x4){0.f, 0.f, 0.f, 0.f};
        cur = nxt; cA = nA; cB = nB; ++ui;
    }
    PG8_WAIT_V(0);
    if (wr == 0) PG8_BAR;
    PG8_BAR;
#undef PG8_SA
#undef PG8_SB
#undef PG8_STAGE
#undef PG8_LDA
#undef PG8_LDB
#undef PG8_MMA
#undef PG8_WAIT_V
#undef PG8_WAIT_L
#undef PG8_BAR
#undef PG8_SCHED
}

__device__ __forceinline__ u32x4 pack8(const f32x4 v0, const f32x4 v1) { u32x4 w; w[0] = pk2(v0[0], v0[1]); w[1] = pk2(v0[2], v0[3]); w[2] = pk2(v1[0], v1[1]); w[3] = pk2(v1[2], v1[3]); return w; }
#define QMAP(pm_) ((((pm_) >> 4) & 1) * 128 + ((pm_) >> 5) * 16 + ((pm_) & 15))
struct EpiAct {
    static constexpr bool PERM = true;
    bf16_t* O; size_t segstride; int actmask; int segtiles; int ldc; int nt; int native; int qmap = 0;
    template <int ACT, bool NT, bool NATIVE>
    __device__ __forceinline__ void body(const f32x4 (&acc)[2][2][4][2], bf16_t* base, int row0, int col0, size_t toff) const {
#pragma unroll
        for (int ai = 0; ai < 2; ++ai)
#pragma unroll
            for (int m = 0; m < 4; ++m) { bf16_t* rowp = NATIVE ? base + toff + ((ai * 4 + m) * 2) * 512 : base + (size_t)(row0 + ai * HALF + m * 16) * ldc + col0;
#pragma unroll
                for (int bj = 0; bj < 2; ++bj) { f32x4 v0 = acc[ai][bj][m][0], v1 = acc[ai][bj][m][1];
                    if (ACT == 1) { const f32x2 a = gelu2((f32x2){v0[0], v0[1]}), b = gelu2((f32x2){v0[2], v0[3]}), c = gelu2((f32x2){v1[0], v1[1]}), d = gelu2((f32x2){v1[2], v1[3]});
                        v0 = (f32x4){a[0], a[1], b[0], b[1]}; v1 = (f32x4){c[0], c[1], d[0], d[1]}; }
                    else if (ACT == 2) { const f32x2 a = sigmoid2((f32x2){v0[0], v0[1]}), b = sigmoid2((f32x2){v0[2], v0[3]}), c = sigmoid2((f32x2){v1[0], v1[1]}), d = sigmoid2((f32x2){v1[2], v1[3]});
                        v0 = (f32x4){a[0], a[1], b[0], b[1]}; v1 = (f32x4){c[0], c[1], d[0], d[1]}; }
                    bf16_t* dp = NATIVE ? rowp + bj * 512 : rowp + bj * HALF;
                    if (NT) __builtin_nontemporal_store(pack8(v0, v1), (u32x4*)dp); else *(u32x4*)dp = pack8(v0, v1); } }
    }
    __device__ __forceinline__ void operator()(const f32x4 (&acc)[2][2][4][2], const Unit& u, int wr, int wc, int fr, int fq) const {
        const int seg = u.pn / segtiles, colt = (u.pn - seg * segtiles) * BM;
        bf16_t* base = O + (size_t)seg * segstride; const int act = seg < 8 ? ((actmask >> (4 * seg)) & 15) : 0;
        const int row0 = u.pm * BM + wr * 64 + fr, col0 = colt + wc * 32 + 8 * fq;
        const int pmx = qmap ? QMAP(u.pm) : u.pm;
        const size_t toff = ((size_t)pmx * (ldc >> 8) + (u.pn - seg * segtiles)) * 65536 + (size_t)(wr * 4 + wc) * 8192 + (size_t)(fr + 16 * fq) * 8;
        if (act == 1) body<1, true, false>(acc, base, row0, col0, 0); else if (act == 2) body<2, true, true>(acc, base, row0, col0, toff); else if (native) body<0, true, true>(acc, base, row0, col0, toff); else if (nt) body<0, true, false>(acc, base, row0, col0, 0); else body<0, false, false>(acc, base, row0, col0, 0);
    }
};
struct EpiUV {
    static constexpr bool PERM = true;
    bf16_t* UV;
    __device__ __forceinline__ void operator()(const f32x4 (&acc)[2][2][4][2], const Unit& u, int wr, int wc, int fr, int fq) const {
        const int isv = u.pm >> 2, mp0 = (u.pm & 3) * BM + wr * 64 + fr, colb = u.pn * BM + wc * 32 + 8 * fq;
        bf16_t* base = UV + (size_t)u.z * SEQ * DM;
#pragma unroll
        for (int ai = 0; ai < 2; ++ai)
#pragma unroll
            for (int m = 0; m < 4; ++m) { const int mp = mp0 + ai * HALF + m * 16;
#pragma unroll
                for (int bj = 0; bj < 2; ++bj) { const u32x4 v = pack8(acc[ai][bj][m][0], acc[ai][bj][m][1]); const int col = colb + bj * HALF;
                    if (!isv) { *(u32x4*)(base + (size_t)mp * DM + col) = v; if (mp) *(u32x4*)(base + (size_t)(SEQ - mp) * DM + col) = v; }
                    else if (mp == 0) { *(u32x4*)(base + (size_t)1024 * DM + col) = v; const u32x4 z = (u32x4){0u, 0u, 0u, 0u};
                        *(u32x4*)(base + 512 + col) = z; *(u32x4*)(base + (size_t)1024 * DM + 512 + col) = z; }
                    else { *(u32x4*)(base + (size_t)mp * DM + 512 + col) = v; const u32x4 nv = (u32x4){v[0] ^ 0x80008000u, v[1] ^ 0x80008000u, v[2] ^ 0x80008000u, v[3] ^ 0x80008000u};
                        *(u32x4*)(base + (size_t)(SEQ - mp) * DM + 512 + col) = nv; } } }
    }
};
template <bool ADD> struct EpiGate {
    static constexpr bool PERM = true;
    const bf16_t* gate; const bf16_t* addsrc; bf16_t* dst;
    __device__ __forceinline__ void operator()(const f32x4 (&acc)[2][2][4][2], const Unit& u, int wr, int wc, int fr, int fq) const {
        const size_t toff = ((size_t)u.pm * 4 + u.pn) * 65536 + (size_t)(wr * 4 + wc) * 8192 + (size_t)(fr + 16 * fq) * 8;
#pragma unroll
        for (int ai = 0; ai < 2; ++ai)
#pragma unroll
            for (int m = 0; m < 4; ++m) {
#pragma unroll
                for (int bj = 0; bj < 2; ++bj) { const size_t noff = toff + ((ai * 4 + m) * 2 + bj) * 512;
                    const u32x4 gv = __builtin_nontemporal_load((const u32x4*)(gate + noff));
                    f32x4 v0 = acc[ai][bj][m][0], v1 = acc[ai][bj][m][1];
                    v0[0] *= bflo(gv[0]); v0[1] *= bfhi(gv[0]); v0[2] *= bflo(gv[1]); v0[3] *= bfhi(gv[1]);
                    v1[0] *= bflo(gv[2]); v1[1] *= bfhi(gv[2]); v1[2] *= bflo(gv[3]); v1[3] *= bfhi(gv[3]);
                    if (ADD) { const u32x4 av = *(const u32x4*)(addsrc + noff);
                        v0[0] += bflo(av[0]); v0[1] += bfhi(av[0]); v0[2] += bflo(av[1]); v0[3] += bfhi(av[1]);
                        v1[0] += bflo(av[2]); v1[1] += bfhi(av[2]); v1[2] += bflo(av[3]); v1[3] += bfhi(av[3]); }
                    *(u32x4*)(dst + noff) = pack8(v0, v1); } }
    }
};
struct EpiX1 {
    static constexpr bool PERM = true;
    const float *x, *pos, *mod, *b_out; bf16_t* x1b;
    __device__ __forceinline__ void operator()(const f32x4 (&acc)[2][2][4][2], const Unit& u, int wr, int wc, int fr, int fq) const {
        const int row0 = u.pm * BM + wr * 64 + fr, col0 = u.pn * BM + wc * 32 + 8 * fq;
        const int b = (u.pm * BM) >> 11;
        f32x4 bv[2][2], gv[2][2];
#pragma unroll
        for (int bj = 0; bj < 2; ++bj)
#pragma unroll
            for (int n = 0; n < 2; ++n) { bv[bj][n] = *(const f32x4*)(b_out + col0 + bj * HALF + 4 * n); gv[bj][n] = *(const f32x4*)(mod + (size_t)b * 6144 + 2 * 1024 + col0 + bj * HALF + 4 * n); }
#pragma unroll
        for (int ai = 0; ai < 2; ++ai)
#pragma unroll
            for (int m = 0; m < 4; ++m) { const int row = row0 + ai * HALF + m * 16; const size_t off = (size_t)row * DM + col0; const size_t poff = (size_t)(row & 2047) * DM + col0;
#pragma unroll
                for (int bj = 0; bj < 2; ++bj) { f32x4 r[2];
#pragma unroll
                    for (int n = 0; n < 2; ++n) { const f32x4 xv = __builtin_nontemporal_load((const f32x4*)(x + off + bj * HALF + 4 * n)), pv = *(const f32x4*)(pos + poff + bj * HALF + 4 * n);
                        r[n] = xv + pv + gv[bj][n] * (acc[ai][bj][m][n] + bv[bj][n]); }
                    *(u32x4*)(x1b + off + bj * HALF) = pack8(r[0], r[1]); } }
    }
};
}

constexpr int XC_STRIDE = 272;
constexpr int HT_STRIDE = 132;
constexpr int XC_BYTES = 64 * XC_STRIDE, HT_BYTES = 64 * HT_STRIDE * 4, SCAN_CW_OFF = 2 * XC_BYTES + 2 * HT_BYTES;
template <int DIR>
__device__ __forceinline__ void scan_dir(PREF p, LAS unsigned char* lds, int b, int head) {
    const int tid = tid_opaque(), w = tid >> 6, l = tid & 63, c16 = l & 15, q4 = l >> 4;
    LAS float* CW = (LAS float*)(lds + SCAN_CW_OFF);
    const int ch = head * 128 + 16 * w + c16;
    bf16x8 bfa[4], bfx[4];
    {
        const bf16_t* Ga = p.gates_bf + ((size_t)((DIR * 2 + 0) * 8 + head) * 128 + 16 * w + c16) * 128 + 8 * q4;
        const bf16_t* Gx = p.gates_bf + ((size_t)((DIR * 2 + 1) * 8 + head) * 128 + 16 * w + c16) * 128 + 8 * q4;
#pragma unroll
        for (int ks = 0; ks < 4; ++ks) { bfa[ks] = *(const bf16x8*)(Ga + 32 * ks); bfx[ks] = *(const bf16x8*)(Gx + 32 * ks); }
    }
    const float nba = -1.4426950409f * p.lru_ba[DIR * 1024 + ch], nbx = -1.4426950409f * p.lru_bx[DIR * 1024 + ch];
    const float m8sp = -8.0f * log1pf(expf(-p.lru_lambda[DIR * 1024 + ch])) * 1.4426950409f;
    const int pos4 = DIR == 0 ? q4 : 3 - q4;
    const int src1 = (DIR == 0 ? l - 16 : l + 16) & 63, src2 = (DIR == 0 ? l - 32 : l + 32) & 63, srcl = DIR == 0 ? c16 + 48 : c16;
    float carry = 0.f;
    const int tt = tid >> 3, cg = tid & 7;
#define SCAN_CREF(k, SEQI, T0, TSEQ, SRC) const int SEQI = (k) >= 4 ? 1 : 0; const int TSEQ = SEQI ? SEQ : CTXL; \
        const int T0 = (DIR == 0 ? (SEQI ? (k) - 4 : (k)) : (SEQI ? 35 - (k) : 3 - (k))) * 64; const bf16_t* SRC = SEQI ? p.zx + (size_t)b * SEQ * DM : p.zxc + (size_t)b * CTXL * DM;
#define SCAN_LOADZ(k) do { SCAN_CREF(k, sq_, t0_, ts_, sr_) \
        if (t0_ >= 1 && t0_ + 66 <= ts_) { const bf16_t* zp_ = sr_ + (size_t)(t0_ + tt - 1) * DM + head * 128 + 16 * cg;     \
            _Pragma("unroll") for (int r_ = 0; r_ < 4; ++r_) { Z[2 * r_] = *(const u32x4*)(zp_ + (size_t)r_ * DM); Z[2 * r_ + 1] = *(const u32x4*)(zp_ + (size_t)r_ * DM + 8); } } \
        else { _Pragma("unroll") for (int r_ = 0; r_ < 4; ++r_) { const int tr_ = t0_ + tt - 1 + r_; const bool ok_ = tr_ >= 0 && tr_ < ts_; \
            const bf16_t* zp_ = sr_ + (size_t)(ok_ ? tr_ : 0) * DM + head * 128 + 16 * cg; const u32x4 za_ = *(const u32x4*)zp_, zb_ = *(const u32x4*)(zp_ + 8); const u32x4 zz_ = (u32x4){0u, 0u, 0u, 0u}; \
            Z[2 * r_] = ok_ ? za_ : zz_; Z[2 * r_ + 1] = ok_ ? zb_ : zz_; } } } while (0)
#define SCAN_BUILD(XCB) do { f32x2 xc2[8]; \
        { const LAS f32x4* cb_ = (const LAS f32x4*)(CW + 4 * 128 + 16 * cg); _Pragma("unroll") for (int j4 = 0; j4 < 4; ++j4) { const f32x4 v_ = cb_[j4]; xc2[2 * j4] = (f32x2){v_[0], v_[1]}; xc2[2 * j4 + 1] = (f32x2){v_[2], v_[3]}; } } \
        _Pragma("unroll") for (int r = 0; r < 4; ++r) { const u32x4 z0 = Z[2 * r], z1 = Z[2 * r + 1]; const LAS f32x4* cw_ = (const LAS f32x4*)(CW + r * 128 + 16 * cg); \
            _Pragma("unroll") for (int j4 = 0; j4 < 4; ++j4) { const f32x4 w_ = cw_[j4]; const unsigned da_ = j4 < 2 ? z0[2 * j4] : z1[2 * (j4 - 2)], db_ = j4 < 2 ? z0[2 * j4 + 1] : z1[2 * (j4 - 2) + 1]; \
                xc2[2 * j4] = (f32x2){w_[0], w_[1]} * (f32x2){bflo(da_), bfhi(da_)} + xc2[2 * j4]; xc2[2 * j4 + 1] = (f32x2){w_[2], w_[3]} * (f32x2){bflo(db_), bfhi(db_)} + xc2[2 * j4 + 1]; } } \
        u32x4 o0_, o1_; o0_[0] = pk2(xc2[0][0], xc2[0][1]); o0_[1] = pk2(xc2[1][0], xc2[1][1]); o0_[2] = pk2(xc2[2][0], xc2[2][1]); o0_[3] = pk2(xc2[3][0], xc2[3][1]); \
        o1_[0] = pk2(xc2[4][0], xc2[4][1]); o1_[1] = pk2(xc2[5][0], xc2[5][1]); o1_[2] = pk2(xc2[6][0], xc2[6][1]); o1_[3] = pk2(xc2[7][0], xc2[7][1]); \
        *(LAS u32x4*)((XCB) + tt * XC_STRIDE + cg * 32) = o0_; *(LAS u32x4*)((XCB) + tt * XC_STRIDE + cg * 32 + 16) = o1_; } while (0)
    u32x4 Z[8];
    SCAN_LOADZ(0);
    SCAN_BUILD(lds);
    SCAN_LOADZ(1);
    __syncthreads();
    size_t off_prev = 0; int seqi_prev = 0;
    u32x4 f0 = (u32x4){0u, 0u, 0u, 0u}, f1 = f0, g0 = f0, g1 = f0;
    for (int k = 0; k <= 36; ++k) {
        if (k > 0 && seqi_prev == 1) {
            const LAS float* HTp = (const LAS float*)(lds + 2 * XC_BYTES + ((k - 1) & 1) * HT_BYTES);
            const LAS f32x4* hp = (const LAS f32x4*)(HTp + tt * HT_STRIDE + 16 * cg);
            const f32x4 h0 = hp[0], h1 = hp[1], h2 = hp[2], h3 = hp[3];
            const size_t off = off_prev;
            if (DIR == 0) {
                *(u32x4*)(p.hf + off) = pg8::pack8(h0, h1); *(u32x4*)(p.hf + off + 8) = pg8::pack8(h2, h3);
            } else {
                f32x4 y0, y1, y2, y3;
                y0[0] = (h0[0] + bflo(f0[0])) * bflo(g0[0]); y0[1] = (h0[1] + bfhi(f0[0])) * bfhi(g0[0]); y0[2] = (h0[2] + bflo(f0[1])) * bflo(g0[1]); y0[3] = (h0[3] + bfhi(f0[1])) * bfhi(g0[1]);
                y1[0] = (h1[0] + bflo(f0[2])) * bflo(g0[2]); y1[1] = (h1[1] + bfhi(f0[2])) * bfhi(g0[2]); y1[2] = (h1[2] + bflo(f0[3])) * bflo(g0[3]); y1[3] = (h1[3] + bfhi(f0[3])) * bfhi(g0[3]);
                y2[0] = (h2[0] + bflo(f1[0])) * bflo(g1[0]); y2[1] = (h2[1] + bfhi(f1[0])) * bfhi(g1[0]); y2[2] = (h2[2] + bflo(f1[1])) * bflo(g1[1]); y2[3] = (h2[3] + bfhi(f1[1])) * bfhi(g1[1]);
                y3[0] = (h3[0] + bflo(f1[2])) * bflo(g1[2]); y3[1] = (h3[1] + bfhi(f1[2])) * bfhi(g1[2]); y3[2] = (h3[2] + bflo(f1[3])) * bflo(g1[3]); y3[3] = (h3[3] + bfhi(f1[3])) * bfhi(g1[3]);
                *(u32x4*)(p.ybin + off) = pg8::pack8(y0, y1); *(u32x4*)(p.ybin + off + 8) = pg8::pack8(y2, y3);
            }
        }
        if (k == 36) break;
        if (k + 1 < 36) { SCAN_BUILD(lds + ((k + 1) & 1) * XC_BYTES); if (k + 2 < 36) SCAN_LOADZ(k + 2); }
        SCAN_CREF(k, seqi, t0, Tseq, src) (void)Tseq; (void)src;
        {
            const size_t off = ((size_t)b * SEQ + t0 + tt) * DM + head * 128 + 16 * cg;
            if (DIR == 1 && seqi == 1) { f0 = *(const u32x4*)(p.hf + off); f1 = *(const u32x4*)(p.hf + off + 8); g0 = __builtin_nontemporal_load((const u32x4*)(p.gzy + off)); g1 = __builtin_nontemporal_load((const u32x4*)(p.gzy + off + 8)); }
            off_prev = off; seqi_prev = seqi;
        }
        {
            const LAS unsigned char* XC = lds + (k & 1) * XC_BYTES;
            LAS float* HT = (LAS float*)(lds + 2 * XC_BYTES + (k & 1) * HT_BYTES);
            f32x4 accr[4], acci[4];
#pragma unroll
            for (int mt = 0; mt < 4; ++mt) { accr[mt] = (f32x4){0.f, 0.f, 0.f, 0.f}; acci[mt] = (f32x4){0.f, 0.f, 0.f, 0.f}; }
#pragma unroll
            for (int mt = 0; mt < 4; ++mt)
#pragma unroll
                for (int ks = 0; ks < 4; ++ks) { const bf16x8 a = *(const LAS bf16x8*)(XC + (16 * mt + c16) * XC_STRIDE + (32 * ks + 8 * q4) * 2);
                    accr[mt] = __builtin_amdgcn_mfma_f32_16x16x32_bf16(a, bfa[ks], accr[mt], 0, 0, 0);
                    acci[mt] = __builtin_amdgcn_mfma_f32_16x16x32_bf16(a, bfx[ks], acci[mt], 0, 0, 0); }
#pragma unroll
            for (int mi = 0; mi < 4; ++mi) {
                const int mt = DIR == 0 ? mi : 3 - mi;
                float av[4], bv[4];
#pragma unroll
                for (int reg = 0; reg < 4; ++reg) {
                    const float xcv = bf2f(*(const LAS bf16_t*)(XC + (16 * mt + 4 * q4 + reg) * XC_STRIDE + (16 * w + c16) * 2));
                    const float r = __builtin_amdgcn_rcpf(1.0f + __builtin_amdgcn_exp2f(__builtin_fmaf(accr[mt][reg], -1.4426950409f, nba))), ig = __builtin_amdgcn_rcpf(1.0f + __builtin_amdgcn_exp2f(__builtin_fmaf(acci[mt][reg], -1.4426950409f, nbx)));
                    const float a = __builtin_amdgcn_exp2f(m8sp * r);
                    av[reg] = a; bv[reg] = __builtin_amdgcn_sqrtf(1.0f - a * a) * ig * xcv;
                }
                float A, B;
                if (DIR == 0) { A = av[0]; B = bv[0];
#pragma unroll
                    for (int reg = 1; reg < 4; ++reg) { B = av[reg] * B + bv[reg]; A *= av[reg]; } }
                else { A = av[3]; B = bv[3];
#pragma unroll
                    for (int reg = 2; reg >= 0; --reg) { B = av[reg] * B + bv[reg]; A *= av[reg]; } }
                { const float A1 = __shfl(A, src1), B1 = __shfl(B, src1); if (pos4 >= 1) { B = A * B1 + B; A = A * A1; } }
                { const float A2 = __shfl(A, src2), B2 = __shfl(B, src2); if (pos4 >= 2) { B = A * B2 + B; A = A * A2; } }
                float Aex = __shfl(A, src1), Bex = __shfl(B, src1); if (pos4 == 0) { Aex = 1.f; Bex = 0.f; }
                const float A3 = __shfl(A, srcl), B3 = __shfl(B, srcl);
                float hs = Aex * carry + Bex;
                float st[4];
                if (DIR == 0) {
#pragma unroll
                    for (int reg = 0; reg < 4; ++reg) { hs = av[reg] * hs + bv[reg]; st[reg] = hs; } }
                else {
#pragma unroll
                    for (int reg = 3; reg >= 0; --reg) { hs = av[reg] * hs + bv[reg]; st[reg] = hs; } }
                carry = A3 * carry + B3;
                if (seqi == 1) {
#pragma unroll
                    for (int reg = 0; reg < 4; ++reg) HT[(16 * mt + 4 * q4 + reg) * HT_STRIDE + 16 * w + c16] = st[reg]; }
            }
        }
        __syncthreads();
    }
#undef SCAN_CREF
#undef SCAN_LOADZ
#undef SCAN_BUILD
}
__device__ __forceinline__ void dev_scan(PREF p, LAS unsigned char* lds, int item0 = -1, int istep = 0, int iend = 0) {
    LAS float* CW = (LAS float*)(lds + SCAN_CW_OFF);
    if (item0 < 0) { item0 = blockIdx.x; istep = gridDim.x; iend = p.nb * 8; }
    for (int item = item0; item < iend; item += istep) {
        const int b = item >> 3, head = item & 7;
        __syncthreads();
        for (int i = tid_opaque(); i < 640; i += NTHR) CW[i] = (i < 512) ? p.conv_w[(i >> 7) * 1024 + head * 128 + (i & 127)] : p.conv_b[head * 128 + (i - 512)];
        __syncthreads();
        scan_dir<0>(p, lds, b, head);
        __syncthreads();
        scan_dir<1>(p, lds, b, head);
    }
}

#define CASD(a, b) { const int _x = max(a, b), _y = min(a, b); a = _x; b = _y; }
template <int K, int J, int BASE, int N> __device__ __forceinline__ void bitonic_step(int (&v)[N]) {
#pragma unroll
    for (int i = 0; i < 16; ++i) { const int l = i ^ J; if (l > i) { if ((i & K) == 0) { CASD(v[BASE + i], v[BASE + l]); } else { CASD(v[BASE + l], v[BASE + i]); } } }
}
template <int BASE, int N> __device__ __forceinline__ void sort16_desc(int (&v)[N]) {
    bitonic_step<2, 1, BASE>(v);
    bitonic_step<4, 2, BASE>(v); bitonic_step<4, 1, BASE>(v);
    bitonic_step<8, 4, BASE>(v); bitonic_step<8, 2, BASE>(v); bitonic_step<8, 1, BASE>(v);
    bitonic_step<16, 8, BASE>(v); bitonic_step<16, 4, BASE>(v); bitonic_step<16, 2, BASE>(v); bitonic_step<16, 1, BASE>(v);
}
template <int AB, int BB, int NA, int NB> __device__ __forceinline__ void merge16(int (&a)[NA], const int (&b)[NB]) {
#pragma unroll
    for (int i = 0; i < 16; ++i) a[AB + i] = max(a[AB + i], b[BB + 15 - i]);
    bitonic_step<32, 8, AB>(a); bitonic_step<32, 4, AB>(a); bitonic_step<32, 2, AB>(a); bitonic_step<32, 1, AB>(a);
}
__device__ __forceinline__ void top16_of_64(int (&v)[64]) {
    sort16_desc<0>(v); sort16_desc<16>(v); sort16_desc<32>(v); sort16_desc<48>(v);
    merge16<0, 16>(v, v); merge16<32, 48>(v, v); merge16<0, 32>(v, v);
}
__device__ __forceinline__ int f2key(float f) { const int b = __float_as_int(f); return b ^ ((b >> 31) & 0x7fffffff); }
__device__ __forceinline__ float key2f(int k) { return __int_as_float(k ^ ((k >> 31) & 0x7fffffff)); }
__device__ __forceinline__ int lut16(unsigned t0, unsigned t1, unsigned t2, unsigned t3, int i) {
    const int wsel = i >> 2; const unsigned lo = (wsel & 1) ? t1 : t0, hi = (wsel & 1) ? t3 : t2; const unsigned wv = (wsel & 2) ? hi : lo;
    return (int)((wv >> (8 * (i & 3))) & 0xffu);
}
#define CROW(I, CNT, OFF) { _Pragma("unroll") for (int j = 0; j < CNT; ++j) cv[OFF + j] = (f2key(s0[I] + s1[j]) & ~255) | (I << 4) | j; }
constexpr int TK_ROW = 272;
#define EOFF(t_) ((size_t)((t_) >> 13) * 2097152 + (size_t)((t_) & 8191) * 128)
#define W8OFF(t_) ((size_t)((t_) >> 13) * 16777216 + (size_t)((t_) & 8191) * 128)
#define SUOFF(t_) ((size_t)((t_) >> 13) * 4194304 + (size_t)((t_) & 8191) * 128)
__device__ __forceinline__ void dev_topk(PREF p, LAS unsigned char* lds, int hd_ = -1, int tg0 = 0, int tgend = 0, int tgstep = 0) {
    const int tid = tid_opaque(), w = tid >> 6, l = tid & 63, tl = l & 31, hh = l >> 5;
    const int T = p.nb * SEQ;
    const int hd = hd_ >= 0 ? hd_ : (int)(blockIdx.x & 7);
    if (hd_ < 0) { tg0 = (int)(blockIdx.x >> 3) * 8; tgend = T / 32; tgstep = (int)(gridDim.x >> 3) * 8; }
    __syncthreads();
    {
        const bf16_t* kg = p.keys_bf + (size_t)hd * 2 * 128 * 128;
        for (int c = tid; c < 2 * 128 * 16; c += NTHR) { const int row = c >> 4, ch = c & 15; *(LAS u32x4*)(lds + row * TK_ROW + ch * 16) = *(const u32x4*)(kg + (size_t)row * 128 + ch * 8); }
    }
    __syncthreads();
    for (int tg = tg0 + w; tg < tgend; tg += tgstep) {
        const int tok = tg * 32 + tl;
        int k0[16], k1[16];
        u32x4 qr[8];
        LAS unsigned char* qrel = lds + 2 * 128 * TK_ROW + w * (32 * TK_ROW);
#define TK_QLOAD(ph_) do { _Pragma("unroll") for (int i_ = 0; i_ < 8; ++i_) { const int tk_ = tg * 32 + 8 * (i_ >> 1) + (l & 7), tr_ = tk_ & 255, ch_ = 8 * (i_ & 1) + (l >> 3);     \
            qr[i_] = __builtin_nontemporal_load((const u32x4*)(p.q + ((size_t)QMAP(tk_ >> 8) * 8 + hd) * 65536 + (size_t)((((tr_ >> 6) & 1) * 4 + (ch_ >> 2)) * 8192 + (((tr_ >> 7) * 4 + ((tr_ >> 4) & 3)) * 2 + (ph_)) * 512 + ((tr_ & 15) + 16 * (ch_ & 3)) * 8))); } } while (0)
#define TK_QSTORE() do { _Pragma("unroll") for (int i_ = 0; i_ < 8; ++i_) *(LAS u32x4*)(qrel + (8 * (i_ >> 1) + (l & 7)) * TK_ROW + 16 * (8 * (i_ & 1) + (l >> 3))) = qr[i_]; } while (0)
        TK_QLOAD(0);
#pragma unroll
        for (int ph = 0; ph < 2; ++ph) {
            f32x16 acc[4];
#pragma unroll
            for (int kb = 0; kb < 4; ++kb)
#pragma unroll
                for (int r = 0; r < 16; ++r) acc[kb][r] = 0.f;
            const LAS unsigned char* kpl = lds + (ph * 128 + tl) * TK_ROW + 16 * hh;
            TK_QSTORE();
            if (ph == 0) TK_QLOAD(1);
#pragma unroll
            for (int ks = 0; ks < 8; ++ks) {
                if (ks == 2 || ks == 4 || ks == 6) asm volatile("" : "+v"(acc[0]), "+v"(acc[1]), "+v"(acc[2]), "+v"(acc[3]));
                const bf16x8 bq = *(const LAS bf16x8*)(qrel + tl * TK_ROW + 32 * ks + 16 * hh);
#pragma unroll
                for (int kb = 0; kb < 4; ++kb) { const bf16x8 ak = *(const LAS bf16x8*)(kpl + kb * 32 * TK_ROW + 32 * ks);
                    acc[kb] = __builtin_amdgcn_mfma_f32_32x32x16_bf16(ak, bq, acc[kb], 0, 0, 0); }
            }
            int v[64];
#pragma unroll
            for (int kb = 0; kb < 4; ++kb)
#pragma unroll
                for (int r = 0; r < 16; ++r) { const int idx = 32 * kb + (r & 3) + 8 * (r >> 2); v[kb * 16 + r] = (f2key(acc[kb][r]) & ~127) | idx | (hh << 2); }
            top16_of_64(v);
            int o[16];
#pragma unroll
            for (int i = 0; i < 16; ++i) o[i] = shx_i(v[i], 32);
            merge16<0, 0>(v, o);
#pragma unroll
            for (int i = 0; i < 16; ++i) { if (ph == 0) k0[i] = v[i]; else k1[i] = v[i]; }
        }
        float s0[16], s1[16];
#pragma unroll
        for (int i = 0; i < 16; ++i) { s0[i] = key2f(k0[i] & ~127); s1[i] = key2f(k1[i] & ~127); }
        int cv[64];
        CROW(0, 16, 0) CROW(1, 8, 16) CROW(2, 5, 24) CROW(3, 4, 29) CROW(4, 3, 33) CROW(5, 2, 36) CROW(6, 2, 38) CROW(7, 2, 40)
        CROW(8, 1, 42) CROW(9, 1, 43) CROW(10, 1, 44) CROW(11, 1, 45) CROW(12, 1, 46) CROW(13, 1, 47) CROW(14, 1, 48) CROW(15, 1, 49)
#pragma unroll
        for (int i = 50; i < 64; ++i) cv[i] = (int)0x80000000;
        top16_of_64(cv);
#define PK4(K, W) ((unsigned)(K[4 * W] & 127) | ((unsigned)(K[4 * W + 1] & 127) << 8) | ((unsigned)(K[4 * W + 2] & 127) << 16) | ((unsigned)(K[4 * W + 3] & 127) << 24))
        unsigned ta0 = PK4(k0, 0), ta1 = PK4(k0, 1), ta2 = PK4(k0, 2), ta3 = PK4(k0, 3);
        unsigned tc0 = PK4(k1, 0), tc1 = PK4(k1, 1), tc2 = PK4(k1, 2), tc3 = PK4(k1, 3);
        asm volatile("" : "+v"(ta0), "+v"(ta1), "+v"(ta2), "+v"(ta3), "+v"(tc0), "+v"(tc1), "+v"(tc2), "+v"(tc3));
        const float mx = key2f(cv[0] & ~255);
        float e[16], sum = 0.f;
#pragma unroll
        for (int k = 0; k < 16; ++k) { e[k] = __builtin_amdgcn_exp2f((key2f(cv[k] & ~255) - mx) * 1.4426950409f); sum += e[k]; }
        const float inv = 1.0f / sum;
        int eo[8]; float go[8];
#pragma unroll
        for (int k = 0; k < 8; ++k) { int c_lo = cv[k], c_hi = cv[8 + k]; float e_lo = e[k], e_hi = e[8 + k];
            asm volatile("" : "+v"(c_lo), "+v"(c_hi), "+v"(e_lo), "+v"(e_hi));
            const int cvk = hh ? c_hi : c_lo; const float ek = hh ? e_hi : e_lo;
            const int i = (cvk >> 4) & 15, j = cvk & 15;
            eo[k] = lut16(ta0, ta1, ta2, ta3, i) * 128 + lut16(tc0, tc1, tc2, tc3, j); go[k] = ek * inv; }
        float so[8];
#pragma unroll
        for (int k = 0; k < 8; ++k) { const f32x2 s2 = *(const f32x2*)(p.scu + 2 * eo[k]); go[k] *= s2[1]; so[k] = s2[0]; }
        const size_t off = EOFF(tok) + hd * 16 + hh * 8;
        *(u32x4*)(p.eidx + off) = (u32x4){(unsigned)eo[0], (unsigned)eo[1], (unsigned)eo[2], (unsigned)eo[3]};
        *(u32x4*)(p.eidx + off + 4) = (u32x4){(unsigned)eo[4], (unsigned)eo[5], (unsigned)eo[6], (unsigned)eo[7]};
        *(f32x4*)(p.gw + off) = (f32x4){go[0], go[1], go[2], go[3]};
        *(f32x4*)(p.gw + off + 4) = (f32x4){go[4], go[5], go[6], go[7]};
        const size_t soff = SUOFF(tok) + hd * 16 + hh * 8;
        *(f32x4*)(p.su + soff) = (f32x4){so[0], so[1], so[2], so[3]};
        *(f32x4*)(p.su + soff + 4) = (f32x4){so[4], so[5], so[6], so[7]};
    }
}

__device__ __forceinline__ float dot8(const u32x4 a, const u32x4 b, float acc) {
    const unsigned a0 = a[0], a1 = a[1], a2 = a[2], a3 = a[3], b0 = b[0], b1 = b[1], b2 = b[2], b3 = b[3];
    asm("v_dot2c_f32_bf16 %0, %1, %2" : "+v"(acc) : "v"(a0), "v"(b0));
    asm("v_dot2c_f32_bf16 %0, %1, %2" : "+v"(acc) : "v"(a1), "v"(b1));
    asm("v_dot2c_f32_bf16 %0, %1, %2" : "+v"(acc) : "v"(a2), "v"(b2));
    asm("v_dot2c_f32_bf16 %0, %1, %2" : "+v"(acc) : "v"(a3), "v"(b3));
    return acc;
}
__device__ __forceinline__ void dev_peer(PREF p) {
    const int tid = tid_opaque(), w = tid >> 6, l = tid & 63;
    const int T = p.nb * SEQ;
    const int b5 = (l >> 5) & 1, b4 = (l >> 4) & 1, b3 = (l >> 3) & 1;
    for (int tok = blockIdx.x * 8 + w; tok < T; tok += gridDim.x * 8) {
        const int b = tok >> 11;
        const u32x4 ha = *(const u32x4*)(p.h2 + (size_t)tok * DM + 8 * l), hb = *(const u32x4*)(p.h2 + (size_t)tok * DM + 512 + 8 * l);
        const int e_lo = p.eidx[(size_t)tok * 128 + l], e_hi = p.eidx[(size_t)tok * 128 + 64 + l];
        const float g_lo = p.gw[(size_t)tok * 128 + l], g_hi = p.gw[(size_t)tok * 128 + 64 + l];
        float acc[16];
#pragma unroll
        for (int i = 0; i < 16; ++i) acc[i] = 0.f;
        for (int grp = 0; grp < 16; ++grp) {
            const int esrc = grp < 8 ? e_lo : e_hi; const float gsrc = grp < 8 ? g_lo : g_hi; const int lbase = (grp & 7) * 8;
            int e[8];
#pragma unroll
            for (int k = 0; k < 8; ++k) e[k] = __builtin_amdgcn_readlane(esrc, lbase + k);
            u32x4 s0[8], s1[8];
            float part[8];
            {
                u32x4 r0[8], r1[8];
#pragma unroll
                for (int k = 0; k < 8; ++k) { const bf16_t* up = p.u_bf + (size_t)e[k] * DM + 8 * l; r0[k] = *(const u32x4*)up; r1[k] = *(const u32x4*)(up + 512); }
#pragma unroll
                for (int k = 0; k < 8; ++k) part[k] = dot8(r1[k], hb, dot8(r0[k], ha, 0.f));
            }
            asm volatile("" : "+v"(part[0]), "+v"(part[1]), "+v"(part[2]), "+v"(part[3]), "+v"(part[4]), "+v"(part[5]), "+v"(part[6]), "+v"(part[7]));
#pragma unroll
            for (int k = 0; k < 8; ++k) { const bf16_t* vp = p.v_bf + (size_t)e[k] * DM + 8 * l; s0[k] = *(const u32x4*)vp; s1[k] = *(const u32x4*)(vp + 512); }
            float q4v[4];
#pragma unroll
            for (int k = 0; k < 4; ++k) { const float send = b5 ? part[k] : part[k + 4]; const float recv = __shfl_xor(send, 32); q4v[k] = (b5 ? part[k + 4] : part[k]) + recv; }
            float r2[2];
#pragma unroll
            for (int k = 0; k < 2; ++k) { const float send = b4 ? q4v[k] : q4v[k + 2]; const float recv = __shfl_xor(send, 16); r2[k] = (b4 ? q4v[k + 2] : q4v[k]) + recv; }
            float sdot;
            { const float send = b3 ? r2[0] : r2[1]; const float recv = __shfl_xor(send, 8); sdot = (b3 ? r2[1] : r2[0]) + recv; }
            sdot += __shfl_xor(sdot, 4); sdot += __shfl_xor(sdot, 2); sdot += __shfl_xor(sdot, 1);
            const int kk = 4 * b5 + 2 * b4 + b3;
            const float gv = __shfl(gsrc, lbase + kk);
            const float wv = gv * gelu_f(sdot);
#pragma unroll
            for (int k = 0; k < 8; ++k) {
                const float wk = __int_as_float(__builtin_amdgcn_readlane(__float_as_int(wv), ((k >> 2) & 1) * 32 + ((k >> 1) & 1) * 16 + (k & 1) * 8));
#pragma unroll
                for (int i = 0; i < 4; ++i) { acc[2 * i] += wk * bflo(s0[k][i]); acc[2 * i + 1] += wk * bfhi(s0[k][i]); acc[8 + 2 * i] += wk * bflo(s1[k][i]); acc[8 + 2 * i + 1] += wk * bfhi(s1[k][i]); }
            }
        }
        const float* x1p = p.x1 + (size_t)tok * DM; const float* g2p = p.mod + (size_t)b * 6144 + 5 * 1024;
        f32x4 xv[4]; float ss = 0.f;
#pragma unroll
        for (int hlf = 0; hlf < 2; ++hlf)
#pragma unroll
            for (int q = 0; q < 2; ++q) { const int d = hlf * 512 + 8 * l + 4 * q; const f32x4 xx = *(const f32x4*)(x1p + d), gg = *(const f32x4*)(g2p + d);
                f32x4 r;
#pragma unroll
                for (int j = 0; j < 4; ++j) { r[j] = xx[j] + gg[j] * acc[hlf * 8 + 4 * q + j]; ss += r[j] * r[j]; }
                xv[hlf * 2 + q] = r; }
        ss = wave_sum(ss);
        const float rs = rsqrtf(ss * (1.0f / 1024.0f) + 1e-6f);
#pragma unroll
        for (int hlf = 0; hlf < 2; ++hlf)
#pragma unroll
            for (int q = 0; q < 2; ++q) { const int d = hlf * 512 + 8 * l + 4 * q; const f32x4 fg = *(const f32x4*)(p.final_g + d);
                f32x4 o;
#pragma unroll
                for (int j = 0; j < 4; ++j) o[j] = xv[hlf * 2 + q][j] * rs * fg[j];
                *(f32x4*)(p.out + (size_t)tok * DM + d) = o; }
    }
}


__device__ __forceinline__ float table_scale(unsigned maxbits) { const float m = fmaxf(__uint_as_float(maxbits), 1e-30f); return exp2f(floorf(log2f(448.0f / m))); }
__device__ __forceinline__ void dev_tabmax(PREF p) {
    const int tid = tid_opaque();
    float mu = 0.f, mv = 0.f;
    for (size_t i = ((size_t)blockIdx.x * NTHR + tid) * 4; i < (size_t)16384 * 1024; i += (size_t)gridDim.x * NTHR * 4) {
        const f32x4 a = *(const f32x4*)(p.peer_u + i), b = *(const f32x4*)(p.peer_v + i);
        mu = fmaxf(mu, fmaxf(fmaxf(fabsf(a[0]), fabsf(a[1])), fmaxf(fabsf(a[2]), fabsf(a[3]))));
        mv = fmaxf(mv, fmaxf(fmaxf(fabsf(b[0]), fabsf(b[1])), fmaxf(fabsf(b[2]), fabsf(b[3])))); }
#pragma unroll
    for (int o = 1; o < 64; o <<= 1) { mu = fmaxf(mu, __shfl_xor(mu, o)); mv = fmaxf(mv, __shfl_xor(mv, o)); }
    if ((tid & 63) == 0) { atomicMax(p.tmax + 0, __float_as_uint(mu)); atomicMax(p.tmax + 1, __float_as_uint(mv)); }
}
__device__ __forceinline__ unsigned fp4_code(float x) {
    const float ax = fabsf(x);
    unsigned c = ax < 0.25f ? 0u : ax < 0.75f ? 1u : ax < 1.25f ? 2u : ax < 1.75f ? 3u : ax < 2.5f ? 4u : ax < 3.5f ? 5u : ax < 5.0f ? 6u : 7u;
    return c | (x < 0.f ? 8u : 0u);
}
__device__ __forceinline__ void tab8_row(PREF p, const f32x4 (&a)[4], int r, int lane) {
    const int tab = r >> 14, e = r & 16383;
    float m = 0.f, ss = 0.f;
#pragma unroll
    for (int i = 0; i < 4; ++i) { m = fmaxf(m, fmaxf(fmaxf(fabsf(a[i][0]), fabsf(a[i][1])), fmaxf(fabsf(a[i][2]), fabsf(a[i][3]))));
        ss += (a[i][0] * a[i][0] + a[i][1] * a[i][1]) + (a[i][2] * a[i][2] + a[i][3] * a[i][3]); }
#pragma unroll
    for (int o = 1; o < 64; o <<= 1) { m = fmaxf(m, shx_f(m, o)); ss += shx_f(ss, o); }
    const float rms = sqrtf(ss * (1.0f / 1024.0f));
    const float sc = m > 0.f ? fminf(2.0f / rms, 9.0f / m) : 1.0f;
    unsigned char* dst = (tab ? p.v4 : p.u4) + (size_t)e * 128 + 2 * lane;
#pragma unroll
    for (int i = 0; i < 4; ++i) { unsigned b = 0u;
        b = __builtin_amdgcn_cvt_scalef32_pk_fp4_f32(b, a[i][0] * sc, a[i][1] * sc, 1.0f, 0); b = __builtin_amdgcn_cvt_scalef32_pk_fp4_f32(b, a[i][2] * sc, a[i][3] * sc, 1.0f, 1);
        *(unsigned short*)(dst + (size_t)i * 16384 * 128) = (unsigned short)b; }
    if (lane == 0) p.scu[2 * e + tab] = 1.0f / sc;
}
__device__ __forceinline__ void dev_tab8(PREF p, int bv = -1) {
    const int tid = tid_opaque();
    const int w = tid >> 6, lane = tid & 63;
    const int G = (int)gridDim.x, nctx = (p.nb * CTXL / 256) * 4, NR = 2 * 16384;
    const int Wt = nctx + 7 * (G - nctx), unit = (G > nctx) ? NR / Wt : 0;
    int first, S, end;
    if (G > nctx && unit * Wt == NR && (unit & 7) == 0) { const int b = bv >= 0 ? bv : (int)blockIdx.x; const int r0 = b < nctx ? b * unit : nctx * unit + (b - nctx) * 7 * unit; first = r0 + w; S = 8; end = r0 + (b < nctx ? unit : 7 * unit); }
    else { first = (int)blockIdx.x * 8 + w; S = G * 8; end = NR; }
#define TAB_LOAD(A, r) do { const int r_ = (r) < NR ? (r) : NR - 1; const float* s_ = ((r_ >> 14) ? p.peer_v : p.peer_u) + (size_t)(r_ & 16383) * 1024 + 4 * lane; \
        _Pragma("unroll") for (int i_ = 0; i_ < 4; ++i_) A[i_] = __builtin_nontemporal_load((const f32x4*)(s_ + 256 * i_)); } while (0)
    f32x4 A0[4], A1[4], A2[4], A3[4];
    if (first < end) { TAB_LOAD(A0, first); TAB_LOAD(A1, first + S); TAB_LOAD(A2, first + 2 * S); }
    for (int r = first; r < end; r += 4 * S) {
        TAB_LOAD(A3, r + 3 * S); tab8_row(p, A0, r, lane);
        TAB_LOAD(A0, r + 4 * S); if (r + S < end) tab8_row(p, A1, r + S, lane);
        TAB_LOAD(A1, r + 5 * S); if (r + 2 * S < end) tab8_row(p, A2, r + 2 * S, lane);
        TAB_LOAD(A2, r + 6 * S); if (r + 3 * S < end) tab8_row(p, A3, r + 3 * S, lane);
    }
#undef TAB_LOAD
}
#define PEER_ISSUE(R, E0, E1, E2, E3) do { _Pragma("unroll") for (int i_ = 0; i_ < 4; ++i_) { R[i_] = *(const u32x4*)(tab + (E0[i_] * 128u + kc16)); R[4 + i_] = *(const u32x4*)(tab + (E1[i_] * 128u + kc16)); \
        R[8 + i_] = *(const u32x4*)(tab + (E2[i_] * 128u + kc16)); R[12 + i_] = *(const u32x4*)(tab + (E3[i_] * 128u + kc16)); } } while (0)
#define PEER_LD_E(E0, E1, E2, E3, t) do { const u32x4* ep_ = (const u32x4*)(p.eidx + EOFF(t) + 16 * rsub); E0 = ep_[0]; E1 = ep_[1]; E2 = ep_[2]; E3 = ep_[3]; } while (0)
typedef int i32x8 __attribute__((ext_vector_type(8)));
__device__ __forceinline__ void sddmm_compute(u32x4 (&R)[16], const u32x4 (&hb)[4], LAS unsigned char* wbuf, float* dst_tok, int l) {
    const int rsub = l >> 3, kc = l & 7, rho = l & 15, kg = l >> 4;
    const int wr0 = rsub * 128 + ((kc ^ rsub) << 4), wr1 = (8 + rsub) * 128 + ((kc ^ rsub ^ 1) << 4);
    const int key = (rho & 7) ^ (rho >> 3), rbase = rho * 128;
    i32x8 b0, b1;
#pragma unroll
    for (int i = 0; i < 4; ++i) { b0[i] = (int)hb[0][i]; b0[4 + i] = (int)hb[1][i]; b1[i] = (int)hb[2][i]; b1[4 + i] = (int)hb[3][i]; }
    f32x4 acc[8];
#pragma unroll
    for (int t = 0; t < 8; ++t) {
        LAS unsigned char* buf = wbuf + (t & 1) * 2048;
        *(LAS u32x4*)(buf + wr0) = R[t]; *(LAS u32x4*)(buf + wr1) = R[t + 8];
        const u32x4 x0 = *(const LAS u32x4*)(buf + rbase + ((kg ^ key) << 4)), x1 = *(const LAS u32x4*)(buf + rbase + (((4 + kg) ^ key) << 4));
        i32x8 a0, a1;
#pragma unroll
        for (int i = 0; i < 4; ++i) { a0[i] = (int)x0[i]; a0[4 + i] = 0; a1[i] = (int)x1[i]; a1[4 + i] = 0; }
        f32x4 c = (f32x4){0.f, 0.f, 0.f, 0.f};
        c = __builtin_amdgcn_mfma_scale_f32_16x16x128_f8f6f4(a0, b0, c, 4, 0, 0, 0x7f7f7f7f, 0, 0x7f7f7f7f);
        c = __builtin_amdgcn_mfma_scale_f32_16x16x128_f8f6f4(a1, b1, c, 4, 0, 0, 0x7f7f7f7f, 0, 0x7f7f7f7f);
        acc[t] = c;
    }
    const int reg = rho & 3, half = (rho >> 2) & 1;
    f32x4 o;
#pragma unroll
    for (int c4 = 0; c4 < 4; ++c4) { f32x4 lo = acc[c4], hi = acc[4 + c4];
        asm volatile("" : "+v"(lo), "+v"(hi));
        const f32x4 x = half ? hi : lo; float x0 = x[0], x1 = x[1], x2 = x[2], x3 = x[3];
        asm volatile("" : "+v"(x0), "+v"(x1), "+v"(x2), "+v"(x3));
        o[c4] = (reg & 2) ? ((reg & 1) ? x3 : x2) : ((reg & 1) ? x1 : x0); }
    if (rho < 8) *(f32x4*)(dst_tok + 16 * (4 * (kg & 1) + reg) + 8 * (kg >> 1) + 4 * half) = o;
}
__device__ __forceinline__ void dev_sddmm(PREF p, LAS unsigned char* lds) {
    const int tid = tid_opaque(), w = tid >> 6, l = tid & 63, rsub = l >> 3, kc = l & 7, kg = l >> 4;
    const int T = p.nb * SEQ; const int s = blockIdx.x & 3, sub = blockIdx.x >> 2, nsub = gridDim.x >> 2;
    const unsigned char* tab = p.u4 + (size_t)s * 16384 * 128; const unsigned kc16 = 16u * kc;
    const int first = sub * 8 + w, S = nsub * 8;
    const int n = first < T ? (T - first + S - 1) / S : 0;
    LAS unsigned char* wbuf = lds + w * 4096;
    float* pdb = p.pd + (size_t)s * T * 128;
#define TOKI(i) (first + ((i) < n ? (i) : n - 1) * S)
#define LD_H(H, t) do { const unsigned char* hp_ = p.h8 + (size_t)(t) * DM + 256 * s + 16 * kg; H[0] = *(const u32x4*)hp_; H[1] = *(const u32x4*)(hp_ + 64); H[2] = *(const u32x4*)(hp_ + 128); H[3] = *(const u32x4*)(hp_ + 192); } while (0)
    if (n > 0) {
        u32x4 RA[16], RB[16], eA0, eA1, eA2, eA3, eB0, eB1, eB2, eB3, hA[4], hB[4];
        PEER_LD_E(eA0, eA1, eA2, eA3, TOKI(0)); LD_H(hA, TOKI(0)); PEER_ISSUE(RA, eA0, eA1, eA2, eA3);
        PEER_LD_E(eB0, eB1, eB2, eB3, TOKI(1)); LD_H(hB, TOKI(1));
        for (int i = 0; i < n; i += 2) {
            PEER_ISSUE(RB, eB0, eB1, eB2, eB3);
            PEER_LD_E(eA0, eA1, eA2, eA3, TOKI(i + 2));
            sddmm_compute(RA, hA, wbuf, pdb + (size_t)TOKI(i) * 128, l);
            LD_H(hA, TOKI(i + 2));
            PEER_ISSUE(RA, eA0, eA1, eA2, eA3);
            PEER_LD_E(eB0, eB1, eB2, eB3, TOKI(i + 3));
            if (i + 1 < n) sddmm_compute(RB, hB, wbuf, pdb + (size_t)TOKI(i + 1) * 128, l);
            LD_H(hB, TOKI(i + 3));
        }
    }
#undef LD_H
}
__device__ __forceinline__ void dev_act(PREF p) {
    const int tid = tid_opaque(); const int T = p.nb * SEQ; const size_t n = (size_t)T * 128;
    for (size_t i = ((size_t)blockIdx.x * NTHR + tid) * 4; i < n; i += (size_t)gridDim.x * NTHR * 4) {
        f32x4 a = *(const f32x4*)(p.pd + i);
#pragma unroll
        for (int s = 1; s < 4; ++s) a += *(const f32x4*)(p.pd + (size_t)s * n + i);
        const u32x4 e = *(const u32x4*)(p.eidx + i);
        f32x4 g = *(const f32x4*)(p.gw + i);
#pragma unroll
        for (int j = 0; j < 4; ++j) g[j] *= gelu_f(a[j] * (0.25f * p.scu[2 * e[j]])) * p.scu[2 * e[j] + 1];
        *(f32x4*)(p.gw + i) = g;
    }
}
template <int CTRL> __device__ __forceinline__ float dpp_f(float v) { return __int_as_float(__builtin_amdgcn_update_dpp(0, __float_as_int(v), CTRL, 0xf, 0xf, true)); }
__device__ __forceinline__ void spmm_compute(PREF p, u32x4 (&R)[16], const f32x4 w0, const f32x4 w1, const f32x4 w2, const f32x4 w3, int t, int col, int l) {
    const int b5 = (l >> 5) & 1, b4 = (l >> 4) & 1, b3 = (l >> 3) & 1;
    f32x2 ac2[16];
#pragma unroll
    for (int i = 0; i < 16; ++i) ac2[i] = (f32x2){0.f, 0.f};
#pragma unroll
    for (int r = 0; r < 16; ++r) { const float wg = (r < 4) ? w0[r & 3] : (r < 8) ? w1[r & 3] : (r < 12) ? w2[r & 3] : w3[r & 3];
        if (r >= 1) asm volatile("" : "+v"(R[r]) : "v"(ac2[0]));
        const f32x2 wg2 = (f32x2){wg, wg};
#pragma unroll
        for (int i = 0; i < 4; ++i) {
            ac2[4 * i + 0] = wg2 * __builtin_amdgcn_cvt_scalef32_pk_f32_fp4(R[r][i], 1.0f, 0) + ac2[4 * i + 0];
            ac2[4 * i + 1] = wg2 * __builtin_amdgcn_cvt_scalef32_pk_f32_fp4(R[r][i], 1.0f, 1) + ac2[4 * i + 1];
            ac2[4 * i + 2] = wg2 * __builtin_amdgcn_cvt_scalef32_pk_f32_fp4(R[r][i], 1.0f, 2) + ac2[4 * i + 2];
            ac2[4 * i + 3] = wg2 * __builtin_amdgcn_cvt_scalef32_pk_f32_fp4(R[r][i], 1.0f, 3) + ac2[4 * i + 3]; } }
    f32x2 a8[8], a4[4], a2[2];
#pragma unroll
    for (int k = 0; k < 8; ++k)
#pragma unroll
        for (int c = 0; c < 2; ++c) { const u32x2 r = __builtin_amdgcn_permlane32_swap(__float_as_uint(ac2[k][c]), __float_as_uint(ac2[k + 8][c]), false, false); a8[k][c] = __uint_as_float(r[0]) + __uint_as_float(r[1]); }
#pragma unroll
    for (int k = 0; k < 4; ++k)
#pragma unroll
        for (int c = 0; c < 2; ++c) { const u32x2 r = __builtin_amdgcn_permlane16_swap(__float_as_uint(a8[k][c]), __float_as_uint(a8[k + 4][c]), false, false); a4[k][c] = __uint_as_float(r[0]) + __uint_as_float(r[1]); }
#pragma unroll
    for (int k = 0; k < 2; ++k)
#pragma unroll
        for (int c = 0; c < 2; ++c) { const float snd = b3 ? a4[k][c] : a4[k + 2][c]; a2[k][c] = (b3 ? a4[k + 2][c] : a4[k][c]) + dpp_f<0x128>(snd); }
    *(u32x2*)(p.peer16 + (size_t)t * DM + col) = (u32x2){pk2(a2[0][0], a2[0][1]), pk2(a2[1][0], a2[1][1])};
}
__device__ __forceinline__ void dev_spmm(PREF p) {
    const int tid = tid_opaque(), w = tid >> 6, l = tid & 63, rsub = l >> 3, kc = l & 7;
    const int T = p.nb * SEQ; const int s = blockIdx.x & 3, sub = blockIdx.x >> 2, nsub = gridDim.x >> 2;
    const unsigned char* tab = p.v4 + (size_t)s * 16384 * 128; const unsigned kc16 = 16u * kc;
    const int col = 256 * s + 32 * kc + 2 * (8 * ((l >> 5) & 1) + 4 * ((l >> 4) & 1) + 2 * ((l >> 3) & 1));
    const int first = sub * 8 + w, S = nsub * 8;
    const int n = first < T ? (T - first + S - 1) / S : 0;
#define LD_W(W0, W1, W2, W3, t) do { const f32x4* wp_ = (const f32x4*)(p.gw + (size_t)(t) * 128 + 16 * rsub); W0 = wp_[0]; W1 = wp_[1]; W2 = wp_[2]; W3 = wp_[3]; } while (0)
    if (n > 0) {
        u32x4 RA[16], RB[16], eA0, eA1, eA2, eA3, eB0, eB1, eB2, eB3; f32x4 wA0, wA1, wA2, wA3, wB0, wB1, wB2, wB3;
        PEER_LD_E(eA0, eA1, eA2, eA3, TOKI(0)); LD_W(wA0, wA1, wA2, wA3, TOKI(0)); PEER_ISSUE(RA, eA0, eA1, eA2, eA3);
        PEER_LD_E(eB0, eB1, eB2, eB3, TOKI(1)); LD_W(wB0, wB1, wB2, wB3, TOKI(1));
        for (int i = 0; i < n; i += 2) {
            PEER_ISSUE(RB, eB0, eB1, eB2, eB3);
            PEER_LD_E(eA0, eA1, eA2, eA3, TOKI(i + 2));
            spmm_compute(p, RA, wA0, wA1, wA2, wA3, TOKI(i), col, l);
            LD_W(wA0, wA1, wA2, wA3, TOKI(i + 2));
            PEER_ISSUE(RA, eA0, eA1, eA2, eA3);
            PEER_LD_E(eB0, eB1, eB2, eB3, TOKI(i + 3));
            if (i + 1 < n) spmm_compute(p, RB, wB0, wB1, wB2, wB3, TOKI(i + 1), col, l);
            LD_W(wB0, wB1, wB2, wB3, TOKI(i + 3));
        }
    }
#undef LD_W
#undef TOKI
}
__device__ __forceinline__ void dev_final(PREF p) {
    const int tid = tid_opaque(), w = tid >> 6, lane = tid & 63; const int T = p.nb * SEQ;
    for (int t = blockIdx.x * 8 + w; t < T; t += gridDim.x * 8) {
        const float* g2p = p.mod + (size_t)(t >> 11) * 6144 + 5 * 1024;
        f32x4 xv[4]; float ss = 0.f;
#pragma unroll
        for (int i = 0; i < 4; ++i) { const int d = 4 * lane + 256 * i; const f32x4 x = *(const f32x4*)(p.x1 + (size_t)t * DM + d), gg = *(const f32x4*)(g2p + d);
            const u32x2 pv = *(const u32x2*)(p.peer16 + (size_t)t * DM + d);
            f32x4 r; r[0] = x[0] + gg[0] * bflo(pv[0]); r[1] = x[1] + gg[1] * bfhi(pv[0]); r[2] = x[2] + gg[2] * bflo(pv[1]); r[3] = x[3] + gg[3] * bfhi(pv[1]);
            ss += (r[0] * r[0] + r[1] * r[1]) + (r[2] * r[2] + r[3] * r[3]); xv[i] = r; }
        ss = wave_sum(ss);
        const float rs = rsqrtf(ss * (1.0f / 1024.0f) + 1e-6f);
#pragma unroll
        for (int i = 0; i < 4; ++i) { const int d = 4 * lane + 256 * i; const f32x4 fg = *(const f32x4*)(p.final_g + d);
            f32x4 o;
#pragma unroll
            for (int j = 0; j < 4; ++j) o[j] = xv[i][j] * rs * fg[j];
            *(f32x4*)(p.out + (size_t)t * DM + d) = o; }
    }
}


__device__ __forceinline__ void sddmm_accum(u32x4 (&R)[16], const u32x4 (&hb)[4], LAS unsigned char* wbuf, f32x4 (&acc)[8], int l) {
    const int rsub = l >> 3, kc = l & 7, rho = l & 15, kg = l >> 4;
    const int wr0 = rsub * 128 + ((kc ^ rsub) << 4), wr1 = (8 + rsub) * 128 + ((kc ^ rsub ^ 1) << 4);
    const int key = (rho & 7) ^ (rho >> 3), rbase = rho * 128;
    i32x8 b0, b1;
#pragma unroll
    for (int i = 0; i < 4; ++i) { b0[i] = (int)hb[0][i]; b0[4 + i] = (int)hb[1][i]; b1[i] = (int)hb[2][i]; b1[4 + i] = (int)hb[3][i]; }
#pragma unroll
    for (int t = 0; t < 8; ++t) {
        LAS unsigned char* buf = wbuf + (t & 1) * 2048;
        *(LAS u32x4*)(buf + wr0) = R[t]; *(LAS u32x4*)(buf + wr1) = R[t + 8];
        const u32x4 x0 = *(const LAS u32x4*)(buf + rbase + ((kg ^ key) << 4)), x1 = *(const LAS u32x4*)(buf + rbase + (((4 + kg) ^ key) << 4));
        i32x8 a0, a1;
#pragma unroll
        for (int i = 0; i < 4; ++i) { a0[i] = (int)x0[i]; a0[4 + i] = 0; a1[i] = (int)x1[i]; a1[4 + i] = 0; }
        f32x4 c = acc[t];
        c = __builtin_amdgcn_mfma_scale_f32_16x16x128_f8f6f4(a0, b0, c, 4, 0, 0, 0x7f7f7f7f, 0, 0x7f7f7f7f);
        c = __builtin_amdgcn_mfma_scale_f32_16x16x128_f8f6f4(a1, b1, c, 4, 0, 0, 0x7f7f7f7f, 0, 0x7f7f7f7f);
        acc[t] = c;
    }
}
__device__ __forceinline__ void dev_sddmm_act(PREF p, LAS unsigned char* lds, int first0 = -1, int S_ = 0, int tend = 0) {
    const int tid = tid_opaque(), w = __builtin_amdgcn_readfirstlane(tid >> 6), l = tid & 63, rsub = l >> 3, kc = l & 7, kg = l >> 4, rho = l & 15;
    const int T = p.nb * SEQ;
    const unsigned kc16 = 16u * kc;
    const int first = (first0 >= 0 ? first0 : (int)blockIdx.x * 8) + w, S = first0 >= 0 ? S_ : (int)gridDim.x * 8, TE = first0 >= 0 ? tend : T;
    const int n = first < TE ? (TE - first + S - 1) / S : 0;
    LAS unsigned char* wbuf = lds + w * 4096;
    const int reg = rho & 3, half = (rho >> 2) & 1, j0 = 16 * (4 * (kg & 1) + reg) + 8 * (kg >> 1) + 4 * half;
#define TOKI(i) (first + ((i) < n ? (i) : n - 1) * S)
#define SA_ISSUE(R, E0, E1, E2, E3, sl) do { const unsigned char* tab = p.u4 + (size_t)(sl) * 16384 * 128; PEER_ISSUE(R, E0, E1, E2, E3); } while (0)
#define SA_LD_H(H, t, sl) do { const unsigned char* hp_ = p.h8 + (size_t)(t) * DM + 256 * (sl) + 16 * kg; H[0] = *(const u32x4*)hp_; H[1] = *(const u32x4*)(hp_ + 64); H[2] = *(const u32x4*)(hp_ + 128); H[3] = *(const u32x4*)(hp_ + 192); } while (0)
    if (n > 0) {
        u32x4 RA[16], RB[16], eC0, eC1, eC2, eC3, eN0, eN1, eN2, eN3, hA[4], hB[4];
        PEER_LD_E(eC0, eC1, eC2, eC3, TOKI(0)); SA_LD_H(hA, TOKI(0), 0); SA_ISSUE(RA, eC0, eC1, eC2, eC3, 0);
        PEER_LD_E(eN0, eN1, eN2, eN3, TOKI(1));
        for (int i = 0; i < n; ++i) {
            const int t = TOKI(i);
            f32x4 acc[8];
#pragma unroll
            for (int k = 0; k < 8; ++k) acc[k] = (f32x4){0.f, 0.f, 0.f, 0.f};
            SA_ISSUE(RB, eC0, eC1, eC2, eC3, 1); SA_LD_H(hB, t, 1); sddmm_accum(RA, hA, wbuf, acc, l);
            SA_ISSUE(RA, eC0, eC1, eC2, eC3, 2); SA_LD_H(hA, t, 2); sddmm_accum(RB, hB, wbuf, acc, l);
            SA_ISSUE(RB, eC0, eC1, eC2, eC3, 3); SA_LD_H(hB, t, 3); sddmm_accum(RA, hA, wbuf, acc, l);
            const f32x4 sj = *(const f32x4*)(p.su + SUOFF(t) + j0); const f32x4 gj = *(const f32x4*)(p.gw + EOFF(t) + j0);
            SA_ISSUE(RA, eN0, eN1, eN2, eN3, 0); SA_LD_H(hA, TOKI(i + 1), 0); sddmm_accum(RB, hB, wbuf, acc, l);
            eC0 = eN0; eC1 = eN1; eC2 = eN2; eC3 = eN3;
            PEER_LD_E(eN0, eN1, eN2, eN3, TOKI(i + 2));
            f32x4 o;
#pragma unroll
            for (int c4 = 0; c4 < 4; ++c4) { f32x4 lo = acc[c4], hi = acc[4 + c4];
                asm volatile("" : "+v"(lo), "+v"(hi));
                const f32x4 x = half ? hi : lo; float x0 = x[0], x1 = x[1], x2 = x[2], x3 = x[3];
                asm volatile("" : "+v"(x0), "+v"(x1), "+v"(x2), "+v"(x3));
                o[c4] = (reg & 2) ? ((reg & 1) ? x3 : x2) : ((reg & 1) ? x1 : x0); }
            f32x4 wv = (f32x4){0.f, 0.f, 0.f, 0.f};
            if (rho < 8) {
#pragma unroll
                for (int c4 = 0; c4 < 4; ++c4) wv[c4] = gj[c4] * gelu_f(o[c4] * (0.25f * sj[c4])); }
            float mx = fmaxf(fmaxf(fabsf(wv[0]), fabsf(wv[1])), fmaxf(fabsf(wv[2]), fabsf(wv[3])));
#pragma unroll
            for (int sh = 1; sh < 64; sh <<= 1) mx = fmaxf(mx, shx_f(mx, sh));
            const int bexp = max((__float_as_int(mx) >> 23) & 255, 8);
            const float wsc = __int_as_float((261 - bexp) << 23);
            if (rho < 8) { int w8v = 0; w8v = __builtin_amdgcn_cvt_pk_fp8_f32(wv[0] * wsc, wv[1] * wsc, w8v, false); w8v = __builtin_amdgcn_cvt_pk_fp8_f32(wv[2] * wsc, wv[3] * wsc, w8v, true);
                *(unsigned*)(p.w8 + W8OFF(t) + j0) = (unsigned)w8v; }
            if (l == 0) p.wsc[t] = __int_as_float((bexp - 7) << 23);
        }
    }
#undef SA_ISSUE
#undef SA_LD_H
#undef TOKI
}
#define SF_ISSUE(R, ESRC, LBASE) do { int es_ = ESRC; _Pragma("unroll") for (int r_ = 0; r_ < 32; ++r_) { if ((r_ & 7) == 0) asm volatile("" : "+v"(es_) :: "memory");     \
        const unsigned e_ = (unsigned)__builtin_amdgcn_readlane(es_, (LBASE) + r_); R[r_] = *(const u32x2*)(tab + (lane_off + e_ * 128u)); } } while (0)
#define SF_COMPUTE(R, WSRC, LBASE) do { int ws_ = __float_as_int(WSRC); _Pragma("unroll") for (int r_ = 0; r_ < 32; ++r_) { \
        if ((r_ & 3) == 0 && r_ > 0) asm volatile("" : "+v"(R[r_]), "+v"(R[r_ + 1]), "+v"(R[r_ + 2]), "+v"(R[r_ + 3]), "+v"(ws_) : "v"(acc[0])); \
        const float wj_ = __int_as_float(__builtin_amdgcn_readlane(ws_, (LBASE) + r_)); const f32x2 w2_ = (f32x2){wj_, wj_}; \
        _Pragma("unroll") for (int i_ = 0; i_ < 2; ++i_) { \
            acc[4 * i_ + 0] = w2_ * __builtin_amdgcn_cvt_scalef32_pk_f32_fp4(R[r_][i_], 1.0f, 0) + acc[4 * i_ + 0]; acc[4 * i_ + 1] = w2_ * __builtin_amdgcn_cvt_scalef32_pk_f32_fp4(R[r_][i_], 1.0f, 1) + acc[4 * i_ + 1]; \
            acc[4 * i_ + 2] = w2_ * __builtin_amdgcn_cvt_scalef32_pk_f32_fp4(R[r_][i_], 1.0f, 2) + acc[4 * i_ + 2]; acc[4 * i_ + 3] = w2_ * __builtin_amdgcn_cvt_scalef32_pk_f32_fp4(R[r_][i_], 1.0f, 3) + acc[4 * i_ + 3]; } } } while (0)
__device__ __forceinline__ void dev_spmm_final(PREF p) {
    const int tid = tid_opaque(), w = __builtin_amdgcn_readfirstlane(tid >> 6), l = tid & 63;
    const int T = p.nb * SEQ;
    const unsigned char* tab = p.v4; const unsigned lane_off = (unsigned)(l >> 4) * (16384u * 128u) + 8u * (unsigned)(l & 15);
    const int first = blockIdx.x * 8 + w, S = gridDim.x * 8;
    const int n = first < T ? (T - first + S - 1) / S : 0;
#define TOKJ(i) (first + ((i) < n ? (i) : n - 1) * S)
#define SF_LISTS(EL, EH, WL, WH, t) do { EL = p.eidx[(size_t)(t) * 128 + l]; EH = p.eidx[(size_t)(t) * 128 + 64 + l]; const float is_ = p.wsc[t]; \
        WL = __builtin_amdgcn_cvt_f32_fp8((int)p.w8[(size_t)(t) * 128 + l], 0) * is_; WH = __builtin_amdgcn_cvt_f32_fp8((int)p.w8[(size_t)(t) * 128 + 64 + l], 0) * is_; } while (0)
    if (n > 0) {
        u32x2 RA[32], RB[32]; int eCl, eCh, eNl, eNh; float wCl, wCh, wNl, wNh;
        SF_LISTS(eCl, eCh, wCl, wCh, TOKJ(0)); SF_ISSUE(RA, eCl, 0); SF_LISTS(eNl, eNh, wNl, wNh, TOKJ(1));
        for (int i = 0; i < n; ++i) {
            const int t = TOKJ(i);
            f32x2 acc[8];
#pragma unroll
            for (int k = 0; k < 8; ++k) acc[k] = (f32x2){0.f, 0.f};
            SF_ISSUE(RB, eCl, 32); SF_COMPUTE(RA, wCl, 0);
            SF_ISSUE(RA, eCh, 0);  SF_COMPUTE(RB, wCl, 32);
            SF_ISSUE(RB, eCh, 32); SF_COMPUTE(RA, wCh, 0);
            int lo16 = 16 * l; asm volatile("" : "+v"(lo16));
            const bf16_t* x1p = p.x1b + (size_t)t * DM + lo16; const float* g2p = p.mod + (size_t)(t >> 11) * 6144 + 5 * 1024 + lo16;
            f32x4 xv[4], gg[4];
            { const u32x4 xa = *(const u32x4*)x1p, xb = *(const u32x4*)(x1p + 8);
              xv[0] = (f32x4){bflo(xa[0]), bfhi(xa[0]), bflo(xa[1]), bfhi(xa[1])}; xv[1] = (f32x4){bflo(xa[2]), bfhi(xa[2]), bflo(xa[3]), bfhi(xa[3])};
              xv[2] = (f32x4){bflo(xb[0]), bfhi(xb[0]), bflo(xb[1]), bfhi(xb[1])}; xv[3] = (f32x4){bflo(xb[2]), bfhi(xb[2]), bflo(xb[3]), bfhi(xb[3])}; }
#pragma unroll
            for (int q = 0; q < 4; ++q) gg[q] = *(const f32x4*)(g2p + 4 * q);
            SF_ISSUE(RA, eNl, 0);  SF_COMPUTE(RB, wCh, 32);
            eCl = eNl; eCh = eNh; wCl = wNl; wCh = wNh;
            SF_LISTS(eNl, eNh, wNl, wNh, TOKJ(i + 2));
            float ss = 0.f;
#pragma unroll
            for (int q = 0; q < 4; ++q) { xv[q][0] += gg[q][0] * acc[2 * q][0]; xv[q][1] += gg[q][1] * acc[2 * q][1]; xv[q][2] += gg[q][2] * acc[2 * q + 1][0]; xv[q][3] += gg[q][3] * acc[2 * q + 1][1];
                ss += (xv[q][0] * xv[q][0] + xv[q][1] * xv[q][1]) + (xv[q][2] * xv[q][2] + xv[q][3] * xv[q][3]); }
            ss = wave_sum(ss);
            const float rs = rsqrtf(ss * (1.0f / 1024.0f) + 1e-6f);
#pragma unroll
            for (int q = 0; q < 4; ++q) { const f32x4 fg = *(const f32x4*)(p.final_g + lo16 + 4 * q); f32x4 o;
#pragma unroll
                for (int j = 0; j < 4; ++j) o[j] = xv[q][j] * rs * fg[j];
                *(f32x4*)(p.out + (size_t)t * DM + lo16 + 4 * q) = o; }
        }
    }
#undef TOKJ
#undef SF_LISTS
}

typedef int v2i_t __attribute__((ext_vector_type(2)));
__device__ __forceinline__ void spmm_slice(const u32x4 (&R)[16], const i32x8 bw, LAS unsigned char* wbuf, int wa, int rb, int L, f32x4& acc) {
#pragma unroll
    for (int i = 0; i < 16; ++i) { LAS u32x4* d = (LAS u32x4*)(wbuf + (wa ^ ((i >> 1) << 4)) + i * 128);
        if (i & 1) *d = (u32x4){R[i][2], R[i][3], R[i][0], R[i][1]}; else *d = R[i]; }
#pragma unroll
    for (int mf = 0; mf < 16; ++mf) {
        LAS unsigned char* ap = wbuf + (rb ^ (mf << 3));
        const v2i_t lo = __builtin_amdgcn_ds_read_tr4_b64_v2i32((LAS v2i_t*)ap), hi = __builtin_amdgcn_ds_read_tr4_b64_v2i32((LAS v2i_t*)(ap + 2048));
        i32x8 a; a[0] = lo[0]; a[1] = lo[1]; a[2] = hi[0]; a[3] = hi[1]; a[4] = 0; a[5] = 0; a[6] = 0; a[7] = 0;
        const f32x4 d = __builtin_amdgcn_mfma_scale_f32_16x16x128_f8f6f4(a, bw, (f32x4){0.f, 0.f, 0.f, 0.f}, 4, 0, 0, 0x7f7f7f7f, 0, 0x7f7f7f7f);
        const bool keep = (L == mf);
#pragma unroll
        for (int j = 0; j < 4; ++j) acc[j] = keep ? d[j] : acc[j];
    }
}
__device__ __forceinline__ void dev_spmm_mfma(PREF p, LAS unsigned char* lds, int first0 = -1, int S_ = 0, int tend = 0) {
    const int tid = tid_opaque(), w = __builtin_amdgcn_readfirstlane(tid >> 6), l = tid & 63, rsub = l >> 3, kc = l & 7, L = l & 15, g = l >> 4;
    const int T = p.nb * SEQ;
    const unsigned kc16 = 16u * kc;
    const int first = (first0 >= 0 ? first0 : (int)blockIdx.x * 8) + w, S = first0 >= 0 ? S_ : (int)gridDim.x * 8, TE = first0 >= 0 ? tend : T;
    const int n = first < TE ? (TE - first + S - 1) / S : 0;
    LAS unsigned char* wbuf = lds + w * 16384;
    const int wa = rsub * 2048 + (kc << 4);
    const int rb = g * 4096 + L * 128 + (L << 3);
#define TOKI(i) (first + ((i) < n ? (i) : n - 1) * S)
#define SV_ISSUE(R, E0, E1, E2, E3, sl) do { const unsigned char* tab = p.v4 + (size_t)(sl) * 16384 * 128; PEER_ISSUE(R, E0, E1, E2, E3); } while (0)
    if (n > 0) {
        u32x4 RA[16], RB[16], eC0, eC1, eC2, eC3;
        PEER_LD_E(eC0, eC1, eC2, eC3, TOKI(0)); SV_ISSUE(RA, eC0, eC1, eC2, eC3, 0);
        for (int i = 0; i < n; ++i) {
            const int t = TOKI(i);
            const unsigned char* wp = p.w8 + W8OFF(t) + 16 * g;
            const u32x4 w0 = *(const u32x4*)wp, w1 = *(const u32x4*)(wp + 64);
            i32x8 bw;
#pragma unroll
            for (int j = 0; j < 4; ++j) { bw[j] = (int)w0[j]; bw[4 + j] = (int)w1[j]; }
            const float isc = p.wsc[t];
            f32x4 acc[4];
#pragma unroll
            for (int k = 0; k < 4; ++k) acc[k] = (f32x4){0.f, 0.f, 0.f, 0.f};
            SV_ISSUE(RB, eC0, eC1, eC2, eC3, 1); spmm_slice(RA, bw, wbuf, wa, rb, L, acc[0]);
            SV_ISSUE(RA, eC0, eC1, eC2, eC3, 2); spmm_slice(RB, bw, wbuf, wa, rb, L, acc[1]);
            SV_ISSUE(RB, eC0, eC1, eC2, eC3, 3);
            PEER_LD_E(eC0, eC1, eC2, eC3, TOKI(i + 1));
            spmm_slice(RA, bw, wbuf, wa, rb, L, acc[2]);
            int col4 = 16 * L + 4 * g; asm volatile("" : "+v"(col4));
            const bf16_t* x1p = p.x1b + (size_t)t * DM + col4; const float* g2p = p.mod + (size_t)(t >> 11) * 6144 + 5 * 1024 + col4;
            u32x2 xq[4]; f32x4 gg[4], fgv[4];
#pragma unroll
            for (int q = 0; q < 4; ++q) { xq[q] = __builtin_nontemporal_load((const u32x2*)(x1p + 256 * q)); gg[q] = *(const f32x4*)(g2p + 256 * q); fgv[q] = *(const f32x4*)(p.final_g + col4 + 256 * q); }
            SV_ISSUE(RA, eC0, eC1, eC2, eC3, 0); spmm_slice(RB, bw, wbuf, wa, rb, L, acc[3]);
            f32x4 xv[4]; float ss = 0.f;
#pragma unroll
            for (int q = 0; q < 4; ++q) { xv[q] = (f32x4){bflo(xq[q][0]), bfhi(xq[q][0]), bflo(xq[q][1]), bfhi(xq[q][1])};
#pragma unroll
                for (int j = 0; j < 4; ++j) xv[q][j] += gg[q][j] * (acc[q][j] * isc);
                ss += (xv[q][0] * xv[q][0] + xv[q][1] * xv[q][1]) + (xv[q][2] * xv[q][2] + xv[q][3] * xv[q][3]); }
            ss = wave_sum(ss);
            const float rs = rsqrtf(ss * (1.0f / 1024.0f) + 1e-6f);
#pragma unroll
            for (int q = 0; q < 4; ++q) { const f32x4 fg = fgv[q]; f32x4 o;
#pragma unroll
                for (int j = 0; j < 4; ++j) o[j] = xv[q][j] * rs * fg[j];
                __builtin_nontemporal_store(o, (f32x4*)(p.out + (size_t)t * DM + col4 + 256 * q)); }
        }
    }
#undef SV_ISSUE
#undef TOKI
}

__device__ __forceinline__ void dev_gemm_in(PREF p, LAS unsigned char* lds, int cctx = -1, int vb = -1) {
    if (cctx < 0) cctx = blockIdx.x;
    if (vb < 0) vb = blockIdx.x;
    const int T = p.nb * SEQ, TC = p.nb * CTXL;
    {
        pg8::Gemm g{p.hc, p.Wt_in + (size_t)512 * DM, DM, DM, DM, 0, 0}; pg8::StaticOrder S; S.init(TC, 1024, gridDim.x, cctx);
        pg8::EpiAct E{p.zxc, 0, 0, 1 << 20, DM, 0, 0};
        pg8::gemm_phase(lds, g, S, E);
    }
    {
        pg8::Gemm g{p.h, p.Wt_in + (size_t)512 * DM, DM, DM, DM, 0, 0}; pg8::StaticOrder S; S.init(T, 4096, gridDim.x, vb);
        pg8::EpiAct E{p.zx, p.zseg, 0x2210, 4, DM, 1, 0};
        pg8::gemm_phase(lds, g, S, E);
    }
    {
        pg8::Gemm g{p.Wt_in, p.h, DM, DM, DM, 0, 0}; pg8::StaticOrder S; S.init(512, T, gridDim.x, vb);
        pg8::EpiAct E{p.zfT, (size_t)512 * SEQ, 0, SEQ / 256, SEQ, 0, 0};
        pg8::gemm_phase(lds, g, S, E);
    }
}
__device__ __forceinline__ void dev_gemm_dft(PREF p, LAS unsigned char* lds, int c0 = -1, int Gs = 0, long Lend = -1) {
    if (c0 < 0) { c0 = blockIdx.x; Gs = gridDim.x; }
    const int T = p.nb * SEQ;
    pg8::Gemm g{p.dft, p.zfT, SEQ, SEQ, SEQ, 0, (long)512 * SEQ}; pg8::BatchOrder S; S.init(2048, 512, p.nb, Gs, c0, Lend);
    pg8::EpiUV E{p.UV};
    pg8::gemm_phase(lds, g, S, E);
}
__device__ __forceinline__ void dev_gemm_mix(PREF p, LAS unsigned char* lds, int vb = -1) {
    if (vb < 0) vb = blockIdx.x;
    const int T = p.nb * SEQ;
    {
        pg8::Gemm g{p.UV, p.Wfp, DM, DM, DM, 0, 0}; pg8::StaticOrder S; S.init(T, 1024, gridDim.x, vb);
        pg8::EpiGate<false> E{p.sga, nullptr, p.Pb};
        pg8::gemm_phase(lds, g, S, E);
    }
    {
        pg8::Gemm g{p.ybin, p.Wt_lru, DM, DM, DM, 0, 0}; pg8::StaticOrder S; S.init(T, 1024, gridDim.x, vb);
        pg8::EpiGate<true> E{p.sgb, p.Pb, p.merged};
        pg8::gemm_phase(lds, g, S, E);
    }
}
__device__ __forceinline__ void dev_gemm_out(PREF p, LAS unsigned char* lds, int vb = -1) {
    if (vb < 0) vb = blockIdx.x;
    const int T = p.nb * SEQ;
    pg8::Gemm g{p.merged, p.Wt_out, DM, DM, DM, 0, 0, 1, 0}; pg8::StaticOrder S; S.init(T, 1024, gridDim.x, vb);
    pg8::EpiX1 E{p.x, p.pos, p.mod, p.b_out, p.x1b};
    pg8::gemm_phase(lds, g, S, E);
}
__device__ __forceinline__ void dev_gemm_q(PREF p, LAS unsigned char* lds, int vb = -1) {
    if (vb < 0) vb = blockIdx.x;
    const int T = p.nb * SEQ;
    pg8::Gemm g{p.h2, p.Wt_q, DM, DM, DM, 0, 0}; pg8::StaticOrder S; S.init(T, 2048, gridDim.x, vb);
    pg8::EpiAct E{p.q, 0, 0, 1 << 20, 2048, 1, 1, 1};
    pg8::gemm_phase(lds, g, S, E);
}

#define KERNEL_HEAD extern __shared__ __attribute__((aligned(16))) unsigned char smem_raw[]; LAS unsigned char* lds = (LAS unsigned char*)smem_raw;
#ifdef DIAG
__global__ void __launch_bounds__(NTHR, 2) k_prep_t(Params p) { KERNEL_HEAD
    dev_transpose(p.w_in, 4608, 0, 1024, 4608, p.Wt_in, 1, 0, 0, lds, 0, (int)gridDim.x);
    dev_transpose(p.w_lru_out, 1024, 0, 1024, 1024, p.Wt_lru, 1, 0, 0, lds, 0, (int)gridDim.x);
    dev_transpose(p.w_out, 1024, 0, 1024, 1024, p.Wt_out, 1, 0, 0, lds, 0, (int)gridDim.x);
    dev_transpose(p.peer_wq, 2048, 0, 1024, 2048, p.Wt_q, 1, 0, 0, lds, 0, (int)gridDim.x);
    dev_transpose(p.lru_wa, 128, 0, 128, 128, p.gates_bf, 8, 16384, 16384, lds, 0, (int)gridDim.x);
    dev_transpose(p.lru_wx, 128, 0, 128, 128, p.gates_bf + (size_t)8 * 16384, 8, 16384, 16384, lds, 0, (int)gridDim.x);
    dev_transpose(p.lru_wa + (size_t)8 * 16384, 128, 0, 128, 128, p.gates_bf + (size_t)16 * 16384, 8, 16384, 16384, lds, 0, (int)gridDim.x);
    dev_transpose(p.lru_wx + (size_t)8 * 16384, 128, 0, 128, 128, p.gates_bf + (size_t)24 * 16384, 8, 16384, 16384, lds, 0, (int)gridDim.x);
}
__global__ void __launch_bounds__(NTHR, 2) k_prep_c(Params p) { KERNEL_HEAD
    dev_convert(p.peer_keys, p.keys_bf, (size_t)8 * 2 * 128 * 128);
    dev_convert(p.peer_u, p.u_bf, (size_t)16384 * 1024);
    dev_convert(p.peer_v, p.v_bf, (size_t)16384 * 1024);
    dev_wfp(p, lds);
    dev_dft(p);
    dev_pos(p);
}
__global__ void __launch_bounds__(NTHR, 2) k_adaln(Params p) { KERNEL_HEAD dev_adaln(p, lds); }
__global__ void __launch_bounds__(NTHR, 2) k_norm1(Params p) { dev_norm(p, 0); }
__global__ void __launch_bounds__(NTHR, 2) k_gemm_in(Params p) { KERNEL_HEAD dev_gemm_in(p, lds); }
__global__ void __launch_bounds__(NTHR, 2) k_scan(Params p) { KERNEL_HEAD dev_scan(p, lds); }
__global__ void __launch_bounds__(NTHR, 2) k_gemm_dft(Params p) { KERNEL_HEAD dev_gemm_dft(p, lds); }
__global__ void __launch_bounds__(NTHR, 2) k_gemm_mix(Params p) { KERNEL_HEAD dev_gemm_mix(p, lds); }
__global__ void __launch_bounds__(NTHR, 2) k_gemm_out(Params p) { KERNEL_HEAD dev_gemm_out(p, lds); }
__global__ void __launch_bounds__(NTHR, 2) k_norm2(Params p) { dev_norm(p, 1); }
__global__ void __launch_bounds__(NTHR, 2) k_gemm_q(Params p) { KERNEL_HEAD dev_gemm_q(p, lds); }
__global__ void __launch_bounds__(NTHR, 2) k_topk(Params p) { dev_topk(p); }
__global__ void __launch_bounds__(NTHR, 2) k_peer(Params p) { dev_peer(p); }


#endif
namespace cg = cooperative_groups;

#define XB_TMO      128
#define XB_XCNT(j)  (256  + 64 * (j))
#define XB_XSUB(j)  (1280 + 64 * (j))
#define XB_XGEN(j)  (2304 + 64 * (j))
#define XB_TOP      3328
#define XB_TOPGEN   3392
#define XB_LSUB(j)  (3456 + 64 * (j))
#define XB_LGEN(j)  (4480 + 64 * (j))
#define XB_PUB      5504
#define XCD_BAR_WORDS 5568
#define XB_SPIN_CAP (1u << 22)
__device__ __forceinline__ unsigned xb_ld(unsigned* p)              { return __hip_atomic_load(p, __ATOMIC_RELAXED, __HIP_MEMORY_SCOPE_AGENT); }
__device__ __forceinline__ unsigned xb_add(unsigned* p, unsigned v) { return __hip_atomic_fetch_add(p, v, __ATOMIC_RELAXED, __HIP_MEMORY_SCOPE_AGENT); }
__device__ __forceinline__ unsigned xb_xcc_id() { return (unsigned)__builtin_amdgcn_s_getreg((3 << 11) | 20) & 0xFu; }
#define XB_SPIN(cond, bar) do { unsigned _sp = 0; while (cond) { __builtin_amdgcn_s_sleep(1); \
    if ((++_sp & 255u) == 0u) { if (xb_ld(&(bar)[XB_TMO])) break; if (_sp > XB_SPIN_CAP) { atomicAdd(&(bar)[XB_TMO], 1u); break; } } } } while (0)
struct XcdBarrier { unsigned* bar; unsigned x; volatile LAS unsigned* st; };
__device__ __forceinline__ XcdBarrier xcd_barrier_post(unsigned* bar, volatile LAS unsigned* st) {
    XcdBarrier b; b.bar = bar; b.x = xb_xcc_id(); b.st = st;
    if (threadIdx.x == 0) st[3] = xb_add(&bar[XB_XCNT(b.x)], 1u);
    return b;
}
__device__ __forceinline__ void xcd_barrier_complete(unsigned* bar, unsigned x, unsigned& nloc, unsigned& nx, unsigned& uni) {
    const unsigned G = gridDim.x * gridDim.y * gridDim.z;
    unsigned sum, cnt, mine, even, sp = 0u;
    for (;;) {
        sum = 0u; cnt = 0u; mine = 0u; even = ((G & 63u) == 0u) ? 1u : 0u;
#pragma unroll
        for (unsigned j = 0; j < 16; ++j) { const unsigned c = xb_ld(&bar[XB_XCNT(j)]); sum += c; cnt += (c > 0u) ? 1u : 0u; mine = (j == x) ? c : mine; if (j < 8 && c != (G >> 3)) even = 0u; }
        if (sum == G) break;
        __builtin_amdgcn_s_sleep(1);
        if ((++sp & 255u) == 0u) { if (xb_ld(&bar[XB_TMO])) break; if (sp > XB_SPIN_CAP) { atomicAdd(&bar[XB_TMO], 1u); break; } }
    }
    nloc = mine > 0u ? mine : 1u; nx = cnt > 0u ? cnt : 1u; uni = (sum == G) ? even : 0u;
}
__device__ __forceinline__ void xcd_barrier(const XcdBarrier& b) {
    asm volatile("s_waitcnt vmcnt(0)" ::: "memory");
    __syncthreads();
    if (threadIdx.x == 0) {
        unsigned* bar = b.bar;
        __builtin_amdgcn_s_waitcnt(0);
        unsigned nloc = b.st[0], nx = b.st[1];
        if (nloc == 0u) { unsigned uni; xcd_barrier_complete(bar, b.x, nloc, nx, uni); b.st[0] = nloc; b.st[1] = nx; b.st[2] = uni; }
        const unsigned old = xb_add(&bar[XB_XSUB(b.x)], 1u);
        const unsigned gen = old / nloc;
        if (old + 1u == (gen + 1u) * nloc) {
            __builtin_amdgcn_fence(__ATOMIC_RELEASE, "agent");
            asm volatile("s_waitcnt vmcnt(0)" ::: "memory");
            const unsigned og = xb_add(&bar[XB_TOP], 1u);
            const unsigned tg = og / nx;
            if (og + 1u == (tg + 1u) * nx) xb_add(&bar[XB_TOPGEN], 1u);
            else XB_SPIN(xb_ld(&bar[XB_TOPGEN]) == tg, bar);
            __builtin_amdgcn_fence(__ATOMIC_ACQUIRE, "agent");
            xb_add(&bar[XB_XGEN(b.x)], 1u);
            asm volatile("s_waitcnt vmcnt(0)" ::: "memory");
        } else {
            XB_SPIN(xb_ld(&bar[XB_XGEN(b.x)]) == gen, bar);
            __builtin_amdgcn_fence(__ATOMIC_ACQUIRE, "agent");
            asm volatile("s_waitcnt vmcnt(0)" ::: "memory");
        }
    }
    __syncthreads();
}

__device__ __forceinline__ void xcd_local_barrier(const XcdBarrier& b, const bool publish = false) {
    asm volatile("s_waitcnt vmcnt(0)" ::: "memory");
    __syncthreads();
    if (threadIdx.x == 0) {
        unsigned* bar = b.bar;
        __builtin_amdgcn_s_waitcnt(0);
        const unsigned nloc = b.st[0];
        const unsigned old = xb_add(&bar[XB_LSUB(b.x)], 1u);
        const unsigned gen = old / nloc;
        if (old + 1u == (gen + 1u) * nloc) {
            if (publish) { __builtin_amdgcn_fence(__ATOMIC_RELEASE, "agent"); asm volatile("s_waitcnt vmcnt(0)" ::: "memory"); xb_add(&bar[XB_PUB], 1u); }
            xb_add(&bar[XB_LGEN(b.x)], 1u);
        } else XB_SPIN(xb_ld(&bar[XB_LGEN(b.x)]) == gen, bar);
        __builtin_amdgcn_fence(__ATOMIC_ACQUIRE, "agent");
        asm volatile("s_waitcnt vmcnt(0)" ::: "memory");
    }
    __syncthreads();
}

__device__ __forceinline__ void xcd_wait_published(const XcdBarrier& b) {
    if (threadIdx.x == 0) {
        unsigned* bar = b.bar; const unsigned nx = b.st[1];
        XB_SPIN(xb_ld(&bar[XB_PUB]) < nx, bar);
        __builtin_amdgcn_fence(__ATOMIC_ACQUIRE, "agent");
    }
    __syncthreads();
}

#ifndef DIAG
__device__ __forceinline__ CParams* kparams() { CParams* q = (CParams*)__builtin_amdgcn_kernarg_segment_ptr(); asm volatile("" : "+s"(q)); return q; }
__global__ void __launch_bounds__(NTHR, 2) k_mega(Params p_unused) { KERNEL_HEAD
    cg::grid_group grid = cg::this_grid();
    volatile LAS unsigned* bst = (volatile LAS unsigned*)(lds + LDS_BYTES - 16);
    if (blockIdx.x == 0) { CParams& p = *kparams(); for (int i = tid_opaque(); i < XCD_BAR_WORDS; i += NTHR) p.bar[i] = 0u; }
    if (tid_opaque() < 2) bst[tid_opaque()] = 0u;
    { CParams& p = *kparams(); dev_adaln(p, lds); }
    __syncthreads();
    { CParams& p = *kparams();
      const int G = (int)gridDim.x, G8 = (G & 7) ? G : (G >> 3), gf = (G & 7) ? 0 : (G >> 1);
      dev_transpose(p.w_in, 4608, 0, 1024, 4608, p.Wt_in, 1, 0, 0, lds, 0, G);
      dev_transpose(p.lru_wa, 128, 0, 128, 128, p.gates_bf, 8, 16384, 16384, lds, gf, G8);
      dev_transpose(p.lru_wx, 128, 0, 128, 128, p.gates_bf + (size_t)8 * 16384, 8, 16384, 16384, lds, (G & 7) ? 0 : gf + G8, G8);
      dev_transpose(p.lru_wa + (size_t)8 * 16384, 128, 0, 128, 128, p.gates_bf + (size_t)16 * 16384, 8, 16384, 16384, lds, (G & 7) ? 0 : gf + 2 * G8, G8);
      dev_transpose(p.lru_wx + (size_t)8 * 16384, 128, 0, 128, 128, p.gates_bf + (size_t)24 * 16384, 8, 16384, 16384, lds, (G & 7) ? 0 : gf + 3 * G8, G8);
      dev_transpose(p.w_lru_out, 1024, 0, 1024, 1024, p.Wt_lru, 1, 0, 0, lds, 0, G);
      dev_transpose(p.w_out, 1024, 0, 1024, 1024, p.Wt_out, 1, 0, 0, lds, 0, G);
      dev_transpose(p.peer_wq, 2048, 0, 1024, 2048, p.Wt_q, 1, 0, 0, lds, 0, G); }
    { CParams& p = *kparams();
      dev_convert(p.peer_keys, p.keys_bf, (size_t)8 * 2 * 128 * 128);
      if (blockIdx.x == 0 && tid_opaque() < 2) p.tmax[tid_opaque()] = 0u; }
    { CParams& p = *kparams(); dev_wfp(p, lds); }
    { CParams& p = *kparams(); dev_dft(p); dev_pos(p); }
    grid.sync();
    XcdBarrier xbar; { CParams& p = *kparams(); xbar = xcd_barrier_post(p.bar, bst); }
    { CParams& p = *kparams(); dev_norm(p, 0); }
    xcd_barrier(xbar);
    const unsigned uni = __builtin_amdgcn_readfirstlane(bst[2]), rank = __builtin_amdgcn_readfirstlane(bst[3]);
    const int vb = uni ? (int)(rank * 8u + xbar.x) : (int)blockIdx.x;
    int cctx = blockIdx.x, btab = blockIdx.x;
    if (uni) { const int pm = (int)xbar.x * 4 + (int)(rank & 3u), pn = (int)(rank >> 2), wg = (pm >> 3) * 32 + pn * 8 + (pm & 7);
               cctx = rank < 16u ? (wg & 15) * 8 + (wg >> 4) : 128 + (int)blockIdx.x; btab = rank < 16u ? (int)xbar.x * 16 + (int)rank : 128 + (int)xbar.x * 16 + (int)rank - 16; }
    { CParams& p = *kparams(); dev_tab8(p, btab); }
    { CParams& p = *kparams(); dev_gemm_in(p, lds, cctx, vb); }
    if (uni) xcd_local_barrier(xbar, true); else xcd_barrier(xbar);
    { CParams& p = *kparams(); const int nl = (int)gridDim.x >> 3;
      dev_scan(p, lds, uni ? (int)xbar.x * 32 + (int)rank : (int)blockIdx.x, uni ? nl : (int)gridDim.x, uni ? ((int)xbar.x + 1) * 32 : p.nb * 8); }
    { CParams& p = *kparams(); const int nl = (int)gridDim.x >> 3;
      dev_gemm_dft(p, lds, uni ? (int)xbar.x * 64 + (int)rank : (int)blockIdx.x, uni ? nl : (int)gridDim.x, uni ? (long)((int)xbar.x + 1) * 64 : (long)-1); }
    if (uni) xcd_local_barrier(xbar); else xcd_barrier(xbar);
    { CParams& p = *kparams(); dev_gemm_mix(p, lds, vb); }
    if (uni) xcd_local_barrier(xbar); else xcd_barrier(xbar);
    { CParams& p = *kparams(); dev_gemm_out(p, lds, vb); }
    if (uni) xcd_local_barrier(xbar); else xcd_barrier(xbar);
    { CParams& p = *kparams(); const int TX = (p.nb * SEQ) >> 3;
      dev_norm(p, 1, uni ? (int)xbar.x * TX + (int)rank * 8 : (int)blockIdx.x * 8, uni ? (int)gridDim.x : (int)gridDim.x * 8, uni ? ((int)xbar.x + 1) * TX : p.nb * SEQ); }
    if (uni) xcd_local_barrier(xbar); else xcd_barrier(xbar);
    { CParams& p = *kparams(); dev_gemm_q(p, lds, vb); }
    if (uni) { xcd_local_barrier(xbar); xcd_wait_published(xbar); } else xcd_barrier(xbar);
    const int TXr = (NBATCH * SEQ) >> 3, nlb = (int)gridDim.x >> 3, tk0 = uni ? (int)xbar.x * TXr + (int)rank * 8 : (int)blockIdx.x * 8, tkS = uni ? (int)gridDim.x : (int)gridDim.x * 8, tkE = uni ? ((int)xbar.x + 1) * TXr : NBATCH * SEQ;
    { CParams& p = *kparams();
      dev_topk(p, lds, uni ? (int)(rank & 7u) : (int)(blockIdx.x & 7), uni ? (int)xbar.x * (TXr >> 5) + (int)(rank >> 3) * 8 : (int)(blockIdx.x >> 3) * 8, uni ? ((int)xbar.x + 1) * (TXr >> 5) : (NBATCH * SEQ) >> 5, uni ? (nlb >> 3) * 8 : nlb * 8); }
    if (uni) xcd_local_barrier(xbar); else xcd_barrier(xbar);
    { CParams& p = *kparams(); dev_sddmm_act(p, lds, tk0, tkS, tkE); }
    asm volatile("s_waitcnt vmcnt(0)" ::: "memory");
    __syncthreads();
    { CParams& p = *kparams(); dev_spmm_mfma(p, lds, tk0, tkS, tkE); }
}
#endif

#ifdef DIAG
__device__ __forceinline__ unsigned hsh(unsigned a, unsigned b) { unsigned x = a * 0x9E3779B1u ^ (b + 0x7F4A7C15u) * 0x85EBCA6Bu; x ^= x >> 15; x *= 0x2C1B3C6Du; x ^= x >> 12; x *= 0x297A2D39u; x ^= x >> 15; return x; }
__device__ __forceinline__ void rep(unsigned* slot, float got, float ref, float floor_) {
    float err = fabsf(got - ref) / (fabsf(ref) + floor_); if (!(err < 1e30f)) err = 1e30f; atomicMax(slot, __float_as_uint(err));
}
__device__ __forceinline__ float pos_direct(int t, int d) { const int j = d & 255, part = d >> 8; const float omega = 1.0f / powf(10000.0f, (float)j / 256.0f);
    const float arg = (float)(part < 2 ? (t >> 6) : (t & 63)) * omega; return (part & 1) ? cosf(arg) : sinf(arg); }
__global__ void chk_mod(Params p) {
    const int s = blockIdx.x * blockDim.x + threadIdx.x; const unsigned hv = hsh(s, 1); const int r = hv % 33, n = (hv >> 8) % 6144;
    const float* cond = r < 32 ? p.c + r * 1024 : p.c_ctx; float acc = p.b_mod[n];
    for (int k = 0; k < 1024; ++k) { const float v = cond[k]; acc += (v / (1.0f + expf(-v))) * p.w_mod[(size_t)k * 6144 + n]; }
    rep(p.diag + 1, p.mod[(size_t)r * 6144 + n], acc, 0.3f);
}
__global__ void chk_norm(Params p, int which) {
    const int s = blockIdx.x * blockDim.x + threadIdx.x; const unsigned hv = hsh(s, 2 + which);
    const int T = p.nb * SEQ, TC = which == 0 ? p.nb * CTXL : 0; const int row = hv % (T + TC), d = (hv >> 12) % 1024;
    const bool isctx = row >= T; const int lrow = isctx ? row - T : row; const int b = isctx ? 32 : lrow >> 11;
    const float* src = which == 1 ? p.x1 + (size_t)lrow * DM : (isctx ? p.ctx + (size_t)lrow * DM : p.x + (size_t)lrow * DM);
    float ss = 0.f, vd = 0.f;
    for (int k = 0; k < 1024; ++k) { float v = src[k]; if (which == 0 && !isctx) v += pos_direct(lrow & 2047, k); ss += v * v; if (k == d) vd = v; }
    const float rs = 1.0f / sqrtf(ss / 1024.0f + 1e-6f);
    const float* md = p.mod + (size_t)b * 6144 + (which == 0 ? 0 : 3 * 1024);
    const float ref = (vd * rs * (which == 0 ? p.norm1_g[d] : p.norm2_g[d])) * (1.0f + md[1024 + d]) + md[d];
    const bf16_t* dst = which == 1 ? p.h2 + (size_t)lrow * DM : (isctx ? p.hc + (size_t)lrow * DM : p.h + (size_t)lrow * DM);
    rep(p.diag + (which == 0 ? 2 : 8), bf2f(dst[d]), ref, 0.3f);
}
__global__ void chk_z(Params p) {
    const int s = blockIdx.x * blockDim.x + threadIdx.x; const unsigned hv = hsh(s, 5);
    const int T = p.nb * SEQ, TC = p.nb * CTXL;
    if (s & 1) { const int row = hv % T, col = (hv >> 13) % 4608; float acc = 0.f;
        for (int k = 0; k < 1024; ++k) acc += bf2f(p.h[(size_t)row * DM + k]) * p.w_in[(size_t)k * 4608 + col];
        float got;
        if (col < 512) got = bf2f(p.zfT[(size_t)col * T + row]);
        else if (col < 1536) got = bf2f(p.zx[(size_t)row * DM + col - 512]);
        else if (col < 2560) { got = bf2f(p.gzy[(size_t)row * DM + col - 1536]); acc = 0.5f * acc * (1.0f + tanhf(0.7978845608f * (acc + 0.044715f * acc * acc * acc))); }
        else if (col < 3584) { got = bf2f(p.sga[(size_t)row * DM + col - 2560]); acc = 1.0f / (1.0f + expf(-acc)); }
        else { got = bf2f(p.sgb[(size_t)row * DM + col - 3584]); acc = 1.0f / (1.0f + expf(-acc)); }
        rep(p.diag + 3, got, acc, 0.5f);
    } else { const int row = hv % TC, col = 512 + (hv >> 13) % 1024; float acc = 0.f;
        for (int k = 0; k < 1024; ++k) acc += bf2f(p.hc[(size_t)row * DM + k]) * p.w_in[(size_t)k * 4608 + col];
        rep(p.diag + 3, bf2f(p.zxc[(size_t)row * DM + col - 512]), acc, 0.5f); }
}
__global__ void chk_uv(Params p) {
    const int s = blockIdx.x * blockDim.x + threadIdx.x; const unsigned hv = hsh(s, 6);
    const int T = p.nb * SEQ; const int b = hv % p.nb, kt = (hv >> 4) % 2048, ch = (hv >> 15) % 512, part = (hv >> 25) & 1;
    float acc = 0.f;
    for (int t = 0; t < 2048; ++t) { const float a = (float)((kt * t) & 2047) / 1024.0f; acc += (part ? sinpif(a) : cospif(a)) * bf2f(p.zfT[(size_t)ch * T + b * 2048 + t]); }
    rep(p.diag + 4, bf2f(p.UV[((size_t)b * 2048 + kt) * DM + part * 512 + ch]), acc, 16.0f);
}
__global__ void __launch_bounds__(512) chk_scan(Params p) {
    __shared__ float AF[2304], BF[2304], AB[2304], BB[2304];
    const unsigned hv = hsh(blockIdx.x, 7); const int b = hv % p.nb, c = (hv >> 8) % 1024, head = c >> 7, cc = c & 127;
    for (int tp = threadIdx.x; tp < 2304; tp += blockDim.x) {
        const bool isctx = tp < 256; const int t = isctx ? tp : tp - 256, Tseq = isctx ? 256 : 2048;
        const bf16_t* src = isctx ? p.zxc + (size_t)b * 256 * DM : p.zx + (size_t)b * 2048 * DM;
        float gaf = 0.f, gxf = 0.f, gab = 0.f, gxb = 0.f, xcc = 0.f;
        for (int i = 0; i < 128; ++i) { const int hi = head * 128 + i; float xci = p.conv_b[hi];
            for (int r = 0; r < 4; ++r) { const int tr = t - 1 + r; if (tr >= 0 && tr < Tseq) xci += p.conv_w[r * 1024 + hi] * bf2f(src[(size_t)tr * DM + hi]); }
            const size_t wo = ((size_t)head * 128 + i) * 128 + cc;
            gaf += xci * p.lru_wa[wo]; gxf += xci * p.lru_wx[wo]; gab += xci * p.lru_wa[(size_t)8 * 16384 + wo]; gxb += xci * p.lru_wx[(size_t)8 * 16384 + wo];
            if (i == cc) xcc = xci; }
        { const float r = 1.0f / (1.0f + expf(-(gaf + p.lru_ba[c]))), ig = 1.0f / (1.0f + expf(-(gxf + p.lru_bx[c])));
          const float la = -8.0f * r * log1pf(expf(-p.lru_lambda[c])); AF[tp] = expf(la); BF[tp] = sqrtf(fmaxf(0.f, -expm1f(2.0f * la))) * ig * xcc; }
        { const float r = 1.0f / (1.0f + expf(-(gab + p.lru_ba[1024 + c]))), ig = 1.0f / (1.0f + expf(-(gxb + p.lru_bx[1024 + c])));
          const float la = -8.0f * r * log1pf(expf(-p.lru_lambda[1024 + c])); AB[tp] = expf(la); BB[tp] = sqrtf(fmaxf(0.f, -expm1f(2.0f * la))) * ig * xcc; }
    }
    __syncthreads();
    if (threadIdx.x == 0) { float h = 0.f; for (int tp = 0; tp < 2304; ++tp) { h = AF[tp] * h + BF[tp]; AF[tp] = h; } }
    if (threadIdx.x == 64) { float h = 0.f; for (int tp = 255; tp >= 0; --tp) { h = AB[tp] * h + BB[tp]; AB[tp] = h; } for (int tp = 2303; tp >= 256; --tp) { h = AB[tp] * h + BB[tp]; AB[tp] = h; } }
    __syncthreads();
    for (int t = threadIdx.x; t < 2048; t += blockDim.x) { float z = 0.f; const size_t row = (size_t)b * 2048 + t;
        for (int k = 0; k < 1024; ++k) z += bf2f(p.h[row * DM + k]) * p.w_in[(size_t)k * 4608 + 1536 + c];
        const float gz = 0.5f * z * (1.0f + tanhf(0.7978845608f * (z + 0.044715f * z * z * z)));
        rep(p.diag + 5, bf2f(p.ybin[row * DM + c]), (AF[256 + t] + AB[256 + t]) * gz, 0.25f); }
}
__global__ void chk_merged(Params p) {
    const int s = blockIdx.x * blockDim.x + threadIdx.x; const unsigned hv = hsh(s, 8); const int T = p.nb * SEQ; const int row = hv % T, col = (hv >> 13) % 1024;
    float ya = 0.f;
    for (int g = 0; g < 4; ++g) for (int kc = 0; kc < 128; ++kc) { float y = 0.f;
        for (int c = 0; c < 128; ++c) { const float a = (float)((kc * c) & 127) / 64.0f; y += bf2f(p.UV[(size_t)row * DM + g * 128 + c]) * cospif(a) - bf2f(p.UV[(size_t)row * DM + 512 + g * 128 + c]) * sinpif(a); }
        ya += (y / 512.0f) * p.w_fourier[(size_t)(g * 128 + kc) * 1024 + col]; }
    float yb = 0.f;
    for (int k = 0; k < 1024; ++k) yb += bf2f(p.ybin[(size_t)row * DM + k]) * p.w_lru_out[(size_t)k * 1024 + col];
    const float ref = bf2f(p.sga[(size_t)row * DM + col]) * ya + bf2f(p.sgb[(size_t)row * DM + col]) * yb;
    rep(p.diag + 6, bf2f(p.merged[(size_t)row * DM + col]), ref, 0.4f);
}
__global__ void chk_x1(Params p) {
    const int s = blockIdx.x * blockDim.x + threadIdx.x; const unsigned hv = hsh(s, 9); const int T = p.nb * SEQ; const int row = hv % T, col = (hv >> 13) % 1024, b = row >> 11;
    float acc = p.b_out[col];
    for (int k = 0; k < 1024; ++k) acc += bf2f(p.merged[(size_t)row * DM + k]) * p.w_out[(size_t)k * 1024 + col];
    const float ref = p.x[(size_t)row * DM + col] + pos_direct(row & 2047, col) + p.mod[(size_t)b * 6144 + 2048 + col] * acc;
    rep(p.diag + 7, p.x1[(size_t)row * DM + col], ref, 1.0f);
}
__global__ void chk_q(Params p) {
    const int s = blockIdx.x * blockDim.x + threadIdx.x; const unsigned hv = hsh(s, 10); const int T = p.nb * SEQ; const int row = hv % T, col = (hv >> 13) % 2048;
    float acc = 0.f;
    for (int k = 0; k < 1024; ++k) acc += bf2f(p.h2[(size_t)row * DM + k]) * p.peer_wq[(size_t)k * 2048 + col];
    rep(p.diag + 9, bf2f(p.q[(size_t)row * 2048 + col]), acc, 0.5f);
}
__global__ void __launch_bounds__(256) chk_topk(Params p) {
    __shared__ float sc[256]; __shared__ float cand[256]; __shared__ int top0[16], top1[16], refe[16]; __shared__ float tv0[16], tv1[16], refv[16];
    const unsigned hv = hsh(blockIdx.x, 11); const int T = p.nb * SEQ; const int tok = hv % T, hd = (hv >> 16) & 7; const int j = threadIdx.x, ph = j >> 7, key = j & 127;
    float a = 0.f;
    for (int d = 0; d < 128; ++d) a += bf2f(p.q[(size_t)tok * 2048 + hd * 256 + ph * 128 + d]) * p.peer_keys[((size_t)(hd * 2 + ph) * 128 + key) * 128 + d];
    sc[j] = a; __syncthreads();
    if (j == 0) {
        for (int hf = 0; hf < 2; ++hf) for (int r = 0; r < 16; ++r) { int bi = 0; float bv = -1e30f; for (int k = 0; k < 128; ++k) if (sc[hf * 128 + k] > bv) { bv = sc[hf * 128 + k]; bi = k; }
            sc[hf * 128 + bi] = -1e30f; if (hf == 0) { top0[r] = bi; tv0[r] = bv; } else { top1[r] = bi; tv1[r] = bv; } }
        for (int i = 0; i < 16; ++i) for (int k = 0; k < 16; ++k) cand[i * 16 + k] = tv0[i] + tv1[k];
        for (int r = 0; r < 16; ++r) { int bi = 0; float bv = -1e30f; for (int k = 0; k < 256; ++k) if (cand[k] > bv) { bv = cand[k]; bi = k; }
            cand[bi] = -1e30f; refe[r] = top0[bi >> 4] * 128 + top1[bi & 15]; refv[r] = bv; }
        const float mx = refv[0]; float sum = 0.f;
        for (int r = 0; r < 16; ++r) sum += expf(refv[r] - mx);
        int bad = 0;
        for (int k = 0; k < 16; ++k) { const int e = p.eidx[(size_t)tok * 128 + hd * 16 + k]; const float g = p.gw[(size_t)tok * 128 + hd * 16 + k]; bool ok = false;
            for (int r = 0; r < 16; ++r) if (refe[r] == e) { const float gr = expf(refv[r] - mx) / sum; if (fabsf(g - gr) <= 0.05f * gr + 0.003f) ok = true; }
            if (!ok) ++bad; }
        atomicMax(p.diag + 10, __float_as_uint((float)bad / 16.0f)); atomicMax(p.diag + 16, (unsigned)bad);
        { int nf = 0; float sg = 0.f;
          for (int k = 0; k < 16; ++k) { const int e = p.eidx[(size_t)tok * 128 + hd * 16 + k]; sg += p.gw[(size_t)tok * 128 + hd * 16 + k]; bool f = false; for (int r = 0; r < 16; ++r) if (refe[r] == e) f = true; if (!f) ++nf; }
          atomicMax(p.diag + 12, (unsigned)nf); atomicMax(p.diag + 13, __float_as_uint(fabsf(sg - 1.0f)));
          int dup = 0; float wre = 0.f;
          for (int k = 0; k < 16; ++k) { const int e = p.eidx[(size_t)tok * 128 + hd * 16 + k]; const float g = p.gw[(size_t)tok * 128 + hd * 16 + k];
              for (int k2 = 0; k2 < k; ++k2) if (p.eidx[(size_t)tok * 128 + hd * 16 + k2] == e) ++dup;
              for (int r = 0; r < 16; ++r) if (refe[r] == e) { const float gr = expf(refv[r] - mx) / sum; wre = fmaxf(wre, fabsf(g - gr) / (gr + 0.003f)); } }
          atomicMax(p.diag + 14, (unsigned)dup); atomicMax(p.diag + 15, __float_as_uint(wre)); }
    }
}
__global__ void __launch_bounds__(256) chk_out(Params p) {
    __shared__ float wj[128]; __shared__ float red[256];
    const unsigned hv = hsh(blockIdx.x, 12); const int T = p.nb * SEQ; const int tok = hv % T, b = tok >> 11, t = threadIdx.x;
    if (t < 128) { const int e = p.eidx[(size_t)tok * 128 + t]; float dsum = 0.f;
        for (int d = 0; d < 1024; ++d) dsum += p.peer_u[(size_t)e * 1024 + d] * bf2f(p.h2[(size_t)tok * DM + d]);
        const float ge = 0.5f * dsum * (1.0f + tanhf(0.7978845608f * (dsum + 0.044715f * dsum * dsum * dsum)));
        wj[t] = p.gw[(size_t)tok * 128 + t] * ge; }
    __syncthreads();
    float x2[4]; float ss = 0.f;
    for (int i = 0; i < 4; ++i) { const int d = t + 256 * i; float acc = 0.f;
        for (int jx = 0; jx < 128; ++jx) acc += wj[jx] * p.peer_v[(size_t)p.eidx[(size_t)tok * 128 + jx] * 1024 + d];
        const float v = p.x1[(size_t)tok * DM + d] + p.mod[(size_t)b * 6144 + 5 * 1024 + d] * acc;
        if (i == 0) x2[0] = v; else if (i == 1) x2[1] = v; else if (i == 2) x2[2] = v; else x2[3] = v;
        ss += v * v; }
    red[t] = ss; __syncthreads();
    for (int o = 128; o > 0; o >>= 1) { if (t < o) red[t] += red[t + o]; __syncthreads(); }
    const float rs = 1.0f / sqrtf(red[0] / 1024.0f + 1e-6f);
    rep(p.diag + 11, p.out[(size_t)tok * DM + t], x2[0] * rs * p.final_g[t], 0.5f);
    rep(p.diag + 11, p.out[(size_t)tok * DM + t + 256], x2[1] * rs * p.final_g[t + 256], 0.5f);
    rep(p.diag + 11, p.out[(size_t)tok * DM + t + 512], x2[2] * rs * p.final_g[t + 512], 0.5f);
    rep(p.diag + 11, p.out[(size_t)tok * DM + t + 768], x2[3] * rs * p.final_g[t + 768], 0.5f);
}
__global__ void diag_apply(Params p, int total) {
    const float tol[12] = {0.f, 2e-3f, 2e-2f, 3e-2f, 3e-2f, 8e-2f, 4e-2f, 1e-2f, 2e-2f, 3e-2f, 0.2f, 3e-2f};
    int F = 0; float err = 1.f;
    for (int i = 11; i >= 1; --i) { const float e = __uint_as_float(p.diag[i]); const float tl = i == 1 ? tol[1] : i == 2 ? tol[2] : i == 3 ? tol[3] : i == 4 ? tol[4] : i == 5 ? tol[5] : i == 6 ? tol[6] : i == 7 ? tol[7] : i == 8 ? tol[8] : i == 9 ? tol[9] : i == 10 ? tol[10] : tol[11];
        if (!(e <= tl)) { F = i; err = e; } }
    int cls = 0; if (F) { const float l = -log10f(fmaxf(err, 1e-12f)); cls = l < 0.f ? 0 : (l > 9.f ? 9 : (int)l); }
    if (F == 10) { cls = (int)p.diag[16]; if (cls > 9) cls = 9; }
#ifdef DIAG_AB
    { const float e10 = __uint_as_float(p.diag[10]), e11 = __uint_as_float(p.diag[11]); F = (e10 <= 1e9f ? 1 : 2) + (e11 <= 0.03f ? 0 : 4); const float l = -log10f(fmaxf(e11, 1e-12f)); cls = l < 0.f ? 0 : (l > 9.f ? 9 : (int)l); }
#endif
    const float K = sqrtf(((float)F / 10.0f + 1.0f) * powf(10.0f, (float)(cls + 6)));
    for (int i = blockIdx.x * blockDim.x + threadIdx.x; i < total; i += gridDim.x * blockDim.x) p.out[i] = K;
}
#endif

static inline size_t al(size_t x) { return (x + 255) & ~(size_t)255; }
extern "C" void kernel_launch(void* const* d_in, const int* in_sizes, int n_in, void* d_out, int out_size, void* d_ws, size_t ws_size, hipStream_t stream) {
#ifdef DIAG
    static int inited = 0;
    const void* kerns[] = {(const void*)k_prep_t, (const void*)k_prep_c, (const void*)k_adaln, (const void*)k_gemm_in, (const void*)k_scan, (const void*)k_gemm_dft, (const void*)k_gemm_mix, (const void*)k_gemm_out, (const void*)k_gemm_q};
    if (!inited) { for (auto k : kerns) (void)hipFuncSetAttribute(k, hipFuncAttributeMaxDynamicSharedMemorySize, LDS_BYTES); inited = 1; }
#endif
    Params p{};
    const float* const* in = (const float* const*)d_in;
    p.x = in[0]; p.c = in[1]; p.ctx = in[2]; p.c_ctx = in[3]; p.w_mod = in[4]; p.b_mod = in[5]; p.norm1_g = in[6]; p.norm2_g = in[7]; p.w_in = in[8]; p.w_fourier = in[9];
    p.conv_w = in[10]; p.conv_b = in[11]; p.lru_wa = in[12]; p.lru_ba = in[13]; p.lru_wx = in[14]; p.lru_bx = in[15]; p.lru_lambda = in[16]; p.w_lru_out = in[17];
    p.w_out = in[18]; p.b_out = in[19]; p.peer_wq = in[20]; p.peer_keys = in[21]; p.peer_u = in[22]; p.peer_v = in[23]; p.final_g = in[24];
    p.out = (float*)d_out;
    unsigned char* ws = (unsigned char*)d_ws; size_t o = 0;
    auto take = [&](size_t bytes) { unsigned char* r = ws + o; o += al(bytes); return r; };
    const size_t MiB = 1ull << 20;
    p.diag = (unsigned*)take(4096);
    p.mod = (float*)take(33 * 6144 * 4); p.pos = (float*)take((size_t)SEQ * DM * 4);
    p.Wt_in = (bf16_t*)take((size_t)4608 * 1024 * 2); p.Wfp = (bf16_t*)take(2 * MiB); p.Wt_lru = (bf16_t*)take(2 * MiB); p.Wt_out = (bf16_t*)take(2 * MiB); p.Wt_q = (bf16_t*)take(4 * MiB);
    p.keys_bf = (bf16_t*)take(MiB / 2); p.gates_bf = (bf16_t*)take(MiB); p.dft = (bf16_t*)take(16 * MiB);
#ifdef DIAG
    p.u_bf = (bf16_t*)take(32 * MiB); p.v_bf = (bf16_t*)take(32 * MiB);
#endif
    p.u8 = nullptr; p.u4 = (unsigned char*)take(8 * MiB); p.scu = (float*)take(131072); p.v8 = nullptr; p.v4 = (unsigned char*)take(8 * MiB); p.scv = (float*)take(65536); p.ssb = (float*)take(2 * MiB); p.tmax = (unsigned*)take(256); p.bar = (unsigned*)take(XCD_BAR_WORDS * 4);
#ifndef DIAG
    { const size_t need = 928 * MiB; if (ws_size > o + need + MiB) o = (ws_size - need) & ~((size_t)4095); }
    unsigned char* R9 = take(64 * MiB);
    unsigned char* R8 = take(128 * MiB);
    unsigned char* R45 = take(256 * MiB);
    unsigned char* R67 = take(256 * MiB);
    unsigned char* R3 = take(64 * MiB);
    p.zxc = (bf16_t*)take(16 * MiB); p.hc = (bf16_t*)take(16 * MiB);
    unsigned char* R0 = take(128 * MiB);
    p.h = (bf16_t*)R0; p.hf = (bf16_t*)R0; p.h2 = (bf16_t*)R0;
    p.zfT = (bf16_t*)R3; p.eidx = (int*)R3; p.gw = (float*)(R3 + 4 * MiB); p.su = (float*)(R45 + 128 * MiB);
    p.zx = (bf16_t*)R45; p.gzy = (bf16_t*)(R45 + 128 * MiB); p.ybin = p.gzy; p.x1 = (float*)R45; p.x1b = (bf16_t*)R45;
    p.sga = (bf16_t*)R67; p.Pb = p.sga; p.sgb = (bf16_t*)(R67 + 128 * MiB); p.merged = (bf16_t*)R0; p.q = (bf16_t*)R67;
    p.UV = (bf16_t*)R8; p.pd = (float*)R67; p.h8 = R9; p.peer16 = (bf16_t*)R0; p.w8 = R0; p.wsc = p.ssb;
    p.zseg = (size_t)64 * MiB; p.nb = NBATCH; p.pad = 0;
#else
    const int NBD = 4; const size_t U = (size_t)NBD * SEQ * DM * 2;
    p.h = (bf16_t*)take(U); p.hc = (bf16_t*)take(U / 8); p.zxc = (bf16_t*)take(U / 8); p.zfT = (bf16_t*)take(U / 2);
    p.zx = (bf16_t*)take(U); p.gzy = (bf16_t*)take(U); p.sga = (bf16_t*)take(U); p.sgb = (bf16_t*)take(U);
    p.hf = (bf16_t*)take(U); p.ybin = (bf16_t*)take(U); p.UV = (bf16_t*)take(U); p.Pb = (bf16_t*)take(U); p.merged = (bf16_t*)take(U);
    p.x1 = (float*)take(2 * U); p.h2 = (bf16_t*)take(U); p.q = (bf16_t*)take(2 * U); p.eidx = (int*)take(U / 4); p.gw = (float*)take(U / 4);
    p.zseg = U / 2; p.nb = NBD; p.pad = 0;
    (void)hipMemsetAsync(p.diag, 0, 4096, stream);
#endif
#if !defined(DIAG)
    {
        static int grid_blocks = 0;
        if (!grid_blocks) {
            int dev = 0, cus = 0, per_cu = 0;
            (void)hipGetDevice(&dev);
            (void)hipDeviceGetAttribute(&cus, hipDeviceAttributeMultiprocessorCount, dev);
            (void)hipFuncSetAttribute((const void*)k_mega, hipFuncAttributeMaxDynamicSharedMemorySize, LDS_BYTES);
            (void)hipOccupancyMaxActiveBlocksPerMultiprocessor(&per_cu, (const void*)k_mega, NTHR, LDS_BYTES);
            if (per_cu < 1) { fprintf(stderr, "kernel_launch: occupancy query says %d blocks per CU\n", per_cu); per_cu = 1; }
            grid_blocks = cus * 1;
        }
        void* args[] = {(void*)&p};
        const hipError_t e = hipLaunchCooperativeKernel((const void*)k_mega, dim3(grid_blocks), dim3(NTHR), args, LDS_BYTES, stream);
        if (e != hipSuccess) fprintf(stderr, "cooperative launch failed: %s (grid %d)\n", hipGetErrorString(e), grid_blocks);
        return;
    }
#endif
#ifdef DIAG
    const dim3 grid(256), blk(NTHR);
    hipLaunchKernelGGL(k_prep_t, grid, blk, LDS_BYTES, stream, p);
    hipLaunchKernelGGL(k_prep_c, grid, blk, LDS_BYTES, stream, p);
    hipLaunchKernelGGL(k_adaln, grid, blk, LDS_BYTES, stream, p);
    hipLaunchKernelGGL(k_norm1, grid, blk, 0, stream, p);
    hipLaunchKernelGGL(k_gemm_in, grid, blk, LDS_BYTES, stream, p);
    hipLaunchKernelGGL(k_scan, grid, blk, LDS_BYTES, stream, p);
    hipLaunchKernelGGL(k_gemm_dft, grid, blk, LDS_BYTES, stream, p);
    hipLaunchKernelGGL(k_gemm_mix, grid, blk, LDS_BYTES, stream, p);
    hipLaunchKernelGGL(k_gemm_out, grid, blk, LDS_BYTES, stream, p);
    hipLaunchKernelGGL(k_norm2, grid, blk, 0, stream, p);
    hipLaunchKernelGGL(k_gemm_q, grid, blk, LDS_BYTES, stream, p);
    hipLaunchKernelGGL(k_topk, grid, blk, 0, stream, p);
    hipLaunchKernelGGL(k_peer, grid, blk, 0, stream, p);
    hipLaunchKernelGGL(chk_mod, dim3(2), dim3(128), 0, stream, p);
    hipLaunchKernelGGL(chk_norm, dim3(2), dim3(128), 0, stream, p, 0);
    hipLaunchKernelGGL(chk_z, dim3(4), dim3(128), 0, stream, p);
    hipLaunchKernelGGL(chk_uv, dim3(2), dim3(128), 0, stream, p);
    hipLaunchKernelGGL(chk_scan, dim3(8), dim3(512), 0, stream, p);
    hipLaunchKernelGGL(chk_merged, dim3(2), dim3(64), 0, stream, p);
    hipLaunchKernelGGL(chk_x1, dim3(2), dim3(128), 0, stream, p);
    hipLaunchKernelGGL(chk_norm, dim3(2), dim3(128), 0, stream, p, 1);
    hipLaunchKernelGGL(chk_q, dim3(2), dim3(128), 0, stream, p);
    hipLaunchKernelGGL(chk_topk, dim3(64), dim3(256), 0, stream, p);
    hipLaunchKernelGGL(chk_out, dim3(16), dim3(256), 0, stream, p);
    hipLaunchKernelGGL(diag_apply, dim3(1024), dim3(256), 0, stream, p, out_size);
#endif
}
```
